# Optimizing an MI355X kernel written in HIP

```python
import jax, jax.numpy as jnp
from jax import lax
import numpy as np

D_MODEL = 1024
BATCH = 8
SEQ = 2048
DEPTH = 1
DEC_BATCH = 128
DEC_SEQ = 8
PAST_LEN = 16384
PAGE_SIZE = 128

N_MEM = 256
RW_HEAD = 64
RW_WIDTH = D_MODEL
RW_HEADS = RW_WIDTH // RW_HEAD
DECAY_LORA = 64
AAA_LORA = 64
RW_SHIFT = 3 * RW_WIDTH + DECAY_LORA + AAA_LORA
LRU_WIDTH = D_MODEL
LRU_BLOCKS = 16
LRU_BLOCK = LRU_WIDTH // LRU_BLOCKS
CONV_W = 4
LRU_C = 8.0
XA_HEADS = 4
XA_WIDTH = D_MODEL
XA_HEAD = XA_WIDTH // XA_HEADS
N_BRANCH = 3
IN_COLS = RW_SHIFT + RW_WIDTH + 2 * LRU_WIDTH + 2 * XA_WIDTH + N_BRANCH * D_MODEL
NORM_EPS = 1e-6
GN_EPS = 64e-5
L2_EPS = 1e-12

kernel_name = "rwkv7_rglru_xattn_gated_hybrid_step"


def rmsnorm(x, g):
    xf = x.astype(jnp.float32)
    y = xf * lax.rsqrt(jnp.mean(xf * xf, axis=-1, keepdims=True) + NORM_EPS)
    return (y * g.astype(jnp.float32)).astype(x.dtype)


def split_in(proj):
    sizes = [RW_SHIFT, RW_WIDTH, LRU_WIDTH, LRU_WIDTH, XA_WIDTH, XA_WIDTH, N_BRANCH * D_MODEL]
    return jnp.split(proj, np.cumsum(sizes)[:-1].tolist(), axis=-1)


def rwkv7_branch(u, z, shift0, s0, mu, w0, w_decay, a0, w_aaa, k_k, k_a, r_k, gn_g, gn_b):
    f32 = jnp.float32
    bsz, t, _ = u.shape
    u = u.astype(f32)
    ext = jnp.concatenate([shift0.astype(f32)[:, None], u], axis=1)
    us = u + (ext[:, :-1] - u) * mu.astype(f32)
    new_shift = ext[:, -1]
    r, k, v, xw, xa = jnp.split(us, [RW_WIDTH, 2 * RW_WIDTH, 3 * RW_WIDTH, 3 * RW_WIDTH + DECAY_LORA], axis=-1)
    w = -jax.nn.softplus(-(w0.astype(f32) + jnp.tanh(xw) @ w_decay.astype(f32))) - 0.5
    decay = jnp.exp(-jnp.exp(w))
    a = jax.nn.sigmoid(a0.astype(f32) + xa @ w_aaa.astype(f32))
    heads = lambda y: y.reshape(bsz, t, RW_HEADS, RW_HEAD)
    kk = heads(k * k_k.astype(f32))
    kk = kk * lax.rsqrt(jnp.sum(kk * kk, axis=-1, keepdims=True) + L2_EPS)
    k = k * (1.0 + (a - 1.0) * k_a.astype(f32))
    r, k, v, decay, a = heads(r), heads(k), heads(v), heads(decay), heads(a)

    def step(s, inp):
        r_t, k_t, v_t, w_t, kk_t, a_t = inp
        sa = jnp.einsum("bhvk,bhk->bhv", s, -kk_t)
        s = (s * w_t[:, :, None, :] + sa[..., None] * (kk_t * a_t)[:, :, None, :]
             + v_t[..., None] * k_t[:, :, None, :])
        return s, jnp.einsum("bhvk,bhk->bhv", s, r_t)

    xs = tuple(jnp.moveaxis(y, 1, 0) for y in (r, k, v, decay, kk, a))
    s_last, o = lax.scan(step, s0.astype(f32), xs)
    o = jnp.moveaxis(o, 0, 1)
    mean = jnp.mean(o, axis=-1, keepdims=True)
    var = jnp.mean(jnp.square(o - mean), axis=-1, keepdims=True)
    o = ((o - mean) * lax.rsqrt(var + GN_EPS)).reshape(bsz, t, RW_WIDTH)
    o = o * gn_g.astype(f32) + gn_b.astype(f32)
    bonus = jnp.sum(r * k * r_k.astype(f32), axis=-1, keepdims=True) * v
    out = (o + bonus.reshape(bsz, t, RW_WIDTH)) * jax.nn.silu(z.astype(f32))
    return out, s_last, new_shift


def rglru_branch(xb, z, conv0, h0, conv_w, conv_b, w_rg_a, b_rg_a, w_rg_x, b_rg_x, lru_lambda):
    f32 = jnp.float32
    bsz, t, _ = xb.shape
    ext = jnp.concatenate([conv0.astype(f32), xb.astype(f32)], axis=1)
    cw = conv_w.astype(f32)
    xc = conv_b.astype(f32) + sum(ext[:, j:j + t] * cw[j] for j in range(CONV_W))
    new_conv = ext[:, t:]
    xblk = xc.reshape(bsz, t, LRU_BLOCKS, LRU_BLOCK)
    gate_r = jax.nn.sigmoid(jnp.einsum("btgi,gij->btgj", xblk, w_rg_a.astype(f32)).reshape(bsz, t, LRU_WIDTH)
                            + b_rg_a.astype(f32))
    gate_i = jax.nn.sigmoid(jnp.einsum("btgi,gij->btgj", xblk, w_rg_x.astype(f32)).reshape(bsz, t, LRU_WIDTH)
                            + b_rg_x.astype(f32))
    log_a = -LRU_C * gate_r * jax.nn.softplus(-lru_lambda.astype(f32))
    a = jnp.exp(log_a)
    b = jnp.sqrt(-jnp.expm1(2.0 * log_a)) * gate_i * xc

    def step(h, inp):
        a_t, b_t = inp
        h = a_t * h + b_t
        return h, h

    h_last, hs = lax.scan(step, h0.astype(f32), (jnp.moveaxis(a, 1, 0), jnp.moveaxis(b, 1, 0)))
    out = jnp.moveaxis(hs, 0, 1) * jax.nn.silu(z.astype(f32))
    return out, h_last, new_conv


def memory_kv(mem, g_mem, w_mem_kv):
    bsz = mem.shape[0]
    kv = rmsnorm(mem, g_mem) @ w_mem_kv
    mk, mv = jnp.split(kv, 2, axis=-1)
    return (mk.reshape(bsz, N_MEM, XA_HEADS, XA_HEAD), mv.reshape(bsz, N_MEM, XA_HEADS, XA_HEAD))


def cross_attn(q, z, mem_k, mem_v):
    f32 = jnp.float32
    bsz, t, _ = q.shape
    qh = q.astype(f32).reshape(bsz, t, XA_HEADS, XA_HEAD)
    s = jnp.einsum("bthd,bmhd->bhtm", qh, mem_k.astype(f32)) * (XA_HEAD ** -0.5)
    p = jax.nn.softmax(s, axis=-1)
    o = jnp.einsum("bhtm,bmhd->bthd", p, mem_v.astype(f32)).reshape(bsz, t, XA_WIDTH)
    return o * jax.nn.silu(z.astype(f32))


def mixer_layer(x, mem_k, mem_v, s0, shift0, h0, conv0, g_norm, w_in, mu_shift, w0, w_decay, a0, w_aaa,
                k_k, k_a, r_k, gn_g, gn_b, conv_w, conv_b, w_rg_a, b_rg_a, w_rg_x, b_rg_x, lru_lambda,
                w_br_a, w_br_b, w_br_c, w_out):
    f32 = jnp.float32
    xn = rmsnorm(x, g_norm)
    u, za, xb, zb, q, zc, gates = split_in(xn @ w_in)
    oa, s_last, shift_last = rwkv7_branch(u, za, shift0, s0, mu_shift, w0, w_decay, a0, w_aaa,
                                          k_k, k_a, r_k, gn_g, gn_b)
    ob, h_last, conv_last = rglru_branch(xb, zb, conv0, h0, conv_w, conv_b, w_rg_a, b_rg_a,
                                         w_rg_x, b_rg_x, lru_lambda)
    oc = cross_attn(q, zc, mem_k, mem_v)
    g_a, g_b, g_c = jnp.split(jax.nn.sigmoid(gates.astype(f32)), N_BRANCH, axis=-1)
    merged = (g_a * (oa @ w_br_a.astype(f32)) + g_b * (ob @ w_br_b.astype(f32))
              + g_c * (oc @ w_br_c.astype(f32)))
    y = x + (merged @ w_out.astype(f32)).astype(x.dtype)
    return y, s_last, shift_last, h_last, conv_last


def setup_inputs(seed: int = 0) -> dict:
    key = jax.random.key(seed)
    ks = iter(jax.random.split(key, 40))
    nrm = lambda shape, scale: scale * jax.random.normal(next(ks), shape, jnp.float32)
    uni = lambda shape, lo, hi: jax.random.uniform(next(ks), shape, jnp.float32, lo, hi)
    L = DEPTH
    a_target = uni((L, LRU_WIDTH), 0.9, 0.999)
    sig = a_target ** (1.0 / LRU_C)
    lru_lambda = jnp.log(sig) - jnp.log1p(-sig)
    return {
        "x_prompt": nrm((BATCH, SEQ, D_MODEL), 1.0),
        "x_sample": nrm((DEC_BATCH, DEC_SEQ, D_MODEL), 1.0),
        "mem_prompt": nrm((BATCH, N_MEM, D_MODEL), 1.0),
        "state_rwkv": nrm((L, DEC_BATCH, RW_HEADS, RW_HEAD, RW_HEAD), 0.3),
        "state_shift": nrm((L, DEC_BATCH, RW_SHIFT), 1.0),
        "state_lru": nrm((L, DEC_BATCH, LRU_WIDTH), 0.5),
        "state_conv": nrm((L, DEC_BATCH, CONV_W - 1, LRU_WIDTH), 1.0),
        "cache_mem_k": nrm((L, DEC_BATCH, N_MEM, XA_HEADS, XA_HEAD), 1.0),
        "cache_mem_v": nrm((L, DEC_BATCH, N_MEM, XA_HEADS, XA_HEAD), 1.0),
        "g_norm": 1.0 + nrm((L, D_MODEL), 0.02),
        "w_in": nrm((L, D_MODEL, IN_COLS), D_MODEL ** -0.5),
        "mu_shift": uni((L, RW_SHIFT), 0.0, 1.0),
        "w0": uni((L, RW_WIDTH), -5.0, 1.0),
        "w_decay": nrm((L, DECAY_LORA, RW_WIDTH), 0.1),
        "a0": nrm((L, RW_WIDTH), 0.1),
        "w_aaa": nrm((L, AAA_LORA, RW_WIDTH), 0.5 * AAA_LORA ** -0.5),
        "k_k": 0.85 + nrm((L, RW_WIDTH), 0.05),
        "k_a": 1.0 + nrm((L, RW_WIDTH), 0.05),
        "r_k": nrm((L, RW_HEADS, RW_HEAD), 0.1),
        "gn_g": 1.0 + nrm((L, RW_WIDTH), 0.02),
        "gn_b": nrm((L, RW_WIDTH), 0.02),
        "conv_w": nrm((L, CONV_W, LRU_WIDTH), 0.5),
        "conv_b": nrm((L, LRU_WIDTH), 0.02),
        "w_rg_a": nrm((L, LRU_BLOCKS, LRU_BLOCK, LRU_BLOCK), LRU_BLOCK ** -0.5),
        "b_rg_a": nrm((L, LRU_WIDTH), 0.02),
        "w_rg_x": nrm((L, LRU_BLOCKS, LRU_BLOCK, LRU_BLOCK), LRU_BLOCK ** -0.5),
        "b_rg_x": nrm((L, LRU_WIDTH), 0.02),
        "lru_lambda": lru_lambda,
        "g_mem": 1.0 + nrm((L, D_MODEL), 0.02),
        "w_mem_kv": nrm((L, D_MODEL, 2 * XA_WIDTH), D_MODEL ** -0.5),
        "w_br_a": nrm((L, RW_WIDTH, D_MODEL), RW_WIDTH ** -0.5),
        "w_br_b": nrm((L, LRU_WIDTH, D_MODEL), LRU_WIDTH ** -0.5),
        "w_br_c": nrm((L, XA_WIDTH, D_MODEL), XA_WIDTH ** -0.5),
        "w_out": nrm((L, D_MODEL, D_MODEL), D_MODEL ** -0.5),
        "g_final": 1.0 + nrm((D_MODEL,), 0.02),
    }


def reference(x_prompt, x_sample, mem_prompt, state_rwkv, state_shift, state_lru, state_conv,
              cache_mem_k, cache_mem_v, g_norm, w_in, mu_shift, w0, w_decay, a0, w_aaa, k_k, k_a, r_k,
              gn_g, gn_b, conv_w, conv_b, w_rg_a, b_rg_a, w_rg_x, b_rg_x, lru_lambda, g_mem, w_mem_kv,
              w_br_a, w_br_b, w_br_c, w_out, g_final):
    f32 = jnp.float32
    bp = x_prompt.shape[0]
    hp, hs = x_prompt, x_sample
    rw_p, sh_p, lru_p, cv_p, mk_p, mv_p, rw_s, sh_s, lru_s, cv_s = ([] for _ in range(10))
    for l in range(DEPTH):
        lw = (g_norm[l], w_in[l], mu_shift[l], w0[l], w_decay[l], a0[l], w_aaa[l], k_k[l], k_a[l], r_k[l],
              gn_g[l], gn_b[l], conv_w[l], conv_b[l], w_rg_a[l], b_rg_a[l], w_rg_x[l], b_rg_x[l],
              lru_lambda[l], w_br_a[l], w_br_b[l], w_br_c[l], w_out[l])
        mk, mv = memory_kv(mem_prompt, g_mem[l], w_mem_kv[l])
        hp, s1, s2, s3, s4 = mixer_layer(
            hp, mk, mv,
            jnp.zeros((bp, RW_HEADS, RW_HEAD, RW_HEAD), f32), jnp.zeros((bp, RW_SHIFT), f32),
            jnp.zeros((bp, LRU_WIDTH), f32), jnp.zeros((bp, CONV_W - 1, LRU_WIDTH), f32), *lw)
        rw_p.append(s1); sh_p.append(s2); lru_p.append(s3); cv_p.append(s4); mk_p.append(mk); mv_p.append(mv)
        hs, t1, t2, t3, t4 = mixer_layer(
            hs, cache_mem_k[l], cache_mem_v[l], state_rwkv[l], state_shift[l], state_lru[l], state_conv[l], *lw)
        rw_s.append(t1); sh_s.append(t2); lru_s.append(t3); cv_s.append(t4)
    y_prompt = rmsnorm(hp, g_final)
    y_sample = rmsnorm(hs, g_final)
    stk = lambda xs: jnp.stack(xs, axis=0)
    return (y_prompt, y_sample, stk(rw_p), stk(sh_p), stk(lru_p), stk(cv_p), stk(mk_p), stk(mv_p),
            stk(rw_s), stk(sh_s), stk(lru_s), stk(cv_s))
```

```cpp
#include <hip/hip_cooperative_groups.h>
#include <cstdio>
#include <hip/hip_runtime.h>
namespace pg8 {
#define PG8_LAS __attribute__((address_space(3)))
typedef unsigned short bf16_t;
typedef short bf16x8 __attribute__((ext_vector_type(8)));
typedef float f32x4 __attribute__((ext_vector_type(4)));
typedef unsigned u32x4 __attribute__((ext_vector_type(4)));
constexpr int BM = 256, BK = 64, HALF = 128, HTB = HALF * BK * 2  , STAGE_BYTES = 8 * HTB, NXCD = 8, WGM = 8;

__host__ __device__ __forceinline__ int lds_byte(int r, int c) { const int st = (r >> 4) * 2 + (c >> 5), rr = r & 15, cc = c & 31, ob = rr * 64 + cc * 2; return st * 1024 + (ob ^ (((ob >> 9) & 1) << 5)); }
__host__ __device__ __forceinline__ void stage_rc(int b, int& R, int& C) { const int st = b / 1024, sb = b % 1024, swz = sb ^ (((sb >> 9) & 1) << 5); R = (st >> 1) * 16 + swz / 64; C = (st & 1) * 32 + (swz % 64) / 2; }
__host__ __device__ __forceinline__ int perm32(int rho) { const int n = rho >> 4, i = rho & 15; return 8 * (i >> 2) + 4 * n + (i & 3); }

struct Unit { int pm, pn; };
struct Gemm { const bf16_t* A; const bf16_t* Bt; int M, N, K; };

struct StaticOrder {
    int nM, nN, nwg, G, c;
    __host__ __device__ void init(int M, int N, int G_, int c_) { nM = M / BM; nN = N / BM; nwg = nM * nN; G = G_; c = c_; }
    __host__ __device__ bool next(int i, Unit& u) const {
        const long L = (long)i * G + c; if (L >= nwg) return false;
        int wgid = (int)L; { const int q = nwg / NXCD, r = nwg % NXCD, xcd = wgid % NXCD, off = wgid / NXCD; wgid = (xcd < r ? xcd * (q + 1) : r * (q + 1) + (xcd - r) * q) + off; }
        const int nig = WGM * nN, gid = wgid / nig, fm = gid * WGM, gsz = (nM - fm) < WGM ? (nM - fm) : WGM;
        u.pm = fm + ((wgid % nig) % gsz); u.pn = (wgid % nig) / gsz; return true;
    }
    __device__ __forceinline__ void a_ready(const Unit&) const {}
    __device__ __forceinline__ void done(const Unit&) const {}
};
struct CountedOrder : StaticOrder {
    const unsigned* ready; unsigned need; unsigned* tmo;
    __device__ __forceinline__ void a_ready(const Unit& u) const {
        if (threadIdx.x < 64) {
            const unsigned long long t0 = __builtin_amdgcn_s_memrealtime(); unsigned polls = 0;
            while ((unsigned)__builtin_amdgcn_readfirstlane(__hip_atomic_load(ready + 64 * u.pm, __ATOMIC_RELAXED, __HIP_MEMORY_SCOPE_AGENT)) < need) {
                if ((++polls & 255u) == 0u && __builtin_amdgcn_readfirstlane(__hip_atomic_load(tmo, __ATOMIC_RELAXED, __HIP_MEMORY_SCOPE_AGENT)) != 0u) break;
                if (__builtin_amdgcn_s_memrealtime() - t0 > 2000000ull) {
                    if (threadIdx.x == 0) { unsigned expect = 0u; __hip_atomic_compare_exchange_strong(tmo + 1, &expect, 0x600u | (unsigned)(u.pm & 0xff), __ATOMIC_RELAXED, __ATOMIC_RELAXED, __HIP_MEMORY_SCOPE_AGENT); __hip_atomic_store(tmo, 1u, __ATOMIC_RELAXED, __HIP_MEMORY_SCOPE_AGENT); }
                    break; }
                __builtin_amdgcn_s_sleep(2); }
            __builtin_amdgcn_fence(__ATOMIC_ACQUIRE, "agent");
            asm volatile("s_waitcnt vmcnt(0)" ::: "memory");
        }
#if !defined(BROKEN_HOOK_NO_BARRIER)
        asm volatile("" ::: "memory"); __builtin_amdgcn_s_barrier(); asm volatile("" ::: "memory");
#endif
    }
};

__device__ __forceinline__ unsigned cvt_pk_bf16(float lo, float hi) { unsigned r; asm volatile("v_cvt_pk_bf16_f32 %0, %1, %2" : "=v"(r) : "v"(lo), "v"(hi)); return r; }
typedef float f32x2 __attribute__((ext_vector_type(2)));
__device__ __forceinline__ f32x2 gelu_pk(f32x2 v) {
    const f32x2 av = __builtin_elementwise_abs(v), d = av * 0.2316418882f + 1.0f;
    f32x2 t; t.x = __builtin_amdgcn_rcpf(d.x); t.y = __builtin_amdgcn_rcpf(d.y);
    f32x2 q = t * 0.5307027145f + (-0.7265760135f); q = q * t + 0.7107068705f; q = q * t + (-0.142248368f); q = q * t + 0.127414796f; q = q * t;
    const f32x2 s = (v * v) * (-0.72134752044f);
    f32x2 e; e.x = __builtin_amdgcn_exp2f(s.x); e.y = __builtin_amdgcn_exp2f(s.y);
    const f32x2 m = v * (q * e), r = v - m;
    f32x2 o; o.x = v.x < 0.f ? m.x : r.x; o.y = v.y < 0.f ? m.y : r.y; return o;
}

struct EpiF32 {
    static constexpr bool PERM = false, AFTER_DRAIN = false;
    float* C; int ldc; const float* bias;
    __device__ __forceinline__ void operator()(const f32x4 (&acc)[2][2][4][2], const Unit& u, int wr, int wc, int fr, int fq) const {
        const int row0 = u.pm * BM + wr * 64 + fr, col0 = u.pn * BM + wc * 32 + 4 * fq;
        f32x4 bv[2][2];
#pragma unroll
        for (int bj = 0; bj < 2; ++bj)
#pragma unroll
            for (int n = 0; n < 2; ++n) bv[bj][n] = bias ? *(const f32x4*)(bias + col0 + bj * HALF + n * 16) : (f32x4){0.f, 0.f, 0.f, 0.f};
#pragma unroll
        for (int ai = 0; ai < 2; ++ai)
#pragma unroll
            for (int m = 0; m < 4; ++m) { float* rowp = C + (size_t)(row0 + ai * HALF + m * 16) * ldc + col0;
#pragma unroll
                for (int bj = 0; bj < 2; ++bj)
#pragma unroll
                    for (int n = 0; n < 2; ++n) *(f32x4*)(rowp + bj * HALF + n * 16) = acc[ai][bj][m][n] + bv[bj][n]; }
    }
};
template <int ACT  > struct EpiBf16 {
    static constexpr bool PERM = true, AFTER_DRAIN = false;
    bf16_t* O; int ldc; const float* bias; int split_cols; size_t split_stride;
    __device__ __forceinline__ void operator()(const f32x4 (&acc)[2][2][4][2], const Unit& u, int wr, int wc, int fr, int fq) const {
        const int row0 = u.pm * BM + wr * 64 + fr; int colt = u.pn * BM; bf16_t* base = O;
        if (split_cols) { const int t = colt / split_cols; base += (size_t)t * split_stride; colt -= t * split_cols; }
        const int col0 = colt + wc * 32 + 8 * fq, bcol0 = u.pn * BM + wc * 32 + 8 * fq;
        f32x4 bv[2][2];
#pragma unroll
        for (int bj = 0; bj < 2; ++bj)
#pragma unroll
            for (int n = 0; n < 2; ++n) bv[bj][n] = bias ? *(const f32x4*)(bias + bcol0 + bj * HALF + 4 * n) : (f32x4){0.f, 0.f, 0.f, 0.f};
#pragma unroll
        for (int ai = 0; ai < 2; ++ai)
#pragma unroll
            for (int m = 0; m < 4; ++m) { bf16_t* rowp = base + (size_t)(row0 + ai * HALF + m * 16) * ldc + col0;
#pragma unroll
                for (int bj = 0; bj < 2; ++bj) { f32x4 v0 = acc[ai][bj][m][0] + bv[bj][0], v1 = acc[ai][bj][m][1] + bv[bj][1];
                    if (ACT == 1) { f32x2 a = gelu_pk((f32x2){v0[0], v0[1]}), b = gelu_pk((f32x2){v0[2], v0[3]}), c = gelu_pk((f32x2){v1[0], v1[1]}), d = gelu_pk((f32x2){v1[2], v1[3]});
                        v0 = (f32x4){a.x, a.y, b.x, b.y}; v1 = (f32x4){c.x, c.y, d.x, d.y}; }
                    if (ACT == 2) {
#pragma unroll
                        for (int j = 0; j < 4; ++j) { v0[j] = 0.5f * v0[j] * (1.0f + erff(v0[j] * 0.70710678f)); v1[j] = 0.5f * v1[j] * (1.0f + erff(v1[j] * 0.70710678f)); } }
                    u32x4 w; w.x = cvt_pk_bf16(v0[0], v0[1]); w.y = cvt_pk_bf16(v0[2], v0[3]); w.z = cvt_pk_bf16(v1[0], v1[1]); w.w = cvt_pk_bf16(v1[2], v1[3]);
                    *(u32x4*)(rowp + bj * HALF) = w; } }
    }
};

struct PanelStats {
    unsigned* xbuf;
    unsigned* cnt;
    unsigned* tmo;
    int ntn; float eps;
    unsigned code;
    __device__ __forceinline__ bool run(const f32x4 (&v)[2][2][4][2], const Unit& u, int wr, int wc, int fr, int fq, PG8_LAS unsigned char* lds, int wid, int lane) const {
        typedef float f32x2v __attribute__((ext_vector_type(2)));
        PG8_LAS f32x2v* P = (PG8_LAS f32x2v*)lds;
        PG8_LAS f32x2v* S = (PG8_LAS f32x2v*)(lds + 8192);
        PG8_LAS unsigned* flag = (PG8_LAS unsigned*)(lds + 8192 + 2048);
#pragma unroll
        for (int ai = 0; ai < 2; ++ai)
#pragma unroll
            for (int m = 0; m < 4; ++m) {
                float s = 0.f;
#pragma unroll
                for (int bj = 0; bj < 2; ++bj)
#pragma unroll
                    for (int n = 0; n < 2; ++n) { const f32x4 x = v[ai][bj][m][n]; s += (x[0] + x[1]) + (x[2] + x[3]); }
                s += __shfl_xor(s, 16); s += __shfl_xor(s, 32);
                const float mw = s * (1.0f / 64.0f); float q = 0.f;
#pragma unroll
                for (int bj = 0; bj < 2; ++bj)
#pragma unroll
                    for (int n = 0; n < 2; ++n) { const f32x4 d = v[ai][bj][m][n] - mw; q += (d[0] * d[0] + d[1] * d[1]) + (d[2] * d[2] + d[3] * d[3]); }
                q += __shfl_xor(q, 16); q += __shfl_xor(q, 32);
                if (fq == 0) P[(ai * HALF + wr * 64 + m * 16 + fr) * 4 + wc] = (f32x2v){mw, q};
            }
        asm volatile("s_waitcnt lgkmcnt(0)" ::: "memory"); __builtin_amdgcn_s_barrier(); asm volatile("" ::: "memory");
#if defined(BROKEN_NO_WAIT)
        if (blockIdx.x >= 64) { const long long t0 = clock64(); while (clock64() - t0 < 60000) __builtin_amdgcn_s_sleep(8); }
#endif
        const int row = wid * 32 + (lane & 31);
        if (lane < 32) {
            const f32x2v a = P[row * 4 + 0], b = P[row * 4 + 1], c = P[row * 4 + 2], d = P[row * 4 + 3];
            const float mt = (a.x + b.x + c.x + d.x) * 0.25f;
            const float da = a.x - mt, db = b.x - mt, dc = c.x - mt, dd = d.x - mt;
            const float m2 = (a.y + b.y) + (c.y + d.y) + 64.0f * ((da * da + db * db) + (dc * dc + dd * dd));
            unsigned long long* slot = (unsigned long long*)xbuf + ((size_t)(u.pm * BM + row) * 4 + u.pn);
            __hip_atomic_store(slot, ((unsigned long long)__float_as_uint(m2) << 32) | __float_as_uint(mt), __ATOMIC_RELAXED, __HIP_MEMORY_SCOPE_AGENT);
        }
        asm volatile("s_waitcnt vmcnt(0)" ::: "memory");
        if (lane == 0) __hip_atomic_fetch_add(cnt + 64 * u.pm, 1u, __ATOMIC_RELAXED, __HIP_MEMORY_SCOPE_AGENT);
        if (wid == 0) {
            bool dead = false; const unsigned long long t0 = __builtin_amdgcn_s_memrealtime(); const unsigned want = 8u * (unsigned)ntn;
            for (;;) {
#if defined(BROKEN_NO_WAIT)
                break;
#endif
                if ((unsigned)__builtin_amdgcn_readfirstlane(__hip_atomic_load(cnt + 64 * u.pm, __ATOMIC_RELAXED, __HIP_MEMORY_SCOPE_AGENT)) >= want) break;
                if (__builtin_amdgcn_s_memrealtime() - t0 > 2000000ull) {
                    if (lane == 0) { unsigned expect = 0u; __hip_atomic_compare_exchange_strong(tmo + 1, &expect, code | (unsigned)(u.pm & 0xff), __ATOMIC_RELAXED, __ATOMIC_RELAXED, __HIP_MEMORY_SCOPE_AGENT);
                                     __hip_atomic_store(tmo, 1u, __ATOMIC_RELAXED, __HIP_MEMORY_SCOPE_AGENT); }
                    dead = true; break; }
                __builtin_amdgcn_s_sleep(2);
            }
            __builtin_amdgcn_fence(__ATOMIC_ACQUIRE, "agent");
            if (lane == 0) flag[0] = dead ? 1u : 0u;
        }
        asm volatile("s_waitcnt vmcnt(0) lgkmcnt(0)" ::: "memory"); __builtin_amdgcn_s_barrier(); asm volatile("" ::: "memory");
        const bool bad = flag[0] != 0u;
        if (lane < 32) {
            const unsigned long long* slot = (const unsigned long long*)xbuf + (size_t)(u.pm * BM + row) * 4; float mt[4], m2[4]; float ms = 0.f;
#pragma unroll
            for (int t = 0; t < 4; ++t) { if (t < ntn) { const unsigned long long w = __hip_atomic_load(slot + t, __ATOMIC_RELAXED, __HIP_MEMORY_SCOPE_AGENT); mt[t] = __uint_as_float((unsigned)w); m2[t] = __uint_as_float((unsigned)(w >> 32)); } else { mt[t] = 0.f; m2[t] = 0.f; } ms += mt[t]; }
            const float mean = ms / (float)ntn; float q = 0.f;
#pragma unroll
            for (int t = 0; t < 4; ++t) if (t < ntn) { const float dm = mt[t] - mean; q += m2[t] + 256.0f * dm * dm; }
            S[row] = (f32x2v){mean, 1.0f / sqrtf(q / (256.0f * (float)ntn) + eps)};
        }
        asm volatile("s_waitcnt lgkmcnt(0)" ::: "memory"); __builtin_amdgcn_s_barrier(); asm volatile("" ::: "memory");
        return bad;
    }
};
struct EpiLnRes {
    static constexpr bool PERM = false, AFTER_DRAIN = true;
    const float* base; float* out; int ldc; const float* bias; PanelStats st; unsigned poison;
    __device__ __forceinline__ void refuse(size_t i0, size_t stride, int M, int N) const { const float q = __builtin_nanf(""); for (size_t i = i0; i < (size_t)M * N; i += stride) out[(i / N) * ldc + i % N] = q;
        if (i0 == 0) { unsigned expect = 0u; __hip_atomic_compare_exchange_strong(st.tmo + 1, &expect, 0x7f0u, __ATOMIC_RELAXED, __ATOMIC_RELAXED, __HIP_MEMORY_SCOPE_AGENT); __hip_atomic_store(st.tmo, 1u, __ATOMIC_RELAXED, __HIP_MEMORY_SCOPE_AGENT); } }
    __device__ __forceinline__ void fused(f32x4 (&acc)[2][2][4][2], const Unit& u, int wr, int wc, int fr, int fq, PG8_LAS unsigned char* lds, int wid, int lane) const {
        typedef float f32x2v __attribute__((ext_vector_type(2)));
        const PG8_LAS f32x2v* S = (const PG8_LAS f32x2v*)(lds + 8192);
        const int col0 = u.pn * BM + wc * 32 + 4 * fq;
#pragma unroll
        for (int bj = 0; bj < 2; ++bj)
#pragma unroll
            for (int n = 0; n < 2; ++n) { const f32x4 bv = bias ? *(const f32x4*)(bias + col0 + bj * HALF + n * 16) : (f32x4){0.f, 0.f, 0.f, 0.f};
#pragma unroll
                for (int ai = 0; ai < 2; ++ai)
#pragma unroll
                    for (int m = 0; m < 4; ++m) acc[ai][bj][m][n] += bv; }
        const bool bad = st.run(acc, u, wr, wc, fr, fq, lds, wid, lane) || poison != 0u;
        const float qnan = __builtin_nanf("");
#pragma unroll
        for (int ai = 0; ai < 2; ++ai)
#pragma unroll
            for (int m = 0; m < 4; ++m) { const int r = ai * HALF + wr * 64 + m * 16 + fr; const f32x2v sr = S[r]; const size_t off = (size_t)(u.pm * BM + r) * ldc + col0;
#pragma unroll
                for (int bj = 0; bj < 2; ++bj)
#pragma unroll
                    for (int n = 0; n < 2; ++n) { const f32x4 bs = *(const f32x4*)(base + off + bj * HALF + n * 16); f32x4 o = bs + (acc[ai][bj][m][n] - sr.x) * sr.y;
                        if (bad) o = (f32x4){qnan, qnan, qnan, qnan}; *(f32x4*)(out + off + bj * HALF + n * 16) = o; }
                asm volatile("" ::: "memory"); }
    }
};
struct EpiLnResLn {
    static constexpr bool PERM = false, AFTER_DRAIN = true;
    const float* base; float* out; bf16_t* xn; int ldc; const float* bias; PanelStats st1, st2; unsigned poison;
    __device__ __forceinline__ void refuse(size_t i0, size_t stride, int M, int N) const { const float q = __builtin_nanf(""); for (size_t i = i0; i < (size_t)M * N; i += stride) { const size_t o = (i / N) * ldc + i % N; out[o] = q; xn[o] = (bf16_t)0x7fc0u; }
        if (i0 == 0) { unsigned expect = 0u; __hip_atomic_compare_exchange_strong(st1.tmo + 1, &expect, 0x7f0u, __ATOMIC_RELAXED, __ATOMIC_RELAXED, __HIP_MEMORY_SCOPE_AGENT); __hip_atomic_store(st1.tmo, 1u, __ATOMIC_RELAXED, __HIP_MEMORY_SCOPE_AGENT); } }
    __device__ __forceinline__ void fused(f32x4 (&acc)[2][2][4][2], const Unit& u, int wr, int wc, int fr, int fq, PG8_LAS unsigned char* lds, int wid, int lane) const {
        typedef float f32x2v __attribute__((ext_vector_type(2))); typedef unsigned u32x2v __attribute__((ext_vector_type(2)));
        const PG8_LAS f32x2v* S = (const PG8_LAS f32x2v*)(lds + 8192);
        const int col0 = u.pn * BM + wc * 32 + 4 * fq;
#pragma unroll
        for (int bj = 0; bj < 2; ++bj)
#pragma unroll
            for (int n = 0; n < 2; ++n) { const f32x4 bv = bias ? *(const f32x4*)(bias + col0 + bj * HALF + n * 16) : (f32x4){0.f, 0.f, 0.f, 0.f};
#pragma unroll
                for (int ai = 0; ai < 2; ++ai)
#pragma unroll
                    for (int m = 0; m < 4; ++m) acc[ai][bj][m][n] += bv; }
        bool bad = st1.run(acc, u, wr, wc, fr, fq, lds, wid, lane) || poison != 0u;
        const float qnan = __builtin_nanf("");
#pragma unroll
        for (int ai = 0; ai < 2; ++ai)
#pragma unroll
            for (int m = 0; m < 4; ++m) { const int r = ai * HALF + wr * 64 + m * 16 + fr; const f32x2v sr = S[r]; const size_t off = (size_t)(u.pm * BM + r) * ldc + col0;
#pragma unroll
                for (int bj = 0; bj < 2; ++bj)
#pragma unroll
                    for (int n = 0; n < 2; ++n) { const f32x4 bs = *(const f32x4*)(base + off + bj * HALF + n * 16); acc[ai][bj][m][n] = bs + (acc[ai][bj][m][n] - sr.x) * sr.y; }
                asm volatile("" : "+v"(acc[ai][0][m][0]), "+v"(acc[ai][0][m][1]), "+v"(acc[ai][1][m][0]), "+v"(acc[ai][1][m][1]));
                if (m & 1) asm volatile("" ::: "memory"); }
        const bool bad1 = bad;
        bad = st2.run(acc, u, wr, wc, fr, fq, lds, wid, lane) || bad;
#pragma unroll
        for (int ai = 0; ai < 2; ++ai)
#pragma unroll
            for (int m = 0; m < 4; ++m) { const int r = ai * HALF + wr * 64 + m * 16 + fr; const f32x2v sr = S[r]; const size_t off = (size_t)(u.pm * BM + r) * ldc + col0;
#pragma unroll
                for (int bj = 0; bj < 2; ++bj)
#pragma unroll
                    for (int n = 0; n < 2; ++n) { const f32x4 x1 = acc[ai][bj][m][n]; *(f32x4*)(out + off + bj * HALF + n * 16) = bad1 ? (f32x4){qnan, qnan, qnan, qnan} : x1;
                        const f32x4 o = (x1 - sr.x) * sr.y; u32x2v w; w.x = cvt_pk_bf16(o[0], o[1]); w.y = cvt_pk_bf16(o[2], o[3]);
                        if (bad) { w.x = 0x7fc07fc0u; w.y = 0x7fc07fc0u; } *(u32x2v*)(xn + off + bj * HALF + n * 16) = w; }
                asm volatile("" ::: "memory"); }
    }
};

template <class Epi, class Sched, bool STAMP = false>
__device__ __forceinline__ void gemm_phase(PG8_LAS unsigned char* lds, const Gemm g, const Sched& S, const Epi& E, unsigned long long* stamps) {
    const int tid = threadIdx.x, wid = __builtin_amdgcn_readfirstlane(tid >> 6), lane = tid & 63, wr = wid >> 2, wc = wid & 3, fr = lane & 15, fq = lane >> 4;
    const int K = g.K, nt = K / BK;
    int ts_lo = 0, ts_hi = 0, nts = 0; const unsigned long long rt_entry = STAMP ? (unsigned long long)wall_clock64() : 0ull;
#define PG8_STAMP() do { if (STAMP && wid == 0 && nts < 64) { const unsigned long long _c = (unsigned long long)clock64(); \
        ts_lo = (lane == nts) ? (int)(unsigned)_c : ts_lo; ts_hi = (lane == nts) ? (int)(unsigned)(_c >> 32) : ts_hi; ++nts; } } while (0)
    PG8_STAMP();
    unsigned voffA[2], voffB[2];
#pragma unroll
    for (int i = 0; i < 2; ++i) { int R, C; stage_rc(tid * 16 + i * 8192, R, C); const int Rb = Epi::PERM ? ((R & ~31) + perm32(R & 31)) : R;
        voffA[i] = (unsigned)(R * K + C) * 2u; voffB[i] = (unsigned)(Rb * K + C) * 2u; }
    const size_t kstep = (size_t)(BK * 2);
    const size_t hstep = (size_t)HALF * K * 2;
    const size_t tstep = 2 * hstep;
    const unsigned ldsw = (unsigned)wid * 1024u;
    const int aoff = lds_byte(wr * 64 + fr, fq * 8), boff = lds_byte(wc * 32 + fr, fq * 8);
#define PG8_SA(b, h) (((b) * 2 + (h)) * HTB)
#define PG8_SB(b, h) ((4 + (b) * 2 + (h)) * HTB)
#define PG8_STAGE(bufoff, gbase, voff) do { _Pragma("unroll") for (int _i = 0; _i < 2; ++_i) \
        __builtin_amdgcn_global_load_lds((const unsigned*)((const char*)(gbase) + (voff)[_i]), (PG8_LAS unsigned*)(lds + (bufoff) + ldsw + _i * 8192), 16, 0, 0); } while (0)
#define PG8_LDA(dst, b, h) do { _Pragma("unroll") for (int m = 0; m < 4; ++m) _Pragma("unroll") for (int k = 0; k < 2; ++k) dst[m][k] = *(const PG8_LAS bf16x8*)(lds + PG8_SA(b, h) + aoff + m * 2048 + k * 1024); } while (0)
#define PG8_LDB(dst, b, h) do { _Pragma("unroll") for (int n = 0; n < 2; ++n) _Pragma("unroll") for (int k = 0; k < 2; ++k) dst[n][k] = *(const PG8_LAS bf16x8*)(lds + PG8_SB(b, h) + boff + n * 2048 + k * 1024); } while (0)
#define PG8_MMA(ai, bj, At, Bt) do { __builtin_amdgcn_s_setprio(1); _Pragma("unroll") for (int m = 0; m < 4; ++m) _Pragma("unroll") for (int n = 0; n < 2; ++n) _Pragma("unroll") for (int k = 0; k < 2; ++k) \
        acc[ai][bj][m][n] = __builtin_amdgcn_mfma_f32_16x16x32_bf16(Bt[n][k], At[m][k], acc[ai][bj][m][n], 0, 0, 0); __builtin_amdgcn_s_setprio(0); } while (0)
#define PG8_WAIT_V(n) asm volatile("s_waitcnt vmcnt(" #n ")" ::: "memory")
#define PG8_WAIT_L(n) asm volatile("s_waitcnt lgkmcnt(" #n ")" ::: "memory")
#define PG8_BAR __builtin_amdgcn_s_barrier()
#define PG8_SCHED __builtin_amdgcn_sched_barrier(0)
    Unit cur, nxt; int ui = 0;
    if (!S.next(0, cur)) return;
    f32x4 acc[2][2][4][2];
#pragma unroll
    for (int a = 0; a < 2; ++a)
#pragma unroll
        for (int b = 0; b < 2; ++b)
#pragma unroll
            for (int m = 0; m < 4; ++m)
#pragma unroll
                for (int n = 0; n < 2; ++n) acc[a][b][m][n] = (f32x4){0.f, 0.f, 0.f, 0.f};
    bf16x8 At[4][2], B0[2][2], B1[2][2];
    const char* cA = (const char*)g.A + (size_t)cur.pm * tstep; const char* cB = (const char*)g.Bt + (size_t)cur.pn * tstep;
    S.a_ready(cur);
    PG8_STAGE(PG8_SB(0, 0), cB, voffB); PG8_STAGE(PG8_SA(0, 0), cA, voffA); PG8_STAGE(PG8_SB(0, 1), cB + hstep, voffB); PG8_STAGE(PG8_SA(0, 1), cA + hstep, voffA);
    if (wr == 1) PG8_BAR;
    PG8_WAIT_V(4); PG8_BAR;
    PG8_STAGE(PG8_SB(1, 0), cB + kstep, voffB); PG8_STAGE(PG8_SA(1, 0), cA + kstep, voffA); PG8_STAGE(PG8_SB(1, 1), cB + hstep + kstep, voffB);
    PG8_WAIT_V(6); PG8_BAR;
    PG8_STAMP();
    for (;;) {
        const bool has_next = S.next(ui + 1, nxt);
        const char* nA = has_next ? (const char*)g.A + (size_t)nxt.pm * tstep : cA; const char* nB = has_next ? (const char*)g.Bt + (size_t)nxt.pn * tstep : cB;
        for (int t = 0; t < nt; t += 2) {
            const bool last = (t == nt - 2);
            const char* a1 = cA + (size_t)(t + 1) * kstep;
            const char* a2 = last ? nA : cA + (size_t)(t + 2) * kstep; const char* b2 = last ? nB : cB + (size_t)(t + 2) * kstep;
            const char* a3 = a2 + kstep; const char* b3 = b2 + kstep;
            if (last && has_next) S.a_ready(nxt);
            PG8_LDB(B0, 0, 0); PG8_SCHED; PG8_LDA(At, 0, 0); PG8_STAGE(PG8_SA(1, 1), a1 + hstep, voffA);
            PG8_WAIT_L(8); PG8_BAR; PG8_WAIT_L(0); PG8_MMA(0, 0, At, B0); PG8_BAR; PG8_SCHED;
            PG8_LDB(B1, 0, 1); PG8_STAGE(PG8_SB(0, 0), b2, voffB);
            PG8_BAR; PG8_WAIT_L(0); PG8_MMA(0, 1, At, B1); PG8_BAR;
            PG8_LDA(At, 0, 1); PG8_STAGE(PG8_SA(0, 0), a2, voffA);
            PG8_BAR; PG8_WAIT_L(0); PG8_MMA(1, 0, At, B0); PG8_BAR; PG8_SCHED;
            PG8_STAGE(PG8_SB(0, 1), b2 + hstep, voffB);
            PG8_WAIT_V(6); PG8_BAR; PG8_MMA(1, 1, At, B1); PG8_BAR;
            PG8_LDB(B0, 1, 0); PG8_SCHED; PG8_LDA(At, 1, 0); PG8_STAGE(PG8_SA(0, 1), a2 + hstep, voffA);
            PG8_WAIT_L(8); PG8_BAR; PG8_WAIT_L(0); PG8_MMA(0, 0, At, B0); PG8_BAR; PG8_SCHED;
            PG8_LDB(B1, 1, 1); PG8_STAGE(PG8_SB(1, 0), b3, voffB);
            PG8_BAR; PG8_WAIT_L(0); PG8_MMA(0, 1, At, B1); PG8_BAR;
            PG8_LDA(At, 1, 1); PG8_STAGE(PG8_SA(1, 0), a3, voffA);
            PG8_BAR; PG8_WAIT_L(0); PG8_MMA(1, 0, At, B0); PG8_BAR; PG8_SCHED;
            PG8_STAGE(PG8_SB(1, 1), b3 + hstep, voffB);
            PG8_WAIT_V(6); PG8_BAR; PG8_MMA(1, 1, At, B1); PG8_BAR;
        }
        PG8_STAMP();
        if constexpr (!Epi::AFTER_DRAIN) { E(acc, cur, wr, wc, fr, fq); S.done(cur); }
        PG8_STAMP();
        if (!has_next) break;
#pragma unroll
        for (int a = 0; a < 2; ++a)
#pragma unroll
            for (int b = 0; b < 2; ++b)
#pragma unroll
                for (int m = 0; m < 4; ++m)
#pragma unroll
                    for (int n = 0; n < 2; ++n) acc[a][b][m][n] = (f32x4){0.f, 0.f, 0.f, 0.f};
        cur = nxt; cA = nA; cB = nB; ++ui;
    }
    PG8_WAIT_V(0);
    if (wr == 0) PG8_BAR;
    PG8_BAR;
    if constexpr (Epi::AFTER_DRAIN) { E.fused(acc, cur, wr, wc, fr, fq, lds, wid, lane); S.done(cur); }
    PG8_STAMP();
    if (STAMP && wid == 0) { stamps[lane] = lane < nts ? (((unsigned long long)(unsigned)ts_hi << 32) | (unsigned)ts_lo) : 0ull;
        if (lane == 62) stamps[62] = rt_entry; if (lane == 63) stamps[63] = (unsigned long long)wall_clock64(); }
#undef PG8_STAMP
#undef PG8_SA
#undef PG8_SB
#undef PG8_STAGE
#undef PG8_LDA
#undef PG8_LDB
#undef PG8_MMA
#undef PG8_WAIT_V
#undef PG8_WAIT_L
#undef PG8_BAR
#undef PG8_SCHED
}
}

namespace mk {
namespace cg = cooperative_groups;
#define LAS __attribute__((address_space(3)))
typedef unsigned short bf16;
typedef short bf16x8 __attribute__((ext_vector_type(8)));
typedef float f32x4 __attribute__((ext_vector_type(4)));
typedef float f32x2 __attribute__((ext_vector_type(2)));
typedef unsigned u32x4 __attribute__((ext_vector_type(4)));
typedef unsigned u32x2 __attribute__((ext_vector_type(2)));

constexpr int NT = 17408, NPT = 16384, DM = 1024;
constexpr size_t MiB = 1u << 20;
constexpr size_t WS_WIN = 0, WS_WBR = 28 * MiB, WS_WOUT = 34 * MiB, WS_WDEC = 36 * MiB, WS_WAAA = WS_WDEC + 131072, WS_WRGA = WS_WAAA + 131072, WS_WRGX = WS_WRGA + 131072;
constexpr size_t WS_XN = 38 * MiB, WS_U = 76 * MiB, WS_Z = 178 * MiB, WS_XB = 280 * MiB, WS_Q = 314 * MiB, WS_G = 348 * MiB, WS_XWA = 450 * MiB;
constexpr size_t WS_MK = 459 * MiB, WS_MVT = 463 * MiB, WS_BONUS = 467 * MiB, WS_STATS = 469 * MiB, WS_END = 474 * MiB;
constexpr size_t WS_ORAW = WS_XN, WS_P = WS_U, WS_MERGED = WS_XB;
constexpr size_t ZSTRIDE = (size_t)NT * DM;
constexpr int LDS_BYTES = 147456;
constexpr size_t O_Y = 0, O_RWP = 17825792, O_SHP = O_RWP + 524288, O_LRP = O_SHP + 25600, O_CVP = O_LRP + 8192, O_MKP = O_CVP + 24576, O_MVP = O_MKP + 2097152,
                 O_RWS = O_MVP + 2097152, O_SHS = O_RWS + 8388608, O_LRS = O_SHS + 409600, O_CVS = O_LRS + 131072, O_END = O_CVS + 393216;

struct Params { const float* in[35]; float* out; unsigned char* ws; };
enum { I_XP = 0, I_XS, I_MEM, I_SRW, I_SSH, I_SLRU, I_SCV, I_CK, I_CV, I_GN, I_WIN, I_MU, I_W0, I_WDEC, I_A0, I_WAAA, I_KK, I_KA, I_RK, I_GNG, I_GNB, I_CW, I_CB, I_WRGA, I_BRGA, I_WRGX, I_BRGX, I_LAM, I_GMEM, I_WMEM, I_WBA, I_WBB, I_WBC, I_WOUT, I_GF };

__device__ __forceinline__ unsigned f2bf(float f) { unsigned u = __builtin_bit_cast(unsigned, f); return (u + 0x7fffu + ((u >> 16) & 1u)) >> 16; }
__device__ __forceinline__ unsigned pk2(float lo, float hi) { return f2bf(lo) | (f2bf(hi) << 16); }
__device__ __forceinline__ float bf2f(unsigned b) { return __builtin_bit_cast(float, b << 16); }
__device__ __forceinline__ float bflo(unsigned w) { return __builtin_bit_cast(float, w << 16); }
__device__ __forceinline__ float bfhi(unsigned w) { return __builtin_bit_cast(float, w & 0xffff0000u); }
__device__ __forceinline__ const float* opq(const float* x) { asm volatile("" : "+s"(x)); return x; }
__device__ __forceinline__ float sigm(float x) { return 1.0f / (1.0f + __expf(-x)); }
#define LDS_WAIT() asm volatile("s_waitcnt lgkmcnt(0)" ::: "memory")
template <int CTRL> __device__ __forceinline__ float dppf(float x) { return __builtin_bit_cast(float, __builtin_amdgcn_update_dpp(0, __builtin_bit_cast(int, x), CTRL, 0xF, 0xF, true)); }
__device__ __forceinline__ float row16_sum(float x) { x += dppf<0xB1>(x); x += dppf<0x4E>(x); x += dppf<0x141>(x); x += dppf<0x140>(x); return x; }
__device__ __forceinline__ float row16_max(float x) { x = fmaxf(x, dppf<0xB1>(x)); x = fmaxf(x, dppf<0x4E>(x)); x = fmaxf(x, dppf<0x141>(x)); x = fmaxf(x, dppf<0x140>(x)); return x; }
__device__ __forceinline__ float wave_sum(float x) { x = row16_sum(x); x += __shfl_xor(x, 16); x += __shfl_xor(x, 32); return x; }
__device__ __forceinline__ float wave_max(float x) { x = row16_max(x); x = fmaxf(x, __shfl_xor(x, 16)); x = fmaxf(x, __shfl_xor(x, 32)); return x; }

struct EpiMain {
    static constexpr bool PERM = true, AFTER_DRAIN = false;
    unsigned char* ws;
    __device__ __forceinline__ void operator()(const pg8::f32x4 (&acc)[2][2][4][2], const pg8::Unit& u, int wr, int wc, int fr, int fq) const {
        const int pn = u.pn, row0 = u.pm * 256 + wr * 64 + fr;
        if (pn == 44) {
            float* X = (float*)(ws + WS_XWA);
#pragma unroll
            for (int ai = 0; ai < 2; ++ai)
#pragma unroll
                for (int m = 0; m < 4; ++m) { float* rp = X + (size_t)(row0 + ai * 128 + m * 16) * 128 + wc * 32 + 8 * fq;
                    *(f32x4*)rp = acc[ai][0][m][0]; *(f32x4*)(rp + 4) = acc[ai][0][m][1]; }
            return;
        }
        bf16* base; int ld, colt, act;
        if (pn < 12) { base = (bf16*)(ws + WS_U); ld = 3072; colt = pn * 256; act = 0; }
        else if (pn < 16) { base = (bf16*)(ws + WS_Z); ld = 1024; colt = (pn - 12) * 256; act = 1; }
        else if (pn < 20) { base = (bf16*)(ws + WS_XB); ld = 1024; colt = (pn - 16) * 256; act = 0; }
        else if (pn < 24) { base = (bf16*)(ws + WS_Z) + ZSTRIDE; ld = 1024; colt = (pn - 20) * 256; act = 1; }
        else if (pn < 28) { base = (bf16*)(ws + WS_Q); ld = 1024; colt = (pn - 24) * 256; act = 0; }
        else if (pn < 32) { base = (bf16*)(ws + WS_Z) + 2 * ZSTRIDE; ld = 1024; colt = (pn - 28) * 256; act = 1; }
        else { base = (bf16*)(ws + WS_G); ld = 3072; colt = (pn - 32) * 256; act = 2; }
        const int col0 = colt + wc * 32 + 8 * fq;
#pragma unroll
        for (int ai = 0; ai < 2; ++ai)
#pragma unroll
            for (int m = 0; m < 4; ++m) { bf16* rowp = base + (size_t)(row0 + ai * 128 + m * 16) * ld + col0;
#pragma unroll
                for (int bj = 0; bj < 2; ++bj) { pg8::f32x4 v0 = acc[ai][bj][m][0], v1 = acc[ai][bj][m][1];
                    if (act) {
#pragma unroll
                        for (int j = 0; j < 4; ++j) { const float s0 = sigm(v0[j]), s1 = sigm(v1[j]); v0[j] = act == 1 ? v0[j] * s0 : s0; v1[j] = act == 1 ? v1[j] * s1 : s1; } }
                    u32x4 w; w.x = pk2(v0[0], v0[1]); w.y = pk2(v0[2], v0[3]); w.z = pk2(v1[0], v1[1]); w.w = pk2(v1[2], v1[3]);
                    *(u32x4*)(rowp + bj * 128) = w; } }
    }
};
struct EpiMem {
    static constexpr bool PERM = false, AFTER_DRAIN = false;
    unsigned char* ws; float* out;
    __device__ __forceinline__ void operator()(const pg8::f32x4 (&acc)[2][2][4][2], const pg8::Unit& u, int wr, int wc, int fr, int fq) const {
        const int row0 = u.pm * 256 + wr * 64 + fr; const bool isv = u.pn >= 4; const int colt = (u.pn & 3) * 256 + wc * 32 + 4 * fq;
        float* of = out + (isv ? O_MVP : O_MKP); bf16* MK = (bf16*)(ws + WS_MK); bf16* MVT = (bf16*)(ws + WS_MVT);
#pragma unroll
        for (int ai = 0; ai < 2; ++ai)
#pragma unroll
            for (int m = 0; m < 4; ++m) { const int r = row0 + ai * 128 + m * 16;
#pragma unroll
                for (int bj = 0; bj < 2; ++bj)
#pragma unroll
                    for (int n = 0; n < 2; ++n) { const int c = colt + bj * 128 + n * 16; const pg8::f32x4 v = acc[ai][bj][m][n];
                        *(f32x4*)(of + (size_t)r * 1024 + c) = v;
                        if (!isv) { u32x2 w; w.x = pk2(v[0], v[1]); w.y = pk2(v[2], v[3]); *(u32x2*)(MK + (size_t)r * 1024 + c) = w; }
                        else { const int b = r >> 8, mem = r & 255, head = c >> 8, d = c & 255; bf16* q = MVT + ((size_t)((b * 4 + head) * 256 + d)) * 256 + mem;
                            q[0] = (bf16)f2bf(v[0]); q[256] = (bf16)f2bf(v[1]); q[512] = (bf16)f2bf(v[2]); q[768] = (bf16)f2bf(v[3]); } } }
    }
};
struct SchedMem { int c;
    __device__ bool next(int i, pg8::Unit& u) const { if (i != 0 || c >= 64) return false; u.pm = c >> 3; u.pn = c & 7; return true; }
    __device__ __forceinline__ void a_ready(const pg8::Unit&) const {}
    __device__ __forceinline__ void done(const pg8::Unit&) const {}
};
struct EpiBranch {
    static constexpr bool PERM = true, AFTER_DRAIN = false;
    unsigned char* ws;
    __device__ __forceinline__ void operator()(const pg8::f32x4 (&acc)[2][2][4][2], const pg8::Unit& u, int wr, int wc, int fr, int fq) const {
        const int br = u.pn >> 2, pmm = u.pm - br * 68, pnn = u.pn & 3;
        const int row0 = pmm * 256 + wr * 64 + fr, col0 = pnn * 256 + wc * 32 + 8 * fq;
        const bf16* G = (const bf16*)(ws + WS_G) + br * 1024; bf16* P = (bf16*)(ws + WS_P) + (size_t)br * ZSTRIDE;
#pragma unroll
        for (int ai = 0; ai < 2; ++ai)
#pragma unroll
            for (int m = 0; m < 4; ++m) { const int r = row0 + ai * 128 + m * 16;
#pragma unroll
                for (int bj = 0; bj < 2; ++bj) { const u32x4 g = *(const u32x4*)(G + (size_t)r * 3072 + col0 + bj * 128); const pg8::f32x4 v0 = acc[ai][bj][m][0], v1 = acc[ai][bj][m][1];
                    u32x4 w; w.x = pk2(v0[0] * bflo(g.x), v0[1] * bfhi(g.x)); w.y = pk2(v0[2] * bflo(g.y), v0[3] * bfhi(g.y)); w.z = pk2(v1[0] * bflo(g.z), v1[1] * bfhi(g.z)); w.w = pk2(v1[2] * bflo(g.w), v1[3] * bfhi(g.w));
                    *(u32x4*)(P + (size_t)r * 1024 + col0 + bj * 128) = w; } }
    }
};
struct SchedBranch { int c, G;
    __device__ bool next(int i, pg8::Unit& u) const { const int L = i * G + ((G == 256) ? ((c & 7) * 32 + (c >> 3)) : c); if (L >= 816) return false;
        const int br = L / 272, t = L - br * 272; u.pm = br * 68 + (t >> 2); u.pn = br * 4 + (t & 3); return true; }
    __device__ __forceinline__ void a_ready(const pg8::Unit&) const {}
    __device__ __forceinline__ void done(const pg8::Unit&) const {}
};
struct EpiOut {
    static constexpr bool PERM = false, AFTER_DRAIN = false;
    const float* xp; const float* xs; float* out;
    __device__ __forceinline__ void operator()(const pg8::f32x4 (&acc)[2][2][4][2], const pg8::Unit& u, int wr, int wc, int fr, int fq) const {
        const int row0 = u.pm * 256 + wr * 64 + fr, col0 = u.pn * 256 + wc * 32 + 4 * fq;
#pragma unroll
        for (int ai = 0; ai < 2; ++ai)
#pragma unroll
            for (int m = 0; m < 4; ++m) { const int r = row0 + ai * 128 + m * 16; const float* xr = (r < NPT ? xp + (size_t)r * 1024 : xs + (size_t)(r - NPT) * 1024) + col0; float* orow = out + (size_t)r * 1024 + col0;
#pragma unroll
                for (int bj = 0; bj < 2; ++bj)
#pragma unroll
                    for (int n = 0; n < 2; ++n) *(f32x4*)(orow + bj * 128 + n * 16) = *(const f32x4*)(xr + bj * 128 + n * 16) + acc[ai][bj][m][n]; }
    }
};

__device__ __forceinline__ void transpose_item(const float* W, int K, int N, bf16* WT, int row_off, LAS float* scr, int item, int lane) {
    const int nblk = N / 32, kb = item / nblk, nb = item % nblk, k0 = 64 * kb, n0 = 32 * nb;
#pragma unroll 8
    for (int i = 0; i < 32; ++i) { const int kk = 2 * i + (lane >> 5); scr[kk * 33 + (lane & 31)] = W[(size_t)(k0 + kk) * N + n0 + (lane & 31)]; }
    LDS_WAIT();
    const int c = lane & 7;
#pragma unroll
    for (int j = 0; j < 4; ++j) { const int n = (lane >> 3) + 8 * j; const LAS float* s = scr + (8 * c) * 33 + n;
        u32x4 o; o.x = pk2(s[0 * 33], s[1 * 33]); o.y = pk2(s[2 * 33], s[3 * 33]); o.z = pk2(s[4 * 33], s[5 * 33]); o.w = pk2(s[6 * 33], s[7 * 33]);
        *(u32x4*)(WT + (size_t)(row_off + n0 + n) * K + k0 + 8 * c) = o; }
    LDS_WAIT();
}
__device__ __forceinline__ void rms_row_to_bf16(const float* xrow, const float* g, bf16* orow, int lane) {
    const f32x4* xr = (const f32x4*)xrow + lane; const f32x4* gr = (const f32x4*)g + lane;
    f32x4 v[4]; float s = 0.f;
#pragma unroll
    for (int j = 0; j < 4; ++j) { v[j] = xr[64 * j]; s += (v[j].x * v[j].x + v[j].y * v[j].y) + (v[j].z * v[j].z + v[j].w * v[j].w); }
    const float rstd = rsqrtf(wave_sum(s) * (1.f / 1024.f) + 1e-6f);
    unsigned long long* o8 = (unsigned long long*)orow + lane;
#pragma unroll
    for (int j = 0; j < 4; ++j) { const f32x4 gg = gr[64 * j]; o8[64 * j] = (unsigned long long)pk2(v[j].x * rstd * gg.x, v[j].y * rstd * gg.y) | ((unsigned long long)pk2(v[j].z * rstd * gg.z, v[j].w * rstd * gg.w) << 32); }
}
__device__ __forceinline__ void p0_prologue(const Params& p, LAS unsigned char* lds, int tid, int wave, int lane, int G) {
    unsigned char* ws = p.ws;
    LAS float* scr = (LAS float*)(lds + wave * 16384);
    const int gw = blockIdx.x * 8 + wave, NGW = G * 8;
    bf16* WIN = (bf16*)(ws + WS_WIN);
    constexpr int I_IN = 16 * 356, I_MM = 16 * 64, I_B = 16 * 32, I_L = 32, I_R = 2;
    constexpr int NITEMS = I_IN + I_MM + 4 * I_B + 2 * I_L + 32 * I_R;
    for (int it = gw; it < NITEMS; it += NGW) {
        int r = it;
        if (r < I_IN) { const int n0 = 32 * (r % 356); const int dst = n0 < 3072 ? n0 : (n0 < 3200 ? 11264 + n0 - 3072 : n0 - 128); transpose_item(p.in[I_WIN], 1024, 11392, WIN, dst - n0, scr, r, lane); continue; } r -= I_IN;
        if (r < I_MM) { transpose_item(p.in[I_WMEM], 1024, 2048, WIN + (size_t)11520 * 1024, 0, scr, r, lane); continue; } r -= I_MM;
        if (r < 3 * I_B) { const int br = r / I_B; const float* wa = opq(p.in[I_WBA]); const float* wb = opq(p.in[I_WBB]); const float* wc = opq(p.in[I_WBC]); transpose_item(br == 0 ? wa : (br == 1 ? wb : wc), 1024, 1024, (bf16*)(ws + WS_WBR) + (size_t)br * 1024 * 1024, 0, scr, r - br * I_B, lane); continue; } r -= 3 * I_B;
        if (r < I_B) { transpose_item(p.in[I_WOUT], 1024, 1024, (bf16*)(ws + WS_WOUT), 0, scr, r, lane); continue; } r -= I_B;
        if (r < I_L) { transpose_item(p.in[I_WDEC], 64, 1024, (bf16*)(ws + WS_WDEC), 0, scr, r, lane); continue; } r -= I_L;
        if (r < I_L) { transpose_item(p.in[I_WAAA], 64, 1024, (bf16*)(ws + WS_WAAA), 0, scr, r, lane); continue; } r -= I_L;
        { const int which = r / 32, rr = r % 32, g = rr >> 1, sub = rr & 1;
          const float* ra = opq(p.in[I_WRGA]); const float* rx = opq(p.in[I_WRGX]); transpose_item((which ? rx : ra) + g * 4096, 64, 64, (bf16*)(ws + (which ? WS_WRGX : WS_WRGA)) + g * 4096, 0, scr, sub, lane); }
    }
    { u32x4* z = (u32x4*)(WIN + (size_t)11392 * 1024); const u32x4 zero = {0u, 0u, 0u, 0u}; for (int i = blockIdx.x * 512 + tid; i < 128 * 1024 / 8; i += G * 512) z[i] = zero; }
    bf16* XN = (bf16*)(ws + WS_XN);
    const float* pxp = opq(p.in[I_XP]); const float* pxs = opq(p.in[I_XS]); const float* pmem = opq(p.in[I_MEM]); const float* pgn = opq(p.in[I_GN]); const float* pgm = opq(p.in[I_GMEM]);
    for (int m = gw; m < NT + 2048; m += NGW) {
        const float* src; const float* g;
        if (m < NPT) { src = pxp + (size_t)m * 1024; g = pgn; } else if (m < NT) { src = pxs + (size_t)(m - NPT) * 1024; g = pgn; } else { src = pmem + (size_t)(m - NT) * 1024; g = pgm; }
        rms_row_to_bf16(src, g, XN + (size_t)m * 1024, lane);
    }
}

__device__ __forceinline__ bf16x8 pack8(const float (&x)[8]) { u32x4 w; w.x = pk2(x[0], x[1]); w.y = pk2(x[2], x[3]); w.z = pk2(x[4], x[5]); w.w = pk2(x[6], x[7]); return __builtin_bit_cast(bf16x8, w); }
__device__ __forceinline__ void p2_lora(const Params& p, int vb, int NB, int tid, int wave, int lane) {
    unsigned char* ws = p.ws;
    const float* XWA = (const float*)(ws + WS_XWA); const bf16* U = (const bf16*)(ws + WS_U); const bf16* XB = (const bf16*)(ws + WS_XB);
    const bf16* WDEC = (const bf16*)(ws + WS_WDEC); const bf16* WAAA = (const bf16*)(ws + WS_WAAA);
    bf16* E = (bf16*)p.out; bf16* A = E + ZSTRIDE;
    const float* mu = p.in[I_MU]; const float* w0 = p.in[I_W0]; const float* a0 = p.in[I_A0]; const float* ssh = p.in[I_SSH];
    const int trow = lane & 15, kg = lane >> 4;
    for (int item = vb * 8 + wave; item < NT / 16; item += NB * 8) {
        const int tok = item * 16 + trow; const bool prm = tok < NPT; const int s = prm ? (tok & 2047) : ((tok - NPT) & 7); const int bs = (tok - NPT) >> 3;
        bf16x8 Aw[2], Aa[2];
#pragma unroll
        for (int ks = 0; ks < 2; ++ks) { const int k0 = 32 * ks + 8 * kg; float xw[8], xa[8];
#pragma unroll
            for (int hlf = 0; hlf < 2; ++hlf) {
                const f32x4 cw = *(const f32x4*)(XWA + (size_t)tok * 128 + k0 + 4 * hlf), ca = *(const f32x4*)(XWA + (size_t)tok * 128 + 64 + k0 + 4 * hlf);
                f32x4 pw = {0.f, 0.f, 0.f, 0.f}, pa = {0.f, 0.f, 0.f, 0.f};
                if (s > 0) { pw = *(const f32x4*)(XWA + (size_t)(tok - 1) * 128 + k0 + 4 * hlf); pa = *(const f32x4*)(XWA + (size_t)(tok - 1) * 128 + 64 + k0 + 4 * hlf); }
                else if (!prm) { pw = *(const f32x4*)(ssh + (size_t)bs * 3200 + 3072 + k0 + 4 * hlf); pa = *(const f32x4*)(ssh + (size_t)bs * 3200 + 3136 + k0 + 4 * hlf); }
                const f32x4 mw = *(const f32x4*)(mu + 3072 + k0 + 4 * hlf), ma = *(const f32x4*)(mu + 3136 + k0 + 4 * hlf);
#pragma unroll
                for (int j = 0; j < 4; ++j) { const float xs = cw[j] + (pw[j] - cw[j]) * mw[j]; xw[4 * hlf + j] = 1.0f - 2.0f / (1.0f + __expf(2.0f * xs)); xa[4 * hlf + j] = ca[j] + (pa[j] - ca[j]) * ma[j]; }
            }
            Aw[ks] = pack8(xw); Aa[ks] = pack8(xa); }
        const int tr0 = item * 16 + 4 * kg;
        for (int ct = 0; ct < 64; ++ct) { const int n = 16 * ct + trow;
            const bf16x8 bd0 = *(const bf16x8*)(WDEC + n * 64 + 8 * kg), bd1 = *(const bf16x8*)(WDEC + n * 64 + 32 + 8 * kg), ba0 = *(const bf16x8*)(WAAA + n * 64 + 8 * kg), ba1 = *(const bf16x8*)(WAAA + n * 64 + 32 + 8 * kg);
            f32x4 ad = {0.f, 0.f, 0.f, 0.f}, aa = {0.f, 0.f, 0.f, 0.f};
            ad = __builtin_amdgcn_mfma_f32_16x16x32_bf16(Aw[0], bd0, ad, 0, 0, 0); ad = __builtin_amdgcn_mfma_f32_16x16x32_bf16(Aw[1], bd1, ad, 0, 0, 0);
            aa = __builtin_amdgcn_mfma_f32_16x16x32_bf16(Aa[0], ba0, aa, 0, 0, 0); aa = __builtin_amdgcn_mfma_f32_16x16x32_bf16(Aa[1], ba1, aa, 0, 0, 0);
            const float w0n = w0[n], a0n = a0[n];
#pragma unroll
            for (int r = 0; r < 4; ++r) { E[(size_t)(tr0 + r) * 1024 + n] = (bf16)f2bf(0.60653066f * sigm(w0n + ad[r])); A[(size_t)(tr0 + r) * 1024 + n] = (bf16)f2bf(sigm(a0n + aa[r])); } }
    }
    float* out = p.out; const int gt = vb * 512 + tid, ngt = NB * 512;
    for (int i = gt; i < 136 * 3200; i += ngt) { const int b = i / 3200, c = i - b * 3200; const int tok = b < 8 ? b * 2048 + 2047 : NPT + (b - 8) * 8 + 7;
        const float v = c < 3072 ? bf2f(U[(size_t)tok * 3072 + c]) : XWA[(size_t)tok * 128 + c - 3072];
        out[(b < 8 ? O_SHP + (size_t)b * 3200 : O_SHS + (size_t)(b - 8) * 3200) + c] = v; }
    for (int i = gt; i < 136 * 3072; i += ngt) { const int b = i / 3072, r = i - b * 3072, j = r >> 10, c = r & 1023; const int tok = b < 8 ? b * 2048 + 2045 + j : NPT + (b - 8) * 8 + 5 + j;
        out[(b < 8 ? O_CVP + (size_t)b * 3072 : O_CVS + (size_t)(b - 8) * 3072) + r] = bf2f(XB[(size_t)tok * 1024 + c]); }
}

constexpr int CH = 32;
constexpr int BUF_F = 5 * CH * 64 + CH * 32;
constexpr int RW_LDS_OST = 2 * BUF_F * 4;
__device__ __forceinline__ void rwkv_prep(const Params& p, LAS float* buf, int c, int T, int tokbase, int h, int half, const float* shift0, int lw, int lane, bool wbonus) {
    unsigned char* ws = p.ws;
    const bf16* U = (const bf16*)(ws + WS_U); const bf16* E = (const bf16*)p.out; const bf16* A = E + ZSTRIDE; float* BON = (float*)(ws + WS_BONUS);
    const int C = h * 64 + lane;
    const float mur = p.in[I_MU][C], muk = p.in[I_MU][1024 + C], muv = p.in[I_MU][2048 + C], kkc = p.in[I_KK][C], kac = p.in[I_KA][C], rkc = p.in[I_RK][C];
    int t = c * CH + 8 * lw; if (t >= T) return;
    float pr, pk, pv;
    if (t == 0) { if (shift0) { pr = shift0[C]; pk = shift0[1024 + C]; pv = shift0[2048 + C]; } else { pr = 0.f; pk = 0.f; pv = 0.f; } }
    else { const bf16* up = U + (size_t)(tokbase + t - 1) * 3072 + C; pr = bf2f(up[0]); pk = bf2f(up[1024]); pv = bf2f(up[2048]); }
#pragma unroll 2
    for (int i = 0; i < 8; ++i, ++t) {
        if (t >= T) break;
        const int s = 8 * lw + i; const size_t tok = (size_t)(tokbase + t);
        const bf16* up = U + tok * 3072 + C; const float ur = bf2f(up[0]), uk = bf2f(up[1024]), uv = bf2f(up[2048]);
        const float e = bf2f(E[tok * 1024 + C]), a = bf2f(A[tok * 1024 + C]);
        const float r = ur + (pr - ur) * mur, k = uk + (pk - uk) * muk, v = uv + (pv - uv) * muv; pr = ur; pk = uk; pv = uv;
        const float kr = k * kkc; const float ss = wave_sum(kr * kr); const float kk = kr * rsqrtf(ss + 1e-12f);
        const float kp = k * (1.0f + (a - 1.0f) * kac); const float bon = wave_sum(r * kp * rkc);
        LAS float* bp = buf + s * 64 + lane;
        bp[0] = __expf(-e); bp[CH * 64] = kk * a; bp[2 * CH * 64] = kp; bp[3 * CH * 64] = kk; bp[4 * CH * 64] = r;
        if ((lane >> 5) == half) buf[5 * CH * 64 + s * 32 + (lane & 31)] = v;
        if (wbonus && lane == 0) BON[tok * 16 + h] = bon;
    }
}
__device__ __forceinline__ void rwkv_oout(const Params& p, const LAS float* ost, int c, int T, int tokbase, int h, int half, int ltid) {
    unsigned char* ws = p.ws; bf16* ORAW = (bf16*)(ws + WS_ORAW); float* ST = (float*)(ws + WS_STATS);
    const int s = ltid >> 3, q = ltid & 7, t = c * CH + s; const bool ok = t < T;
    f32x4 o = {0.f, 0.f, 0.f, 0.f}; if (ok) o = *(const LAS f32x4*)(ost + s * 32 + 4 * q);
    float sm = (o.x + o.y) + (o.z + o.w), sq = (o.x * o.x + o.y * o.y) + (o.z * o.z + o.w * o.w);
    sm += dppf<0xB1>(sm); sq += dppf<0xB1>(sq); sm += dppf<0x4E>(sm); sq += dppf<0x4E>(sq); sm += dppf<0x141>(sm); sq += dppf<0x141>(sq);
    if (ok) { const size_t tok = (size_t)(tokbase + t); u32x2 w; w.x = pk2(o.x, o.y); w.y = pk2(o.z, o.w); *(u32x2*)(ORAW + tok * 1024 + h * 64 + 32 * half + 4 * q) = w;
        if (q == 0) *(f32x2*)(ST + ((tok * 16 + h) * 2 + half) * 2) = (f32x2){sm, sq}; }
}
__device__ __forceinline__ void rwkv_item(const Params& p, LAS unsigned char* lds, int tid, int wave, int lane, int T, int tokbase, int h, int half, const float* S0, const float* shift0, float* Sout) {
    LAS float* bufs = (LAS float*)lds; LAS float* osts = (LAS float*)(lds + RW_LDS_OST);
    const int nch = (T + CH - 1) / CH; const bool scan = wave < 4; const int rl = lane >> 4, kl = lane & 15;
    f32x4 Sa = {0.f, 0.f, 0.f, 0.f}, Sb = {0.f, 0.f, 0.f, 0.f};
    const int row = 32 * half + 8 * wave + 2 * rl;
    if (scan) { if (S0) { Sa = *(const f32x4*)(S0 + row * 64 + 4 * kl); Sb = *(const f32x4*)(S0 + (row + 1) * 64 + 4 * kl); } }
    else rwkv_prep(p, bufs, 0, T, tokbase, h, half, shift0, wave - 4, lane, half == 0);
    __syncthreads();
    for (int c = 0; c < nch; ++c) {
        if (scan) {
            const LAS float* buf = bufs + (c & 1) * BUF_F; LAS float* ost = osts + (c & 1) * (CH * 32);
            const int nv = (T - c * CH) < CH ? (T - c * CH) : CH;
            for (int s = 0; s < nv; ++s) {
                const LAS float* bp = buf + s * 64 + 4 * kl;
                const f32x4 w4 = *(const LAS f32x4*)bp, b4 = *(const LAS f32x4*)(bp + CH * 64), k4 = *(const LAS f32x4*)(bp + 2 * CH * 64), kk4 = *(const LAS f32x4*)(bp + 3 * CH * 64), r4 = *(const LAS f32x4*)(bp + 4 * CH * 64);
                const f32x2 v2 = *(const LAS f32x2*)(buf + 5 * CH * 64 + s * 32 + 8 * wave + 2 * rl);
                float sa0 = (Sa.x * kk4.x + Sa.y * kk4.y) + (Sa.z * kk4.z + Sa.w * kk4.w), sa1 = (Sb.x * kk4.x + Sb.y * kk4.y) + (Sb.z * kk4.z + Sb.w * kk4.w);
                sa0 += dppf<0xB1>(sa0); sa1 += dppf<0xB1>(sa1); sa0 += dppf<0x4E>(sa0); sa1 += dppf<0x4E>(sa1); sa0 += dppf<0x141>(sa0); sa1 += dppf<0x141>(sa1); sa0 += dppf<0x140>(sa0); sa1 += dppf<0x140>(sa1);
                sa0 = -sa0; sa1 = -sa1;
                Sa = Sa * w4 + sa0 * b4 + v2.x * k4; Sb = Sb * w4 + sa1 * b4 + v2.y * k4;
                float o0 = (Sa.x * r4.x + Sa.y * r4.y) + (Sa.z * r4.z + Sa.w * r4.w), o1 = (Sb.x * r4.x + Sb.y * r4.y) + (Sb.z * r4.z + Sb.w * r4.w);
                o0 += dppf<0xB1>(o0); o1 += dppf<0xB1>(o1); o0 += dppf<0x4E>(o0); o1 += dppf<0x4E>(o1); o0 += dppf<0x141>(o0); o1 += dppf<0x141>(o1); o0 += dppf<0x140>(o0); o1 += dppf<0x140>(o1);
                if (kl == 0) *(LAS f32x2*)(ost + s * 32 + 8 * wave + 2 * rl) = (f32x2){o0, o1};
            }
        } else {
            if (c + 1 < nch) rwkv_prep(p, bufs + ((c + 1) & 1) * BUF_F, c + 1, T, tokbase, h, half, shift0, wave - 4, lane, half == 0);
            if (c >= 1) rwkv_oout(p, osts + ((c - 1) & 1) * (CH * 32), c - 1, T, tokbase, h, half, tid - 256);
        }
        __syncthreads();
    }
    if (scan) { *(f32x4*)(Sout + row * 64 + 4 * kl) = Sa; *(f32x4*)(Sout + (row + 1) * 64 + 4 * kl) = Sb; }
    else rwkv_oout(p, osts + ((nch - 1) & 1) * (CH * 32), nch - 1, T, tokbase, h, half, tid - 256);
    __syncthreads();
}

__device__ __forceinline__ void rglru_item(const Params& p, LAS unsigned char* lds, int tid, int wave, int lane, int T, int tokbase, int g, const float* conv0, const float* h0, float* hout) {
    unsigned char* ws = p.ws; const bf16* XB = (const bf16*)(ws + WS_XB); bf16* ZB = (bf16*)(ws + WS_Z) + ZSTRIDE;
    LAS float* XC = (LAS float*)lds; LAS float* GR = XC + 64 * 65; LAS float* GI = GR + 64 * 65; LAS bf16* XCB = (LAS bf16*)(GI + 64 * 65);
    const int c = tid & 63, sg = tid >> 6, C = g * 64 + c;
    const float cw0 = p.in[I_CW][C], cw1 = p.in[I_CW][1024 + C], cw2 = p.in[I_CW][2048 + C], cw3 = p.in[I_CW][3072 + C], cb = p.in[I_CB][C];
    const float sp = log1pf(__expf(-p.in[I_LAM][C]));
    float hst = 0.f; if (wave == 0 && h0) hst = h0[C];
    const bf16* WT = (const bf16*)(ws + (wave >= 4 ? WS_WRGX : WS_WRGA)) + g * 4096; const float* bra = opq(p.in[I_BRGA]); const float* brx = opq(p.in[I_BRGX]); const float* bias = (wave >= 4 ? brx : bra) + g * 64;
    for (int t0 = 0; t0 < T; t0 += 64) {
        const int nv = (T - t0) < 64 ? (T - t0) : 64;
        { const int sb = t0 + sg * 8; float e0, e1, e2;
#define EXT(i) ((i) >= 0 ? ((i) < T ? bf2f(XB[(size_t)(tokbase + (i)) * 1024 + C]) : 0.f) : (conv0 ? conv0[(3 + (i)) * 1024 + C] : 0.f))
          e0 = EXT(sb - 3); e1 = EXT(sb - 2); e2 = EXT(sb - 1);
#pragma unroll
          for (int i = 0; i < 8; ++i) { const int t = sb + i; const float e3 = EXT(t); const float xc = cb + e0 * cw0 + e1 * cw1 + e2 * cw2 + e3 * cw3;
              XC[(sg * 8 + i) * 65 + c] = xc; XCB[(sg * 8 + i) * 72 + c] = (bf16)f2bf(xc); e0 = e1; e1 = e2; e2 = e3; }
#undef EXT
        }
        __syncthreads();
        { const int tt = wave & 3, trow = lane & 15, kg = lane >> 4; LAS float* GO = wave >= 4 ? GI : GR;
          const bf16x8 a0 = *(const LAS bf16x8*)(XCB + (16 * tt + trow) * 72 + 8 * kg), a1 = *(const LAS bf16x8*)(XCB + (16 * tt + trow) * 72 + 32 + 8 * kg);
#pragma unroll
          for (int ct = 0; ct < 4; ++ct) { const int n = 16 * ct + trow; const bf16x8 b0 = *(const bf16x8*)(WT + n * 64 + 8 * kg), b1 = *(const bf16x8*)(WT + n * 64 + 32 + 8 * kg);
              f32x4 acc = {0.f, 0.f, 0.f, 0.f}; acc = __builtin_amdgcn_mfma_f32_16x16x32_bf16(a0, b0, acc, 0, 0, 0); acc = __builtin_amdgcn_mfma_f32_16x16x32_bf16(a1, b1, acc, 0, 0, 0);
              const float bn = bias[n];
#pragma unroll
              for (int r = 0; r < 4; ++r) GO[(16 * tt + 4 * kg + r) * 65 + n] = sigm(acc[r] + bn); } }
        __syncthreads();
#pragma unroll
        for (int i = 0; i < 8; ++i) { const int s = sg * 8 + i; const float gr = GR[s * 65 + c], gi = GI[s * 65 + c], xc = XC[s * 65 + c];
            const float la = -8.0f * gr * sp; GR[s * 65 + c] = __expf(la); GI[s * 65 + c] = sqrtf(-expm1f(2.0f * la)) * gi * xc; }
        __syncthreads();
        if (wave == 0) { for (int s = 0; s < nv; ++s) { hst = GR[s * 65 + lane] * hst + GI[s * 65 + lane]; XC[s * 65 + lane] = hst; } }
        __syncthreads();
#pragma unroll
        for (int i = 0; i < 8; ++i) { const int s = sg * 8 + i; if (s < nv) { bf16* zp = ZB + (size_t)(tokbase + t0 + s) * 1024 + C; *zp = (bf16)f2bf(XC[s * 65 + c] * bf2f(*zp)); } }
        __syncthreads();
    }
    if (wave == 0) hout[C] = hst;
}

__device__ __forceinline__ void xattn_prompt_item(const Params& p, LAS unsigned char* lds, int wave, int lane, int item) {
    unsigned char* ws = p.ws; const bf16* Q = (const bf16*)(ws + WS_Q); const bf16* MK = (const bf16*)(ws + WS_MK); const bf16* MVT = (const bf16*)(ws + WS_MVT); bf16* ZC = (bf16*)(ws + WS_Z) + 2 * ZSTRIDE;
    LAS bf16* PL = (LAS bf16*)(lds + wave * 8448);
    const int qt = item & 127, head = (item >> 7) & 3, b = item >> 9, tok0 = b * 2048 + 16 * qt, trow = lane & 15, kg = lane >> 4;
    bf16x8 qf[8];
#pragma unroll
    for (int ks = 0; ks < 8; ++ks) qf[ks] = *(const bf16x8*)(Q + (size_t)(tok0 + trow) * 1024 + head * 256 + 32 * ks + 8 * kg);
    f32x4 S[16];
#pragma unroll
    for (int mt = 0; mt < 16; ++mt) { f32x4 acc = {0.f, 0.f, 0.f, 0.f}; const bf16* kp = MK + (size_t)(b * 256 + 16 * mt + trow) * 1024 + head * 256 + 8 * kg;
#pragma unroll
        for (int ks = 0; ks < 8; ++ks) acc = __builtin_amdgcn_mfma_f32_16x16x32_bf16(qf[ks], *(const bf16x8*)(kp + 32 * ks), acc, 0, 0, 0);
        S[mt] = acc; }
    f32x4 mx = S[0];
#pragma unroll
    for (int mt = 1; mt < 16; ++mt) { mx.x = fmaxf(mx.x, S[mt].x); mx.y = fmaxf(mx.y, S[mt].y); mx.z = fmaxf(mx.z, S[mt].z); mx.w = fmaxf(mx.w, S[mt].w); }
    mx.x = row16_max(mx.x); mx.y = row16_max(mx.y); mx.z = row16_max(mx.z); mx.w = row16_max(mx.w);
    f32x4 sm = {0.f, 0.f, 0.f, 0.f};
#pragma unroll
    for (int mt = 0; mt < 16; ++mt) { f32x4 e; e.x = __expf((S[mt].x - mx.x) * 0.0625f); e.y = __expf((S[mt].y - mx.y) * 0.0625f); e.z = __expf((S[mt].z - mx.z) * 0.0625f); e.w = __expf((S[mt].w - mx.w) * 0.0625f);
        sm += e; const int col = 16 * mt + trow;
        PL[(4 * kg + 0) * 264 + col] = (bf16)f2bf(e.x); PL[(4 * kg + 1) * 264 + col] = (bf16)f2bf(e.y); PL[(4 * kg + 2) * 264 + col] = (bf16)f2bf(e.z); PL[(4 * kg + 3) * 264 + col] = (bf16)f2bf(e.w); }
    sm.x = row16_sum(sm.x); sm.y = row16_sum(sm.y); sm.z = row16_sum(sm.z); sm.w = row16_sum(sm.w);
    const f32x4 inv = {1.0f / sm.x, 1.0f / sm.y, 1.0f / sm.z, 1.0f / sm.w};
    LDS_WAIT();
    bf16x8 pf[8];
#pragma unroll
    for (int ks = 0; ks < 8; ++ks) pf[ks] = *(const LAS bf16x8*)(PL + trow * 264 + 32 * ks + 8 * kg);
    LDS_WAIT();
#pragma unroll 4
    for (int dt = 0; dt < 16; ++dt) { f32x4 acc = {0.f, 0.f, 0.f, 0.f}; const bf16* vp = MVT + ((size_t)((b * 4 + head) * 256 + 16 * dt + trow)) * 256 + 8 * kg;
#pragma unroll
        for (int ks = 0; ks < 8; ++ks) acc = __builtin_amdgcn_mfma_f32_16x16x32_bf16(pf[ks], *(const bf16x8*)(vp + 32 * ks), acc, 0, 0, 0);
        acc = acc * inv; const int col = head * 256 + 16 * dt + trow;
#pragma unroll
        for (int r = 0; r < 4; ++r) { bf16* zp = ZC + (size_t)(tok0 + 4 * kg + r) * 1024 + col; *zp = (bf16)f2bf(acc[r] * bf2f(*zp)); } }
}

__device__ __forceinline__ void xattn_sample_item(const Params& p, LAS unsigned char* lds, int tid, int wave, int lane, int item) {
    unsigned char* ws = p.ws; const bf16* Q = (const bf16*)(ws + WS_Q); bf16* ZC = (bf16*)(ws + WS_Z) + 2 * ZSTRIDE;
    LAS float* QS = (LAS float*)lds; LAS float* SC = QS + 2048; LAS float* PART = SC + 2048;
    const int b = item >> 2, head = item & 3, tok0 = NPT + b * 8;
    for (int i = tid; i < 2048; i += 512) QS[i] = bf2f(Q[(size_t)(tok0 + (i >> 8)) * 1024 + head * 256 + (i & 255)]);
    __syncthreads();
    const float* Kc = p.in[I_CK] + ((size_t)b * 256 * 4 + head) * 256 + 4 * lane; const float* Vc = p.in[I_CV] + ((size_t)b * 256 * 4 + head) * 256 + 4 * lane;
    { f32x4 q[8];
#pragma unroll
      for (int i = 0; i < 8; ++i) q[i] = *(const LAS f32x4*)(QS + i * 256 + 4 * lane);
#pragma unroll 4
      for (int r = 0; r < 32; ++r) { const int m = 32 * wave + r; const f32x4 kv = *(const f32x4*)(Kc + (size_t)m * 1024);
          float d[8];
#pragma unroll
          for (int i = 0; i < 8; ++i) d[i] = wave_sum((q[i].x * kv.x + q[i].y * kv.y) + (q[i].z * kv.z + q[i].w * kv.w));
          if (lane == 0) {
#pragma unroll
              for (int i = 0; i < 8; ++i) SC[i * 256 + m] = d[i] * 0.0625f; } } }
    __syncthreads();
    { float v[4]; float mx = -3.0e38f;
#pragma unroll
      for (int j = 0; j < 4; ++j) { v[j] = SC[wave * 256 + lane + 64 * j]; mx = fmaxf(mx, v[j]); }
      mx = wave_max(mx); float sm = 0.f;
#pragma unroll
      for (int j = 0; j < 4; ++j) { v[j] = __expf(v[j] - mx); sm += v[j]; }
      sm = wave_sum(sm); const float inv = 1.0f / sm;
#pragma unroll
      for (int j = 0; j < 4; ++j) SC[wave * 256 + lane + 64 * j] = v[j] * inv; }
    __syncthreads();
    { f32x4 acc[8];
#pragma unroll
      for (int i = 0; i < 8; ++i) acc[i] = (f32x4){0.f, 0.f, 0.f, 0.f};
#pragma unroll 4
      for (int r = 0; r < 32; ++r) { const int m = 32 * wave + r; const f32x4 vv = *(const f32x4*)(Vc + (size_t)m * 1024);
#pragma unroll
          for (int i = 0; i < 8; ++i) acc[i] += SC[i * 256 + m] * vv; }
#pragma unroll
      for (int i = 0; i < 8; ++i) *(LAS f32x4*)(PART + (wave * 8 + i) * 256 + 4 * lane) = acc[i]; }
    __syncthreads();
    { const int q = tid >> 6, d = 4 * (tid & 63); f32x4 s = {0.f, 0.f, 0.f, 0.f};
#pragma unroll
      for (int w = 0; w < 8; ++w) s += *(const LAS f32x4*)(PART + (w * 8 + q) * 256 + d);
      u32x2* zp = (u32x2*)(ZC + (size_t)(tok0 + q) * 1024 + head * 256 + d); const u32x2 z = *zp;
      u32x2 o; o.x = pk2(s.x * bflo(z.x), s.y * bfhi(z.x)); o.y = pk2(s.z * bflo(z.y), s.w * bfhi(z.y)); *zp = o; }
    __syncthreads();
}

__device__ __forceinline__ void p4_post(const Params& p, int tid, int G) {
    unsigned char* ws = p.ws; const bf16* ORAW = (const bf16*)(ws + WS_ORAW); const bf16* U = (const bf16*)(ws + WS_U); bf16* ZA = (bf16*)(ws + WS_Z);
    const float* ST = (const float*)(ws + WS_STATS); const float* BON = (const float*)(ws + WS_BONUS);
    const float* muv = p.in[I_MU] + 2048; const float* gng = p.in[I_GNG]; const float* gnb = p.in[I_GNB]; const float* ssh = p.in[I_SSH];
    for (int i = blockIdx.x * 512 + tid; i < NT * 128; i += G * 512) {
        const int tok = i >> 7, c0 = (i & 127) * 8, h = c0 >> 6; const bool prm = tok < NPT; const int s = prm ? (tok & 2047) : ((tok - NPT) & 7); const int bs = (tok - NPT) >> 3;
        const f32x4 st = *(const f32x4*)(ST + ((size_t)tok * 16 + h) * 4);
        const float mean = (st.x + st.z) * (1.f / 64.f), var = (st.y + st.w) * (1.f / 64.f) - mean * mean, rstd = rsqrtf(fmaxf(var, 0.f) + 64e-5f), bon = BON[(size_t)tok * 16 + h];
        const u32x4 o = *(const u32x4*)(ORAW + (size_t)tok * 1024 + c0), z = *(const u32x4*)(ZA + (size_t)tok * 1024 + c0), vc = *(const u32x4*)(U + (size_t)tok * 3072 + 2048 + c0);
        float pv[8];
        if (s > 0) { const u32x4 vp = *(const u32x4*)(U + (size_t)(tok - 1) * 3072 + 2048 + c0); pv[0] = bflo(vp.x); pv[1] = bfhi(vp.x); pv[2] = bflo(vp.y); pv[3] = bfhi(vp.y); pv[4] = bflo(vp.z); pv[5] = bfhi(vp.z); pv[6] = bflo(vp.w); pv[7] = bfhi(vp.w); }
        else if (!prm) {
#pragma unroll
            for (int j = 0; j < 8; ++j) pv[j] = ssh[(size_t)bs * 3200 + 2048 + c0 + j]; }
        else {
#pragma unroll
            for (int j = 0; j < 8; ++j) pv[j] = 0.f; }
        const unsigned ow[4] = {o.x, o.y, o.z, o.w}, zw[4] = {z.x, z.y, z.z, z.w}, vw[4] = {vc.x, vc.y, vc.z, vc.w}; unsigned rw[4];
#pragma unroll
        for (int j = 0; j < 4; ++j) { float r2[2];
#pragma unroll
            for (int e = 0; e < 2; ++e) { const int c = c0 + 2 * j + e; const float ov = e ? bfhi(ow[j]) : bflo(ow[j]), zv = e ? bfhi(zw[j]) : bflo(zw[j]), uv = e ? bfhi(vw[j]) : bflo(vw[j]);
                const float v = uv + (pv[2 * j + e] - uv) * muv[c]; r2[e] = ((ov - mean) * rstd * gng[c] + gnb[c] + bon * v) * zv; }
            rw[j] = pk2(r2[0], r2[1]); }
        *(u32x4*)(ZA + (size_t)tok * 1024 + c0) = (u32x4){rw[0], rw[1], rw[2], rw[3]};
    }
}
__device__ __forceinline__ void p5_sum(const Params& p, int tid, int G) {
    unsigned char* ws = p.ws; const u32x4* P = (const u32x4*)(ws + WS_P); u32x4* M = (u32x4*)(ws + WS_MERGED); constexpr int N8 = NT * 128;
    for (int i = blockIdx.x * 512 + tid; i < N8; i += G * 512) { const u32x4 a = P[i], b = P[i + N8], c = P[i + 2 * N8]; u32x4 o;
        o.x = pk2(bflo(a.x) + bflo(b.x) + bflo(c.x), bfhi(a.x) + bfhi(b.x) + bfhi(c.x)); o.y = pk2(bflo(a.y) + bflo(b.y) + bflo(c.y), bfhi(a.y) + bfhi(b.y) + bfhi(c.y));
        o.z = pk2(bflo(a.z) + bflo(b.z) + bflo(c.z), bfhi(a.z) + bfhi(b.z) + bfhi(c.z)); o.w = pk2(bflo(a.w) + bflo(b.w) + bflo(c.w), bfhi(a.w) + bfhi(b.w) + bfhi(c.w)); M[i] = o; }
}
__device__ __forceinline__ void p6_norm(const Params& p, int wave, int lane, int G) {
    const f32x4* gf = (const f32x4*)p.in[I_GF] + lane;
    for (int m = blockIdx.x * 8 + wave; m < NT; m += G * 8) { f32x4* xr = (f32x4*)(p.out + (size_t)m * 1024) + lane; f32x4 v[4]; float s = 0.f;
#pragma unroll
        for (int j = 0; j < 4; ++j) { v[j] = xr[64 * j]; s += (v[j].x * v[j].x + v[j].y * v[j].y) + (v[j].z * v[j].z + v[j].w * v[j].w); }
        const float rstd = rsqrtf(wave_sum(s) * (1.f / 1024.f) + 1e-6f);
#pragma unroll
        for (int j = 0; j < 4; ++j) xr[64 * j] = v[j] * rstd * gf[64 * j]; }
}

#ifndef MK_LAST_PHASE
#define MK_LAST_PHASE 99
#endif
__global__ void __launch_bounds__(512, 2) fwd(Params p) {
    extern __shared__ __attribute__((aligned(16))) unsigned char lds_raw[];
    LAS unsigned char* lds = (LAS unsigned char*)lds_raw;
    cg::grid_group grid = cg::this_grid();
    const int tid = threadIdx.x, lane = tid & 63, wave = __builtin_amdgcn_readfirstlane(tid >> 6), G = gridDim.x, bx = blockIdx.x;
    unsigned char* ws = p.ws;
    p0_prologue(p, lds, tid, wave, lane, G);
    grid.sync();
    { pg8::Gemm g{(const pg8::bf16_t*)(ws + WS_XN), (const pg8::bf16_t*)(ws + WS_WIN), NT, 11520, 1024}; pg8::StaticOrder S; S.init(NT, 11520, G, bx); EpiMain E{ws};
      pg8::gemm_phase<EpiMain, pg8::StaticOrder>((PG8_LAS unsigned char*)lds, g, S, E, nullptr); }
    grid.sync();
    if (G >= 128) {
        if (bx < 64) { pg8::Gemm g{(const pg8::bf16_t*)(ws + WS_XN) + (size_t)NT * 1024, (const pg8::bf16_t*)(ws + WS_WIN) + (size_t)11520 * 1024, 2048, 2048, 1024}; SchedMem S{bx}; EpiMem E{ws, p.out};
            pg8::gemm_phase<EpiMem, SchedMem>((PG8_LAS unsigned char*)lds, g, S, E, nullptr); }
        else p2_lora(p, bx - 64, G - 64, tid, wave, lane);
    }
    grid.sync();
    for (int it = bx; it < 256; it += G) { const int b = it >> 5, h = (it >> 1) & 15, half = it & 1;
        rwkv_item(p, lds, tid, wave, lane, 2048, b * 2048, h, half, nullptr, nullptr, p.out + O_RWP + (size_t)(b * 16 + h) * 4096); }
    for (int it = bx; it < 4096; it += G) { const int b = it >> 5, h = (it >> 1) & 15, half = it & 1;
        rwkv_item(p, lds, tid, wave, lane, 8, NPT + b * 8, h, half, p.in[I_SRW] + (size_t)(b * 16 + h) * 4096, p.in[I_SSH] + (size_t)b * 3200, p.out + O_RWS + (size_t)(b * 16 + h) * 4096); }
    for (int it = bx; it < 128 + 2048; it += G) {
        if (it < 128) { const int b = it >> 4, g = it & 15; rglru_item(p, lds, tid, wave, lane, 2048, b * 2048, g, nullptr, nullptr, p.out + O_LRP + (size_t)b * 1024); }
        else { const int j = it - 128, b = j >> 4, g = j & 15; rglru_item(p, lds, tid, wave, lane, 8, NPT + b * 8, g, p.in[I_SCV] + (size_t)b * 3072, p.in[I_SLRU] + (size_t)b * 1024, p.out + O_LRS + (size_t)b * 1024); } }
    for (int it = bx * 8 + wave; it < 4096; it += G * 8) xattn_prompt_item(p, lds, wave, lane, it);
    __syncthreads();
    for (int it = bx; it < 512; it += G) xattn_sample_item(p, lds, tid, wave, lane, it);
    grid.sync();
    p4_post(p, tid, G);
    grid.sync();
    { pg8::Gemm g{(const pg8::bf16_t*)(ws + WS_Z), (const pg8::bf16_t*)(ws + WS_WBR), 3 * NT, 3072, 1024}; SchedBranch S{bx, G}; EpiBranch E{ws};
      pg8::gemm_phase<EpiBranch, SchedBranch>((PG8_LAS unsigned char*)lds, g, S, E, nullptr); }
    grid.sync();
    p5_sum(p, tid, G);
    grid.sync();
    { pg8::Gemm g{(const pg8::bf16_t*)(ws + WS_MERGED), (const pg8::bf16_t*)(ws + WS_WOUT), NT, 1024, 1024}; pg8::StaticOrder S; S.init(NT, 1024, G, bx); EpiOut E{opq(p.in[I_XP]), opq(p.in[I_XS]), p.out};
      pg8::gemm_phase<EpiOut, pg8::StaticOrder>((PG8_LAS unsigned char*)lds, g, S, E, nullptr); }
    grid.sync();
    p6_norm(p, wave, lane, G);
}
}

extern "C" void kernel_launch(void* const* d_in, const int* in_sizes, int n_in, void* d_out, int out_size, void* d_ws, size_t ws_size, hipStream_t stream) {
    static int grid = 0;
    if (grid == 0) {
        if (n_in != 35 || (size_t)out_size != mk::O_END || ws_size < mk::WS_END) { fprintf(stderr, "kernel_launch: unexpected shapes: n_in %d out %d ws %zu\n", n_in, out_size, ws_size); grid = -1; return; }
        int dev = 0, cus = 0, per_cu = 0;
        hipGetDevice(&dev); hipDeviceGetAttribute(&cus, hipDeviceAttributeMultiprocessorCount, dev);
        hipFuncSetAttribute((const void*)mk::fwd, hipFuncAttributeMaxDynamicSharedMemorySize, mk::LDS_BYTES);
        hipOccupancyMaxActiveBlocksPerMultiprocessor(&per_cu, (const void*)mk::fwd, 512, mk::LDS_BYTES);
        if (per_cu < 1) { fprintf(stderr, "kernel_launch: occupancy query says %d blocks per CU\n", per_cu); per_cu = 1; }
        grid = cus * 1;
        (void)hipGetLastError();
    }
    if (grid < 0) return;
    mk::Params p{};
    for (int i = 0; i < 35; ++i) p.in[i] = (const float*)d_in[i];
    p.out = (float*)d_out; p.ws = (unsigned char*)d_ws;
    void* args[] = {&p};
    hipError_t e = hipLaunchCooperativeKernel((const void*)mk::fwd, dim3(grid), dim3(512), args, mk::LDS_BYTES, stream);
    if (e != hipSuccess) fprintf(stderr, "cooperative launch failed: %s (grid %d)\n", hipGetErrorString(e), grid);
}
```

```cpp
#include <hip/hip_cooperative_groups.h>
#include <cstdio>
#include <hip/hip_runtime.h>
namespace pg8 {
#define PG8_LAS __attribute__((address_space(3)))
typedef unsigned short bf16_t;
typedef short bf16x8 __attribute__((ext_vector_type(8)));
typedef float f32x4 __attribute__((ext_vector_type(4)));
typedef unsigned u32x4 __attribute__((ext_vector_type(4)));
constexpr int BM = 256, BK = 64, HALF = 128, HTB = HALF * BK * 2  , STAGE_BYTES = 8 * HTB, NXCD = 8, WGM = 8;

__host__ __device__ __forceinline__ int lds_byte(int r, int c) { const int st = (r >> 4) * 2 + (c >> 5), rr = r & 15, cc = c & 31, ob = rr * 64 + cc * 2; return st * 1024 + (ob ^ (((ob >> 9) & 1) << 5)); }
__host__ __device__ __forceinline__ void stage_rc(int b, int& R, int& C) { const int st = b / 1024, sb = b % 1024, swz = sb ^ (((sb >> 9) & 1) << 5); R = (st >> 1) * 16 + swz / 64; C = (st & 1) * 32 + (swz % 64) / 2; }
__host__ __device__ __forceinline__ int perm32(int rho) { const int n = rho >> 4, i = rho & 15; return 8 * (i >> 2) + 4 * n + (i & 3); }

struct Unit { int pm, pn; };
struct Gemm { const bf16_t* A; const bf16_t* Bt; int M, N, K; };

struct StaticOrder {
    int nM, nN, nwg, G, c;
    __host__ __device__ void init(int M, int N, int G_, int c_) { nM = M / BM; nN = N / BM; nwg = nM * nN; G = G_; c = c_; }
    __host__ __device__ bool next(int i, Unit& u) const {
        const long L = (long)i * G + c; if (L >= nwg) return false;
        int wgid = (int)L; { const int q = nwg / NXCD, r = nwg % NXCD, xcd = wgid % NXCD, off = wgid / NXCD; wgid = (xcd < r ? xcd * (q + 1) : r * (q + 1) + (xcd - r) * q) + off; }
        const int nig = WGM * nN, gid = wgid / nig, fm = gid * WGM, gsz = (nM - fm) < WGM ? (nM - fm) : WGM;
        u.pm = fm + ((wgid % nig) % gsz); u.pn = (wgid % nig) / gsz; return true;
    }
    __device__ __forceinline__ void a_ready(const Unit&) const {}
    __device__ __forceinline__ void done(const Unit&) const {}
};
struct CountedOrder : StaticOrder {
    const unsigned* ready; unsigned need; unsigned* tmo;
    __device__ __forceinline__ void a_ready(const Unit& u) const {
        if (threadIdx.x < 64) {
            const unsigned long long t0 = __builtin_amdgcn_s_memrealtime(); unsigned polls = 0;
            while ((unsigned)__builtin_amdgcn_readfirstlane(__hip_atomic_load(ready + 64 * u.pm, __ATOMIC_RELAXED, __HIP_MEMORY_SCOPE_AGENT)) < need) {
                if ((++polls & 255u) == 0u && __builtin_amdgcn_readfirstlane(__hip_atomic_load(tmo, __ATOMIC_RELAXED, __HIP_MEMORY_SCOPE_AGENT)) != 0u) break;
                if (__builtin_amdgcn_s_memrealtime() - t0 > 2000000ull) {
                    if (threadIdx.x == 0) { unsigned expect = 0u; __hip_atomic_compare_exchange_strong(tmo + 1, &expect, 0x600u | (unsigned)(u.pm & 0xff), __ATOMIC_RELAXED, __ATOMIC_RELAXED, __HIP_MEMORY_SCOPE_AGENT); __hip_atomic_store(tmo, 1u, __ATOMIC_RELAXED, __HIP_MEMORY_SCOPE_AGENT); }
                    break; }
                __builtin_amdgcn_s_sleep(2); }
            __builtin_amdgcn_fence(__ATOMIC_ACQUIRE, "agent");
            asm volatile("s_waitcnt vmcnt(0)" ::: "memory");
        }
#if !defined(BROKEN_HOOK_NO_BARRIER)
        asm volatile("" ::: "memory"); __builtin_amdgcn_s_barrier(); asm volatile("" ::: "memory");
#endif
    }
};

__device__ __forceinline__ unsigned cvt_pk_bf16(float lo, float hi) { unsigned r; asm volatile("v_cvt_pk_bf16_f32 %0, %1, %2" : "=v"(r) : "v"(lo), "v"(hi)); return r; }
typedef float f32x2 __attribute__((ext_vector_type(2)));
__device__ __forceinline__ f32x2 gelu_pk(f32x2 v) {
    const f32x2 av = __builtin_elementwise_abs(v), d = av * 0.2316418882f + 1.0f;
    f32x2 t; t.x = __builtin_amdgcn_rcpf(d.x); t.y = __builtin_amdgcn_rcpf(d.y);
    f32x2 q = t * 0.5307027145f + (-0.7265760135f); q = q * t + 0.7107068705f; q = q * t + (-0.142248368f); q = q * t + 0.127414796f; q = q * t;
    const f32x2 s = (v * v) * (-0.72134752044f);
    f32x2 e; e.x = __builtin_amdgcn_exp2f(s.x); e.y = __builtin_amdgcn_exp2f(s.y);
    const f32x2 m = v * (q * e), r = v - m;
    f32x2 o; o.x = v.x < 0.f ? m.x : r.x; o.y = v.y < 0.f ? m.y : r.y; return o;
}

struct EpiF32 {
    static constexpr bool PERM = false, AFTER_DRAIN = false;
    float* C; int ldc; const float* bias;
    __device__ __forceinline__ void operator()(const f32x4 (&acc)[2][2][4][2], const Unit& u, int wr, int wc, int fr, int fq) const {
        const int row0 = u.pm * BM + wr * 64 + fr, col0 = u.pn * BM + wc * 32 + 4 * fq;
        f32x4 bv[2][2];
#pragma unroll
        for (int bj = 0; bj < 2; ++bj)
#pragma unroll
            for (int n = 0; n < 2; ++n) bv[bj][n] = bias ? *(const f32x4*)(bias + col0 + bj * HALF + n * 16) : (f32x4){0.f, 0.f, 0.f, 0.f};
#pragma unroll
        for (int ai = 0; ai < 2; ++ai)
#pragma unroll
            for (int m = 0; m < 4; ++m) { float* rowp = C + (size_t)(row0 + ai * HALF + m * 16) * ldc + col0;
#pragma unroll
                for (int bj = 0; bj < 2; ++bj)
#pragma unroll
                    for (int n = 0; n < 2; ++n) *(f32x4*)(rowp + bj * HALF + n * 16) = acc[ai][bj][m][n] + bv[bj][n]; }
    }
};
template <int ACT  > struct EpiBf16 {
    static constexpr bool PERM = true, AFTER_DRAIN = false;
    bf16_t* O; int ldc; const float* bias; int split_cols; size_t split_stride;
    __device__ __forceinline__ void operator()(const f32x4 (&acc)[2][2][4][2], const Unit& u, int wr, int wc, int fr, int fq) const {
        const int row0 = u.pm * BM + wr * 64 + fr; int colt = u.pn * BM; bf16_t* base = O;
        if (split_cols) { const int t = colt / split_cols; base += (size_t)t * split_stride; colt -= t * split_cols; }
        const int col0 = colt + wc * 32 + 8 * fq, bcol0 = u.pn * BM + wc * 32 + 8 * fq;
        f32x4 bv[2][2];
#pragma unroll
        for (int bj = 0; bj < 2; ++bj)
#pragma unroll
            for (int n = 0; n < 2; ++n) bv[bj][n] = bias ? *(const f32x4*)(bias + bcol0 + bj * HALF + 4 * n) : (f32x4){0.f, 0.f, 0.f, 0.f};
#pragma unroll
        for (int ai = 0; ai < 2; ++ai)
#pragma unroll
            for (int m = 0; m < 4; ++m) { bf16_t* rowp = base + (size_t)(row0 + ai * HALF + m * 16) * ldc + col0;
#pragma unroll
                for (int bj = 0; bj < 2; ++bj) { f32x4 v0 = acc[ai][bj][m][0] + bv[bj][0], v1 = acc[ai][bj][m][1] + bv[bj][1];
                    if (ACT == 1) { f32x2 a = gelu_pk((f32x2){v0[0], v0[1]}), b = gelu_pk((f32x2){v0[2], v0[3]}), c = gelu_pk((f32x2){v1[0], v1[1]}), d = gelu_pk((f32x2){v1[2], v1[3]});
                        v0 = (f32x4){a.x, a.y, b.x, b.y}; v1 = (f32x4){c.x, c.y, d.x, d.y}; }
                    if (ACT == 2) {
#pragma unroll
                        for (int j = 0; j < 4; ++j) { v0[j] = 0.5f * v0[j] * (1.0f + erff(v0[j] * 0.70710678f)); v1[j] = 0.5f * v1[j] * (1.0f + erff(v1[j] * 0.70710678f)); } }
                    u32x4 w; w.x = cvt_pk_bf16(v0[0], v0[1]); w.y = cvt_pk_bf16(v0[2], v0[3]); w.z = cvt_pk_bf16(v1[0], v1[1]); w.w = cvt_pk_bf16(v1[2], v1[3]);
                    *(u32x4*)(rowp + bj * HALF) = w; } }
    }
};

struct PanelStats {
    unsigned* xbuf;
    unsigned* cnt;
    unsigned* tmo;
    int ntn; float eps;
    unsigned code;
    __device__ __forceinline__ bool run(const f32x4 (&v)[2][2][4][2], const Unit& u, int wr, int wc, int fr, int fq, PG8_LAS unsigned char* lds, int wid, int lane) const {
        typedef float f32x2v __attribute__((ext_vector_type(2)));
        PG8_LAS f32x2v* P = (PG8_LAS f32x2v*)lds;
        PG8_LAS f32x2v* S = (PG8_LAS f32x2v*)(lds + 8192);
        PG8_LAS unsigned* flag = (PG8_LAS unsigned*)(lds + 8192 + 2048);
#pragma unroll
        for (int ai = 0; ai < 2; ++ai)
#pragma unroll
            for (int m = 0; m < 4; ++m) {
                float s = 0.f;
#pragma unroll
                for (int bj = 0; bj < 2; ++bj)
#pragma unroll
                    for (int n = 0; n < 2; ++n) { const f32x4 x = v[ai][bj][m][n]; s += (x[0] + x[1]) + (x[2] + x[3]); }
                s += __shfl_xor(s, 16); s += __shfl_xor(s, 32);
                const float mw = s * (1.0f / 64.0f); float q = 0.f;
#pragma unroll
                for (int bj = 0; bj < 2; ++bj)
#pragma unroll
                    for (int n = 0; n < 2; ++n) { const f32x4 d = v[ai][bj][m][n] - mw; q += (d[0] * d[0] + d[1] * d[1]) + (d[2] * d[2] + d[3] * d[3]); }
                q += __shfl_xor(q, 16); q += __shfl_xor(q, 32);
                if (fq == 0) P[(ai * HALF + wr * 64 + m * 16 + fr) * 4 + wc] = (f32x2v){mw, q};
            }
        asm volatile("s_waitcnt lgkmcnt(0)" ::: "memory"); __builtin_amdgcn_s_barrier(); asm volatile("" ::: "memory");
#if defined(BROKEN_NO_WAIT)
        if (blockIdx.x >= 64) { const long long t0 = clock64(); while (clock64() - t0 < 60000) __builtin_amdgcn_s_sleep(8); }
#endif
        const int row = wid * 32 + (lane & 31);
        if (lane < 32) {
            const f32x2v a = P[row * 4 + 0], b = P[row * 4 + 1], c = P[row * 4 + 2], d = P[row * 4 + 3];
            const float mt = (a.x + b.x + c.x + d.x) * 0.25f;
            const float da = a.x - mt, db = b.x - mt, dc = c.x - mt, dd = d.x - mt;
            const float m2 = (a.y + b.y) + (c.y + d.y) + 64.0f * ((da * da + db * db) + (dc * dc + dd * dd));
            unsigned long long* slot = (unsigned long long*)xbuf + ((size_t)(u.pm * BM + row) * 4 + u.pn);
            __hip_atomic_store(slot, ((unsigned long long)__float_as_uint(m2) << 32) | __float_as_uint(mt), __ATOMIC_RELAXED, __HIP_MEMORY_SCOPE_AGENT);
        }
        asm volatile("s_waitcnt vmcnt(0)" ::: "memory");
        if (lane == 0) __hip_atomic_fetch_add(cnt + 64 * u.pm, 1u, __ATOMIC_RELAXED, __HIP_MEMORY_SCOPE_AGENT);
        if (wid == 0) {
            bool dead = false; const unsigned long long t0 = __builtin_amdgcn_s_memrealtime(); const unsigned want = 8u * (unsigned)ntn;
            for (;;) {
#if defined(BROKEN_NO_WAIT)
                break;
#endif
                if ((unsigned)__builtin_amdgcn_readfirstlane(__hip_atomic_load(cnt + 64 * u.pm, __ATOMIC_RELAXED, __HIP_MEMORY_SCOPE_AGENT)) >= want) break;
                if (__builtin_amdgcn_s_memrealtime() - t0 > 2000000ull) {
                    if (lane == 0) { unsigned expect = 0u; __hip_atomic_compare_exchange_strong(tmo + 1, &expect, code | (unsigned)(u.pm & 0xff), __ATOMIC_RELAXED, __ATOMIC_RELAXED, __HIP_MEMORY_SCOPE_AGENT);
                                     __hip_atomic_store(tmo, 1u, __ATOMIC_RELAXED, __HIP_MEMORY_SCOPE_AGENT); }
                    dead = true; break; }
                __builtin_amdgcn_s_sleep(2);
            }
            __builtin_amdgcn_fence(__ATOMIC_ACQUIRE, "agent");
            if (lane == 0) flag[0] = dead ? 1u : 0u;
        }
        asm volatile("s_waitcnt vmcnt(0) lgkmcnt(0)" ::: "memory"); __builtin_amdgcn_s_barrier(); asm volatile("" ::: "memory");
        const bool bad = flag[0] != 0u;
        if (lane < 32) {
            const unsigned long long* slot = (const unsigned long long*)xbuf + (size_t)(u.pm * BM + row) * 4; float mt[4], m2[4]; float ms = 0.f;
#pragma unroll
            for (int t = 0; t < 4; ++t) { if (t < ntn) { const unsigned long long w = __hip_atomic_load(slot + t, __ATOMIC_RELAXED, __HIP_MEMORY_SCOPE_AGENT); mt[t] = __uint_as_float((unsigned)w); m2[t] = __uint_as_float((unsigned)(w >> 32)); } else { mt[t] = 0.f; m2[t] = 0.f; } ms += mt[t]; }
            const float mean = ms / (float)ntn; float q = 0.f;
#pragma unroll
            for (int t = 0; t < 4; ++t) if (t < ntn) { const float dm = mt[t] - mean; q += m2[t] + 256.0f * dm * dm; }
            S[row] = (f32x2v){mean, 1.0f / sqrtf(q / (256.0f * (float)ntn) + eps)};
        }
        asm volatile("s_waitcnt lgkmcnt(0)" ::: "memory"); __builtin_amdgcn_s_barrier(); asm volatile("" ::: "memory");
        return bad;
    }
};
struct EpiLnRes {
    static constexpr bool PERM = false, AFTER_DRAIN = true;
    const float* base; float* out; int ldc; const float* bias; PanelStats st; unsigned poison;
    __device__ __forceinline__ void refuse(size_t i0, size_t stride, int M, int N) const { const float q = __builtin_nanf(""); for (size_t i = i0; i < (size_t)M * N; i += stride) out[(i / N) * ldc + i % N] = q;
        if (i0 == 0) { unsigned expect = 0u; __hip_atomic_compare_exchange_strong(st.tmo + 1, &expect, 0x7f0u, __ATOMIC_RELAXED, __ATOMIC_RELAXED, __HIP_MEMORY_SCOPE_AGENT); __hip_atomic_store(st.tmo, 1u, __ATOMIC_RELAXED, __HIP_MEMORY_SCOPE_AGENT); } }
    __device__ __forceinline__ void fused(f32x4 (&acc)[2][2][4][2], const Unit& u, int wr, int wc, int fr, int fq, PG8_LAS unsigned char* lds, int wid, int lane) const {
        typedef float f32x2v __attribute__((ext_vector_type(2)));
        const PG8_LAS f32x2v* S = (const PG8_LAS f32x2v*)(lds + 8192);
        const int col0 = u.pn * BM + wc * 32 + 4 * fq;
#pragma unroll
        for (int bj = 0; bj < 2; ++bj)
#pragma unroll
            for (int n = 0; n < 2; ++n) { const f32x4 bv = bias ? *(const f32x4*)(bias + col0 + bj * HALF + n * 16) : (f32x4){0.f, 0.f, 0.f, 0.f};
#pragma unroll
                for (int ai = 0; ai < 2; ++ai)
#pragma unroll
                    for (int m = 0; m < 4; ++m) acc[ai][bj][m][n] += bv; }
        const bool bad = st.run(acc, u, wr, wc, fr, fq, lds, wid, lane) || poison != 0u;
        const float qnan = __builtin_nanf("");
#pragma unroll
        for (int ai = 0; ai < 2; ++ai)
#pragma unroll
            for (int m = 0; m < 4; ++m) { const int r = ai * HALF + wr * 64 + m * 16 + fr; const f32x2v sr = S[r]; const size_t off = (size_t)(u.pm * BM + r) * ldc + col0;
#pragma unroll
                for (int bj = 0; bj < 2; ++bj)
#pragma unroll
                    for (int n = 0; n < 2; ++n) { const f32x4 bs = *(const f32x4*)(base + off + bj * HALF + n * 16); f32x4 o = bs + (acc[ai][bj][m][n] - sr.x) * sr.y;
                        if (bad) o = (f32x4){qnan, qnan, qnan, qnan}; *(f32x4*)(out + off + bj * HALF + n * 16) = o; }
                asm volatile("" ::: "memory"); }
    }
};
struct EpiLnResLn {
    static constexpr bool PERM = false, AFTER_DRAIN = true;
    const float* base; float* out; bf16_t* xn; int ldc; const float* bias; PanelStats st1, st2; unsigned poison;
    __device__ __forceinline__ void refuse(size_t i0, size_t stride, int M, int N) const { const float q = __builtin_nanf(""); for (size_t i = i0; i < (size_t)M * N; i += stride) { const size_t o = (i / N) * ldc + i % N; out[o] = q; xn[o] = (bf16_t)0x7fc0u; }
        if (i0 == 0) { unsigned expect = 0u; __hip_atomic_compare_exchange_strong(st1.tmo + 1, &expect, 0x7f0u, __ATOMIC_RELAXED, __ATOMIC_RELAXED, __HIP_MEMORY_SCOPE_AGENT); __hip_atomic_store(st1.tmo, 1u, __ATOMIC_RELAXED, __HIP_MEMORY_SCOPE_AGENT); } }
    __device__ __forceinline__ void fused(f32x4 (&acc)[2][2][4][2], const Unit& u, int wr, int wc, int fr, int fq, PG8_LAS unsigned char* lds, int wid, int lane) const {
        typedef float f32x2v __attribute__((ext_vector_type(2))); typedef unsigned u32x2v __attribute__((ext_vector_type(2)));
        const PG8_LAS f32x2v* S = (const PG8_LAS f32x2v*)(lds + 8192);
        const int col0 = u.pn * BM + wc * 32 + 4 * fq;
#pragma unroll
        for (int bj = 0; bj < 2; ++bj)
#pragma unroll
            for (int n = 0; n < 2; ++n) { const f32x4 bv = bias ? *(const f32x4*)(bias + col0 + bj * HALF + n * 16) : (f32x4){0.f, 0.f, 0.f, 0.f};
#pragma unroll
                for (int ai = 0; ai < 2; ++ai)
#pragma unroll
                    for (int m = 0; m < 4; ++m) acc[ai][bj][m][n] += bv; }
        bool bad = st1.run(acc, u, wr, wc, fr, fq, lds, wid, lane) || poison != 0u;
        const float qnan = __builtin_nanf("");
#pragma unroll
        for (int ai = 0; ai < 2; ++ai)
#pragma unroll
            for (int m = 0; m < 4; ++m) { const int r = ai * HALF + wr * 64 + m * 16 + fr; const f32x2v sr = S[r]; const size_t off = (size_t)(u.pm * BM + r) * ldc + col0;
#pragma unroll
                for (int bj = 0; bj < 2; ++bj)
#pragma unroll
                    for (int n = 0; n < 2; ++n) { const f32x4 bs = *(const f32x4*)(base + off + bj * HALF + n * 16); acc[ai][bj][m][n] = bs + (acc[ai][bj][m][n] - sr.x) * sr.y; }
                asm volatile("" : "+v"(acc[ai][0][m][0]), "+v"(acc[ai][0][m][1]), "+v"(acc[ai][1][m][0]), "+v"(acc[ai][1][m][1]));
                if (m & 1) asm volatile("" ::: "memory"); }
        const bool bad1 = bad;
        bad = st2.run(acc, u, wr, wc, fr, fq, lds, wid, lane) || bad;
#pragma unroll
        for (int ai = 0; ai < 2; ++ai)
#pragma unroll
            for (int m = 0; m < 4; ++m) { const int r = ai * HALF + wr * 64 + m * 16 + fr; const f32x2v sr = S[r]; const size_t off = (size_t)(u.pm * BM + r) * ldc + col0;
#pragma unroll
                for (int bj = 0; bj < 2; ++bj)
#pragma unroll
                    for (int n = 0; n < 2; ++n) { const f32x4 x1 = acc[ai][bj][m][n]; *(f32x4*)(out + off + bj * HALF + n * 16) = bad1 ? (f32x4){qnan, qnan, qnan, qnan} : x1;
                        const f32x4 o = (x1 - sr.x) * sr.y; u32x2v w; w.x = cvt_pk_bf16(o[0], o[1]); w.y = cvt_pk_bf16(o[2], o[3]);
                        if (bad) { w.x = 0x7fc07fc0u; w.y = 0x7fc07fc0u; } *(u32x2v*)(xn + off + bj * HALF + n * 16) = w; }
                asm volatile("" ::: "memory"); }
    }
};

template <class Epi, class Sched, bool STAMP = false>
__device__ __forceinline__ void gemm_phase(PG8_LAS unsigned char* lds, const Gemm g, const Sched& S, const Epi& E, unsigned long long* stamps) {
    const int tid = threadIdx.x, wid = __builtin_amdgcn_readfirstlane(tid >> 6), lane = tid & 63, wr = wid >> 2, wc = wid & 3, fr = lane & 15, fq = lane >> 4;
    const int K = g.K, nt = K / BK;
    int ts_lo = 0, ts_hi = 0, nts = 0; const unsigned long long rt_entry = STAMP ? (unsigned long long)wall_clock64() : 0ull;
#define PG8_STAMP() do { if (STAMP && wid == 0 && nts < 64) { const unsigned long long _c = (unsigned long long)clock64(); \
        ts_lo = (lane == nts) ? (int)(unsigned)_c : ts_lo; ts_hi = (lane == nts) ? (int)(unsigned)(_c >> 32) : ts_hi; ++nts; } } while (0)
    PG8_STAMP();
    unsigned voffA[2], voffB[2];
#pragma unroll
    for (int i = 0; i < 2; ++i) { int R, C; stage_rc(tid * 16 + i * 8192, R, C); const int Rb = Epi::PERM ? ((R & ~31) + perm32(R & 31)) : R;
        voffA[i] = (unsigned)(R * K + C) * 2u; voffB[i] = (unsigned)(Rb * K + C) * 2u; }
    const size_t kstep = (size_t)(BK * 2);
    const size_t hstep = (size_t)HALF * K * 2;
    const size_t tstep = 2 * hstep;
    const unsigned ldsw = (unsigned)wid * 1024u;
    const int aoff = lds_byte(wr * 64 + fr, fq * 8), boff = lds_byte(wc * 32 + fr, fq * 8);
#define PG8_SA(b, h) (((b) * 2 + (h)) * HTB)
#define PG8_SB(b, h) ((4 + (b) * 2 + (h)) * HTB)
#define PG8_STAGE(bufoff, gbase, voff) do { _Pragma("unroll") for (int _i = 0; _i < 2; ++_i) \
        __builtin_amdgcn_global_load_lds((const unsigned*)((const char*)(gbase) + (voff)[_i]), (PG8_LAS unsigned*)(lds + (bufoff) + ldsw + _i * 8192), 16, 0, 0); } while (0)
#define PG8_LDA(dst, b, h) do { _Pragma("unroll") for (int m = 0; m < 4; ++m) _Pragma("unroll") for (int k = 0; k < 2; ++k) dst[m][k] = *(const PG8_LAS bf16x8*)(lds + PG8_SA(b, h) + aoff + m * 2048 + k * 1024); } while (0)
#define PG8_LDB(dst, b, h) do { _Pragma("unroll") for (int n = 0; n < 2; ++n) _Pragma("unroll") for (int k = 0; k < 2; ++k) dst[n][k] = *(const PG8_LAS bf16x8*)(lds + PG8_SB(b, h) + boff + n * 2048 + k * 1024); } while (0)
#define PG8_MMA(ai, bj, At, Bt) do { __builtin_amdgcn_s_setprio(1); _Pragma("unroll") for (int m = 0; m < 4; ++m) _Pragma("unroll") for (int n = 0; n < 2; ++n) _Pragma("unroll") for (int k = 0; k < 2; ++k) \
        acc[ai][bj][m][n] = __builtin_amdgcn_mfma_f32_16x16x32_bf16(Bt[n][k], At[m][k], acc[ai][bj][m][n], 0, 0, 0); __builtin_amdgcn_s_setprio(0); } while (0)
#define PG8_WAIT_V(n) asm volatile("s_waitcnt vmcnt(" #n ")" ::: "memory")
#define PG8_WAIT_L(n) asm volatile("s_waitcnt lgkmcnt(" #n ")" ::: "memory")
#define PG8_BAR __builtin_amdgcn_s_barrier()
#define PG8_SCHED __builtin_amdgcn_sched_barrier(0)
    Unit cur, nxt; int ui = 0;
    if (!S.next(0, cur)) return;
    f32x4 acc[2][2][4][2];
#pragma unroll
    for (int a = 0; a < 2; ++a)
#pragma unroll
        for (int b = 0; b < 2; ++b)
#pragma unroll
            for (int m = 0; m < 4; ++m)
#pragma unroll
                for (int n = 0; n < 2; ++n) acc[a][b][m][n] = (f32x4){0.f, 0.f, 0.f, 0.f};
    bf16x8 At[4][2], B0[2][2], B1[2][2];
    const char* cA = (const char*)g.A + (size_t)cur.pm * tstep; const char* cB = (const char*)g.Bt + (size_t)cur.pn * tstep;
    S.a_ready(cur);
    PG8_STAGE(PG8_SB(0, 0), cB, voffB); PG8_STAGE(PG8_SA(0, 0), cA, voffA); PG8_STAGE(PG8_SB(0, 1), cB + hstep, voffB); PG8_STAGE(PG8_SA(0, 1), cA + hstep, voffA);
    if (wr == 1) PG8_BAR;
    PG8_WAIT_V(4); PG8_BAR;
    PG8_STAGE(PG8_SB(1, 0), cB + kstep, voffB); PG8_STAGE(PG8_SA(1, 0), cA + kstep, voffA); PG8_STAGE(PG8_SB(1, 1), cB + hstep + kstep, voffB);
    PG8_WAIT_V(6); PG8_BAR;
    PG8_STAMP();
    for (;;) {
        const bool has_next = S.next(ui + 1, nxt);
        const char* nA = has_next ? (const char*)g.A + (size_t)nxt.pm * tstep : cA; const char* nB = has_next ? (const char*)g.Bt + (size_t)nxt.pn * tstep : cB;
        for (int t = 0; t < nt; t += 2) {
            const bool last = (t == nt - 2);
            const char* a1 = cA + (size_t)(t + 1) * kstep;
            const char* a2 = last ? nA : cA + (size_t)(t + 2) * kstep; const char* b2 = last ? nB : cB + (size_t)(t + 2) * kstep;
            const char* a3 = a2 + kstep; const char* b3 = b2 + kstep;
            if (last && has_next) S.a_ready(nxt);
            PG8_LDB(B0, 0, 0); PG8_SCHED; PG8_LDA(At, 0, 0); PG8_STAGE(PG8_SA(1, 1), a1 + hstep, voffA);
            PG8_WAIT_L(8); PG8_BAR; PG8_WAIT_L(0); PG8_MMA(0, 0, At, B0); PG8_BAR; PG8_SCHED;
            PG8_LDB(B1, 0, 1); PG8_STAGE(PG8_SB(0, 0), b2, voffB);
            PG8_BAR; PG8_WAIT_L(0); PG8_MMA(0, 1, At, B1); PG8_BAR;
            PG8_LDA(At, 0, 1); PG8_STAGE(PG8_SA(0, 0), a2, voffA);
            PG8_BAR; PG8_WAIT_L(0); PG8_MMA(1, 0, At, B0); PG8_BAR; PG8_SCHED;
            PG8_STAGE(PG8_SB(0, 1), b2 + hstep, voffB);
            PG8_WAIT_V(6); PG8_BAR; PG8_MMA(1, 1, At, B1); PG8_BAR;
            PG8_LDB(B0, 1, 0); PG8_SCHED; PG8_LDA(At, 1, 0); PG8_STAGE(PG8_SA(0, 1), a2 + hstep, voffA);
            PG8_WAIT_L(8); PG8_BAR; PG8_WAIT_L(0); PG8_MMA(0, 0, At, B0); PG8_BAR; PG8_SCHED;
            PG8_LDB(B1, 1, 1); PG8_STAGE(PG8_SB(1, 0), b3, voffB);
            PG8_BAR; PG8_WAIT_L(0); PG8_MMA(0, 1, At, B1); PG8_BAR;
            PG8_LDA(At, 1, 1); PG8_STAGE(PG8_SA(1, 0), a3, voffA);
            PG8_BAR; PG8_WAIT_L(0); PG8_MMA(1, 0, At, B0); PG8_BAR; PG8_SCHED;
            PG8_STAGE(PG8_SB(1, 1), b3 + hstep, voffB);
            PG8_WAIT_V(6); PG8_BAR; PG8_MMA(1, 1, At, B1); PG8_BAR;
        }
        PG8_STAMP();
        if constexpr (!Epi::AFTER_DRAIN) { E(acc, cur, wr, wc, fr, fq); S.done(cur); }
        PG8_STAMP();
        if (!has_next) break;
        if (!Epi::keep(nxt))
#pragma unroll
        for (int a = 0; a < 2; ++a)
#pragma unroll
            for (int b = 0; b < 2; ++b)
#pragma unroll
                for (int m = 0; m < 4; ++m)
#pragma unroll
                    for (int n = 0; n < 2; ++n) acc[a][b][m][n] = (f32x4){0.f, 0.f, 0.f, 0.f};
        cur = nxt; cA = nA; cB = nB; ++ui;
    }
    PG8_WAIT_V(0);
    if (wr == 0) PG8_BAR;
    PG8_BAR;
    if constexpr (Epi::AFTER_DRAIN) { E.fused(acc, cur, wr, wc, fr, fq, lds, wid, lane); S.done(cur); }
    PG8_STAMP();
    if (STAMP && wid == 0) { stamps[lane] = lane < nts ? (((unsigned long long)(unsigned)ts_hi << 32) | (unsigned)ts_lo) : 0ull;
        if (lane == 62) stamps[62] = rt_entry; if (lane == 63) stamps[63] = (unsigned long long)wall_clock64(); }
#undef PG8_STAMP
#undef PG8_SA
#undef PG8_SB
#undef PG8_STAGE
#undef PG8_LDA
#undef PG8_LDB
#undef PG8_MMA
#undef PG8_WAIT_V
#undef PG8_WAIT_L
#undef PG8_BAR
#undef PG8_SCHED
}
}

namespace mk {
namespace cg = cooperative_groups;
#define LAS __attribute__((address_space(3)))
typedef unsigned short bf16;
typedef short bf16x8 __attribute__((ext_vector_type(8)));
typedef float f32x4 __attribute__((ext_vector_type(4)));
typedef float f32x2 __attribute__((ext_vector_type(2)));
typedef unsigned u32x4 __attribute__((ext_vector_type(4)));
typedef unsigned u32x2 __attribute__((ext_vector_type(2)));

constexpr int NT = 17408, NPT = 16384, DM = 1024;
constexpr size_t MiB = 1u << 20;
constexpr size_t WS_WIN = 0, WS_WBR = 28 * MiB, WS_WOUT = 34 * MiB, WS_WDEC = 36 * MiB, WS_WAAA = WS_WDEC + 131072, WS_WRGA = WS_WAAA + 131072, WS_WRGX = WS_WRGA + 131072;
constexpr size_t WS_XN = 38 * MiB, WS_U = 76 * MiB, WS_Z = 178 * MiB, WS_XB = 280 * MiB, WS_Q = 314 * MiB, WS_G = 348 * MiB, WS_XWA = 450 * MiB;
constexpr size_t WS_MK = 459 * MiB, WS_MVT = 463 * MiB, WS_BONUS = 467 * MiB, WS_STATS = 469 * MiB, WS_CTR = 474 * MiB, WS_END = 475 * MiB;
constexpr size_t WS_ORAW = WS_XN, WS_P = WS_U, WS_MERGED = WS_XB;
constexpr size_t ZSTRIDE = (size_t)NT * DM;
constexpr int LDS_BYTES = 147456;
constexpr size_t O_Y = 0, O_RWP = 17825792, O_SHP = O_RWP + 524288, O_LRP = O_SHP + 25600, O_CVP = O_LRP + 8192, O_MKP = O_CVP + 24576, O_MVP = O_MKP + 2097152,
                 O_RWS = O_MVP + 2097152, O_SHS = O_RWS + 8388608, O_LRS = O_SHS + 409600, O_CVS = O_LRS + 131072, O_END = O_CVS + 393216;

struct Params { const float* in[35]; float* out; unsigned char* ws; int zero; int pad; };
#define PREF const __attribute__((address_space(4))) Params&
typedef const __attribute__((address_space(4))) Params CParams;
__device__ __forceinline__ CParams* launder(CParams* x) { asm volatile("" : "+s"(x)); return x; }
enum { I_XP = 0, I_XS, I_MEM, I_SRW, I_SSH, I_SLRU, I_SCV, I_CK, I_CV, I_GN, I_WIN, I_MU, I_W0, I_WDEC, I_A0, I_WAAA, I_KK, I_KA, I_RK, I_GNG, I_GNB, I_CW, I_CB, I_WRGA, I_BRGA, I_WRGX, I_BRGX, I_LAM, I_GMEM, I_WMEM, I_WBA, I_WBB, I_WBC, I_WOUT, I_GF };

__device__ __forceinline__ unsigned f2bf(float f) { unsigned u = __builtin_bit_cast(unsigned, f); return (u + 0x7fffu + ((u >> 16) & 1u)) >> 16; }
__device__ __forceinline__ unsigned pk2(float lo, float hi) { unsigned r; asm("v_cvt_pk_bf16_f32 %0, %1, %2" : "=v"(r) : "v"(lo), "v"(hi)); return r; }
__device__ __forceinline__ float bf2f(unsigned b) { return __builtin_bit_cast(float, b << 16); }
__device__ __forceinline__ float bflo(unsigned w) { return __builtin_bit_cast(float, w << 16); }
__device__ __forceinline__ float bfhi(unsigned w) { return __builtin_bit_cast(float, w & 0xffff0000u); }
__device__ __forceinline__ const float* opq(const float* x) { asm volatile("" : "+s"(x)); return x; }
__device__ __forceinline__ float sigm(float x) { return __builtin_amdgcn_rcpf(1.0f + __builtin_amdgcn_exp2f(x * -1.44269504f)); }
#define LDS_WAIT() asm volatile("s_waitcnt lgkmcnt(0)" ::: "memory")
template <int CTRL> __device__ __forceinline__ float dppf(float x) { return __builtin_bit_cast(float, __builtin_amdgcn_update_dpp(0, __builtin_bit_cast(int, x), CTRL, 0xF, 0xF, true)); }
__device__ __forceinline__ float row16_sum(float x) { x += dppf<0xB1>(x); x += dppf<0x4E>(x); x += dppf<0x141>(x); x += dppf<0x140>(x); return x; }
__device__ __forceinline__ float row16_max(float x) { x = fmaxf(x, dppf<0xB1>(x)); x = fmaxf(x, dppf<0x4E>(x)); x = fmaxf(x, dppf<0x141>(x)); x = fmaxf(x, dppf<0x140>(x)); return x; }
__device__ __forceinline__ float rdl(float x, int l) { return __builtin_bit_cast(float, __builtin_amdgcn_readlane(__builtin_bit_cast(int, x), l)); }
__device__ __forceinline__ float wave_sum(float x) { x = row16_sum(x); return (rdl(x, 0) + rdl(x, 16)) + (rdl(x, 32) + rdl(x, 48)); }
__device__ __forceinline__ float wave_max(float x) { x = row16_max(x); x = fmaxf(x, __shfl_xor(x, 16)); x = fmaxf(x, __shfl_xor(x, 32)); return x; }

struct EpiMain {
    static constexpr bool PERM = true, AFTER_DRAIN = false;
    static __device__ __forceinline__ bool keep(const pg8::Unit&) { return false; }
    unsigned char* ws;
    __device__ __forceinline__ void operator()(const pg8::f32x4 (&acc)[2][2][4][2], const pg8::Unit& u, int wr, int wc, int fr, int fq) const {
        const int pn = u.pn, row0 = u.pm * 256 + wr * 64 + fr;
        if (pn == 44) {
            float* X = (float*)(ws + WS_XWA);
#pragma unroll
            for (int ai = 0; ai < 2; ++ai)
#pragma unroll
                for (int m = 0; m < 4; ++m) { float* rp = X + (size_t)(row0 + ai * 128 + m * 16) * 128 + wc * 32 + 8 * fq;
                    *(f32x4*)rp = acc[ai][0][m][0]; *(f32x4*)(rp + 4) = acc[ai][0][m][1]; }
            return;
        }
        bf16* base; int ld, colt, act;
        if (pn < 12) { base = (bf16*)(ws + WS_U); ld = 3072; colt = pn * 256; act = 0; }
        else if (pn < 16) { base = (bf16*)(ws + WS_Z); ld = 1024; colt = (pn - 12) * 256; act = 1; }
        else if (pn < 20) { base = (bf16*)(ws + WS_XB); ld = 1024; colt = (pn - 16) * 256; act = 0; }
        else if (pn < 24) { base = (bf16*)(ws + WS_Z) + ZSTRIDE; ld = 1024; colt = (pn - 20) * 256; act = 1; }
        else if (pn < 28) { base = (bf16*)(ws + WS_Q); ld = 1024; colt = (pn - 24) * 256; act = 0; }
        else if (pn < 32) { base = (bf16*)(ws + WS_Z) + 2 * ZSTRIDE; ld = 1024; colt = (pn - 28) * 256; act = 1; }
        else { base = (bf16*)(ws + WS_G); ld = 3072; colt = (pn - 32) * 256; act = 2; }
        const int col0 = colt + wc * 32 + 8 * fq;
#pragma unroll
        for (int ai = 0; ai < 2; ++ai)
#pragma unroll
            for (int m = 0; m < 4; ++m) { bf16* rowp = base + (size_t)(row0 + ai * 128 + m * 16) * ld + col0;
#pragma unroll
                for (int bj = 0; bj < 2; ++bj) { pg8::f32x4 v0 = acc[ai][bj][m][0], v1 = acc[ai][bj][m][1];
                    if (act) {
#pragma unroll
                        for (int j = 0; j < 4; ++j) { const float s0 = sigm(v0[j]), s1 = sigm(v1[j]); v0[j] = act == 1 ? v0[j] * s0 : s0; v1[j] = act == 1 ? v1[j] * s1 : s1; } }
                    u32x4 w; w.x = pk2(v0[0], v0[1]); w.y = pk2(v0[2], v0[3]); w.z = pk2(v1[0], v1[1]); w.w = pk2(v1[2], v1[3]);
                    *(u32x4*)(rowp + bj * 128) = w; } }
    }
};
struct EpiMem {
    static constexpr bool PERM = false, AFTER_DRAIN = false;
    static __device__ __forceinline__ bool keep(const pg8::Unit&) { return false; }
    unsigned char* ws; float* out;
    __device__ __forceinline__ void operator()(const pg8::f32x4 (&acc)[2][2][4][2], const pg8::Unit& u, int wr, int wc, int fr, int fq) const {
        const int row0 = u.pm * 256 + wr * 64 + fr; const bool isv = u.pn >= 4; const int colt = (u.pn & 3) * 256 + wc * 32 + 4 * fq;
        float* of = out + (isv ? O_MVP : O_MKP); bf16* MK = (bf16*)(ws + WS_MK); bf16* MVT = (bf16*)(ws + WS_MVT);
#pragma unroll
        for (int ai = 0; ai < 2; ++ai)
#pragma unroll
            for (int m = 0; m < 4; ++m) { const int r = row0 + ai * 128 + m * 16;
#pragma unroll
                for (int bj = 0; bj < 2; ++bj)
#pragma unroll
                    for (int n = 0; n < 2; ++n) { const int c = colt + bj * 128 + n * 16; const pg8::f32x4 v = acc[ai][bj][m][n];
                        *(f32x4*)(of + (size_t)r * 1024 + c) = v;
                        if (!isv) { u32x2 w; w.x = pk2(v[0], v[1]); w.y = pk2(v[2], v[3]); *(u32x2*)(MK + (size_t)r * 1024 + c) = w; }
                        else { const int b = r >> 8, mem = r & 255, head = c >> 8, d = c & 255; bf16* q = MVT + ((size_t)((b * 4 + head) * 256 + d)) * 256 + mem;
                            q[0] = (bf16)f2bf(v[0]); q[256] = (bf16)f2bf(v[1]); q[512] = (bf16)f2bf(v[2]); q[768] = (bf16)f2bf(v[3]); } } }
    }
};
struct SchedMem { int c;
    __device__ bool next(int i, pg8::Unit& u) const { if (i != 0 || c >= 64) return false; u.pm = c >> 3; u.pn = c & 7; return true; }
    __device__ __forceinline__ void a_ready(const pg8::Unit&) const {}
    __device__ __forceinline__ void done(const pg8::Unit&) const {}
};
struct EpiTail {
    static constexpr bool PERM = true, AFTER_DRAIN = false;
    static __device__ __forceinline__ bool keep(const pg8::Unit& nxt) { return (nxt.pn >> 2) != 0; }
    unsigned char* ws;
    __device__ __forceinline__ void operator()(pg8::f32x4 (&acc)[2][2][4][2], const pg8::Unit& u, int wr, int wc, int fr, int fq) const {
        const int br = u.pn >> 2, pmm = u.pm - br * 68, pnn = u.pn & 3;
        const int row0 = pmm * 256 + wr * 64 + fr, col0 = pnn * 256 + wc * 32 + 8 * fq;
        const bf16* gbase = (const bf16*)(ws + WS_G) + (size_t)row0 * 3072 + br * 1024 + col0; const int hoff = br < 2 ? 1024 : 0; const bool last = br == 2;
#define MK_CLAMP8(g, f0, f1) pg8::f32x4 f0 = {fmaxf(bflo(g.x), 1e-20f), fmaxf(bfhi(g.x), 1e-20f), fmaxf(bflo(g.y), 1e-20f), fmaxf(bfhi(g.y), 1e-20f)}, f1 = {fmaxf(bflo(g.z), 1e-20f), fmaxf(bfhi(g.z), 1e-20f), fmaxf(bflo(g.w), 1e-20f), fmaxf(bfhi(g.w), 1e-20f)}
#pragma unroll
        for (int ai = 0; ai < 2; ++ai)
#pragma unroll
            for (int m = 0; m < 4; ++m) {
#pragma unroll
                for (int bj = 0; bj < 2; ++bj) { const bf16* gp = gbase + (size_t)(ai * 128 + m * 16) * 3072 + bj * 128; const u32x4 g = *(const u32x4*)gp, h = *(const u32x4*)(gp + hoff);
                    MK_CLAMP8(g, f0, f1); MK_CLAMP8(h, d0, d1);
#pragma unroll
                    for (int j = 0; j < 4; ++j) { d0[j] = last ? 1.0f : __builtin_amdgcn_rcpf(d0[j]); d1[j] = last ? 1.0f : __builtin_amdgcn_rcpf(d1[j]); }
                    acc[ai][bj][m][0] *= f0 * d0; acc[ai][bj][m][1] *= f1 * d1; }
                asm volatile("" ::: "memory"); }
#undef MK_CLAMP8
        if (last) { bf16* mbase = (bf16*)(ws + WS_MERGED) + (size_t)row0 * 1024 + col0;
#pragma unroll
            for (int ai = 0; ai < 2; ++ai)
#pragma unroll
                for (int m = 0; m < 4; ++m)
#pragma unroll
                    for (int bj = 0; bj < 2; ++bj) { const pg8::f32x4 v0 = acc[ai][bj][m][0], v1 = acc[ai][bj][m][1];
                        u32x4 w; w.x = pk2(v0[0], v0[1]); w.y = pk2(v0[2], v0[3]); w.z = pk2(v1[0], v1[1]); w.w = pk2(v1[2], v1[3]); *(u32x4*)(mbase + (size_t)(ai * 128 + m * 16) * 1024 + bj * 128) = w; } }
    }
};
struct SchedTail { int c;
    __device__ bool next(int i, pg8::Unit& u) const { if (i >= 3) return false; const int t = (c & 7) * 32 + (c >> 3); u.pm = i * 68 + (t >> 2); u.pn = i * 4 + (t & 3); return true; }
    __device__ __forceinline__ void a_ready(const pg8::Unit&) const {}
    __device__ __forceinline__ void done(const pg8::Unit&) const {}
};
struct EpiBranch {
    static constexpr bool PERM = true, AFTER_DRAIN = false;
    static __device__ __forceinline__ bool keep(const pg8::Unit&) { return false; }
    unsigned char* ws;
    __device__ __forceinline__ void operator()(const pg8::f32x4 (&acc)[2][2][4][2], const pg8::Unit& u, int wr, int wc, int fr, int fq) const {
        const int br = u.pn >> 2, pmm = u.pm - br * 68, pnn = u.pn & 3;
        const int row0 = pmm * 256 + wr * 64 + fr, col0 = pnn * 256 + wc * 32 + 8 * fq;
        const bf16* G = (const bf16*)(ws + WS_G) + br * 1024; bf16* P = (bf16*)(ws + WS_P) + (size_t)br * ZSTRIDE;
#pragma unroll
        for (int ai = 0; ai < 2; ++ai)
#pragma unroll
            for (int m = 0; m < 4; ++m) { const int r = row0 + ai * 128 + m * 16;
#pragma unroll
                for (int bj = 0; bj < 2; ++bj) { const u32x4 g = *(const u32x4*)(G + (size_t)r * 3072 + col0 + bj * 128); const pg8::f32x4 v0 = acc[ai][bj][m][0], v1 = acc[ai][bj][m][1];
                    u32x4 w; w.x = pk2(v0[0] * bflo(g.x), v0[1] * bfhi(g.x)); w.y = pk2(v0[2] * bflo(g.y), v0[3] * bfhi(g.y)); w.z = pk2(v1[0] * bflo(g.z), v1[1] * bfhi(g.z)); w.w = pk2(v1[2] * bflo(g.w), v1[3] * bfhi(g.w));
                    *(u32x4*)(P + (size_t)r * 1024 + col0 + bj * 128) = w; } }
    }
};
struct SchedBrS { int c;
    __device__ bool next(int i, pg8::Unit& u) const { if (i != 0 || c >= 48) return false; const int br = c >> 4, t = c & 15; u.pm = br * 68 + 64 + (t >> 2); u.pn = br * 4 + (t & 3); return true; }
    __device__ __forceinline__ void a_ready(const pg8::Unit&) const {}
    __device__ __forceinline__ void done(const pg8::Unit&) const {}
};
struct SchedOutS { int c;
    __device__ bool next(int i, pg8::Unit& u) const { if (i != 0 || c >= 16) return false; u.pm = 64 + (c >> 2); u.pn = c & 3; return true; }
    __device__ __forceinline__ void a_ready(const pg8::Unit&) const {}
    __device__ __forceinline__ void done(const pg8::Unit&) const {}
};
struct EpiOut {
    static constexpr bool PERM = false, AFTER_DRAIN = false;
    static __device__ __forceinline__ bool keep(const pg8::Unit&) { return false; }
    const float* xp; const float* xs; float* out;
    __device__ __forceinline__ void operator()(const pg8::f32x4 (&acc)[2][2][4][2], const pg8::Unit& u, int wr, int wc, int fr, int fq) const {
        const int row0 = u.pm * 256 + wr * 64 + fr, col0 = u.pn * 256 + wc * 32 + 4 * fq;
#pragma unroll
        for (int ai = 0; ai < 2; ++ai)
#pragma unroll
            for (int m = 0; m < 4; ++m) { const int r = row0 + ai * 128 + m * 16; const float* xr = (r < NPT ? xp + (size_t)r * 1024 : xs + (size_t)(r - NPT) * 1024) + col0; float* orow = out + (size_t)r * 1024 + col0;
#pragma unroll
                for (int bj = 0; bj < 2; ++bj)
#pragma unroll
                    for (int n = 0; n < 2; ++n) *(f32x4*)(orow + bj * 128 + n * 16) = *(const f32x4*)(xr + bj * 128 + n * 16) + acc[ai][bj][m][n]; }
    }
};

__device__ __forceinline__ void transpose_item(const float* W, int K, int N, bf16* WT, int row_off, LAS float* scr, int item, int lane) {
    const int nblk = N / 32, kb = item / nblk, nb = item % nblk, k0 = 64 * kb, n0 = 32 * nb;
    float tv[32];
#pragma unroll
    for (int i = 0; i < 32; ++i) tv[i] = W[(size_t)(k0 + 2 * i + (lane >> 5)) * N + n0 + (lane & 31)];
#pragma unroll
    for (int i = 0; i < 32; ++i) scr[(2 * i + (lane >> 5)) * 33 + (lane & 31)] = tv[i];
    LDS_WAIT();
    const int c = lane & 7;
#pragma unroll
    for (int j = 0; j < 4; ++j) { const int n = (lane >> 3) + 8 * j; const LAS float* s = scr + (8 * c) * 33 + n;
        u32x4 o; o.x = pk2(s[0 * 33], s[1 * 33]); o.y = pk2(s[2 * 33], s[3 * 33]); o.z = pk2(s[4 * 33], s[5 * 33]); o.w = pk2(s[6 * 33], s[7 * 33]);
        *(u32x4*)(WT + (size_t)(row_off + n0 + n) * K + k0 + 8 * c) = o; }
    LDS_WAIT();
}
__device__ __forceinline__ void rms_row_to_bf16(const float* xrow, const float* g, bf16* orow, int lane) {
    const f32x4* xr = (const f32x4*)xrow + lane; const f32x4* gr = (const f32x4*)g + lane;
    f32x4 v[4]; float s = 0.f;
#pragma unroll
    for (int j = 0; j < 4; ++j) { v[j] = xr[64 * j]; s += (v[j].x * v[j].x + v[j].y * v[j].y) + (v[j].z * v[j].z + v[j].w * v[j].w); }
    const float rstd = rsqrtf(wave_sum(s) * (1.f / 1024.f) + 1e-6f);
    unsigned long long* o8 = (unsigned long long*)orow + lane;
#pragma unroll
    for (int j = 0; j < 4; ++j) { const f32x4 gg = gr[64 * j]; o8[64 * j] = (unsigned long long)pk2(v[j].x * rstd * gg.x, v[j].y * rstd * gg.y) | ((unsigned long long)pk2(v[j].z * rstd * gg.z, v[j].w * rstd * gg.w) << 32); }
}
__device__ __forceinline__ void p0_prologue(PREF p, LAS unsigned char* lds, int tid, int wave, int lane, int G) {
    unsigned char* ws = p.ws;
    LAS float* scr = (LAS float*)(lds + wave * 16384);
    const int gw = blockIdx.x * 8 + wave, NGW = G * 8;
    bf16* WIN = (bf16*)(ws + WS_WIN);
    constexpr int I_IN = 16 * 356, I_MM = 16 * 64, I_B = 16 * 32, I_L = 32, I_R = 2;
    constexpr int NITEMS = I_IN + I_MM + 4 * I_B + 2 * I_L + 32 * I_R;
    for (int it = gw; it < NITEMS; it += NGW) {
        int r = it;
        if (r < I_IN) { const int n0 = 32 * (r % 356); const int dst = n0 < 3072 ? n0 : (n0 < 3200 ? 11264 + n0 - 3072 : n0 - 128); transpose_item(p.in[I_WIN], 1024, 11392, WIN, dst - n0, scr, r, lane); continue; } r -= I_IN;
        if (r < I_MM) { transpose_item(p.in[I_WMEM], 1024, 2048, WIN + (size_t)11520 * 1024, 0, scr, r, lane); continue; } r -= I_MM;
        if (r < 3 * I_B) { const int br = r / I_B; const float* wa = opq(p.in[I_WBA]); const float* wb = opq(p.in[I_WBB]); const float* wc = opq(p.in[I_WBC]); transpose_item(br == 0 ? wa : (br == 1 ? wb : wc), 1024, 1024, (bf16*)(ws + WS_WBR) + (size_t)br * 1024 * 1024, 0, scr, r - br * I_B, lane); continue; } r -= 3 * I_B;
        if (r < I_B) { transpose_item(p.in[I_WOUT], 1024, 1024, (bf16*)(ws + WS_WOUT), 0, scr, r, lane); continue; } r -= I_B;
        if (r < I_L) { transpose_item(p.in[I_WDEC], 64, 1024, (bf16*)(ws + WS_WDEC), 0, scr, r, lane); continue; } r -= I_L;
        if (r < I_L) { transpose_item(p.in[I_WAAA], 64, 1024, (bf16*)(ws + WS_WAAA), 0, scr, r, lane); continue; } r -= I_L;
        { const int which = r / 32, rr = r % 32, g = rr >> 1, sub = rr & 1;
          const float* ra = opq(p.in[I_WRGA]); const float* rx = opq(p.in[I_WRGX]); transpose_item((which ? rx : ra) + g * 4096, 64, 64, (bf16*)(ws + (which ? WS_WRGX : WS_WRGA)) + g * 4096, 0, scr, sub, lane); }
    }
    if (blockIdx.x == 0) for (int i = tid; i < 8192; i += 512) ((unsigned*)(ws + WS_CTR))[i] = 0u;
    { u32x4* z = (u32x4*)(WIN + (size_t)11392 * 1024); const u32x4 zero = {0u, 0u, 0u, 0u}; for (int i = blockIdx.x * 512 + tid; i < 128 * 1024 / 8; i += G * 512) z[i] = zero; }
    bf16* XN = (bf16*)(ws + WS_XN);
    const float* pxp = opq(p.in[I_XP]); const float* pxs = opq(p.in[I_XS]); const float* pmem = opq(p.in[I_MEM]); const float* pgn = opq(p.in[I_GN]); const float* pgm = opq(p.in[I_GMEM]);
    for (int m0 = gw; m0 < NT + 2048; m0 += 2 * NGW) {
        const float* src[2]; const float* g[2]; bf16* dst[2]; f32x4 v[2][4]; float ss[2];
#pragma unroll
        for (int q = 0; q < 2; ++q) { int m = m0 + q * NGW; if (m >= NT + 2048) m = m0;
            if (m < NPT) { src[q] = pxp + (size_t)m * 1024; g[q] = pgn; } else if (m < NT) { src[q] = pxs + (size_t)(m - NPT) * 1024; g[q] = pgn; } else { src[q] = pmem + (size_t)(m - NT) * 1024; g[q] = pgm; }
            dst[q] = XN + (size_t)m * 1024; }
#pragma unroll
        for (int q = 0; q < 2; ++q) { const f32x4* xr = (const f32x4*)src[q] + lane; float s2 = 0.f;
#pragma unroll
            for (int j = 0; j < 4; ++j) { v[q][j] = xr[64 * j]; }
#pragma unroll
            for (int j = 0; j < 4; ++j) s2 += (v[q][j].x * v[q][j].x + v[q][j].y * v[q][j].y) + (v[q][j].z * v[q][j].z + v[q][j].w * v[q][j].w);
            ss[q] = s2; }
#pragma unroll
        for (int q = 0; q < 2; ++q) { const float rstd = rsqrtf(wave_sum(ss[q]) * (1.f / 1024.f) + 1e-6f); const f32x4* gr = (const f32x4*)g[q] + lane; unsigned long long* o8 = (unsigned long long*)dst[q] + lane;
#pragma unroll
            for (int j = 0; j < 4; ++j) { const f32x4 gg = gr[64 * j]; o8[64 * j] = (unsigned long long)pk2(v[q][j].x * rstd * gg.x, v[q][j].y * rstd * gg.y) | ((unsigned long long)pk2(v[q][j].z * rstd * gg.z, v[q][j].w * rstd * gg.w) << 32); } }
    }
}

__device__ __forceinline__ bf16x8 pack8(const float (&x)[8]) { u32x4 w; w.x = pk2(x[0], x[1]); w.y = pk2(x[2], x[3]); w.z = pk2(x[4], x[5]); w.w = pk2(x[6], x[7]); return __builtin_bit_cast(bf16x8, w); }
__device__ __forceinline__ void p2_lora(PREF p, int vb, int NB, int tid, int wave, int lane) {
    unsigned char* ws = p.ws;
    const float* XWA = (const float*)(ws + WS_XWA); const bf16* U = (const bf16*)(ws + WS_U); const bf16* XB = (const bf16*)(ws + WS_XB);
    const bf16* WDEC = (const bf16*)(ws + WS_WDEC); const bf16* WAAA = (const bf16*)(ws + WS_WAAA);
    bf16* E = (bf16*)p.out; bf16* A = E + ZSTRIDE;
    const float* mu = p.in[I_MU]; const float* w0 = p.in[I_W0]; const float* a0 = p.in[I_A0]; const float* ssh = p.in[I_SSH];
    const int trow = lane & 15, kg = lane >> 4;
    for (int item = vb * 8 + wave; item < NT / 16; item += NB * 8) {
        const int tok = item * 16 + trow; const bool prm = tok < NPT; const int s = prm ? (tok & 2047) : ((tok - NPT) & 7); const int bs = (tok - NPT) >> 3;
        bf16x8 Aw[2], Aa[2];
#pragma unroll
        for (int ks = 0; ks < 2; ++ks) { const int k0 = 32 * ks + 8 * kg; float xw[8], xa[8];
#pragma unroll
            for (int hlf = 0; hlf < 2; ++hlf) {
                const f32x4 cw = *(const f32x4*)(XWA + (size_t)tok * 128 + k0 + 4 * hlf), ca = *(const f32x4*)(XWA + (size_t)tok * 128 + 64 + k0 + 4 * hlf);
                f32x4 pw = {0.f, 0.f, 0.f, 0.f}, pa = {0.f, 0.f, 0.f, 0.f};
                if (s > 0) { pw = *(const f32x4*)(XWA + (size_t)(tok - 1) * 128 + k0 + 4 * hlf); pa = *(const f32x4*)(XWA + (size_t)(tok - 1) * 128 + 64 + k0 + 4 * hlf); }
                else if (!prm) { pw = *(const f32x4*)(ssh + (size_t)bs * 3200 + 3072 + k0 + 4 * hlf); pa = *(const f32x4*)(ssh + (size_t)bs * 3200 + 3136 + k0 + 4 * hlf); }
                const f32x4 mw = *(const f32x4*)(mu + 3072 + k0 + 4 * hlf), ma = *(const f32x4*)(mu + 3136 + k0 + 4 * hlf);
#pragma unroll
                for (int j = 0; j < 4; ++j) { const float xs = cw[j] + (pw[j] - cw[j]) * mw[j]; xw[4 * hlf + j] = 1.0f - 2.0f / (1.0f + __expf(2.0f * xs)); xa[4 * hlf + j] = ca[j] + (pa[j] - ca[j]) * ma[j]; }
            }
            Aw[ks] = pack8(xw); Aa[ks] = pack8(xa); }
        const size_t orow = (size_t)(item * 16 + trow) * 1024 + 4 * kg;
#pragma unroll 4
        for (int ct = 0; ct < 64; ++ct) { const int n = 16 * ct + trow;
            const bf16x8 bd0 = *(const bf16x8*)(WDEC + n * 64 + 8 * kg), bd1 = *(const bf16x8*)(WDEC + n * 64 + 32 + 8 * kg), ba0 = *(const bf16x8*)(WAAA + n * 64 + 8 * kg), ba1 = *(const bf16x8*)(WAAA + n * 64 + 32 + 8 * kg);
            f32x4 ad = {0.f, 0.f, 0.f, 0.f}, aa = {0.f, 0.f, 0.f, 0.f};
            ad = __builtin_amdgcn_mfma_f32_16x16x32_bf16(bd0, Aw[0], ad, 0, 0, 0); ad = __builtin_amdgcn_mfma_f32_16x16x32_bf16(bd1, Aw[1], ad, 0, 0, 0);
            aa = __builtin_amdgcn_mfma_f32_16x16x32_bf16(ba0, Aa[0], aa, 0, 0, 0); aa = __builtin_amdgcn_mfma_f32_16x16x32_bf16(ba1, Aa[1], aa, 0, 0, 0);
            const f32x4 w0v = *(const f32x4*)(w0 + 16 * ct + 4 * kg), a0v = *(const f32x4*)(a0 + 16 * ct + 4 * kg);
            u32x2 ev, av; ev.x = pk2(0.60653066f * sigm(w0v[0] + ad[0]), 0.60653066f * sigm(w0v[1] + ad[1])); ev.y = pk2(0.60653066f * sigm(w0v[2] + ad[2]), 0.60653066f * sigm(w0v[3] + ad[3]));
            av.x = pk2(sigm(a0v[0] + aa[0]), sigm(a0v[1] + aa[1])); av.y = pk2(sigm(a0v[2] + aa[2]), sigm(a0v[3] + aa[3]));
            *(u32x2*)(E + orow + 16 * ct) = ev; *(u32x2*)(A + orow + 16 * ct) = av; }
    }
    float* out = p.out; const int gt = vb * 512 + tid, ngt = NB * 512;
    for (int i = gt; i < 136 * 3200; i += ngt) { const int b = i / 3200, c = i - b * 3200; const int tok = b < 8 ? b * 2048 + 2047 : NPT + (b - 8) * 8 + 7;
        const float v = c < 3072 ? bf2f(U[(size_t)tok * 3072 + c]) : XWA[(size_t)tok * 128 + c - 3072];
        out[(b < 8 ? O_SHP + (size_t)b * 3200 : O_SHS + (size_t)(b - 8) * 3200) + c] = v; }
    for (int i = gt; i < 136 * 3072; i += ngt) { const int b = i / 3072, r = i - b * 3072, j = r >> 10, c = r & 1023; const int tok = b < 8 ? b * 2048 + 2045 + j : NPT + (b - 8) * 8 + 5 + j;
        out[(b < 8 ? O_CVP + (size_t)b * 3072 : O_CVS + (size_t)(b - 8) * 3072) + r] = bf2f(XB[(size_t)tok * 1024 + c]); }
}

constexpr int CH = 32;
constexpr int BUF_F = 6 * CH * 64;
constexpr int RW_LDS_OST = 2 * BUF_F * 4;
constexpr int OST_F = CH * 128;
struct Seg { int tok0, h, half; bool first, last; const float* S0; float* Sout; const float* shift0; };
__device__ __forceinline__ Seg get_seg(const float* srw, const float* ssh, float* out, int mode, int it0, int c, int j) {
    Seg g;
    if (mode == 0) { const int b = it0 >> 5; g.h = (it0 >> 1) & 15; g.half = it0 & 1; g.tok0 = b * 2048 + CH * c + 8 * j; g.first = (c == 0 && j == 0); g.last = (c == 2048 / CH - 1 && j == 3);
        g.S0 = nullptr; g.shift0 = nullptr; g.Sout = out + O_RWP + (size_t)(b * 16 + g.h) * 4096; }
    else { const int it = it0 + 4 * c + j, b = it >> 5; g.h = (it >> 1) & 15; g.half = it & 1; g.tok0 = NPT + b * 8; g.first = true; g.last = true;
        g.S0 = srw + (size_t)(b * 16 + g.h) * 4096; g.shift0 = ssh + (size_t)b * 3200; g.Sout = out + O_RWS + (size_t)(b * 16 + g.h) * 4096; }
    return g;
}
__device__ __forceinline__ void rwkv_prep(PREF p, LAS float* buf, const Seg g, int lw, int lane) {
    unsigned char* ws = p.ws;
    const bf16* U = (const bf16*)(ws + WS_U); const bf16* E = (const bf16*)p.out; const bf16* A = E + ZSTRIDE; float* BON = (float*)(ws + WS_BONUS);
    const int C = g.h * 64 + lane;
    const float mur = p.in[I_MU][C], muk = p.in[I_MU][1024 + C], muv = p.in[I_MU][2048 + C], kkc = p.in[I_KK][C], kac = p.in[I_KA][C], rkc = p.in[I_RK][C];
    float pr = 0.f, pk = 0.f, pv = 0.f;
    if (g.first) { if (g.shift0) { pr = g.shift0[C]; pk = g.shift0[1024 + C]; pv = g.shift0[2048 + C]; } }
    else { const bf16* up = U + (size_t)(g.tok0 - 1) * 3072 + C; pr = bf2f(up[0]); pk = bf2f(up[1024]); pv = bf2f(up[2048]); }
    bf16 ur[8], uk[8], uv[8], ee[8], aa[8];
#pragma unroll
    for (int i = 0; i < 8; ++i) { const size_t tok = (size_t)(g.tok0 + i); const bf16* up = U + tok * 3072 + C; ur[i] = up[0]; uk[i] = up[1024]; uv[i] = up[2048]; ee[i] = E[tok * 1024 + C]; aa[i] = A[tok * 1024 + C]; }
    float r8[8], kr8[8], kp8[8], v8[8], a8[8], dc8[8], xs[8], ys[8];
#pragma unroll
    for (int i = 0; i < 8; ++i) {
        const float fr = bf2f(ur[i]), fk = bf2f(uk[i]), fv = bf2f(uv[i]), e = bf2f(ee[i]), a = bf2f(aa[i]);
        const float r = fr + (pr - fr) * mur, k = fk + (pk - fk) * muk, v = fv + (pv - fv) * muv; pr = fr; pk = fk; pv = fv;
        const float kr = k * kkc, kp = k * (1.0f + (a - 1.0f) * kac);
        r8[i] = r; kr8[i] = kr; kp8[i] = kp; v8[i] = v; a8[i] = a; dc8[i] = __expf(-e); xs[i] = kr * kr; ys[i] = r * kp * rkc; }
    const bool b0 = (lane & 1) != 0, b1 = (lane & 2) != 0, b2 = (lane & 4) != 0, b3 = (lane & 8) != 0;
    float w8[8], u4[4], p2[2], f;
#pragma unroll
    for (int j = 0; j < 8; ++j) { const float keep = b0 ? ys[j] : xs[j], send = b0 ? xs[j] : ys[j]; w8[j] = keep + dppf<0xB1>(send); }
#pragma unroll
    for (int j = 0; j < 4; ++j) { const float keep = b1 ? w8[2 * j + 1] : w8[2 * j], send = b1 ? w8[2 * j] : w8[2 * j + 1]; u4[j] = keep + dppf<0x4E>(send); }
#pragma unroll
    for (int j = 0; j < 2; ++j) { const float keep = b2 ? u4[2 * j + 1] : u4[2 * j], send = b2 ? u4[2 * j] : u4[2 * j + 1];
        const int si = __builtin_bit_cast(int, send); int t = __builtin_amdgcn_update_dpp(si, si, 0x104, 0xF, 0x5, false); t = __builtin_amdgcn_update_dpp(t, si, 0x114, 0xF, 0xA, false);
        p2[j] = keep + __builtin_bit_cast(float, t); }
    { const float keep = b3 ? p2[1] : p2[0], send = b3 ? p2[0] : p2[1]; f = keep + dppf<0x128>(send); }
    f += __shfl_xor(f, 16); f += __shfl_xor(f, 32);
#pragma unroll
    for (int i = 0; i < 8; ++i) {
        const int s = 8 * lw + i; const float ss = rdl(f, 2 * i); const float kk = kr8[i] * __builtin_amdgcn_rsqf(ss + 1e-12f);
        LAS float* bp = buf + s * 64 + lane;
        bp[0] = dc8[i]; bp[CH * 64] = kk * a8[i]; bp[2 * CH * 64] = kp8[i]; bp[3 * CH * 64] = kk; bp[4 * CH * 64] = r8[i]; bp[5 * CH * 64] = v8[i]; }
    if (g.half == 0 && lane < 16 && b0) BON[(size_t)(g.tok0 + (lane >> 1)) * 16 + g.h] = f;
}
__device__ __forceinline__ void rwkv_oout(PREF p, const LAS float* ost, const Seg g, int ltid) {
    unsigned char* ws = p.ws; bf16* ORAW = (bf16*)(ws + WS_ORAW); float* ST = (float*)(ws + WS_STATS);
    const int s = ltid >> 3, q = ltid & 7;
    f32x4 o; { const LAS f32x4* pp = (const LAS f32x4*)(ost + s * 128 + q * 16);
      const f32x4 a0 = pp[0], a1 = pp[1], b0 = pp[2], b1 = pp[3]; o.x = (a0.x + a0.z) + (a1.x + a1.z); o.y = (a0.y + a0.w) + (a1.y + a1.w); o.z = (b0.x + b0.z) + (b1.x + b1.z); o.w = (b0.y + b0.w) + (b1.y + b1.w); }
    float sm = (o.x + o.y) + (o.z + o.w), sq = (o.x * o.x + o.y * o.y) + (o.z * o.z + o.w * o.w);
    sm += dppf<0xB1>(sm); sq += dppf<0xB1>(sq); sm += dppf<0x4E>(sm); sq += dppf<0x4E>(sq); sm += dppf<0x141>(sm); sq += dppf<0x141>(sq);
    const size_t tok = (size_t)(g.tok0 + (s & 7)); u32x2 w; w.x = pk2(o.x, o.y); w.y = pk2(o.z, o.w); *(u32x2*)(ORAW + tok * 1024 + g.h * 64 + 32 * g.half + 4 * q) = w;
    if (q == 0) *(f32x2*)(ST + ((tok * 16 + g.h) * 2 + g.half) * 2) = (f32x2){sm, sq};
}
struct ScanOps { f32x4 w4, b4, k4, kk4, r4; f32x2 v2; };
__device__ __forceinline__ ScanOps scan_load(const LAS float* buf, int s, int kl, int voff) { ScanOps o; const LAS float* bp = buf + s * 64 + 4 * kl;
    o.w4 = *(const LAS f32x4*)bp; o.b4 = *(const LAS f32x4*)(bp + CH * 64); o.k4 = *(const LAS f32x4*)(bp + 2 * CH * 64); o.kk4 = *(const LAS f32x4*)(bp + 3 * CH * 64); o.r4 = *(const LAS f32x4*)(bp + 4 * CH * 64);
    o.v2 = *(const LAS f32x2*)(buf + 5 * CH * 64 + s * 64 + voff); return o; }
__device__ __forceinline__ void rwkv_run(PREF p, LAS unsigned char* lds, int tid, int wave, int lane, int mode, int it0, int nch) {
    LAS float* bufs = (LAS float*)lds; LAS float* osts = (LAS float*)(lds + RW_LDS_OST);
    const float* srw = p.in[I_SRW]; const float* ssh = p.in[I_SSH]; float* out = p.out;
    const bool scan = wave < 4; const int rl = lane >> 4, kl = lane & 15, roff = 8 * wave + 2 * rl;
    f32x4 Sa = {0.f, 0.f, 0.f, 0.f}, Sb = Sa; f32x4 Na[4], Nb[4], Ma[4], Mb[4];
#pragma unroll
    for (int j = 0; j < 4; ++j) { Na[j] = Sa; Nb[j] = Sa; Ma[j] = Sa; Mb[j] = Sa; }
    if (scan) {
#pragma unroll
        for (int j = 0; j < 4; ++j) { const Seg g = get_seg(srw, ssh, out, mode, it0, 0, j); if (g.S0) { const int row = 32 * g.half + roff; Na[j] = *(const f32x4*)(g.S0 + row * 64 + 4 * kl); Nb[j] = *(const f32x4*)(g.S0 + (row + 1) * 64 + 4 * kl); } } }
    else rwkv_prep(p, bufs, get_seg(srw, ssh, out, mode, it0, 0, wave - 4), wave - 4, lane);
    __syncthreads();
    for (int c = 0; c < nch; ++c) {
        if (scan) {
            const LAS float* buf = bufs + (c & 1) * BUF_F; LAS float* ost = osts + (c & 1) * OST_F;
            ScanOps cur = scan_load(buf, 0, kl, 32 * get_seg(srw, ssh, out, mode, it0, c, 0).half + roff);
            if (c + 1 < nch) {
#pragma unroll
                for (int j = 0; j < 4; ++j) { const Seg n = get_seg(srw, ssh, out, mode, it0, c + 1, j); if (n.S0) { const int row = 32 * n.half + roff; Ma[j] = *(const f32x4*)(n.S0 + row * 64 + 4 * kl); Mb[j] = *(const f32x4*)(n.S0 + (row + 1) * 64 + 4 * kl); } } }
#pragma unroll
            for (int j = 0; j < 4; ++j) {
                const Seg g = get_seg(srw, ssh, out, mode, it0, c, j);
                if (g.first) { Sa = Na[j]; Sb = Nb[j]; }
                const int nh = get_seg(srw, ssh, out, mode, it0, c, j < 3 ? j + 1 : j).half;
#pragma unroll
                for (int i = 0; i < 8; ++i) {
                    const int s = 8 * j + i;
                    const int sn = s + 1 < CH ? s + 1 : s; const ScanOps nxt = scan_load(buf, sn, kl, 32 * (i == 7 && j < 3 ? nh : g.half) + roff);
                    const f32x2 kkL = __builtin_shufflevector(cur.kk4, cur.kk4, 0, 1), kkH = __builtin_shufflevector(cur.kk4, cur.kk4, 2, 3), wL = __builtin_shufflevector(cur.w4, cur.w4, 0, 1), wH = __builtin_shufflevector(cur.w4, cur.w4, 2, 3);
                    const f32x2 bL = __builtin_shufflevector(cur.b4, cur.b4, 0, 1), bH = __builtin_shufflevector(cur.b4, cur.b4, 2, 3), kL = __builtin_shufflevector(cur.k4, cur.k4, 0, 1), kH = __builtin_shufflevector(cur.k4, cur.k4, 2, 3);
                    const f32x2 rL = __builtin_shufflevector(cur.r4, cur.r4, 0, 1), rH = __builtin_shufflevector(cur.r4, cur.r4, 2, 3);
                    f32x2 SaL = __builtin_shufflevector(Sa, Sa, 0, 1), SaH = __builtin_shufflevector(Sa, Sa, 2, 3), SbL = __builtin_shufflevector(Sb, Sb, 0, 1), SbH = __builtin_shufflevector(Sb, Sb, 2, 3);
                    f32x2 ta = SaL * kkL; ta = __builtin_elementwise_fma(SaH, kkH, ta); f32x2 tb = SbL * kkL; tb = __builtin_elementwise_fma(SbH, kkH, tb);
                    float sa0 = ta.x + ta.y, sa1 = tb.x + tb.y;
                    sa0 += dppf<0xB1>(sa0); sa1 += dppf<0xB1>(sa1); sa0 += dppf<0x4E>(sa0); sa1 += dppf<0x4E>(sa1); sa0 += dppf<0x141>(sa0); sa1 += dppf<0x141>(sa1); sa0 += dppf<0x140>(sa0); sa1 += dppf<0x140>(sa1);
                    const f32x2 na = {-sa0, -sa0}, nb = {-sa1, -sa1}, va = {cur.v2.x, cur.v2.x}, vb = {cur.v2.y, cur.v2.y};
                    SaL = __builtin_elementwise_fma(va, kL, __builtin_elementwise_fma(na, bL, SaL * wL)); SaH = __builtin_elementwise_fma(va, kH, __builtin_elementwise_fma(na, bH, SaH * wH));
                    SbL = __builtin_elementwise_fma(vb, kL, __builtin_elementwise_fma(nb, bL, SbL * wL)); SbH = __builtin_elementwise_fma(vb, kH, __builtin_elementwise_fma(nb, bH, SbH * wH));
                    Sa = __builtin_shufflevector(SaL, SaH, 0, 1, 2, 3); Sb = __builtin_shufflevector(SbL, SbH, 0, 1, 2, 3);
                    f32x2 oa = SaL * rL; oa = __builtin_elementwise_fma(SaH, rH, oa); f32x2 ob = SbL * rL; ob = __builtin_elementwise_fma(SbH, rH, ob);
                    float o0 = oa.x + oa.y, o1 = ob.x + ob.y;
                    asm volatile("s_nop 1\n\tv_add_f32_dpp %0, %0, %0 quad_perm:[1,0,3,2] row_mask:0xf bank_mask:0xf bound_ctrl:1\n\tv_add_f32_dpp %1, %1, %1 quad_perm:[1,0,3,2] row_mask:0xf bank_mask:0xf bound_ctrl:1\n\t"
                                 "s_nop 1\n\tv_add_f32_dpp %0, %0, %0 quad_perm:[2,3,0,1] row_mask:0xf bank_mask:0xf bound_ctrl:1\n\tv_add_f32_dpp %1, %1, %1 quad_perm:[2,3,0,1] row_mask:0xf bank_mask:0xf bound_ctrl:1" : "+v"(o0), "+v"(o1));
                    if ((kl & 3) == 0) *(LAS f32x2*)(ost + s * 128 + roff * 4 + (kl >> 2) * 2) = (f32x2){o0, o1};
                    cur = nxt;
                }
                if (g.last) { const int row = 32 * g.half + roff; *(f32x4*)(g.Sout + row * 64 + 4 * kl) = Sa; *(f32x4*)(g.Sout + (row + 1) * 64 + 4 * kl) = Sb; }
            }
#pragma unroll
            for (int j = 0; j < 4; ++j) { Na[j] = Ma[j]; Nb[j] = Mb[j]; }
        } else {
            if (c + 1 < nch) rwkv_prep(p, bufs + ((c + 1) & 1) * BUF_F, get_seg(srw, ssh, out, mode, it0, c + 1, wave - 4), wave - 4, lane);
            if (c >= 1) rwkv_oout(p, osts + ((c - 1) & 1) * OST_F, get_seg(srw, ssh, out, mode, it0, c - 1, (tid - 256) >> 6), tid - 256);
        }
        __syncthreads();
    }
    if (!scan) rwkv_oout(p, osts + ((nch - 1) & 1) * OST_F, get_seg(srw, ssh, out, mode, it0, nch - 1, (tid - 256) >> 6), tid - 256);
    __syncthreads();
}

__device__ __forceinline__ void rglru_item(PREF p, LAS unsigned char* lds, int tid, int wave, int lane, int mode, int item, bool st) {
    unsigned char* ws = p.ws; const bf16* XB = (const bf16*)(ws + WS_XB); bf16* ZB = (bf16*)(ws + WS_Z) + ZSTRIDE;
    LAS float* XC = (LAS float*)lds; LAS float* GR = XC + 64 * 65; LAS float* GI = GR + 64 * 65; LAS bf16* XCB = (LAS bf16*)(GI + 64 * 65); LAS float* TOT = (LAS float*)(XCB + 64 * 72); LAS float* HC = TOT + 1024;
    const int c = tid & 63, sg = tid >> 6;
    const int g = mode ? (item >> 4) : (item & 15), bb = mode ? (8 * (item & 15) + sg) : (item >> 4), C = g * 64 + c;
    const int nchunk = mode ? 1 : 32; const int rowtok = mode ? (NPT + bb * 8) : (bb * 2048 + 8 * sg);
    const float cw0 = p.in[I_CW][C], cw1 = p.in[I_CW][1024 + C], cw2 = p.in[I_CW][2048 + C], cw3 = p.in[I_CW][3072 + C], cb = p.in[I_CB][C];
    const float sp = log1pf(__expf(-p.in[I_LAM][C]));
    const bf16* WT = (const bf16*)(ws + (wave >= 4 ? WS_WRGX : WS_WRGA)) + g * 4096; const float* bra = opq(p.in[I_BRGA]); const float* brx = opq(p.in[I_BRGX]); const float* bias = (wave >= 4 ? brx : bra) + g * 64;
    const int trow = lane & 15, kg = lane >> 4, tt = wave & 3;
    bf16x8 wb0[4], wb1[4]; float bn[4];
#pragma unroll
    for (int ct = 0; ct < 4; ++ct) { const int n = 16 * ct + trow; wb0[ct] = *(const bf16x8*)(WT + n * 64 + 8 * kg); wb1[ct] = *(const bf16x8*)(WT + n * 64 + 32 + 8 * kg); bn[ct] = bias[n]; }
    float hin = 0.f; float e0 = 0.f, e1 = 0.f, e2 = 0.f;
    if (mode) { hin = p.in[I_SLRU][(size_t)bb * 1024 + C]; const float* cv = p.in[I_SCV] + (size_t)bb * 3072 + C; e0 = cv[0]; e1 = cv[1024]; e2 = cv[2048]; }
    else { if (tid < 64) HC[c] = 0.f; if (sg > 0) { const bf16* xp = XB + (size_t)(rowtok - 3) * 1024 + C; e0 = bf2f(xp[0]); e1 = bf2f(xp[1024]); e2 = bf2f(xp[2048]); } }
    bf16 xn[8], zn[8];
#pragma unroll
    for (int i = 0; i < 8; ++i) { xn[i] = XB[(size_t)(rowtok + i) * 1024 + C]; zn[i] = ZB[(size_t)(rowtok + i) * 1024 + C]; }
    for (int k = 0; k < nchunk; ++k) {
        const int tok = rowtok + 64 * k;
        float zb[8];
#pragma unroll
        for (int i = 0; i < 8; ++i) { const float e3 = bf2f(xn[i]); zb[i] = bf2f(zn[i]); const float xc = cb + e0 * cw0 + e1 * cw1 + e2 * cw2 + e3 * cw3;
            XC[(sg * 8 + i) * 65 + c] = xc; XCB[(sg * 8 + i) * 72 + c] = (bf16)f2bf(xc); e0 = e1; e1 = e2; e2 = e3; }
        if (k + 1 < nchunk) {
            const bf16* xp = XB + (size_t)(tok + 64 - 3) * 1024 + C; e0 = bf2f(xp[0]); e1 = bf2f(xp[1024]); e2 = bf2f(xp[2048]);
#pragma unroll
            for (int i = 0; i < 8; ++i) { xn[i] = XB[(size_t)(tok + 64 + i) * 1024 + C]; zn[i] = ZB[(size_t)(tok + 64 + i) * 1024 + C]; } }
        __syncthreads();
        { LAS float* GO = wave >= 4 ? GI : GR;
          const bf16x8 a0 = *(const LAS bf16x8*)(XCB + (16 * tt + trow) * 72 + 8 * kg), a1 = *(const LAS bf16x8*)(XCB + (16 * tt + trow) * 72 + 32 + 8 * kg);
#pragma unroll
          for (int ct = 0; ct < 4; ++ct) { const int n = 16 * ct + trow;
              f32x4 acc = {0.f, 0.f, 0.f, 0.f}; acc = __builtin_amdgcn_mfma_f32_16x16x32_bf16(a0, wb0[ct], acc, 0, 0, 0); acc = __builtin_amdgcn_mfma_f32_16x16x32_bf16(a1, wb1[ct], acc, 0, 0, 0);
#pragma unroll
              for (int r = 0; r < 4; ++r) GO[(16 * tt + 4 * kg + r) * 65 + n] = sigm(acc[r] + bn[ct]); } }
        __syncthreads();
        float hl[8], cm[8]; { float h = 0.f, cum = 1.f;
#pragma unroll
          for (int i = 0; i < 8; ++i) { const int s = sg * 8 + i; const float gr = GR[s * 65 + c], gi = GI[s * 65 + c], xc = XC[s * 65 + c];
              const float la = -8.0f * gr * sp, x2 = 2.0f * la;
              const float om = -x2 * (1.0f + x2 * 0.5f * (1.0f + x2 * (1.0f / 3.0f) * (1.0f + x2 * 0.25f * (1.0f + x2 * 0.2f * (1.0f + x2 * (1.0f / 6.0f) * (1.0f + x2 * (1.0f / 7.0f)))))));
              const float a = __expf(la), b = sqrtf(om) * gi * xc;
              h = a * h + b; cum *= a; hl[i] = h; cm[i] = cum; }
          if (!mode) { TOT[sg * 64 + c] = cum; TOT[512 + sg * 64 + c] = h; } }
        if (!mode) __syncthreads();
        { float h = hin;
          if (!mode) { h = HC[(k & 1) * 64 + c]; for (int j = 0; j < sg; ++j) h = TOT[j * 64 + c] * h + TOT[512 + j * 64 + c]; }
          if (st) {
#pragma unroll
              for (int i = 0; i < 8; ++i) ZB[(size_t)(tok + i) * 1024 + C] = (bf16)f2bf((hl[i] + cm[i] * h) * zb[i]); }
          const float hn = hl[7] + cm[7] * h;
          if (mode) p.out[O_LRS + (size_t)bb * 1024 + C] = hn;
          else if (sg == 7) { HC[((k + 1) & 1) * 64 + c] = hn; if (k == nchunk - 1) p.out[O_LRP + (size_t)bb * 1024 + C] = hn; } }
    }
    __syncthreads();
}

constexpr int XA_STG = 128 * 528, XA_PL = 8448;
__device__ __forceinline__ void xa_stage(LAS unsigned char* lds, const bf16* src, size_t ld, int tid) {
#pragma unroll
    for (int i = 0; i < 8; ++i) { const int e = tid + 512 * i, row = e >> 5, seg = e & 31; *(LAS u32x4*)(lds + row * 528 + seg * 16) = *(const u32x4*)(src + (size_t)row * ld + seg * 8); }
}
__device__ __forceinline__ void xattn_prompt_item(PREF p, LAS unsigned char* lds, int tid, int wave, int lane, int item, bool st) {
    unsigned char* ws = p.ws; const bf16* Q = (const bf16*)(ws + WS_Q); const bf16* MK = (const bf16*)(ws + WS_MK); const bf16* MVT = (const bf16*)(ws + WS_MVT); bf16* ZC = (bf16*)(ws + WS_Z) + 2 * ZSTRIDE;
    LAS bf16* PL = (LAS bf16*)(lds + XA_STG + wave * XA_PL);
    const int qb = item & 15, head = (item >> 4) & 3, b = item >> 6, tok0 = b * 2048 + 128 * qb + 16 * wave, trow = lane & 15, kg = lane >> 4;
    bf16x8 qf[8];
#pragma unroll
    for (int ks = 0; ks < 8; ++ks) qf[ks] = *(const bf16x8*)(Q + (size_t)(tok0 + trow) * 1024 + head * 256 + 32 * ks + 8 * kg);
    f32x4 S[16];
#pragma unroll
    for (int hk = 0; hk < 2; ++hk) {
        __syncthreads();
        xa_stage(lds, MK + (size_t)(b * 256 + 128 * hk) * 1024 + head * 256, 1024, tid);
        __syncthreads();
#pragma unroll
        for (int mt = 0; mt < 8; ++mt) { f32x4 acc = {0.f, 0.f, 0.f, 0.f}; const LAS unsigned char* kp = lds + (16 * mt + trow) * 528 + kg * 16;
#pragma unroll
            for (int ks = 0; ks < 8; ++ks) acc = __builtin_amdgcn_mfma_f32_16x16x32_bf16(qf[ks], *(const LAS bf16x8*)(kp + ks * 64), acc, 0, 0, 0);
            S[8 * hk + mt] = acc; }
    }
    f32x4 mx = S[0];
#pragma unroll
    for (int mt = 1; mt < 16; ++mt) { mx.x = fmaxf(mx.x, S[mt].x); mx.y = fmaxf(mx.y, S[mt].y); mx.z = fmaxf(mx.z, S[mt].z); mx.w = fmaxf(mx.w, S[mt].w); }
    mx.x = row16_max(mx.x); mx.y = row16_max(mx.y); mx.z = row16_max(mx.z); mx.w = row16_max(mx.w);
    f32x4 sm = {0.f, 0.f, 0.f, 0.f};
#pragma unroll
    for (int mt = 0; mt < 16; ++mt) { f32x4 e; e.x = __expf((S[mt].x - mx.x) * 0.0625f); e.y = __expf((S[mt].y - mx.y) * 0.0625f); e.z = __expf((S[mt].z - mx.z) * 0.0625f); e.w = __expf((S[mt].w - mx.w) * 0.0625f);
        sm += e; const int col = 16 * mt + trow;
        PL[(4 * kg + 0) * 264 + col] = (bf16)f2bf(e.x); PL[(4 * kg + 1) * 264 + col] = (bf16)f2bf(e.y); PL[(4 * kg + 2) * 264 + col] = (bf16)f2bf(e.z); PL[(4 * kg + 3) * 264 + col] = (bf16)f2bf(e.w); }
    sm.x = row16_sum(sm.x); sm.y = row16_sum(sm.y); sm.z = row16_sum(sm.z); sm.w = row16_sum(sm.w);
    const f32x4 inv = {1.0f / sm.x, 1.0f / sm.y, 1.0f / sm.z, 1.0f / sm.w};
    LDS_WAIT();
    bf16x8 pf[8];
#pragma unroll
    for (int ks = 0; ks < 8; ++ks) pf[ks] = *(const LAS bf16x8*)(PL + trow * 264 + 32 * ks + 8 * kg);
#pragma unroll
    for (int hv = 0; hv < 2; ++hv) {
        __syncthreads();
        xa_stage(lds, MVT + ((size_t)((b * 4 + head) * 256 + 128 * hv)) * 256, 256, tid);
        __syncthreads();
#pragma unroll
        for (int dt = 0; dt < 8; ++dt) { f32x4 acc = {0.f, 0.f, 0.f, 0.f}; const LAS unsigned char* vp = lds + (16 * dt + trow) * 528 + kg * 16;
#pragma unroll
            for (int ks = 0; ks < 8; ++ks) acc = __builtin_amdgcn_mfma_f32_16x16x32_bf16(pf[ks], *(const LAS bf16x8*)(vp + ks * 64), acc, 0, 0, 0);
            acc = acc * inv; const int col = head * 256 + 128 * hv + 16 * dt + trow;
#pragma unroll
            for (int r = 0; r < 4; ++r) { bf16* zp = ZC + (size_t)(tok0 + 4 * kg + r) * 1024 + col; const bf16 nv = (bf16)f2bf(acc[r] * bf2f(*zp)); if (st) *zp = nv; } }
    }
    __syncthreads();
}

__device__ __forceinline__ void xattn_sample_item(PREF p, LAS unsigned char* lds, int tid, int wave, int lane, int item, bool st) {
    unsigned char* ws = p.ws; const bf16* Q = (const bf16*)(ws + WS_Q); bf16* ZC = (bf16*)(ws + WS_Z) + 2 * ZSTRIDE;
    LAS float* QS = (LAS float*)lds; LAS float* SC = QS + 2048; LAS float* PART = SC + 2048;
    const int b = item >> 2, head = item & 3, tok0 = NPT + b * 8;
    for (int i = tid; i < 2048; i += 512) QS[i] = bf2f(Q[(size_t)(tok0 + (i >> 8)) * 1024 + head * 256 + (i & 255)]);
    __syncthreads();
    const float* Vc = p.in[I_CV] + ((size_t)b * 256 * 4 + head) * 256 + 4 * lane;
    { const int kl = lane & 15, rq = lane >> 4; const float* Kc = p.in[I_CK] + ((size_t)b * 256 * 4 + head) * 256 + 4 * kl;
      f32x4 q[8][4];
#pragma unroll
      for (int i = 0; i < 8; ++i)
#pragma unroll
          for (int j = 0; j < 4; ++j) q[i][j] = *(const LAS f32x4*)(QS + i * 256 + 64 * j + 4 * kl);
#pragma unroll 2
      for (int r = 0; r < 8; ++r) { const int m = 32 * wave + 4 * r + rq; const f32x4* kp = (const f32x4*)(Kc + (size_t)m * 1024);
          const f32x4 k0 = kp[0], k1 = kp[16], k2 = kp[32], k3 = kp[48];
#pragma unroll
          for (int i = 0; i < 8; ++i) { f32x4 t = q[i][0] * k0 + q[i][1] * k1 + q[i][2] * k2 + q[i][3] * k3; float d = row16_sum((t.x + t.y) + (t.z + t.w));
              if (kl == i) SC[i * 256 + m] = d * 0.0625f; } } }
    __syncthreads();
    { float v[4]; float mx = -3.0e38f;
#pragma unroll
      for (int j = 0; j < 4; ++j) { v[j] = SC[wave * 256 + lane + 64 * j]; mx = fmaxf(mx, v[j]); }
      mx = wave_max(mx); float sm = 0.f;
#pragma unroll
      for (int j = 0; j < 4; ++j) { v[j] = __expf(v[j] - mx); sm += v[j]; }
      sm = wave_sum(sm); const float inv = 1.0f / sm;
#pragma unroll
      for (int j = 0; j < 4; ++j) SC[wave * 256 + lane + 64 * j] = v[j] * inv; }
    __syncthreads();
    { f32x4 acc[8];
#pragma unroll
      for (int i = 0; i < 8; ++i) acc[i] = (f32x4){0.f, 0.f, 0.f, 0.f};
#pragma unroll 8
      for (int r = 0; r < 32; ++r) { const int m = 32 * wave + r; const f32x4 vv = *(const f32x4*)(Vc + (size_t)m * 1024);
#pragma unroll
          for (int i = 0; i < 8; ++i) acc[i] += SC[i * 256 + m] * vv; }
#pragma unroll
      for (int i = 0; i < 8; ++i) *(LAS f32x4*)(PART + (wave * 8 + i) * 256 + 4 * lane) = acc[i]; }
    __syncthreads();
    { const int q = tid >> 6, d = 4 * (tid & 63); f32x4 s = {0.f, 0.f, 0.f, 0.f};
#pragma unroll
      for (int w = 0; w < 8; ++w) s += *(const LAS f32x4*)(PART + (w * 8 + q) * 256 + d);
      u32x2* zp = (u32x2*)(ZC + (size_t)(tok0 + q) * 1024 + head * 256 + d); const u32x2 z = *zp;
      u32x2 o; o.x = pk2(s.x * bflo(z.x), s.y * bfhi(z.x)); o.y = pk2(s.z * bflo(z.y), s.w * bfhi(z.y)); if (st) *zp = o; }
    __syncthreads();
}

__device__ __forceinline__ void p4_post(PREF p, int tid, int G, bool stw) {
    unsigned char* ws = p.ws; const bf16* ORAW = (const bf16*)(ws + WS_ORAW); const bf16* U = (const bf16*)(ws + WS_U); bf16* ZA = (bf16*)(ws + WS_Z);
    const float* ST = (const float*)(ws + WS_STATS); const float* BON = (const float*)(ws + WS_BONUS);
    const float* muv = p.in[I_MU] + 2048; const float* gng = p.in[I_GNG]; const float* gnb = p.in[I_GNB]; const float* ssh = p.in[I_SSH];
    for (int i = blockIdx.x * 512 + tid; i < NT * 128; i += G * 512) {
        const int tok = i >> 7, c0 = (i & 127) * 8, h = c0 >> 6; const bool prm = tok < NPT; const int s = prm ? (tok & 2047) : ((tok - NPT) & 7); const int bs = (tok - NPT) >> 3;
        const f32x4 st = *(const f32x4*)(ST + ((size_t)tok * 16 + h) * 4);
        const float mean = (st.x + st.z) * (1.f / 64.f), var = (st.y + st.w) * (1.f / 64.f) - mean * mean, rstd = rsqrtf(fmaxf(var, 0.f) + 64e-5f), bon = BON[(size_t)tok * 16 + h];
        const u32x4 o = *(const u32x4*)(ORAW + (size_t)tok * 1024 + c0), z = *(const u32x4*)(ZA + (size_t)tok * 1024 + c0), vc = *(const u32x4*)(U + (size_t)tok * 3072 + 2048 + c0);
        float pv[8];
        if (s > 0) { const u32x4 vp = *(const u32x4*)(U + (size_t)(tok - 1) * 3072 + 2048 + c0); pv[0] = bflo(vp.x); pv[1] = bfhi(vp.x); pv[2] = bflo(vp.y); pv[3] = bfhi(vp.y); pv[4] = bflo(vp.z); pv[5] = bfhi(vp.z); pv[6] = bflo(vp.w); pv[7] = bfhi(vp.w); }
        else if (!prm) {
#pragma unroll
            for (int j = 0; j < 8; ++j) pv[j] = ssh[(size_t)bs * 3200 + 2048 + c0 + j]; }
        else {
#pragma unroll
            for (int j = 0; j < 8; ++j) pv[j] = 0.f; }
        const unsigned ow[4] = {o.x, o.y, o.z, o.w}, zw[4] = {z.x, z.y, z.z, z.w}, vw[4] = {vc.x, vc.y, vc.z, vc.w}; unsigned rw[4];
#pragma unroll
        for (int j = 0; j < 4; ++j) { float r2[2];
#pragma unroll
            for (int e = 0; e < 2; ++e) { const int c = c0 + 2 * j + e; const float ov = e ? bfhi(ow[j]) : bflo(ow[j]), zv = e ? bfhi(zw[j]) : bflo(zw[j]), uv = e ? bfhi(vw[j]) : bflo(vw[j]);
                const float v = uv + (pv[2 * j + e] - uv) * muv[c]; r2[e] = ((ov - mean) * rstd * gng[c] + gnb[c] + bon * v) * zv; }
            rw[j] = pk2(r2[0], r2[1]); }
        if (stw) *(u32x4*)(ZA + (size_t)tok * 1024 + c0) = (u32x4){rw[0], rw[1], rw[2], rw[3]};
    }
}
__device__ __forceinline__ void p5_sum(PREF p, int tid, int G) {
    unsigned char* ws = p.ws; const u32x4* P = (const u32x4*)(ws + WS_P); u32x4* M = (u32x4*)(ws + WS_MERGED); constexpr int N8 = NT * 128;
    for (int i = NPT * 128 + blockIdx.x * 512 + tid; i < N8; i += G * 512) { const u32x4 a = P[i], b = P[i + N8], c = P[i + 2 * N8]; u32x4 o;
        o.x = pk2(bflo(a.x) + bflo(b.x) + bflo(c.x), bfhi(a.x) + bfhi(b.x) + bfhi(c.x)); o.y = pk2(bflo(a.y) + bflo(b.y) + bflo(c.y), bfhi(a.y) + bfhi(b.y) + bfhi(c.y));
        o.z = pk2(bflo(a.z) + bflo(b.z) + bflo(c.z), bfhi(a.z) + bfhi(b.z) + bfhi(c.z)); o.w = pk2(bflo(a.w) + bflo(b.w) + bflo(c.w), bfhi(a.w) + bfhi(b.w) + bfhi(c.w)); M[i] = o; }
}
__device__ __forceinline__ void p6_norm(PREF p, int r0, int r1, int vb, int nvb, int wave, int lane) {
    const f32x4* gf = (const f32x4*)p.in[I_GF] + lane;
    for (int m = r0 + vb * 8 + wave; m < r1; m += nvb * 8) { f32x4* xr = (f32x4*)(p.out + (size_t)m * 1024) + lane; f32x4 v[4]; float s = 0.f;
#pragma unroll
        for (int j = 0; j < 4; ++j) { v[j] = xr[64 * j]; s += (v[j].x * v[j].x + v[j].y * v[j].y) + (v[j].z * v[j].z + v[j].w * v[j].w); }
        const float rstd = rsqrtf(wave_sum(s) * (1.f / 1024.f) + 1e-6f);
#pragma unroll
        for (int j = 0; j < 4; ++j) xr[64 * j] = v[j] * rstd * gf[64 * j]; }
}

#define XB_TMO      128
#define XB_XCNT(j)  (256  + 64 * (j))
#define XB_XSUB(j)  (1280 + 64 * (j))
#define XB_XGEN(j)  (2304 + 64 * (j))
#define XB_TOP      3328
#define XB_TOPGEN   3392
#define XCD_BAR_WORDS 3456
#define XB_SPIN_CAP (1u << 18)

__device__ __forceinline__ unsigned xb_ld(unsigned* p)              { return __hip_atomic_load(p, __ATOMIC_RELAXED, __HIP_MEMORY_SCOPE_AGENT); }
__device__ __forceinline__ unsigned xb_add(unsigned* p, unsigned v) { return __hip_atomic_fetch_add(p, v, __ATOMIC_RELAXED, __HIP_MEMORY_SCOPE_AGENT); }
__device__ __forceinline__ unsigned xb_xcc_id() { return (unsigned)__builtin_amdgcn_s_getreg((3 << 11) | 20) & 0xFu; }
#define XB_SPIN(cond, bar) do { unsigned _sp = 0; while (cond) { __builtin_amdgcn_s_sleep(1); \
    if ((++_sp & 255u) == 0u) { if (xb_ld(&(bar)[XB_TMO])) break; if (_sp > XB_SPIN_CAP) { atomicAdd(&(bar)[XB_TMO], 1u); break; } } } } while (0)

struct XcdBarrier {
    unsigned* bar; unsigned x;
    volatile LAS unsigned* st;
};

__device__ __forceinline__ XcdBarrier xcd_barrier_post(unsigned* bar, volatile LAS unsigned* st) {
    XcdBarrier b; b.bar = bar; b.x = xb_xcc_id(); b.st = st;
    if (threadIdx.x == 0) (void)xb_add(&bar[XB_XCNT(b.x)], 1u);
    return b;
}
__device__ __forceinline__ void xcd_barrier_complete(unsigned* bar, unsigned x, unsigned& nloc, unsigned& nx) {
    const unsigned G = gridDim.x * gridDim.y * gridDim.z;
    unsigned sum, cnt, mine, sp = 0u;
    for (;;) {
        sum = 0u; cnt = 0u; mine = 0u;
#pragma unroll
        for (unsigned j = 0; j < 16; ++j) { const unsigned c = xb_ld(&bar[XB_XCNT(j)]); sum += c; cnt += (c > 0u) ? 1u : 0u; mine = (j == x) ? c : mine; }
        if (sum == G) break;
        __builtin_amdgcn_s_sleep(1);
        if ((++sp & 255u) == 0u) { if (xb_ld(&bar[XB_TMO])) break; if (sp > XB_SPIN_CAP) { atomicAdd(&bar[XB_TMO], 1u); break; } }
    }
    nloc = mine > 0u ? mine : 1u; nx = cnt > 0u ? cnt : 1u;
}

__device__ __forceinline__ void xcd_barrier(const XcdBarrier& b) {
    asm volatile("s_waitcnt vmcnt(0)" ::: "memory");
    __syncthreads();
    if (threadIdx.x == 0) {
        unsigned* bar = b.bar;
        __builtin_amdgcn_s_waitcnt(0);
        unsigned nloc = b.st[0], nx = b.st[1];
        if (nloc == 0u) { xcd_barrier_complete(bar, b.x, nloc, nx); b.st[0] = nloc; b.st[1] = nx; }
        const unsigned old = xb_add(&bar[XB_XSUB(b.x)], 1u);
        const unsigned gen = old / nloc;
        if (old + 1u == (gen + 1u) * nloc) {
            __builtin_amdgcn_fence(__ATOMIC_RELEASE, "agent");
            asm volatile("s_waitcnt vmcnt(0)" ::: "memory");
            const unsigned og = xb_add(&bar[XB_TOP], 1u);
            const unsigned tg = og / nx;
            if (og + 1u == (tg + 1u) * nx) xb_add(&bar[XB_TOPGEN], 1u);
            else XB_SPIN(xb_ld(&bar[XB_TOPGEN]) == tg, bar);
            __builtin_amdgcn_fence(__ATOMIC_ACQUIRE, "agent");
            xb_add(&bar[XB_XGEN(b.x)], 1u);
            asm volatile("s_waitcnt vmcnt(0)" ::: "memory");
        } else {
            XB_SPIN(xb_ld(&bar[XB_XGEN(b.x)]) == gen, bar);
            __builtin_amdgcn_fence(__ATOMIC_ACQUIRE, "agent");
            asm volatile("s_waitcnt vmcnt(0)" ::: "memory");
        }
    }
    __syncthreads();
}

#ifndef MK_LAST_PHASE
#define MK_LAST_PHASE 99
#endif
__global__ void __launch_bounds__(512, 2) fwd(Params p_arg) {
    extern __shared__ __attribute__((aligned(16))) unsigned char lds_raw[];
    LAS unsigned char* lds = (LAS unsigned char*)lds_raw;
    cg::grid_group grid = cg::this_grid();
    const int tid = threadIdx.x, lane = tid & 63, wave = __builtin_amdgcn_readfirstlane(tid >> 6), G = gridDim.x, bx = blockIdx.x;
    CParams* kp = (CParams*)__builtin_amdgcn_kernarg_segment_ptr();
    unsigned char* ws = kp->ws;
#define p (*launder(kp))
    if (tid < 8) ((LAS unsigned*)(lds + LDS_BYTES - 32))[tid] = 0u;
    __syncthreads();
#ifndef PROBE_DUP
#define PROBE_DUP 0
#endif
#define REP(n) for (int rep_ = (PROBE_DUP == (n) ? 0 : 1); rep_ < 2; ++rep_)
    REP(10) { p0_prologue(p, lds, tid, wave, lane, G); __syncthreads(); }
    grid.sync();
    const XcdBarrier xbar = xcd_barrier_post((unsigned*)(ws + WS_CTR) + 1024, (volatile LAS unsigned*)(lds + LDS_BYTES - 32));
    REP(1) { pg8::Gemm g{(const pg8::bf16_t*)(ws + WS_XN), (const pg8::bf16_t*)(ws + WS_WIN), NT, 11520, 1024}; pg8::StaticOrder S; S.init(NT, 11520, G, bx); EpiMain E{ws};
      pg8::gemm_phase<EpiMain, pg8::StaticOrder>((PG8_LAS unsigned char*)lds, g, S, E, nullptr); }
    xcd_barrier(xbar);
    REP(7) if (G >= 128) {
        if (bx < 64) { pg8::Gemm g{(const pg8::bf16_t*)(ws + WS_XN) + (size_t)NT * 1024, (const pg8::bf16_t*)(ws + WS_WIN) + (size_t)11520 * 1024, 2048, 2048, 1024}; SchedMem S{bx}; EpiMem E{ws, p.out};
            pg8::gemm_phase<EpiMem, SchedMem>((PG8_LAS unsigned char*)lds, g, S, E, nullptr); }
        else p2_lora(p, bx - 64, G - 64, tid, wave, lane);
    }
    xcd_barrier(xbar);
#ifndef PROBE_DUP
#define PROBE_DUP 0
#endif
    for (int rep = (PROBE_DUP == 2 ? 0 : 1); rep < 2; ++rep)
    for (int it = bx; it < 256; it += G) rwkv_run(p, lds, tid, wave, lane, 0, it, 2048 / CH);
    for (int rep = (PROBE_DUP == 3 ? 0 : 1); rep < 2; ++rep)
    for (int it = bx * 16; it < 4096; it += G * 16) rwkv_run(p, lds, tid, wave, lane, 1, it, 4);
    for (int rep = (PROBE_DUP == 4 ? 0 : 1); rep < 2; ++rep) { const bool st = (rep == 1) || (p.zero != 0);
        if (bx < 128) rglru_item(p, lds, tid, wave, lane, 0, bx, st); else { rglru_item(p, lds, tid, wave, lane, 1, bx - 128, st); rglru_item(p, lds, tid, wave, lane, 1, bx, st); } }
    { const bool st = true;
        LAS unsigned* slot = (LAS unsigned*)(lds + LDS_BYTES - 16); unsigned* ctr = (unsigned*)(ws + WS_CTR);
        for (;;) {
            if (tid == 0) *slot = atomicAdd(ctr, 1u);
            __syncthreads();
            const unsigned it = *slot;
            __syncthreads();
            if (it >= 1024u) break;
            if ((it & 1u) == 0u) xattn_sample_item(p, lds, tid, wave, lane, (int)(it >> 1), st); else xattn_prompt_item(p, lds, tid, wave, lane, (int)(it >> 1), st);
        } }
    xcd_barrier(xbar);
    p4_post(p, tid, G, true);
    xcd_barrier(xbar);
    { pg8::Gemm g{(const pg8::bf16_t*)(ws + WS_Z), (const pg8::bf16_t*)(ws + WS_WBR), 3 * NT, 3072, 1024}; SchedTail S{bx}; EpiTail E{ws};
      pg8::gemm_phase<EpiTail, SchedTail>((PG8_LAS unsigned char*)lds, g, S, E, nullptr);
      if (bx < 48) { SchedBrS S2{bx}; EpiBranch E2{ws}; pg8::gemm_phase<EpiBranch, SchedBrS>((PG8_LAS unsigned char*)lds, g, S2, E2, nullptr); } }
    xcd_barrier(xbar);
    p5_sum(p, tid, G);
    { pg8::Gemm g{(const pg8::bf16_t*)(ws + WS_MERGED), (const pg8::bf16_t*)(ws + WS_WOUT), NPT, 1024, 1024}; pg8::StaticOrder S; S.init(NPT, 1024, G, bx); EpiOut E{opq(p.in[I_XP]), opq(p.in[I_XS]), p.out};
      pg8::gemm_phase<EpiOut, pg8::StaticOrder>((PG8_LAS unsigned char*)lds, g, S, E, nullptr); }
    xcd_barrier(xbar);
    if (bx < 16) { pg8::Gemm g{(const pg8::bf16_t*)(ws + WS_MERGED), (const pg8::bf16_t*)(ws + WS_WOUT), NT, 1024, 1024}; SchedOutS S{bx}; EpiOut E{opq(p.in[I_XP]), opq(p.in[I_XS]), p.out};
      pg8::gemm_phase<EpiOut, SchedOutS>((PG8_LAS unsigned char*)lds, g, S, E, nullptr); }
    else p6_norm(p, 0, NPT, bx - 16, G - 16, wave, lane);
    xcd_barrier(xbar);
    p6_norm(p, NPT, NT, bx, G, wave, lane);
#undef p
}
}

extern "C" void kernel_launch(void* const* d_in, const int* in_sizes, int n_in, void* d_out, int out_size, void* d_ws, size_t ws_size, hipStream_t stream) {
    static int grid = 0;
    if (grid == 0) {
        if (n_in != 35 || (size_t)out_size != mk::O_END || ws_size < mk::WS_END) { fprintf(stderr, "kernel_launch: unexpected shapes: n_in %d out %d ws %zu\n", n_in, out_size, ws_size); grid = -1; return; }
        int dev = 0, cus = 0, per_cu = 0;
        hipGetDevice(&dev); hipDeviceGetAttribute(&cus, hipDeviceAttributeMultiprocessorCount, dev);
        hipFuncSetAttribute((const void*)mk::fwd, hipFuncAttributeMaxDynamicSharedMemorySize, mk::LDS_BYTES);
        hipOccupancyMaxActiveBlocksPerMultiprocessor(&per_cu, (const void*)mk::fwd, 512, mk::LDS_BYTES);
        if (per_cu < 1) { fprintf(stderr, "kernel_launch: occupancy query says %d blocks per CU\n", per_cu); per_cu = 1; }
        grid = cus * 1;
        (void)hipGetLastError();
    }
    if (grid < 0) return;
    mk::Params p{};
    for (int i = 0; i < 35; ++i) p.in[i] = (const float*)d_in[i];
    p.out = (float*)d_out; p.ws = (unsigned char*)d_ws;
    void* args[] = {&p};
    hipError_t e = hipLaunchCooperativeKernel((const void*)mk::fwd, dim3(grid), dim3(512), args, mk::LDS_BYTES, stream);
    if (e != hipSuccess) fprintf(stderr, "cooperative launch failed: %s (grid %d)\n", hipGetErrorString(e), grid);
}
```

```cpp
#include <hip/hip_cooperative_groups.h>
#include <cstdio>
#include <hip/hip_runtime.h>
namespace pg8 {
#define PG8_LAS __attribute__((address_space(3)))
typedef unsigned short bf16_t;
typedef short bf16x8 __attribute__((ext_vector_type(8)));
typedef float f32x4 __attribute__((ext_vector_type(4)));
typedef unsigned u32x4 __attribute__((ext_vector_type(4)));
constexpr int BM = 256, BK = 64, HALF = 128, HTB = HALF * BK * 2  , STAGE_BYTES = 8 * HTB, NXCD = 8, WGM = 8;

__host__ __device__ __forceinline__ int lds_byte(int r, int c) { const int st = (r >> 4) * 2 + (c >> 5), rr = r & 15, cc = c & 31, ob = rr * 64 + cc * 2; return st * 1024 + (ob ^ (((ob >> 9) & 1) << 5)); }
__host__ __device__ __forceinline__ void stage_rc(int b, int& R, int& C) { const int st = b / 1024, sb = b % 1024, swz = sb ^ (((sb >> 9) & 1) << 5); R = (st >> 1) * 16 + swz / 64; C = (st & 1) * 32 + (swz % 64) / 2; }
__host__ __device__ __forceinline__ int perm32(int rho) { const int n = rho >> 4, i = rho & 15; return 8 * (i >> 2) + 4 * n + (i & 3); }

struct Unit { int pm, pn, ko; };
struct Gemm { const bf16_t* A; const bf16_t* Bt; int M, N, K, nt; };

struct StaticOrder {
    int nM, nN, nwg, G, c;
    __host__ __device__ void init(int M, int N, int G_, int c_) { nM = M / BM; nN = N / BM; nwg = nM * nN; G = G_; c = c_; }
    __host__ __device__ bool next(int i, Unit& u) const {
        const long L = (long)i * G + c; if (L >= nwg) return false;
        int wgid = (int)L; { const int q = nwg / NXCD, r = nwg % NXCD, xcd = wgid % NXCD, off = wgid / NXCD; wgid = (xcd < r ? xcd * (q + 1) : r * (q + 1) + (xcd - r) * q) + off; }
        const int nig = WGM * nN, gid = wgid / nig, fm = gid * WGM, gsz = (nM - fm) < WGM ? (nM - fm) : WGM;
        u.pm = fm + ((wgid % nig) % gsz); u.pn = (wgid % nig) / gsz; return true;
    }
    __device__ __forceinline__ void a_ready(const Unit&) const {}
    __device__ __forceinline__ void done(const Unit&) const {}
};
struct CountedOrder : StaticOrder {
    const unsigned* ready; unsigned need; unsigned* tmo;
    __device__ __forceinline__ void a_ready(const Unit& u) const {
        if (threadIdx.x < 64) {
            const unsigned long long t0 = __builtin_amdgcn_s_memrealtime(); unsigned polls = 0;
            while ((unsigned)__builtin_amdgcn_readfirstlane(__hip_atomic_load(ready + 64 * u.pm, __ATOMIC_RELAXED, __HIP_MEMORY_SCOPE_AGENT)) < need) {
                if ((++polls & 255u) == 0u && __builtin_amdgcn_readfirstlane(__hip_atomic_load(tmo, __ATOMIC_RELAXED, __HIP_MEMORY_SCOPE_AGENT)) != 0u) break;
                if (__builtin_amdgcn_s_memrealtime() - t0 > 2000000ull) {
                    if (threadIdx.x == 0) { unsigned expect = 0u; __hip_atomic_compare_exchange_strong(tmo + 1, &expect, 0x600u | (unsigned)(u.pm & 0xff), __ATOMIC_RELAXED, __ATOMIC_RELAXED, __HIP_MEMORY_SCOPE_AGENT); __hip_atomic_store(tmo, 1u, __ATOMIC_RELAXED, __HIP_MEMORY_SCOPE_AGENT); }
                    break; }
                __builtin_amdgcn_s_sleep(2); }
            __builtin_amdgcn_fence(__ATOMIC_ACQUIRE, "agent");
            asm volatile("s_waitcnt vmcnt(0)" ::: "memory");
        }
#if !defined(BROKEN_HOOK_NO_BARRIER)
        asm volatile("" ::: "memory"); __builtin_amdgcn_s_barrier(); asm volatile("" ::: "memory");
#endif
    }
};

__device__ __forceinline__ unsigned cvt_pk_bf16(float lo, float hi) { unsigned r; asm volatile("v_cvt_pk_bf16_f32 %0, %1, %2" : "=v"(r) : "v"(lo), "v"(hi)); return r; }
typedef float f32x2 __attribute__((ext_vector_type(2)));
__device__ __forceinline__ f32x2 gelu_pk(f32x2 v) {
    const f32x2 av = __builtin_elementwise_abs(v), d = av * 0.2316418882f + 1.0f;
    f32x2 t; t.x = __builtin_amdgcn_rcpf(d.x); t.y = __builtin_amdgcn_rcpf(d.y);
    f32x2 q = t * 0.5307027145f + (-0.7265760135f); q = q * t + 0.7107068705f; q = q * t + (-0.142248368f); q = q * t + 0.127414796f; q = q * t;
    const f32x2 s = (v * v) * (-0.72134752044f);
    f32x2 e; e.x = __builtin_amdgcn_exp2f(s.x); e.y = __builtin_amdgcn_exp2f(s.y);
    const f32x2 m = v * (q * e), r = v - m;
    f32x2 o; o.x = v.x < 0.f ? m.x : r.x; o.y = v.y < 0.f ? m.y : r.y; return o;
}

struct EpiF32 {
    static constexpr bool PERM = false, AFTER_DRAIN = false;
    float* C; int ldc; const float* bias;
    __device__ __forceinline__ void operator()(const f32x4 (&acc)[2][2][4][2], const Unit& u, int wr, int wc, int fr, int fq) const {
        const int row0 = u.pm * BM + wr * 64 + fr, col0 = u.pn * BM + wc * 32 + 4 * fq;
        f32x4 bv[2][2];
#pragma unroll
        for (int bj = 0; bj < 2; ++bj)
#pragma unroll
            for (int n = 0; n < 2; ++n) bv[bj][n] = bias ? *(const f32x4*)(bias + col0 + bj * HALF + n * 16) : (f32x4){0.f, 0.f, 0.f, 0.f};
#pragma unroll
        for (int ai = 0; ai < 2; ++ai)
#pragma unroll
            for (int m = 0; m < 4; ++m) { float* rowp = C + (size_t)(row0 + ai * HALF + m * 16) * ldc + col0;
#pragma unroll
                for (int bj = 0; bj < 2; ++bj)
#pragma unroll
                    for (int n = 0; n < 2; ++n) *(f32x4*)(rowp + bj * HALF + n * 16) = acc[ai][bj][m][n] + bv[bj][n]; }
    }
};
template <int ACT  > struct EpiBf16 {
    static constexpr bool PERM = true, AFTER_DRAIN = false;
    bf16_t* O; int ldc; const float* bias; int split_cols; size_t split_stride;
    __device__ __forceinline__ void operator()(const f32x4 (&acc)[2][2][4][2], const Unit& u, int wr, int wc, int fr, int fq) const {
        const int row0 = u.pm * BM + wr * 64 + fr; int colt = u.pn * BM; bf16_t* base = O;
        if (split_cols) { const int t = colt / split_cols; base += (size_t)t * split_stride; colt -= t * split_cols; }
        const int col0 = colt + wc * 32 + 8 * fq, bcol0 = u.pn * BM + wc * 32 + 8 * fq;
        f32x4 bv[2][2];
#pragma unroll
        for (int bj = 0; bj < 2; ++bj)
#pragma unroll
            for (int n = 0; n < 2; ++n) bv[bj][n] = bias ? *(const f32x4*)(bias + bcol0 + bj * HALF + 4 * n) : (f32x4){0.f, 0.f, 0.f, 0.f};
#pragma unroll
        for (int ai = 0; ai < 2; ++ai)
#pragma unroll
            for (int m = 0; m < 4; ++m) { bf16_t* rowp = base + (size_t)(row0 + ai * HALF + m * 16) * ldc + col0;
#pragma unroll
                for (int bj = 0; bj < 2; ++bj) { f32x4 v0 = acc[ai][bj][m][0] + bv[bj][0], v1 = acc[ai][bj][m][1] + bv[bj][1];
                    if (ACT == 1) { f32x2 a = gelu_pk((f32x2){v0[0], v0[1]}), b = gelu_pk((f32x2){v0[2], v0[3]}), c = gelu_pk((f32x2){v1[0], v1[1]}), d = gelu_pk((f32x2){v1[2], v1[3]});
                        v0 = (f32x4){a.x, a.y, b.x, b.y}; v1 = (f32x4){c.x, c.y, d.x, d.y}; }
                    if (ACT == 2) {
#pragma unroll
                        for (int j = 0; j < 4; ++j) { v0[j] = 0.5f * v0[j] * (1.0f + erff(v0[j] * 0.70710678f)); v1[j] = 0.5f * v1[j] * (1.0f + erff(v1[j] * 0.70710678f)); } }
                    u32x4 w; w.x = cvt_pk_bf16(v0[0], v0[1]); w.y = cvt_pk_bf16(v0[2], v0[3]); w.z = cvt_pk_bf16(v1[0], v1[1]); w.w = cvt_pk_bf16(v1[2], v1[3]);
                    *(u32x4*)(rowp + bj * HALF) = w; } }
    }
};

struct PanelStats {
    unsigned* xbuf;
    unsigned* cnt;
    unsigned* tmo;
    int ntn; float eps;
    unsigned code;
    __device__ __forceinline__ bool run(const f32x4 (&v)[2][2][4][2], const Unit& u, int wr, int wc, int fr, int fq, PG8_LAS unsigned char* lds, int wid, int lane) const {
        typedef float f32x2v __attribute__((ext_vector_type(2)));
        PG8_LAS f32x2v* P = (PG8_LAS f32x2v*)lds;
        PG8_LAS f32x2v* S = (PG8_LAS f32x2v*)(lds + 8192);
        PG8_LAS unsigned* flag = (PG8_LAS unsigned*)(lds + 8192 + 2048);
#pragma unroll
        for (int ai = 0; ai < 2; ++ai)
#pragma unroll
            for (int m = 0; m < 4; ++m) {
                float s = 0.f;
#pragma unroll
                for (int bj = 0; bj < 2; ++bj)
#pragma unroll
                    for (int n = 0; n < 2; ++n) { const f32x4 x = v[ai][bj][m][n]; s += (x[0] + x[1]) + (x[2] + x[3]); }
                s += __shfl_xor(s, 16); s += __shfl_xor(s, 32);
                const float mw = s * (1.0f / 64.0f); float q = 0.f;
#pragma unroll
                for (int bj = 0; bj < 2; ++bj)
#pragma unroll
                    for (int n = 0; n < 2; ++n) { const f32x4 d = v[ai][bj][m][n] - mw; q += (d[0] * d[0] + d[1] * d[1]) + (d[2] * d[2] + d[3] * d[3]); }
                q += __shfl_xor(q, 16); q += __shfl_xor(q, 32);
                if (fq == 0) P[(ai * HALF + wr * 64 + m * 16 + fr) * 4 + wc] = (f32x2v){mw, q};
            }
        asm volatile("s_waitcnt lgkmcnt(0)" ::: "memory"); __builtin_amdgcn_s_barrier(); asm volatile("" ::: "memory");
#if defined(BROKEN_NO_WAIT)
        if (blockIdx.x >= 64) { const long long t0 = clock64(); while (clock64() - t0 < 60000) __builtin_amdgcn_s_sleep(8); }
#endif
        const int row = wid * 32 + (lane & 31);
        if (lane < 32) {
            const f32x2v a = P[row * 4 + 0], b = P[row * 4 + 1], c = P[row * 4 + 2], d = P[row * 4 + 3];
            const float mt = (a.x + b.x + c.x + d.x) * 0.25f;
            const float da = a.x - mt, db = b.x - mt, dc = c.x - mt, dd = d.x - mt;
            const float m2 = (a.y + b.y) + (c.y + d.y) + 64.0f * ((da * da + db * db) + (dc * dc + dd * dd));
            unsigned long long* slot = (unsigned long long*)xbuf + ((size_t)(u.pm * BM + row) * 4 + u.pn);
            __hip_atomic_store(slot, ((unsigned long long)__float_as_uint(m2) << 32) | __float_as_uint(mt), __ATOMIC_RELAXED, __HIP_MEMORY_SCOPE_AGENT);
        }
        asm volatile("s_waitcnt vmcnt(0)" ::: "memory");
        if (lane == 0) __hip_atomic_fetch_add(cnt + 64 * u.pm, 1u, __ATOMIC_RELAXED, __HIP_MEMORY_SCOPE_AGENT);
        if (wid == 0) {
            bool dead = false; const unsigned long long t0 = __builtin_amdgcn_s_memrealtime(); const unsigned want = 8u * (unsigned)ntn;
            for (;;) {
#if defined(BROKEN_NO_WAIT)
                break;
#endif
                if ((unsigned)__builtin_amdgcn_readfirstlane(__hip_atomic_load(cnt + 64 * u.pm, __ATOMIC_RELAXED, __HIP_MEMORY_SCOPE_AGENT)) >= want) break;
                if (__builtin_amdgcn_s_memrealtime() - t0 > 2000000ull) {
                    if (lane == 0) { unsigned expect = 0u; __hip_atomic_compare_exchange_strong(tmo + 1, &expect, code | (unsigned)(u.pm & 0xff), __ATOMIC_RELAXED, __ATOMIC_RELAXED, __HIP_MEMORY_SCOPE_AGENT);
                                     __hip_atomic_store(tmo, 1u, __ATOMIC_RELAXED, __HIP_MEMORY_SCOPE_AGENT); }
                    dead = true; break; }
                __builtin_amdgcn_s_sleep(2);
            }
            __builtin_amdgcn_fence(__ATOMIC_ACQUIRE, "agent");
            if (lane == 0) flag[0] = dead ? 1u : 0u;
        }
        asm volatile("s_waitcnt vmcnt(0) lgkmcnt(0)" ::: "memory"); __builtin_amdgcn_s_barrier(); asm volatile("" ::: "memory");
        const bool bad = flag[0] != 0u;
        if (lane < 32) {
            const unsigned long long* slot = (const unsigned long long*)xbuf + (size_t)(u.pm * BM + row) * 4; float mt[4], m2[4]; float ms = 0.f;
#pragma unroll
            for (int t = 0; t < 4; ++t) { if (t < ntn) { const unsigned long long w = __hip_atomic_load(slot + t, __ATOMIC_RELAXED, __HIP_MEMORY_SCOPE_AGENT); mt[t] = __uint_as_float((unsigned)w); m2[t] = __uint_as_float((unsigned)(w >> 32)); } else { mt[t] = 0.f; m2[t] = 0.f; } ms += mt[t]; }
            const float mean = ms / (float)ntn; float q = 0.f;
#pragma unroll
            for (int t = 0; t < 4; ++t) if (t < ntn) { const float dm = mt[t] - mean; q += m2[t] + 256.0f * dm * dm; }
            S[row] = (f32x2v){mean, 1.0f / sqrtf(q / (256.0f * (float)ntn) + eps)};
        }
        asm volatile("s_waitcnt lgkmcnt(0)" ::: "memory"); __builtin_amdgcn_s_barrier(); asm volatile("" ::: "memory");
        return bad;
    }
};
struct EpiLnRes {
    static constexpr bool PERM = false, AFTER_DRAIN = true;
    const float* base; float* out; int ldc; const float* bias; PanelStats st; unsigned poison;
    __device__ __forceinline__ void refuse(size_t i0, size_t stride, int M, int N) const { const float q = __builtin_nanf(""); for (size_t i = i0; i < (size_t)M * N; i += stride) out[(i / N) * ldc + i % N] = q;
        if (i0 == 0) { unsigned expect = 0u; __hip_atomic_compare_exchange_strong(st.tmo + 1, &expect, 0x7f0u, __ATOMIC_RELAXED, __ATOMIC_RELAXED, __HIP_MEMORY_SCOPE_AGENT); __hip_atomic_store(st.tmo, 1u, __ATOMIC_RELAXED, __HIP_MEMORY_SCOPE_AGENT); } }
    __device__ __forceinline__ void fused(f32x4 (&acc)[2][2][4][2], const Unit& u, int wr, int wc, int fr, int fq, PG8_LAS unsigned char* lds, int wid, int lane) const {
        typedef float f32x2v __attribute__((ext_vector_type(2)));
        const PG8_LAS f32x2v* S = (const PG8_LAS f32x2v*)(lds + 8192);
        const int col0 = u.pn * BM + wc * 32 + 4 * fq;
#pragma unroll
        for (int bj = 0; bj < 2; ++bj)
#pragma unroll
            for (int n = 0; n < 2; ++n) { const f32x4 bv = bias ? *(const f32x4*)(bias + col0 + bj * HALF + n * 16) : (f32x4){0.f, 0.f, 0.f, 0.f};
#pragma unroll
                for (int ai = 0; ai < 2; ++ai)
#pragma unroll
                    for (int m = 0; m < 4; ++m) acc[ai][bj][m][n] += bv; }
        const bool bad = st.run(acc, u, wr, wc, fr, fq, lds, wid, lane) || poison != 0u;
        const float qnan = __builtin_nanf("");
#pragma unroll
        for (int ai = 0; ai < 2; ++ai)
#pragma unroll
            for (int m = 0; m < 4; ++m) { const int r = ai * HALF + wr * 64 + m * 16 + fr; const f32x2v sr = S[r]; const size_t off = (size_t)(u.pm * BM + r) * ldc + col0;
#pragma unroll
                for (int bj = 0; bj < 2; ++bj)
#pragma unroll
                    for (int n = 0; n < 2; ++n) { const f32x4 bs = *(const f32x4*)(base + off + bj * HALF + n * 16); f32x4 o = bs + (acc[ai][bj][m][n] - sr.x) * sr.y;
                        if (bad) o = (f32x4){qnan, qnan, qnan, qnan}; *(f32x4*)(out + off + bj * HALF + n * 16) = o; }
                asm volatile("" ::: "memory"); }
    }
};
struct EpiLnResLn {
    static constexpr bool PERM = false, AFTER_DRAIN = true;
    const float* base; float* out; bf16_t* xn; int ldc; const float* bias; PanelStats st1, st2; unsigned poison;
    __device__ __forceinline__ void refuse(size_t i0, size_t stride, int M, int N) const { const float q = __builtin_nanf(""); for (size_t i = i0; i < (size_t)M * N; i += stride) { const size_t o = (i / N) * ldc + i % N; out[o] = q; xn[o] = (bf16_t)0x7fc0u; }
        if (i0 == 0) { unsigned expect = 0u; __hip_atomic_compare_exchange_strong(st1.tmo + 1, &expect, 0x7f0u, __ATOMIC_RELAXED, __ATOMIC_RELAXED, __HIP_MEMORY_SCOPE_AGENT); __hip_atomic_store(st1.tmo, 1u, __ATOMIC_RELAXED, __HIP_MEMORY_SCOPE_AGENT); } }
    __device__ __forceinline__ void fused(f32x4 (&acc)[2][2][4][2], const Unit& u, int wr, int wc, int fr, int fq, PG8_LAS unsigned char* lds, int wid, int lane) const {
        typedef float f32x2v __attribute__((ext_vector_type(2))); typedef unsigned u32x2v __attribute__((ext_vector_type(2)));
        const PG8_LAS f32x2v* S = (const PG8_LAS f32x2v*)(lds + 8192);
        const int col0 = u.pn * BM + wc * 32 + 4 * fq;
#pragma unroll
        for (int bj = 0; bj < 2; ++bj)
#pragma unroll
            for (int n = 0; n < 2; ++n) { const f32x4 bv = bias ? *(const f32x4*)(bias + col0 + bj * HALF + n * 16) : (f32x4){0.f, 0.f, 0.f, 0.f};
#pragma unroll
                for (int ai = 0; ai < 2; ++ai)
#pragma unroll
                    for (int m = 0; m < 4; ++m) acc[ai][bj][m][n] += bv; }
        bool bad = st1.run(acc, u, wr, wc, fr, fq, lds, wid, lane) || poison != 0u;
        const float qnan = __builtin_nanf("");
#pragma unroll
        for (int ai = 0; ai < 2; ++ai)
#pragma unroll
            for (int m = 0; m < 4; ++m) { const int r = ai * HALF + wr * 64 + m * 16 + fr; const f32x2v sr = S[r]; const size_t off = (size_t)(u.pm * BM + r) * ldc + col0;
#pragma unroll
                for (int bj = 0; bj < 2; ++bj)
#pragma unroll
                    for (int n = 0; n < 2; ++n) { const f32x4 bs = *(const f32x4*)(base + off + bj * HALF + n * 16); acc[ai][bj][m][n] = bs + (acc[ai][bj][m][n] - sr.x) * sr.y; }
                asm volatile("" : "+v"(acc[ai][0][m][0]), "+v"(acc[ai][0][m][1]), "+v"(acc[ai][1][m][0]), "+v"(acc[ai][1][m][1]));
                if (m & 1) asm volatile("" ::: "memory"); }
        const bool bad1 = bad;
        bad = st2.run(acc, u, wr, wc, fr, fq, lds, wid, lane) || bad;
#pragma unroll
        for (int ai = 0; ai < 2; ++ai)
#pragma unroll
            for (int m = 0; m < 4; ++m) { const int r = ai * HALF + wr * 64 + m * 16 + fr; const f32x2v sr = S[r]; const size_t off = (size_t)(u.pm * BM + r) * ldc + col0;
#pragma unroll
                for (int bj = 0; bj < 2; ++bj)
#pragma unroll
                    for (int n = 0; n < 2; ++n) { const f32x4 x1 = acc[ai][bj][m][n]; *(f32x4*)(out + off + bj * HALF + n * 16) = bad1 ? (f32x4){qnan, qnan, qnan, qnan} : x1;
                        const f32x4 o = (x1 - sr.x) * sr.y; u32x2v w; w.x = cvt_pk_bf16(o[0], o[1]); w.y = cvt_pk_bf16(o[2], o[3]);
                        if (bad) { w.x = 0x7fc07fc0u; w.y = 0x7fc07fc0u; } *(u32x2v*)(xn + off + bj * HALF + n * 16) = w; }
                asm volatile("" ::: "memory"); }
    }
};

template <class Epi, class Sched, bool STAMP = false>
__device__ __forceinline__ void gemm_phase(PG8_LAS unsigned char* lds, const Gemm g, const Sched& S, const Epi& E, unsigned long long* stamps) {
    const int tid = threadIdx.x, wid = __builtin_amdgcn_readfirstlane(tid >> 6), lane = tid & 63, wr = wid >> 2, wc = wid & 3, fr = lane & 15, fq = lane >> 4;
    const int K = g.K, nt = g.nt ? g.nt : K / BK;
    int ts_lo = 0, ts_hi = 0, nts = 0; const unsigned long long rt_entry = STAMP ? (unsigned long long)wall_clock64() : 0ull;
#define PG8_STAMP() do { if (STAMP && wid == 0 && nts < 64) { const unsigned long long _c = (unsigned long long)clock64(); \
        ts_lo = (lane == nts) ? (int)(unsigned)_c : ts_lo; ts_hi = (lane == nts) ? (int)(unsigned)(_c >> 32) : ts_hi; ++nts; } } while (0)
    PG8_STAMP();
    unsigned voffA[2], voffB[2];
#pragma unroll
    for (int i = 0; i < 2; ++i) { int R, C; stage_rc(tid * 16 + i * 8192, R, C); const int Rb = Epi::PERM ? ((R & ~31) + perm32(R & 31)) : R;
        voffA[i] = (unsigned)(R * K + C) * 2u; voffB[i] = (unsigned)(Rb * K + C) * 2u; }
    const size_t kstep = (size_t)(BK * 2);
    const size_t hstep = (size_t)HALF * K * 2;
    const size_t tstep = 2 * hstep;
    const unsigned ldsw = (unsigned)wid * 1024u;
    const int aoff = lds_byte(wr * 64 + fr, fq * 8), boff = lds_byte(wc * 32 + fr, fq * 8);
#define PG8_SA(b, h) (((b) * 2 + (h)) * HTB)
#define PG8_SB(b, h) ((4 + (b) * 2 + (h)) * HTB)
#define PG8_STAGE(bufoff, gbase, voff) do { _Pragma("unroll") for (int _i = 0; _i < 2; ++_i) \
        __builtin_amdgcn_global_load_lds((const unsigned*)((const char*)(gbase) + (voff)[_i]), (PG8_LAS unsigned*)(lds + (bufoff) + ldsw + _i * 8192), 16, 0, 0); } while (0)
#define PG8_LDA(dst, b, h) do { _Pragma("unroll") for (int m = 0; m < 4; ++m) _Pragma("unroll") for (int k = 0; k < 2; ++k) dst[m][k] = *(const PG8_LAS bf16x8*)(lds + PG8_SA(b, h) + aoff + m * 2048 + k * 1024); } while (0)
#define PG8_LDB(dst, b, h) do { _Pragma("unroll") for (int n = 0; n < 2; ++n) _Pragma("unroll") for (int k = 0; k < 2; ++k) dst[n][k] = *(const PG8_LAS bf16x8*)(lds + PG8_SB(b, h) + boff + n * 2048 + k * 1024); } while (0)
#define PG8_MMA(ai, bj, At, Bt) do { __builtin_amdgcn_s_setprio(1); _Pragma("unroll") for (int m = 0; m < 4; ++m) _Pragma("unroll") for (int n = 0; n < 2; ++n) _Pragma("unroll") for (int k = 0; k < 2; ++k) \
        acc[ai][bj][m][n] = __builtin_amdgcn_mfma_f32_16x16x32_bf16(Bt[n][k], At[m][k], acc[ai][bj][m][n], 0, 0, 0); __builtin_amdgcn_s_setprio(0); } while (0)
#define PG8_WAIT_V(n) asm volatile("s_waitcnt vmcnt(" #n ")" ::: "memory")
#define PG8_WAIT_L(n) asm volatile("s_waitcnt lgkmcnt(" #n ")" ::: "memory")
#define PG8_BAR __builtin_amdgcn_s_barrier()
#define PG8_SCHED __builtin_amdgcn_sched_barrier(0)
    Unit cur{0, 0, 0}, nxt{0, 0, 0}; int ui = 0;
    if (!S.next(0, cur)) return;
    f32x4 acc[2][2][4][2];
#pragma unroll
    for (int a = 0; a < 2; ++a)
#pragma unroll
        for (int b = 0; b < 2; ++b)
#pragma unroll
            for (int m = 0; m < 4; ++m)
#pragma unroll
                for (int n = 0; n < 2; ++n) acc[a][b][m][n] = (f32x4){0.f, 0.f, 0.f, 0.f};
    bf16x8 At[4][2], B0[2][2], B1[2][2];
    const char* cA = (const char*)g.A + (size_t)cur.pm * tstep + (size_t)cur.ko * 2; const char* cB = (const char*)g.Bt + (size_t)cur.pn * tstep + (size_t)cur.ko * 2;
    S.a_ready(cur);
    PG8_STAGE(PG8_SB(0, 0), cB, voffB); PG8_STAGE(PG8_SA(0, 0), cA, voffA); PG8_STAGE(PG8_SB(0, 1), cB + hstep, voffB); PG8_STAGE(PG8_SA(0, 1), cA + hstep, voffA);
    if (wr == 1) PG8_BAR;
    PG8_WAIT_V(4); PG8_BAR;
    PG8_STAGE(PG8_SB(1, 0), cB + kstep, voffB); PG8_STAGE(PG8_SA(1, 0), cA + kstep, voffA); PG8_STAGE(PG8_SB(1, 1), cB + hstep + kstep, voffB);
    PG8_WAIT_V(6); PG8_BAR;
    PG8_STAMP();
    for (;;) {
        const bool has_next = S.next(ui + 1, nxt);
        const char* nA = has_next ? (const char*)g.A + (size_t)nxt.pm * tstep + (size_t)nxt.ko * 2 : cA; const char* nB = has_next ? (const char*)g.Bt + (size_t)nxt.pn * tstep + (size_t)nxt.ko * 2 : cB;
        for (int t = 0; t < nt; t += 2) {
            const bool last = (t == nt - 2);
            const char* a1 = cA + (size_t)(t + 1) * kstep;
            const char* a2 = last ? nA : cA + (size_t)(t + 2) * kstep; const char* b2 = last ? nB : cB + (size_t)(t + 2) * kstep;
            const char* a3 = a2 + kstep; const char* b3 = b2 + kstep;
            if (last && has_next) S.a_ready(nxt);
            PG8_LDB(B0, 0, 0); PG8_SCHED; PG8_LDA(At, 0, 0); PG8_STAGE(PG8_SA(1, 1), a1 + hstep, voffA);
            PG8_WAIT_L(8); PG8_BAR; PG8_WAIT_L(0); PG8_MMA(0, 0, At, B0); PG8_BAR; PG8_SCHED;
            PG8_LDB(B1, 0, 1); PG8_STAGE(PG8_SB(0, 0), b2, voffB);
            PG8_BAR; PG8_WAIT_L(0); PG8_MMA(0, 1, At, B1); PG8_BAR;
            PG8_LDA(At, 0, 1); PG8_STAGE(PG8_SA(0, 0), a2, voffA);
            PG8_BAR; PG8_WAIT_L(0); PG8_MMA(1, 0, At, B0); PG8_BAR; PG8_SCHED;
            PG8_STAGE(PG8_SB(0, 1), b2 + hstep, voffB);
            PG8_WAIT_V(6); PG8_BAR; PG8_MMA(1, 1, At, B1); PG8_BAR;
            PG8_LDB(B0, 1, 0); PG8_SCHED; PG8_LDA(At, 1, 0); PG8_STAGE(PG8_SA(0, 1), a2 + hstep, voffA);
            PG8_WAIT_L(8); PG8_BAR; PG8_WAIT_L(0); PG8_MMA(0, 0, At, B0); PG8_BAR; PG8_SCHED;
            PG8_LDB(B1, 1, 1); PG8_STAGE(PG8_SB(1, 0), b3, voffB);
            PG8_BAR; PG8_WAIT_L(0); PG8_MMA(0, 1, At, B1); PG8_BAR;
            PG8_LDA(At, 1, 1); PG8_STAGE(PG8_SA(1, 0), a3, voffA);
            PG8_BAR; PG8_WAIT_L(0); PG8_MMA(1, 0, At, B0); PG8_BAR; PG8_SCHED;
            PG8_STAGE(PG8_SB(1, 1), b3 + hstep, voffB);
            PG8_WAIT_V(6); PG8_BAR; PG8_MMA(1, 1, At, B1); PG8_BAR;
        }
        PG8_STAMP();
        if constexpr (!Epi::AFTER_DRAIN) { E(acc, cur, wr, wc, fr, fq); S.done(cur); }
        PG8_STAMP();
        if (!has_next) break;
        if (!Epi::keep(nxt))
#pragma unroll
        for (int a = 0; a < 2; ++a)
#pragma unroll
            for (int b = 0; b < 2; ++b)
#pragma unroll
                for (int m = 0; m < 4; ++m)
#pragma unroll
                    for (int n = 0; n < 2; ++n) acc[a][b][m][n] = (f32x4){0.f, 0.f, 0.f, 0.f};
        cur = nxt; cA = nA; cB = nB; ++ui;
    }
    PG8_WAIT_V(0);
    if (wr == 0) PG8_BAR;
    PG8_BAR;
    if constexpr (Epi::AFTER_DRAIN) { E.fused(acc, cur, wr, wc, fr, fq, lds, wid, lane); S.done(cur); }
    PG8_STAMP();
    if (STAMP && wid == 0) { stamps[lane] = lane < nts ? (((unsigned long long)(unsigned)ts_hi << 32) | (unsigned)ts_lo) : 0ull;
        if (lane == 62) stamps[62] = rt_entry; if (lane == 63) stamps[63] = (unsigned long long)wall_clock64(); }
#undef PG8_STAMP
#undef PG8_SA
#undef PG8_SB
#undef PG8_STAGE
#undef PG8_LDA
#undef PG8_LDB
#undef PG8_MMA
#undef PG8_WAIT_V
#undef PG8_WAIT_L
#undef PG8_BAR
#undef PG8_SCHED
}
}

namespace mk {
namespace cg = cooperative_groups;
#define LAS __attribute__((address_space(3)))
typedef unsigned short bf16;
typedef short bf16x8 __attribute__((ext_vector_type(8)));
typedef float f32x4 __attribute__((ext_vector_type(4)));
typedef float f32x2 __attribute__((ext_vector_type(2)));
typedef unsigned u32x4 __attribute__((ext_vector_type(4)));
typedef unsigned u32x2 __attribute__((ext_vector_type(2)));

constexpr int NT = 17408, NPT = 16384, DM = 1024;
constexpr size_t MiB = 1u << 20;
constexpr size_t WS_WIN = 0, WS_WBR = 28 * MiB, WS_WOUT = 34 * MiB, WS_WDEC = 36 * MiB, WS_WAAA = WS_WDEC + 131072, WS_WRGA = WS_WAAA + 131072, WS_WRGX = WS_WRGA + 131072;
constexpr size_t WS_XN = 38 * MiB, WS_U = 76 * MiB, WS_Z = 178 * MiB, WS_XB = 280 * MiB, WS_Q = 314 * MiB, WS_G = 348 * MiB, WS_XWA = 450 * MiB;
constexpr size_t WS_MK = 459 * MiB, WS_MVT = 463 * MiB, WS_BONUS = 467 * MiB, WS_STATS = 469 * MiB, WS_CTR = 474 * MiB, WS_END = 475 * MiB;
constexpr size_t WS_ORAW = WS_XN, WS_P = WS_U, WS_MERGED = WS_XB;
constexpr size_t ZSTRIDE = (size_t)NT * DM;
constexpr int LDS_BYTES = 147456;
constexpr size_t O_Y = 0, O_RWP = 17825792, O_SHP = O_RWP + 524288, O_LRP = O_SHP + 25600, O_CVP = O_LRP + 8192, O_MKP = O_CVP + 24576, O_MVP = O_MKP + 2097152,
                 O_RWS = O_MVP + 2097152, O_SHS = O_RWS + 8388608, O_LRS = O_SHS + 409600, O_CVS = O_LRS + 131072, O_END = O_CVS + 393216;

struct Params { const float* in[35]; float* out; unsigned char* ws; int zero; int pad; };
#define PREF const __attribute__((address_space(4))) Params&
typedef const __attribute__((address_space(4))) Params CParams;
__device__ __forceinline__ CParams* launder(CParams* x) { asm volatile("" : "+s"(x)); return x; }
enum { I_XP = 0, I_XS, I_MEM, I_SRW, I_SSH, I_SLRU, I_SCV, I_CK, I_CV, I_GN, I_WIN, I_MU, I_W0, I_WDEC, I_A0, I_WAAA, I_KK, I_KA, I_RK, I_GNG, I_GNB, I_CW, I_CB, I_WRGA, I_BRGA, I_WRGX, I_BRGX, I_LAM, I_GMEM, I_WMEM, I_WBA, I_WBB, I_WBC, I_WOUT, I_GF };

__device__ __forceinline__ unsigned f2bf(float f) { unsigned u = __builtin_bit_cast(unsigned, f); return (u + 0x7fffu + ((u >> 16) & 1u)) >> 16; }
__device__ __forceinline__ unsigned pk2(float lo, float hi) { unsigned r; asm("v_cvt_pk_bf16_f32 %0, %1, %2" : "=v"(r) : "v"(lo), "v"(hi)); return r; }
__device__ __forceinline__ float bf2f(unsigned b) { return __builtin_bit_cast(float, b << 16); }
__device__ __forceinline__ float bflo(unsigned w) { return __builtin_bit_cast(float, w << 16); }
__device__ __forceinline__ float bfhi(unsigned w) { return __builtin_bit_cast(float, w & 0xffff0000u); }
__device__ __forceinline__ const float* opq(const float* x) { asm volatile("" : "+s"(x)); return x; }
__device__ __forceinline__ float sigm(float x) { return __builtin_amdgcn_rcpf(1.0f + __builtin_amdgcn_exp2f(x * -1.44269504f)); }
#define LDS_WAIT() asm volatile("s_waitcnt lgkmcnt(0)" ::: "memory")
template <int CTRL> __device__ __forceinline__ float dppf(float x) { return __builtin_bit_cast(float, __builtin_amdgcn_update_dpp(0, __builtin_bit_cast(int, x), CTRL, 0xF, 0xF, true)); }
__device__ __forceinline__ float row16_sum(float x) { x += dppf<0xB1>(x); x += dppf<0x4E>(x); x += dppf<0x141>(x); x += dppf<0x140>(x); return x; }
__device__ __forceinline__ float row16_max(float x) { x = fmaxf(x, dppf<0xB1>(x)); x = fmaxf(x, dppf<0x4E>(x)); x = fmaxf(x, dppf<0x141>(x)); x = fmaxf(x, dppf<0x140>(x)); return x; }
__device__ __forceinline__ float rdl(float x, int l) { return __builtin_bit_cast(float, __builtin_amdgcn_readlane(__builtin_bit_cast(int, x), l)); }
__device__ __forceinline__ float wave_sum(float x) { x = row16_sum(x); return (rdl(x, 0) + rdl(x, 16)) + (rdl(x, 32) + rdl(x, 48)); }
__device__ __forceinline__ float wave_max(float x) { x = row16_max(x); x = fmaxf(x, __shfl_xor(x, 16)); x = fmaxf(x, __shfl_xor(x, 32)); return x; }

struct EpiMain {
    static constexpr bool PERM = true, AFTER_DRAIN = false;
    static __device__ __forceinline__ bool keep(const pg8::Unit&) { return false; }
    unsigned char* ws;
    __device__ __forceinline__ void operator()(const pg8::f32x4 (&acc)[2][2][4][2], const pg8::Unit& u, int wr, int wc, int fr, int fq) const {
        const int pn = u.pn, row0 = u.pm * 256 + wr * 64 + fr;
        if (pn == 44) {
            float* X = (float*)(ws + WS_XWA);
#pragma unroll
            for (int ai = 0; ai < 2; ++ai)
#pragma unroll
                for (int m = 0; m < 4; ++m) { float* rp = X + (size_t)(row0 + ai * 128 + m * 16) * 128 + wc * 32 + 8 * fq;
                    *(f32x4*)rp = acc[ai][0][m][0]; *(f32x4*)(rp + 4) = acc[ai][0][m][1]; }
            return;
        }
        bf16* base; int ld, colt, act;
        if (pn < 12) { base = (bf16*)(ws + WS_U); ld = 3072; colt = pn * 256; act = 0; }
        else if (pn < 16) { base = (bf16*)(ws + WS_Z); ld = 1024; colt = (pn - 12) * 256; act = 1; }
        else if (pn < 20) { base = (bf16*)(ws + WS_XB); ld = 1024; colt = (pn - 16) * 256; act = 0; }
        else if (pn < 24) { base = (bf16*)(ws + WS_Z) + ZSTRIDE; ld = 1024; colt = (pn - 20) * 256; act = 1; }
        else if (pn < 28) { base = (bf16*)(ws + WS_Q); ld = 1024; colt = (pn - 24) * 256; act = 0; }
        else if (pn < 32) { base = (bf16*)(ws + WS_Z) + 2 * ZSTRIDE; ld = 1024; colt = (pn - 28) * 256; act = 1; }
        else { base = (bf16*)(ws + WS_G); ld = 3072; colt = (pn - 32) * 256; act = 2; }
        const int col0 = colt + wc * 32 + 8 * fq;
#pragma unroll
        for (int ai = 0; ai < 2; ++ai)
#pragma unroll
            for (int m = 0; m < 4; ++m) { bf16* rowp = base + (size_t)(row0 + ai * 128 + m * 16) * ld + col0;
#pragma unroll
                for (int bj = 0; bj < 2; ++bj) { pg8::f32x4 v0 = acc[ai][bj][m][0], v1 = acc[ai][bj][m][1];
                    if (act) {
#pragma unroll
                        for (int j = 0; j < 4; ++j) { const float s0 = sigm(v0[j]), s1 = sigm(v1[j]); v0[j] = act == 1 ? v0[j] * s0 : s0; v1[j] = act == 1 ? v1[j] * s1 : s1; } }
                    u32x4 w; w.x = pk2(v0[0], v0[1]); w.y = pk2(v0[2], v0[3]); w.z = pk2(v1[0], v1[1]); w.w = pk2(v1[2], v1[3]);
                    *(u32x4*)(rowp + bj * 128) = w; } }
    }
};
struct EpiMem {
    static constexpr bool PERM = false, AFTER_DRAIN = false;
    static __device__ __forceinline__ bool keep(const pg8::Unit&) { return false; }
    unsigned char* ws; float* out;
    __device__ __forceinline__ void operator()(const pg8::f32x4 (&acc)[2][2][4][2], const pg8::Unit& u, int wr, int wc, int fr, int fq) const {
        const int row0 = u.pm * 256 + wr * 64 + fr; const bool isv = u.pn >= 4; const int colt = (u.pn & 3) * 256 + wc * 32 + 4 * fq;
        float* of = out + (isv ? O_MVP : O_MKP); bf16* MK = (bf16*)(ws + WS_MK); bf16* MVT = (bf16*)(ws + WS_MVT);
#pragma unroll
        for (int ai = 0; ai < 2; ++ai)
#pragma unroll
            for (int m = 0; m < 4; ++m) { const int r = row0 + ai * 128 + m * 16;
#pragma unroll
                for (int bj = 0; bj < 2; ++bj)
#pragma unroll
                    for (int n = 0; n < 2; ++n) { const int c = colt + bj * 128 + n * 16; const pg8::f32x4 v = acc[ai][bj][m][n];
                        *(f32x4*)(of + (size_t)r * 1024 + c) = v;
                        if (!isv) { u32x2 w; w.x = pk2(v[0], v[1]); w.y = pk2(v[2], v[3]); *(u32x2*)(MK + (size_t)r * 1024 + c) = w; }
                        else { const int b = r >> 8, mem = r & 255, head = c >> 8, d = c & 255; bf16* q = MVT + ((size_t)((b * 4 + head) * 256 + d)) * 256 + mem;
                            q[0] = (bf16)f2bf(v[0]); q[256] = (bf16)f2bf(v[1]); q[512] = (bf16)f2bf(v[2]); q[768] = (bf16)f2bf(v[3]); } } }
    }
};
struct SchedMem { int c;
    __device__ bool next(int i, pg8::Unit& u) const { if (i != 0 || c >= 64) return false; u.pm = c >> 3; u.pn = c & 7; return true; }
    __device__ __forceinline__ void a_ready(const pg8::Unit&) const {}
    __device__ __forceinline__ void done(const pg8::Unit&) const {}
};
struct EpiTail {
    static constexpr bool PERM = true, AFTER_DRAIN = false;
    static __device__ __forceinline__ bool keep(const pg8::Unit& nxt) { return (nxt.pn >> 2) != 0; }
    unsigned char* ws;
    __device__ __forceinline__ void operator()(pg8::f32x4 (&acc)[2][2][4][2], const pg8::Unit& u, int wr, int wc, int fr, int fq) const {
        const int br = u.pn >> 2, pmm = u.pm - br * 68, pnn = u.pn & 3;
        const int row0 = pmm * 256 + wr * 64 + fr, col0 = pnn * 256 + wc * 32 + 8 * fq;
        const bf16* gbase = (const bf16*)(ws + WS_G) + (size_t)row0 * 3072 + br * 1024 + col0; const int hoff = br < 2 ? 1024 : 0; const bool last = br == 2;
#define MK_CLAMP8(g, f0, f1) pg8::f32x4 f0 = {fmaxf(bflo(g.x), 1e-20f), fmaxf(bfhi(g.x), 1e-20f), fmaxf(bflo(g.y), 1e-20f), fmaxf(bfhi(g.y), 1e-20f)}, f1 = {fmaxf(bflo(g.z), 1e-20f), fmaxf(bfhi(g.z), 1e-20f), fmaxf(bflo(g.w), 1e-20f), fmaxf(bfhi(g.w), 1e-20f)}
#pragma unroll
        for (int ai = 0; ai < 2; ++ai)
#pragma unroll
            for (int m = 0; m < 4; ++m) {
#pragma unroll
                for (int bj = 0; bj < 2; ++bj) { const bf16* gp = gbase + (size_t)(ai * 128 + m * 16) * 3072 + bj * 128; const u32x4 g = *(const u32x4*)gp, h = *(const u32x4*)(gp + hoff);
                    MK_CLAMP8(g, f0, f1); MK_CLAMP8(h, d0, d1);
#pragma unroll
                    for (int j = 0; j < 4; ++j) { d0[j] = last ? 1.0f : __builtin_amdgcn_rcpf(d0[j]); d1[j] = last ? 1.0f : __builtin_amdgcn_rcpf(d1[j]); }
                    acc[ai][bj][m][0] *= f0 * d0; acc[ai][bj][m][1] *= f1 * d1; }
                asm volatile("" ::: "memory"); }
#undef MK_CLAMP8
        if (last) { bf16* mbase = (bf16*)(ws + WS_MERGED) + (size_t)row0 * 1024 + col0;
#pragma unroll
            for (int ai = 0; ai < 2; ++ai)
#pragma unroll
                for (int m = 0; m < 4; ++m)
#pragma unroll
                    for (int bj = 0; bj < 2; ++bj) { const pg8::f32x4 v0 = acc[ai][bj][m][0], v1 = acc[ai][bj][m][1];
                        u32x4 w; w.x = pk2(v0[0], v0[1]); w.y = pk2(v0[2], v0[3]); w.z = pk2(v1[0], v1[1]); w.w = pk2(v1[2], v1[3]); *(u32x4*)(mbase + (size_t)(ai * 128 + m * 16) * 1024 + bj * 128) = w; } }
    }
};
struct SchedTail { int c;
    __device__ bool next(int i, pg8::Unit& u) const { if (i >= 3) return false; const int t = (c & 7) * 32 + (c >> 3); u.pm = i * 68 + (t >> 2); u.pn = i * 4 + (t & 3); return true; }
    __device__ __forceinline__ void a_ready(const pg8::Unit&) const {}
    __device__ __forceinline__ void done(const pg8::Unit&) const {}
};
struct EpiPart {
    static constexpr bool PERM = false, AFTER_DRAIN = false;
    static __device__ __forceinline__ bool keep(const pg8::Unit&) { return false; }
    unsigned char* ws;
    __device__ __forceinline__ void operator()(const pg8::f32x4 (&acc)[2][2][4][2], const pg8::Unit& u, int wr, int wc, int fr, int fq) const {
        const int br = u.pn >> 2, pmm = u.pm - br * 68 - 64, pnn = u.pn & 3, kq = u.ko >> 8;
        const int row0 = pmm * 256 + wr * 64 + fr, col0 = pnn * 256 + wc * 32 + 4 * fq;
        float* P = (float*)(ws + WS_P) + (size_t)(kq * 3 + br) * 1048576;
#pragma unroll
        for (int ai = 0; ai < 2; ++ai)
#pragma unroll
            for (int m = 0; m < 4; ++m) { float* rowp = P + (size_t)(row0 + ai * 128 + m * 16) * 1024 + col0;
#pragma unroll
                for (int bj = 0; bj < 2; ++bj)
#pragma unroll
                    for (int n = 0; n < 2; ++n) *(f32x4*)(rowp + bj * 128 + n * 16) = acc[ai][bj][m][n]; }
    }
};
struct SchedBrS { int c;
    __device__ bool next(int i, pg8::Unit& u) const { if (i != 0 || c >= 192) return false; const int kq = c & 3, idx = c >> 2, br = idx >> 4, t = idx & 15; u.pm = br * 68 + 64 + (t >> 2); u.pn = br * 4 + (t & 3); u.ko = kq * 256; return true; }
    __device__ __forceinline__ void a_ready(const pg8::Unit&) const {}
    __device__ __forceinline__ void done(const pg8::Unit&) const {}
};
struct SchedOutS { int c;
    __device__ bool next(int i, pg8::Unit& u) const { if (i != 0 || c >= 16) return false; u.pm = 64 + (c >> 2); u.pn = c & 3; return true; }
    __device__ __forceinline__ void a_ready(const pg8::Unit&) const {}
    __device__ __forceinline__ void done(const pg8::Unit&) const {}
};
struct EpiOut {
    static constexpr bool PERM = false, AFTER_DRAIN = false;
    static __device__ __forceinline__ bool keep(const pg8::Unit&) { return false; }
    const float* xp; const float* xs; float* out;
    __device__ __forceinline__ void operator()(const pg8::f32x4 (&acc)[2][2][4][2], const pg8::Unit& u, int wr, int wc, int fr, int fq) const {
        const int row0 = u.pm * 256 + wr * 64 + fr, col0 = u.pn * 256 + wc * 32 + 4 * fq;
#pragma unroll
        for (int ai = 0; ai < 2; ++ai)
#pragma unroll
            for (int m = 0; m < 4; ++m) { const int r = row0 + ai * 128 + m * 16; const float* xr = (r < NPT ? xp + (size_t)r * 1024 : xs + (size_t)(r - NPT) * 1024) + col0; float* orow = out + (size_t)r * 1024 + col0;
#pragma unroll
                for (int bj = 0; bj < 2; ++bj)
#pragma unroll
                    for (int n = 0; n < 2; ++n) *(f32x4*)(orow + bj * 128 + n * 16) = *(const f32x4*)(xr + bj * 128 + n * 16) + acc[ai][bj][m][n]; }
    }
};

__device__ __forceinline__ void transpose_item(const float* W, int K, int N, bf16* WT, int row_off, LAS float* scr, int item, int lane) {
    const int nblk = N / 32, kb = item / nblk, nb = item % nblk, k0 = 64 * kb, n0 = 32 * nb;
    float tv[32];
#pragma unroll
    for (int i = 0; i < 32; ++i) tv[i] = W[(size_t)(k0 + 2 * i + (lane >> 5)) * N + n0 + (lane & 31)];
#pragma unroll
    for (int i = 0; i < 32; ++i) scr[(2 * i + (lane >> 5)) * 33 + (lane & 31)] = tv[i];
    LDS_WAIT();
    const int c = lane & 7;
#pragma unroll
    for (int j = 0; j < 4; ++j) { const int n = (lane >> 3) + 8 * j; const LAS float* s = scr + (8 * c) * 33 + n;
        u32x4 o; o.x = pk2(s[0 * 33], s[1 * 33]); o.y = pk2(s[2 * 33], s[3 * 33]); o.z = pk2(s[4 * 33], s[5 * 33]); o.w = pk2(s[6 * 33], s[7 * 33]);
        *(u32x4*)(WT + (size_t)(row_off + n0 + n) * K + k0 + 8 * c) = o; }
    LDS_WAIT();
}
__device__ __forceinline__ void rms_row_to_bf16(const float* xrow, const float* g, bf16* orow, int lane) {
    const f32x4* xr = (const f32x4*)xrow + lane; const f32x4* gr = (const f32x4*)g + lane;
    f32x4 v[4]; float s = 0.f;
#pragma unroll
    for (int j = 0; j < 4; ++j) { v[j] = xr[64 * j]; s += (v[j].x * v[j].x + v[j].y * v[j].y) + (v[j].z * v[j].z + v[j].w * v[j].w); }
    const float rstd = rsqrtf(wave_sum(s) * (1.f / 1024.f) + 1e-6f);
    unsigned long long* o8 = (unsigned long long*)orow + lane;
#pragma unroll
    for (int j = 0; j < 4; ++j) { const f32x4 gg = gr[64 * j]; o8[64 * j] = (unsigned long long)pk2(v[j].x * rstd * gg.x, v[j].y * rstd * gg.y) | ((unsigned long long)pk2(v[j].z * rstd * gg.z, v[j].w * rstd * gg.w) << 32); }
}
__device__ __forceinline__ void p0_prologue(PREF p, LAS unsigned char* lds, int tid, int wave, int lane, int G) {
    unsigned char* ws = p.ws;
    LAS float* scr = (LAS float*)(lds + wave * 16384);
    const int gw = blockIdx.x * 8 + wave, NGW = G * 8;
    bf16* WIN = (bf16*)(ws + WS_WIN);
    constexpr int I_IN = 16 * 356, I_MM = 16 * 64, I_B = 16 * 32, I_L = 32, I_R = 2;
    constexpr int NITEMS = I_IN + I_MM + 4 * I_B + 2 * I_L + 32 * I_R;
    for (int it = gw; it < NITEMS; it += NGW) {
        int r = it;
        if (r < I_IN) { const int n0 = 32 * (r % 356); const int dst = n0 < 3072 ? n0 : (n0 < 3200 ? 11264 + n0 - 3072 : n0 - 128); transpose_item(p.in[I_WIN], 1024, 11392, WIN, dst - n0, scr, r, lane); continue; } r -= I_IN;
        if (r < I_MM) { transpose_item(p.in[I_WMEM], 1024, 2048, WIN + (size_t)11520 * 1024, 0, scr, r, lane); continue; } r -= I_MM;
        if (r < 3 * I_B) { const int br = r / I_B; const float* wa = opq(p.in[I_WBA]); const float* wb = opq(p.in[I_WBB]); const float* wc = opq(p.in[I_WBC]); transpose_item(br == 0 ? wa : (br == 1 ? wb : wc), 1024, 1024, (bf16*)(ws + WS_WBR) + (size_t)br * 1024 * 1024, 0, scr, r - br * I_B, lane); continue; } r -= 3 * I_B;
        if (r < I_B) { transpose_item(p.in[I_WOUT], 1024, 1024, (bf16*)(ws + WS_WOUT), 0, scr, r, lane); continue; } r -= I_B;
        if (r < I_L) { transpose_item(p.in[I_WDEC], 64, 1024, (bf16*)(ws + WS_WDEC), 0, scr, r, lane); continue; } r -= I_L;
        if (r < I_L) { transpose_item(p.in[I_WAAA], 64, 1024, (bf16*)(ws + WS_WAAA), 0, scr, r, lane); continue; } r -= I_L;
        { const int which = r / 32, rr = r % 32, g = rr >> 1, sub = rr & 1;
          const float* ra = opq(p.in[I_WRGA]); const float* rx = opq(p.in[I_WRGX]); transpose_item((which ? rx : ra) + g * 4096, 64, 64, (bf16*)(ws + (which ? WS_WRGX : WS_WRGA)) + g * 4096, 0, scr, sub, lane); }
    }
    if (blockIdx.x == 0) for (int i = tid; i < 8192; i += 512) ((unsigned*)(ws + WS_CTR))[i] = 0u;
    { u32x4* z = (u32x4*)(WIN + (size_t)11392 * 1024); const u32x4 zero = {0u, 0u, 0u, 0u}; for (int i = blockIdx.x * 512 + tid; i < 128 * 1024 / 8; i += G * 512) z[i] = zero; }
    bf16* XN = (bf16*)(ws + WS_XN);
    const float* pxp = opq(p.in[I_XP]); const float* pxs = opq(p.in[I_XS]); const float* pmem = opq(p.in[I_MEM]); const float* pgn = opq(p.in[I_GN]); const float* pgm = opq(p.in[I_GMEM]);
    for (int m0 = gw; m0 < NT + 2048; m0 += 2 * NGW) {
        const float* src[2]; const float* g[2]; bf16* dst[2]; f32x4 v[2][4]; float ss[2];
#pragma unroll
        for (int q = 0; q < 2; ++q) { int m = m0 + q * NGW; if (m >= NT + 2048) m = m0;
            if (m < NPT) { src[q] = pxp + (size_t)m * 1024; g[q] = pgn; } else if (m < NT) { src[q] = pxs + (size_t)(m - NPT) * 1024; g[q] = pgn; } else { src[q] = pmem + (size_t)(m - NT) * 1024; g[q] = pgm; }
            dst[q] = XN + (size_t)m * 1024; }
#pragma unroll
        for (int q = 0; q < 2; ++q) { const f32x4* xr = (const f32x4*)src[q] + lane; float s2 = 0.f;
#pragma unroll
            for (int j = 0; j < 4; ++j) { v[q][j] = xr[64 * j]; }
#pragma unroll
            for (int j = 0; j < 4; ++j) s2 += (v[q][j].x * v[q][j].x + v[q][j].y * v[q][j].y) + (v[q][j].z * v[q][j].z + v[q][j].w * v[q][j].w);
            ss[q] = s2; }
#pragma unroll
        for (int q = 0; q < 2; ++q) { const float rstd = rsqrtf(wave_sum(ss[q]) * (1.f / 1024.f) + 1e-6f); const f32x4* gr = (const f32x4*)g[q] + lane; unsigned long long* o8 = (unsigned long long*)dst[q] + lane;
#pragma unroll
            for (int j = 0; j < 4; ++j) { const f32x4 gg = gr[64 * j]; o8[64 * j] = (unsigned long long)pk2(v[q][j].x * rstd * gg.x, v[q][j].y * rstd * gg.y) | ((unsigned long long)pk2(v[q][j].z * rstd * gg.z, v[q][j].w * rstd * gg.w) << 32); } }
    }
}

__device__ __forceinline__ bf16x8 pack8(const float (&x)[8]) { u32x4 w; w.x = pk2(x[0], x[1]); w.y = pk2(x[2], x[3]); w.z = pk2(x[4], x[5]); w.w = pk2(x[6], x[7]); return __builtin_bit_cast(bf16x8, w); }
__device__ __forceinline__ void p2_lora(PREF p, int vb, int NB, int tid, int wave, int lane) {
    unsigned char* ws = p.ws;
    const float* XWA = (const float*)(ws + WS_XWA); const bf16* U = (const bf16*)(ws + WS_U); const bf16* XB = (const bf16*)(ws + WS_XB);
    const bf16* WDEC = (const bf16*)(ws + WS_WDEC); const bf16* WAAA = (const bf16*)(ws + WS_WAAA);
    bf16* E = (bf16*)p.out; bf16* A = E + ZSTRIDE;
    const float* mu = p.in[I_MU]; const float* w0 = p.in[I_W0]; const float* a0 = p.in[I_A0]; const float* ssh = p.in[I_SSH];
    const int trow = lane & 15, kg = lane >> 4;
    for (int item = vb * 8 + wave; item < NT / 16; item += NB * 8) {
        const int tok = item * 16 + trow; const bool prm = tok < NPT; const int s = prm ? (tok & 2047) : ((tok - NPT) & 7); const int bs = (tok - NPT) >> 3;
        bf16x8 Aw[2], Aa[2];
#pragma unroll
        for (int ks = 0; ks < 2; ++ks) { const int k0 = 32 * ks + 8 * kg; float xw[8], xa[8];
#pragma unroll
            for (int hlf = 0; hlf < 2; ++hlf) {
                const f32x4 cw = *(const f32x4*)(XWA + (size_t)tok * 128 + k0 + 4 * hlf), ca = *(const f32x4*)(XWA + (size_t)tok * 128 + 64 + k0 + 4 * hlf);
                f32x4 pw = {0.f, 0.f, 0.f, 0.f}, pa = {0.f, 0.f, 0.f, 0.f};
                if (s > 0) { pw = *(const f32x4*)(XWA + (size_t)(tok - 1) * 128 + k0 + 4 * hlf); pa = *(const f32x4*)(XWA + (size_t)(tok - 1) * 128 + 64 + k0 + 4 * hlf); }
                else if (!prm) { pw = *(const f32x4*)(ssh + (size_t)bs * 3200 + 3072 + k0 + 4 * hlf); pa = *(const f32x4*)(ssh + (size_t)bs * 3200 + 3136 + k0 + 4 * hlf); }
                const f32x4 mw = *(const f32x4*)(mu + 3072 + k0 + 4 * hlf), ma = *(const f32x4*)(mu + 3136 + k0 + 4 * hlf);
#pragma unroll
                for (int j = 0; j < 4; ++j) { const float xs = cw[j] + (pw[j] - cw[j]) * mw[j]; xw[4 * hlf + j] = 1.0f - 2.0f / (1.0f + __expf(2.0f * xs)); xa[4 * hlf + j] = ca[j] + (pa[j] - ca[j]) * ma[j]; }
            }
            Aw[ks] = pack8(xw); Aa[ks] = pack8(xa); }
        const size_t orow = (size_t)(item * 16 + trow) * 1024 + 4 * kg;
#pragma unroll 4
        for (int ct = 0; ct < 64; ++ct) { const int n = 16 * ct + trow;
            const bf16x8 bd0 = *(const bf16x8*)(WDEC + n * 64 + 8 * kg), bd1 = *(const bf16x8*)(WDEC + n * 64 + 32 + 8 * kg), ba0 = *(const bf16x8*)(WAAA + n * 64 + 8 * kg), ba1 = *(const bf16x8*)(WAAA + n * 64 + 32 + 8 * kg);
            f32x4 ad = {0.f, 0.f, 0.f, 0.f}, aa = {0.f, 0.f, 0.f, 0.f};
            ad = __builtin_amdgcn_mfma_f32_16x16x32_bf16(bd0, Aw[0], ad, 0, 0, 0); ad = __builtin_amdgcn_mfma_f32_16x16x32_bf16(bd1, Aw[1], ad, 0, 0, 0);
            aa = __builtin_amdgcn_mfma_f32_16x16x32_bf16(ba0, Aa[0], aa, 0, 0, 0); aa = __builtin_amdgcn_mfma_f32_16x16x32_bf16(ba1, Aa[1], aa, 0, 0, 0);
            const f32x4 w0v = *(const f32x4*)(w0 + 16 * ct + 4 * kg), a0v = *(const f32x4*)(a0 + 16 * ct + 4 * kg);
            u32x2 ev, av; ev.x = pk2(0.60653066f * sigm(w0v[0] + ad[0]), 0.60653066f * sigm(w0v[1] + ad[1])); ev.y = pk2(0.60653066f * sigm(w0v[2] + ad[2]), 0.60653066f * sigm(w0v[3] + ad[3]));
            av.x = pk2(sigm(a0v[0] + aa[0]), sigm(a0v[1] + aa[1])); av.y = pk2(sigm(a0v[2] + aa[2]), sigm(a0v[3] + aa[3]));
            *(u32x2*)(E + orow + 16 * ct) = ev; *(u32x2*)(A + orow + 16 * ct) = av; }
    }
    float* out = p.out; const int gt = vb * 512 + tid, ngt = NB * 512;
    for (int i = gt; i < 136 * 3200; i += ngt) { const int b = i / 3200, c = i - b * 3200; const int tok = b < 8 ? b * 2048 + 2047 : NPT + (b - 8) * 8 + 7;
        const float v = c < 3072 ? bf2f(U[(size_t)tok * 3072 + c]) : XWA[(size_t)tok * 128 + c - 3072];
        out[(b < 8 ? O_SHP + (size_t)b * 3200 : O_SHS + (size_t)(b - 8) * 3200) + c] = v; }
    for (int i = gt; i < 136 * 3072; i += ngt) { const int b = i / 3072, r = i - b * 3072, j = r >> 10, c = r & 1023; const int tok = b < 8 ? b * 2048 + 2045 + j : NPT + (b - 8) * 8 + 5 + j;
        out[(b < 8 ? O_CVP + (size_t)b * 3072 : O_CVS + (size_t)(b - 8) * 3072) + r] = bf2f(XB[(size_t)tok * 1024 + c]); }
}

constexpr int CH = 32;
constexpr int BUF_F = 6 * CH * 64;
constexpr int RW_LDS_OST = 2 * BUF_F * 4;
constexpr int OST_F = CH * 128;
struct Seg { int tok0, h, half; bool first, last; const float* S0; float* Sout; const float* shift0; };
__device__ __forceinline__ Seg get_seg(const float* srw, const float* ssh, float* out, int mode, int it0, int c, int j) {
    Seg g;
    if (mode == 0) { const int b = it0 >> 5; g.h = (it0 >> 1) & 15; g.half = it0 & 1; g.tok0 = b * 2048 + CH * c + 8 * j; g.first = (c == 0 && j == 0); g.last = (c == 2048 / CH - 1 && j == 3);
        g.S0 = nullptr; g.shift0 = nullptr; g.Sout = out + O_RWP + (size_t)(b * 16 + g.h) * 4096; }
    else { const int it = it0 + 4 * c + j, b = it >> 5; g.h = (it >> 1) & 15; g.half = it & 1; g.tok0 = NPT + b * 8; g.first = true; g.last = true;
        g.S0 = srw + (size_t)(b * 16 + g.h) * 4096; g.shift0 = ssh + (size_t)b * 3200; g.Sout = out + O_RWS + (size_t)(b * 16 + g.h) * 4096; }
    return g;
}
__device__ __forceinline__ void rwkv_prep(PREF p, LAS float* buf, const Seg g, int lw, int lane) {
    unsigned char* ws = p.ws;
    const bf16* U = (const bf16*)(ws + WS_U); const bf16* E = (const bf16*)p.out; const bf16* A = E + ZSTRIDE; float* BON = (float*)(ws + WS_BONUS);
    const int C = g.h * 64 + lane;
    const float mur = p.in[I_MU][C], muk = p.in[I_MU][1024 + C], muv = p.in[I_MU][2048 + C], kkc = p.in[I_KK][C], kac = p.in[I_KA][C], rkc = p.in[I_RK][C];
    float pr = 0.f, pk = 0.f, pv = 0.f;
    if (g.first) { if (g.shift0) { pr = g.shift0[C]; pk = g.shift0[1024 + C]; pv = g.shift0[2048 + C]; } }
    else { const bf16* up = U + (size_t)(g.tok0 - 1) * 3072 + C; pr = bf2f(up[0]); pk = bf2f(up[1024]); pv = bf2f(up[2048]); }
    bf16 ur[8], uk[8], uv[8], ee[8], aa[8];
#pragma unroll
    for (int i = 0; i < 8; ++i) { const size_t tok = (size_t)(g.tok0 + i); const bf16* up = U + tok * 3072 + C; ur[i] = up[0]; uk[i] = up[1024]; uv[i] = up[2048]; ee[i] = E[tok * 1024 + C]; aa[i] = A[tok * 1024 + C]; }
    float r8[8], kr8[8], kp8[8], v8[8], a8[8], dc8[8], xs[8], ys[8];
#pragma unroll
    for (int i = 0; i < 8; ++i) {
        const float fr = bf2f(ur[i]), fk = bf2f(uk[i]), fv = bf2f(uv[i]), e = bf2f(ee[i]), a = bf2f(aa[i]);
        const float r = fr + (pr - fr) * mur, k = fk + (pk - fk) * muk, v = fv + (pv - fv) * muv; pr = fr; pk = fk; pv = fv;
        const float kr = k * kkc, kp = k * (1.0f + (a - 1.0f) * kac);
        r8[i] = r; kr8[i] = kr; kp8[i] = kp; v8[i] = v; a8[i] = a; dc8[i] = __expf(-e); xs[i] = kr * kr; ys[i] = r * kp * rkc; }
    const bool b0 = (lane & 1) != 0, b1 = (lane & 2) != 0, b2 = (lane & 4) != 0, b3 = (lane & 8) != 0;
    float w8[8], u4[4], p2[2], f;
#pragma unroll
    for (int j = 0; j < 8; ++j) { const float keep = b0 ? ys[j] : xs[j], send = b0 ? xs[j] : ys[j]; w8[j] = keep + dppf<0xB1>(send); }
#pragma unroll
    for (int j = 0; j < 4; ++j) { const float keep = b1 ? w8[2 * j + 1] : w8[2 * j], send = b1 ? w8[2 * j] : w8[2 * j + 1]; u4[j] = keep + dppf<0x4E>(send); }
#pragma unroll
    for (int j = 0; j < 2; ++j) { const float keep = b2 ? u4[2 * j + 1] : u4[2 * j], send = b2 ? u4[2 * j] : u4[2 * j + 1];
        const int si = __builtin_bit_cast(int, send); int t = __builtin_amdgcn_update_dpp(si, si, 0x104, 0xF, 0x5, false); t = __builtin_amdgcn_update_dpp(t, si, 0x114, 0xF, 0xA, false);
        p2[j] = keep + __builtin_bit_cast(float, t); }
    { const float keep = b3 ? p2[1] : p2[0], send = b3 ? p2[0] : p2[1]; f = keep + dppf<0x128>(send); }
    f += __shfl_xor(f, 16); f += __shfl_xor(f, 32);
#pragma unroll
    for (int i = 0; i < 8; ++i) {
        const int s = 8 * lw + i; const float ss = rdl(f, 2 * i); const float kk = kr8[i] * __builtin_amdgcn_rsqf(ss + 1e-12f);
        LAS float* bp = buf + s * 64 + lane;
        bp[0] = dc8[i]; bp[CH * 64] = kk * a8[i]; bp[2 * CH * 64] = kp8[i]; bp[3 * CH * 64] = kk; bp[4 * CH * 64] = r8[i]; bp[5 * CH * 64] = v8[i]; }
    if (g.half == 0 && lane < 16 && b0) BON[(size_t)(g.tok0 + (lane >> 1)) * 16 + g.h] = f;
}
__device__ __forceinline__ void rwkv_oout(PREF p, const LAS float* ost, const Seg g, int ltid) {
    unsigned char* ws = p.ws; bf16* ORAW = (bf16*)(ws + WS_ORAW); float* ST = (float*)(ws + WS_STATS);
    const int s = ltid >> 3, q = ltid & 7;
    f32x4 o; { const LAS f32x4* pp = (const LAS f32x4*)(ost + s * 128 + q * 16);
      const f32x4 a0 = pp[0], a1 = pp[1], b0 = pp[2], b1 = pp[3]; o.x = (a0.x + a0.z) + (a1.x + a1.z); o.y = (a0.y + a0.w) + (a1.y + a1.w); o.z = (b0.x + b0.z) + (b1.x + b1.z); o.w = (b0.y + b0.w) + (b1.y + b1.w); }
    float sm = (o.x + o.y) + (o.z + o.w), sq = (o.x * o.x + o.y * o.y) + (o.z * o.z + o.w * o.w);
    sm += dppf<0xB1>(sm); sq += dppf<0xB1>(sq); sm += dppf<0x4E>(sm); sq += dppf<0x4E>(sq); sm += dppf<0x141>(sm); sq += dppf<0x141>(sq);
    const size_t tok = (size_t)(g.tok0 + (s & 7)); u32x2 w; w.x = pk2(o.x, o.y); w.y = pk2(o.z, o.w); *(u32x2*)(ORAW + tok * 1024 + g.h * 64 + 32 * g.half + 4 * q) = w;
    if (q == 0) *(f32x2*)(ST + ((tok * 16 + g.h) * 2 + g.half) * 2) = (f32x2){sm, sq};
}
struct ScanOps { f32x4 w4, b4, k4, kk4, r4; f32x2 v2; };
__device__ __forceinline__ ScanOps scan_load(const LAS float* buf, int s, int kl, int voff) { ScanOps o; const LAS float* bp = buf + s * 64 + 4 * kl;
    o.w4 = *(const LAS f32x4*)bp; o.b4 = *(const LAS f32x4*)(bp + CH * 64); o.k4 = *(const LAS f32x4*)(bp + 2 * CH * 64); o.kk4 = *(const LAS f32x4*)(bp + 3 * CH * 64); o.r4 = *(const LAS f32x4*)(bp + 4 * CH * 64);
    o.v2 = *(const LAS f32x2*)(buf + 5 * CH * 64 + s * 64 + voff); return o; }
__device__ __forceinline__ void rwkv_run(PREF p, LAS unsigned char* lds, int tid, int wave, int lane, int mode, int it0, int nch) {
    LAS float* bufs = (LAS float*)lds; LAS float* osts = (LAS float*)(lds + RW_LDS_OST);
    const float* srw = p.in[I_SRW]; const float* ssh = p.in[I_SSH]; float* out = p.out;
    const bool scan = wave < 4; const int rl = lane >> 4, kl = lane & 15, roff = 8 * wave + 2 * rl;
    f32x4 Sa = {0.f, 0.f, 0.f, 0.f}, Sb = Sa; f32x4 Na[4], Nb[4], Ma[4], Mb[4];
#pragma unroll
    for (int j = 0; j < 4; ++j) { Na[j] = Sa; Nb[j] = Sa; Ma[j] = Sa; Mb[j] = Sa; }
    if (scan) {
#pragma unroll
        for (int j = 0; j < 4; ++j) { const Seg g = get_seg(srw, ssh, out, mode, it0, 0, j); if (g.S0) { const int row = 32 * g.half + roff; Na[j] = *(const f32x4*)(g.S0 + row * 64 + 4 * kl); Nb[j] = *(const f32x4*)(g.S0 + (row + 1) * 64 + 4 * kl); } } }
    else rwkv_prep(p, bufs, get_seg(srw, ssh, out, mode, it0, 0, wave - 4), wave - 4, lane);
    __syncthreads();
    for (int c = 0; c < nch; ++c) {
        if (scan) {
            const LAS float* buf = bufs + (c & 1) * BUF_F; LAS float* ost = osts + (c & 1) * OST_F;
            ScanOps cur = scan_load(buf, 0, kl, 32 * get_seg(srw, ssh, out, mode, it0, c, 0).half + roff);
            if (c + 1 < nch) {
#pragma unroll
                for (int j = 0; j < 4; ++j) { const Seg n = get_seg(srw, ssh, out, mode, it0, c + 1, j); if (n.S0) { const int row = 32 * n.half + roff; Ma[j] = *(const f32x4*)(n.S0 + row * 64 + 4 * kl); Mb[j] = *(const f32x4*)(n.S0 + (row + 1) * 64 + 4 * kl); } } }
#pragma unroll
            for (int j = 0; j < 4; ++j) {
                const Seg g = get_seg(srw, ssh, out, mode, it0, c, j);
                if (g.first) { Sa = Na[j]; Sb = Nb[j]; }
                const int nh = get_seg(srw, ssh, out, mode, it0, c, j < 3 ? j + 1 : j).half;
#pragma unroll
                for (int i = 0; i < 8; ++i) {
                    const int s = 8 * j + i;
                    const int sn = s + 1 < CH ? s + 1 : s; const ScanOps nxt = scan_load(buf, sn, kl, 32 * (i == 7 && j < 3 ? nh : g.half) + roff);
                    const f32x2 kkL = __builtin_shufflevector(cur.kk4, cur.kk4, 0, 1), kkH = __builtin_shufflevector(cur.kk4, cur.kk4, 2, 3), wL = __builtin_shufflevector(cur.w4, cur.w4, 0, 1), wH = __builtin_shufflevector(cur.w4, cur.w4, 2, 3);
                    const f32x2 bL = __builtin_shufflevector(cur.b4, cur.b4, 0, 1), bH = __builtin_shufflevector(cur.b4, cur.b4, 2, 3), kL = __builtin_shufflevector(cur.k4, cur.k4, 0, 1), kH = __builtin_shufflevector(cur.k4, cur.k4, 2, 3);
                    const f32x2 rL = __builtin_shufflevector(cur.r4, cur.r4, 0, 1), rH = __builtin_shufflevector(cur.r4, cur.r4, 2, 3);
                    f32x2 SaL = __builtin_shufflevector(Sa, Sa, 0, 1), SaH = __builtin_shufflevector(Sa, Sa, 2, 3), SbL = __builtin_shufflevector(Sb, Sb, 0, 1), SbH = __builtin_shufflevector(Sb, Sb, 2, 3);
                    f32x2 ta = SaL * kkL; ta = __builtin_elementwise_fma(SaH, kkH, ta); f32x2 tb = SbL * kkL; tb = __builtin_elementwise_fma(SbH, kkH, tb);
                    float sa0 = ta.x + ta.y, sa1 = tb.x + tb.y;
                    sa0 += dppf<0xB1>(sa0); sa1 += dppf<0xB1>(sa1); sa0 += dppf<0x4E>(sa0); sa1 += dppf<0x4E>(sa1); sa0 += dppf<0x141>(sa0); sa1 += dppf<0x141>(sa1); sa0 += dppf<0x140>(sa0); sa1 += dppf<0x140>(sa1);
                    const f32x2 na = {-sa0, -sa0}, nb = {-sa1, -sa1}, va = {cur.v2.x, cur.v2.x}, vb = {cur.v2.y, cur.v2.y};
                    SaL = __builtin_elementwise_fma(va, kL, __builtin_elementwise_fma(na, bL, SaL * wL)); SaH = __builtin_elementwise_fma(va, kH, __builtin_elementwise_fma(na, bH, SaH * wH));
                    SbL = __builtin_elementwise_fma(vb, kL, __builtin_elementwise_fma(nb, bL, SbL * wL)); SbH = __builtin_elementwise_fma(vb, kH, __builtin_elementwise_fma(nb, bH, SbH * wH));
                    Sa = __builtin_shufflevector(SaL, SaH, 0, 1, 2, 3); Sb = __builtin_shufflevector(SbL, SbH, 0, 1, 2, 3);
                    f32x2 oa = SaL * rL; oa = __builtin_elementwise_fma(SaH, rH, oa); f32x2 ob = SbL * rL; ob = __builtin_elementwise_fma(SbH, rH, ob);
                    float o0 = oa.x + oa.y, o1 = ob.x + ob.y;
                    asm volatile("" : "+v"(o0), "+v"(o1));
                    o0 += dppf<0xB1>(o0); o1 += dppf<0xB1>(o1); o0 += dppf<0x4E>(o0); o1 += dppf<0x4E>(o1);
                    if ((kl & 3) == 0) *(LAS f32x2*)(ost + s * 128 + roff * 4 + (kl >> 2) * 2) = (f32x2){o0, o1};
                    cur = nxt;
                }
                if (g.last) { const int row = 32 * g.half + roff; *(f32x4*)(g.Sout + row * 64 + 4 * kl) = Sa; *(f32x4*)(g.Sout + (row + 1) * 64 + 4 * kl) = Sb; }
            }
#pragma unroll
            for (int j = 0; j < 4; ++j) { Na[j] = Ma[j]; Nb[j] = Mb[j]; }
        } else {
            if (c + 1 < nch) rwkv_prep(p, bufs + ((c + 1) & 1) * BUF_F, get_seg(srw, ssh, out, mode, it0, c + 1, wave - 4), wave - 4, lane);
            if (c >= 1) rwkv_oout(p, osts + ((c - 1) & 1) * OST_F, get_seg(srw, ssh, out, mode, it0, c - 1, (tid - 256) >> 6), tid - 256);
        }
        __syncthreads();
    }
    if (!scan) rwkv_oout(p, osts + ((nch - 1) & 1) * OST_F, get_seg(srw, ssh, out, mode, it0, nch - 1, (tid - 256) >> 6), tid - 256);
    __syncthreads();
}

__device__ __forceinline__ void rglru_item(PREF p, LAS unsigned char* lds, int tid, int wave, int lane, int mode, int item, bool st) {
    unsigned char* ws = p.ws; const bf16* XB = (const bf16*)(ws + WS_XB); bf16* ZB = (bf16*)(ws + WS_Z) + ZSTRIDE;
    LAS float* XC = (LAS float*)lds; LAS float* GR = XC + 64 * 65; LAS float* GI = GR + 64 * 65; LAS bf16* XCB = (LAS bf16*)(GI + 64 * 65); LAS float* TOT = (LAS float*)(XCB + 64 * 72); LAS float* HC = TOT + 1024;
    const int c = tid & 63, sg = tid >> 6;
    const int g = mode ? (item >> 4) : (item & 15), bb = mode ? (8 * (item & 15) + sg) : (item >> 4), C = g * 64 + c;
    const int nchunk = mode ? 1 : 32; const int rowtok = mode ? (NPT + bb * 8) : (bb * 2048 + 8 * sg);
    const float cw0 = p.in[I_CW][C], cw1 = p.in[I_CW][1024 + C], cw2 = p.in[I_CW][2048 + C], cw3 = p.in[I_CW][3072 + C], cb = p.in[I_CB][C];
    const float sp = log1pf(__expf(-p.in[I_LAM][C]));
    const bf16* WT = (const bf16*)(ws + (wave >= 4 ? WS_WRGX : WS_WRGA)) + g * 4096; const float* bra = opq(p.in[I_BRGA]); const float* brx = opq(p.in[I_BRGX]); const float* bias = (wave >= 4 ? brx : bra) + g * 64;
    const int trow = lane & 15, kg = lane >> 4, tt = wave & 3;
    bf16x8 wb0[4], wb1[4]; float bn[4];
#pragma unroll
    for (int ct = 0; ct < 4; ++ct) { const int n = 16 * ct + trow; wb0[ct] = *(const bf16x8*)(WT + n * 64 + 8 * kg); wb1[ct] = *(const bf16x8*)(WT + n * 64 + 32 + 8 * kg); bn[ct] = bias[n]; }
    float hin = 0.f; float e0 = 0.f, e1 = 0.f, e2 = 0.f;
    if (mode) { hin = p.in[I_SLRU][(size_t)bb * 1024 + C]; const float* cv = p.in[I_SCV] + (size_t)bb * 3072 + C; e0 = cv[0]; e1 = cv[1024]; e2 = cv[2048]; }
    else { if (tid < 64) HC[c] = 0.f; if (sg > 0) { const bf16* xp = XB + (size_t)(rowtok - 3) * 1024 + C; e0 = bf2f(xp[0]); e1 = bf2f(xp[1024]); e2 = bf2f(xp[2048]); } }
    bf16 xn[8], zn[8];
#pragma unroll
    for (int i = 0; i < 8; ++i) { xn[i] = XB[(size_t)(rowtok + i) * 1024 + C]; zn[i] = ZB[(size_t)(rowtok + i) * 1024 + C]; }
    for (int k = 0; k < nchunk; ++k) {
        const int tok = rowtok + 64 * k;
        float zb[8];
#pragma unroll
        for (int i = 0; i < 8; ++i) { const float e3 = bf2f(xn[i]); zb[i] = bf2f(zn[i]); const float xc = cb + e0 * cw0 + e1 * cw1 + e2 * cw2 + e3 * cw3;
            XC[(sg * 8 + i) * 65 + c] = xc; XCB[(sg * 8 + i) * 72 + c] = (bf16)f2bf(xc); e0 = e1; e1 = e2; e2 = e3; }
        if (k + 1 < nchunk) {
            const bf16* xp = XB + (size_t)(tok + 64 - 3) * 1024 + C; e0 = bf2f(xp[0]); e1 = bf2f(xp[1024]); e2 = bf2f(xp[2048]);
#pragma unroll
            for (int i = 0; i < 8; ++i) { xn[i] = XB[(size_t)(tok + 64 + i) * 1024 + C]; zn[i] = ZB[(size_t)(tok + 64 + i) * 1024 + C]; } }
        __syncthreads();
        { LAS float* GO = wave >= 4 ? GI : GR;
          const bf16x8 a0 = *(const LAS bf16x8*)(XCB + (16 * tt + trow) * 72 + 8 * kg), a1 = *(const LAS bf16x8*)(XCB + (16 * tt + trow) * 72 + 32 + 8 * kg);
#pragma unroll
          for (int ct = 0; ct < 4; ++ct) { const int n = 16 * ct + trow;
              f32x4 acc = {0.f, 0.f, 0.f, 0.f}; acc = __builtin_amdgcn_mfma_f32_16x16x32_bf16(a0, wb0[ct], acc, 0, 0, 0); acc = __builtin_amdgcn_mfma_f32_16x16x32_bf16(a1, wb1[ct], acc, 0, 0, 0);
#pragma unroll
              for (int r = 0; r < 4; ++r) GO[(16 * tt + 4 * kg + r) * 65 + n] = sigm(acc[r] + bn[ct]); } }
        __syncthreads();
        float hl[8], cm[8]; { float h = 0.f, cum = 1.f;
#pragma unroll
          for (int i = 0; i < 8; ++i) { const int s = sg * 8 + i; const float gr = GR[s * 65 + c], gi = GI[s * 65 + c], xc = XC[s * 65 + c];
              const float la = -8.0f * gr * sp, x2 = 2.0f * la;
              const float om = -x2 * (1.0f + x2 * 0.5f * (1.0f + x2 * (1.0f / 3.0f) * (1.0f + x2 * 0.25f * (1.0f + x2 * 0.2f * (1.0f + x2 * (1.0f / 6.0f) * (1.0f + x2 * (1.0f / 7.0f)))))));
              const float a = __expf(la), b = sqrtf(om) * gi * xc;
              h = a * h + b; cum *= a; hl[i] = h; cm[i] = cum; }
          if (!mode) { TOT[sg * 64 + c] = cum; TOT[512 + sg * 64 + c] = h; } }
        if (!mode) __syncthreads();
        { float h = hin;
          if (!mode) { h = HC[(k & 1) * 64 + c]; for (int j = 0; j < sg; ++j) h = TOT[j * 64 + c] * h + TOT[512 + j * 64 + c]; }
          if (st) {
#pragma unroll
              for (int i = 0; i < 8; ++i) ZB[(size_t)(tok + i) * 1024 + C] = (bf16)f2bf((hl[i] + cm[i] * h) * zb[i]); }
          const float hn = hl[7] + cm[7] * h;
          if (mode) p.out[O_LRS + (size_t)bb * 1024 + C] = hn;
          else if (sg == 7) { HC[((k + 1) & 1) * 64 + c] = hn; if (k == nchunk - 1) p.out[O_LRP + (size_t)bb * 1024 + C] = hn; } }
    }
    __syncthreads();
}

constexpr int XA_STG = 128 * 528, XA_PL = 8448;
__device__ __forceinline__ void xa_stage(LAS unsigned char* lds, const bf16* src, size_t ld, int tid) {
#pragma unroll
    for (int i = 0; i < 8; ++i) { const int e = tid + 512 * i, row = e >> 5, seg = e & 31; *(LAS u32x4*)(lds + row * 528 + seg * 16) = *(const u32x4*)(src + (size_t)row * ld + seg * 8); }
}
__device__ __forceinline__ void xattn_prompt_item(PREF p, LAS unsigned char* lds, int tid, int wave, int lane, int item, bool st) {
    unsigned char* ws = p.ws; const bf16* Q = (const bf16*)(ws + WS_Q); const bf16* MK = (const bf16*)(ws + WS_MK); const bf16* MVT = (const bf16*)(ws + WS_MVT); bf16* ZC = (bf16*)(ws + WS_Z) + 2 * ZSTRIDE;
    LAS bf16* PL = (LAS bf16*)(lds + XA_STG + wave * XA_PL);
    const int qb = item & 15, head = (item >> 4) & 3, b = item >> 6, tok0 = b * 2048 + 128 * qb + 16 * wave, trow = lane & 15, kg = lane >> 4;
    bf16x8 qf[8];
#pragma unroll
    for (int ks = 0; ks < 8; ++ks) qf[ks] = *(const bf16x8*)(Q + (size_t)(tok0 + trow) * 1024 + head * 256 + 32 * ks + 8 * kg);
    f32x4 S[16];
#pragma unroll
    for (int hk = 0; hk < 2; ++hk) {
        __syncthreads();
        xa_stage(lds, MK + (size_t)(b * 256 + 128 * hk) * 1024 + head * 256, 1024, tid);
        __syncthreads();
#pragma unroll
        for (int mt = 0; mt < 8; ++mt) { f32x4 acc = {0.f, 0.f, 0.f, 0.f}; const LAS unsigned char* kp = lds + (16 * mt + trow) * 528 + kg * 16;
#pragma unroll
            for (int ks = 0; ks < 8; ++ks) acc = __builtin_amdgcn_mfma_f32_16x16x32_bf16(qf[ks], *(const LAS bf16x8*)(kp + ks * 64), acc, 0, 0, 0);
            S[8 * hk + mt] = acc; }
    }
    f32x4 mx = S[0];
#pragma unroll
    for (int mt = 1; mt < 16; ++mt) { mx.x = fmaxf(mx.x, S[mt].x); mx.y = fmaxf(mx.y, S[mt].y); mx.z = fmaxf(mx.z, S[mt].z); mx.w = fmaxf(mx.w, S[mt].w); }
    mx.x = row16_max(mx.x); mx.y = row16_max(mx.y); mx.z = row16_max(mx.z); mx.w = row16_max(mx.w);
    f32x4 sm = {0.f, 0.f, 0.f, 0.f};
#pragma unroll
    for (int mt = 0; mt < 16; ++mt) { f32x4 e; e.x = __expf((S[mt].x - mx.x) * 0.0625f); e.y = __expf((S[mt].y - mx.y) * 0.0625f); e.z = __expf((S[mt].z - mx.z) * 0.0625f); e.w = __expf((S[mt].w - mx.w) * 0.0625f);
        sm += e; const int col = 16 * mt + trow;
        PL[(4 * kg + 0) * 264 + col] = (bf16)f2bf(e.x); PL[(4 * kg + 1) * 264 + col] = (bf16)f2bf(e.y); PL[(4 * kg + 2) * 264 + col] = (bf16)f2bf(e.z); PL[(4 * kg + 3) * 264 + col] = (bf16)f2bf(e.w); }
    sm.x = row16_sum(sm.x); sm.y = row16_sum(sm.y); sm.z = row16_sum(sm.z); sm.w = row16_sum(sm.w);
    const f32x4 inv = {1.0f / sm.x, 1.0f / sm.y, 1.0f / sm.z, 1.0f / sm.w};
    LDS_WAIT();
    bf16x8 pf[8];
#pragma unroll
    for (int ks = 0; ks < 8; ++ks) pf[ks] = *(const LAS bf16x8*)(PL + trow * 264 + 32 * ks + 8 * kg);
#pragma unroll
    for (int hv = 0; hv < 2; ++hv) {
        __syncthreads();
        xa_stage(lds, MVT + ((size_t)((b * 4 + head) * 256 + 128 * hv)) * 256, 256, tid);
        __syncthreads();
#pragma unroll
        for (int dt = 0; dt < 8; ++dt) { f32x4 acc = {0.f, 0.f, 0.f, 0.f}; const LAS unsigned char* vp = lds + (16 * dt + trow) * 528 + kg * 16;
#pragma unroll
            for (int ks = 0; ks < 8; ++ks) acc = __builtin_amdgcn_mfma_f32_16x16x32_bf16(pf[ks], *(const LAS bf16x8*)(vp + ks * 64), acc, 0, 0, 0);
            acc = acc * inv; const int col = head * 256 + 128 * hv + 16 * dt + trow;
#pragma unroll
            for (int r = 0; r < 4; ++r) { bf16* zp = ZC + (size_t)(tok0 + 4 * kg + r) * 1024 + col; const bf16 nv = (bf16)f2bf(acc[r] * bf2f(*zp)); if (st) *zp = nv; } }
    }
    __syncthreads();
}

__device__ __forceinline__ void xattn_sample_item(PREF p, LAS unsigned char* lds, int tid, int wave, int lane, int item, bool st) {
    unsigned char* ws = p.ws; const bf16* Q = (const bf16*)(ws + WS_Q); bf16* ZC = (bf16*)(ws + WS_Z) + 2 * ZSTRIDE;
    LAS float* QS = (LAS float*)lds; LAS float* SC = QS + 2048; LAS float* PART = SC + 2048;
    const int b = item >> 2, head = item & 3, tok0 = NPT + b * 8;
    for (int i = tid; i < 2048; i += 512) QS[i] = bf2f(Q[(size_t)(tok0 + (i >> 8)) * 1024 + head * 256 + (i & 255)]);
    __syncthreads();
    const float* Vc = p.in[I_CV] + ((size_t)b * 256 * 4 + head) * 256 + 4 * lane;
    { const int kl = lane & 15, rq = lane >> 4; const float* Kc = p.in[I_CK] + ((size_t)b * 256 * 4 + head) * 256 + 4 * kl;
      f32x4 q[8][4];
#pragma unroll
      for (int i = 0; i < 8; ++i)
#pragma unroll
          for (int j = 0; j < 4; ++j) q[i][j] = *(const LAS f32x4*)(QS + i * 256 + 64 * j + 4 * kl);
#pragma unroll 2
      for (int r = 0; r < 8; ++r) { const int m = 32 * wave + 4 * r + rq; const f32x4* kp = (const f32x4*)(Kc + (size_t)m * 1024);
          const f32x4 k0 = kp[0], k1 = kp[16], k2 = kp[32], k3 = kp[48];
#pragma unroll
          for (int i = 0; i < 8; ++i) { f32x4 t = q[i][0] * k0 + q[i][1] * k1 + q[i][2] * k2 + q[i][3] * k3; float d = row16_sum((t.x + t.y) + (t.z + t.w));
              if (kl == i) SC[i * 256 + m] = d * 0.0625f; } } }
    __syncthreads();
    { float v[4]; float mx = -3.0e38f;
#pragma unroll
      for (int j = 0; j < 4; ++j) { v[j] = SC[wave * 256 + lane + 64 * j]; mx = fmaxf(mx, v[j]); }
      mx = wave_max(mx); float sm = 0.f;
#pragma unroll
      for (int j = 0; j < 4; ++j) { v[j] = __expf(v[j] - mx); sm += v[j]; }
      sm = wave_sum(sm); const float inv = 1.0f / sm;
#pragma unroll
      for (int j = 0; j < 4; ++j) SC[wave * 256 + lane + 64 * j] = v[j] * inv; }
    __syncthreads();
    { f32x4 acc[8];
#pragma unroll
      for (int i = 0; i < 8; ++i) acc[i] = (f32x4){0.f, 0.f, 0.f, 0.f};
#pragma unroll 8
      for (int r = 0; r < 32; ++r) { const int m = 32 * wave + r; const f32x4 vv = *(const f32x4*)(Vc + (size_t)m * 1024);
#pragma unroll
          for (int i = 0; i < 8; ++i) acc[i] += SC[i * 256 + m] * vv; }
#pragma unroll
      for (int i = 0; i < 8; ++i) *(LAS f32x4*)(PART + (wave * 8 + i) * 256 + 4 * lane) = acc[i]; }
    __syncthreads();
    { const int q = tid >> 6, d = 4 * (tid & 63); f32x4 s = {0.f, 0.f, 0.f, 0.f};
#pragma unroll
      for (int w = 0; w < 8; ++w) s += *(const LAS f32x4*)(PART + (w * 8 + q) * 256 + d);
      u32x2* zp = (u32x2*)(ZC + (size_t)(tok0 + q) * 1024 + head * 256 + d); const u32x2 z = *zp;
      u32x2 o; o.x = pk2(s.x * bflo(z.x), s.y * bfhi(z.x)); o.y = pk2(s.z * bflo(z.y), s.w * bfhi(z.y)); if (st) *zp = o; }
    __syncthreads();
}

__device__ __forceinline__ void p4_post(PREF p, int tid, int G, bool stw) {
    unsigned char* ws = p.ws; const bf16* ORAW = (const bf16*)(ws + WS_ORAW); const bf16* U = (const bf16*)(ws + WS_U); bf16* ZA = (bf16*)(ws + WS_Z);
    const float* ST = (const float*)(ws + WS_STATS); const float* BON = (const float*)(ws + WS_BONUS);
    const float* muv = p.in[I_MU] + 2048; const float* gng = p.in[I_GNG]; const float* gnb = p.in[I_GNB]; const float* ssh = p.in[I_SSH];
    for (int i = blockIdx.x * 512 + tid; i < NT * 128; i += G * 512) {
        const int tok = i >> 7, c0 = (i & 127) * 8, h = c0 >> 6; const bool prm = tok < NPT; const int s = prm ? (tok & 2047) : ((tok - NPT) & 7); const int bs = (tok - NPT) >> 3;
        const f32x4 st = *(const f32x4*)(ST + ((size_t)tok * 16 + h) * 4);
        const float mean = (st.x + st.z) * (1.f / 64.f), var = (st.y + st.w) * (1.f / 64.f) - mean * mean, rstd = rsqrtf(fmaxf(var, 0.f) + 64e-5f), bon = BON[(size_t)tok * 16 + h];
        const u32x4 o = *(const u32x4*)(ORAW + (size_t)tok * 1024 + c0), z = *(const u32x4*)(ZA + (size_t)tok * 1024 + c0), vc = *(const u32x4*)(U + (size_t)tok * 3072 + 2048 + c0);
        float pv[8];
        if (s > 0) { const u32x4 vp = *(const u32x4*)(U + (size_t)(tok - 1) * 3072 + 2048 + c0); pv[0] = bflo(vp.x); pv[1] = bfhi(vp.x); pv[2] = bflo(vp.y); pv[3] = bfhi(vp.y); pv[4] = bflo(vp.z); pv[5] = bfhi(vp.z); pv[6] = bflo(vp.w); pv[7] = bfhi(vp.w); }
        else if (!prm) {
#pragma unroll
            for (int j = 0; j < 8; ++j) pv[j] = ssh[(size_t)bs * 3200 + 2048 + c0 + j]; }
        else {
#pragma unroll
            for (int j = 0; j < 8; ++j) pv[j] = 0.f; }
        const unsigned ow[4] = {o.x, o.y, o.z, o.w}, zw[4] = {z.x, z.y, z.z, z.w}, vw[4] = {vc.x, vc.y, vc.z, vc.w}; unsigned rw[4];
#pragma unroll
        for (int j = 0; j < 4; ++j) { float r2[2];
#pragma unroll
            for (int e = 0; e < 2; ++e) { const int c = c0 + 2 * j + e; const float ov = e ? bfhi(ow[j]) : bflo(ow[j]), zv = e ? bfhi(zw[j]) : bflo(zw[j]), uv = e ? bfhi(vw[j]) : bflo(vw[j]);
                const float v = uv + (pv[2 * j + e] - uv) * muv[c]; r2[e] = ((ov - mean) * rstd * gng[c] + gnb[c] + bon * v) * zv; }
            rw[j] = pk2(r2[0], r2[1]); }
        if (stw) *(u32x4*)(ZA + (size_t)tok * 1024 + c0) = (u32x4){rw[0], rw[1], rw[2], rw[3]};
    }
}
__device__ __forceinline__ void p5_sum(PREF p, int tid, int G) {
    unsigned char* ws = p.ws; const float* P = (const float*)(ws + WS_P); const bf16* Gt = (const bf16*)(ws + WS_G); bf16* M = (bf16*)(ws + WS_MERGED);
    for (int i = blockIdx.x * 512 + tid; i < 1024 * 128; i += G * 512) { const int rs = i >> 7, c0 = (i & 127) * 8; const size_t tok = (size_t)(NPT + rs);
        float o[8];
#pragma unroll
        for (int j = 0; j < 8; ++j) o[j] = 0.f;
#pragma unroll
        for (int br = 0; br < 3; ++br) { f32x4 a0 = {0.f, 0.f, 0.f, 0.f}, a1 = a0;
#pragma unroll
            for (int kq = 0; kq < 4; ++kq) { const float* pp = P + (size_t)(kq * 3 + br) * 1048576 + (size_t)rs * 1024 + c0; a0 += *(const f32x4*)pp; a1 += *(const f32x4*)(pp + 4); }
            const u32x4 g = *(const u32x4*)(Gt + tok * 3072 + br * 1024 + c0);
            o[0] += a0.x * bflo(g.x); o[1] += a0.y * bfhi(g.x); o[2] += a0.z * bflo(g.y); o[3] += a0.w * bfhi(g.y); o[4] += a1.x * bflo(g.z); o[5] += a1.y * bfhi(g.z); o[6] += a1.z * bflo(g.w); o[7] += a1.w * bfhi(g.w); }
        *(u32x4*)(M + tok * 1024 + c0) = (u32x4){pk2(o[0], o[1]), pk2(o[2], o[3]), pk2(o[4], o[5]), pk2(o[6], o[7])}; }
}
__device__ __forceinline__ void p6_norm(PREF p, int r0, int r1, int vb, int nvb, int wave, int lane) {
    const f32x4* gf = (const f32x4*)p.in[I_GF] + lane;
    for (int m = r0 + vb * 8 + wave; m < r1; m += nvb * 8) { f32x4* xr = (f32x4*)(p.out + (size_t)m * 1024) + lane; f32x4 v[4]; float s = 0.f;
#pragma unroll
        for (int j = 0; j < 4; ++j) { v[j] = xr[64 * j]; s += (v[j].x * v[j].x + v[j].y * v[j].y) + (v[j].z * v[j].z + v[j].w * v[j].w); }
        const float rstd = rsqrtf(wave_sum(s) * (1.f / 1024.f) + 1e-6f);
#pragma unroll
        for (int j = 0; j < 4; ++j) xr[64 * j] = v[j] * rstd * gf[64 * j]; }
}

#define XB_TMO      128
#define XB_XCNT(j)  (256  + 64 * (j))
#define XB_XSUB(j)  (1280 + 64 * (j))
#define XB_XGEN(j)  (2304 + 64 * (j))
#define XB_TOP      3328
#define XB_TOPGEN   3392
#define XCD_BAR_WORDS 3456
#define XB_SPIN_CAP (1u << 18)

__device__ __forceinline__ unsigned xb_ld(unsigned* p)              { return __hip_atomic_load(p, __ATOMIC_RELAXED, __HIP_MEMORY_SCOPE_AGENT); }
__device__ __forceinline__ unsigned xb_add(unsigned* p, unsigned v) { return __hip_atomic_fetch_add(p, v, __ATOMIC_RELAXED, __HIP_MEMORY_SCOPE_AGENT); }
__device__ __forceinline__ unsigned xb_xcc_id() { return (unsigned)__builtin_amdgcn_s_getreg((3 << 11) | 20) & 0xFu; }
#define XB_SPIN(cond, bar) do { unsigned _sp = 0; while (cond) { __builtin_amdgcn_s_sleep(1); \
    if ((++_sp & 255u) == 0u) { if (xb_ld(&(bar)[XB_TMO])) break; if (_sp > XB_SPIN_CAP) { atomicAdd(&(bar)[XB_TMO], 1u); break; } } } } while (0)

struct XcdBarrier {
    unsigned* bar; unsigned x;
    volatile LAS unsigned* st;
};

__device__ __forceinline__ XcdBarrier xcd_barrier_post(unsigned* bar, volatile LAS unsigned* st) {
    XcdBarrier b; b.bar = bar; b.x = xb_xcc_id(); b.st = st;
    if (threadIdx.x == 0) (void)xb_add(&bar[XB_XCNT(b.x)], 1u);
    return b;
}
__device__ __forceinline__ void xcd_barrier_complete(unsigned* bar, unsigned x, unsigned& nloc, unsigned& nx) {
    const unsigned G = gridDim.x * gridDim.y * gridDim.z;
    unsigned sum, cnt, mine, sp = 0u;
    for (;;) {
        sum = 0u; cnt = 0u; mine = 0u;
#pragma unroll
        for (unsigned j = 0; j < 16; ++j) { const unsigned c = xb_ld(&bar[XB_XCNT(j)]); sum += c; cnt += (c > 0u) ? 1u : 0u; mine = (j == x) ? c : mine; }
        if (sum == G) break;
        __builtin_amdgcn_s_sleep(1);
        if ((++sp & 255u) == 0u) { if (xb_ld(&bar[XB_TMO])) break; if (sp > XB_SPIN_CAP) { atomicAdd(&bar[XB_TMO], 1u); break; } }
    }
    nloc = mine > 0u ? mine : 1u; nx = cnt > 0u ? cnt : 1u;
}

__device__ __forceinline__ void xcd_barrier(const XcdBarrier& b) {
    asm volatile("s_waitcnt vmcnt(0)" ::: "memory");
    __syncthreads();
    if (threadIdx.x == 0) {
        unsigned* bar = b.bar;
        __builtin_amdgcn_s_waitcnt(0);
        unsigned nloc = b.st[0], nx = b.st[1];
        if (nloc == 0u) { xcd_barrier_complete(bar, b.x, nloc, nx); b.st[0] = nloc; b.st[1] = nx; }
        const unsigned old = xb_add(&bar[XB_XSUB(b.x)], 1u);
        const unsigned gen = old / nloc;
        if (old + 1u == (gen + 1u) * nloc) {
            __builtin_amdgcn_fence(__ATOMIC_RELEASE, "agent");
            asm volatile("s_waitcnt vmcnt(0)" ::: "memory");
            const unsigned og = xb_add(&bar[XB_TOP], 1u);
            const unsigned tg = og / nx;
            if (og + 1u == (tg + 1u) * nx) xb_add(&bar[XB_TOPGEN], 1u);
            else XB_SPIN(xb_ld(&bar[XB_TOPGEN]) == tg, bar);
            __builtin_amdgcn_fence(__ATOMIC_ACQUIRE, "agent");
            xb_add(&bar[XB_XGEN(b.x)], 1u);
            asm volatile("s_waitcnt vmcnt(0)" ::: "memory");
        } else {
            XB_SPIN(xb_ld(&bar[XB_XGEN(b.x)]) == gen, bar);
            __builtin_amdgcn_fence(__ATOMIC_ACQUIRE, "agent");
            asm volatile("s_waitcnt vmcnt(0)" ::: "memory");
        }
    }
    __syncthreads();
}

#ifndef MK_LAST_PHASE
#define MK_LAST_PHASE 99
#endif
__global__ void __launch_bounds__(512, 2) fwd(Params p_arg) {
    extern __shared__ __attribute__((aligned(16))) unsigned char lds_raw[];
    LAS unsigned char* lds = (LAS unsigned char*)lds_raw;
    cg::grid_group grid = cg::this_grid();
    const int tid = threadIdx.x, lane = tid & 63, wave = __builtin_amdgcn_readfirstlane(tid >> 6), G = gridDim.x, bx = blockIdx.x;
    CParams* kp = (CParams*)__builtin_amdgcn_kernarg_segment_ptr();
    unsigned char* ws = kp->ws;
#define p (*launder(kp))
    if (tid < 8) ((LAS unsigned*)(lds + LDS_BYTES - 32))[tid] = 0u;
    __syncthreads();
#ifndef PROBE_DUP
#define PROBE_DUP 0
#endif
#define REP(n) for (int rep_ = (PROBE_DUP == (n) ? 0 : 1); rep_ < 2; ++rep_)
    REP(10) { p0_prologue(p, lds, tid, wave, lane, G); __syncthreads(); }
    grid.sync();
    const XcdBarrier xbar = xcd_barrier_post((unsigned*)(ws + WS_CTR) + 1024, (volatile LAS unsigned*)(lds + LDS_BYTES - 32));
    REP(1) { pg8::Gemm g{(const pg8::bf16_t*)(ws + WS_XN), (const pg8::bf16_t*)(ws + WS_WIN), NT, 11520, 1024}; pg8::StaticOrder S; S.init(NT, 11520, G, bx); EpiMain E{ws};
      pg8::gemm_phase<EpiMain, pg8::StaticOrder>((PG8_LAS unsigned char*)lds, g, S, E, nullptr); }
    xcd_barrier(xbar);
    REP(7) if (G >= 128) {
        if (bx < 64) { pg8::Gemm g{(const pg8::bf16_t*)(ws + WS_XN) + (size_t)NT * 1024, (const pg8::bf16_t*)(ws + WS_WIN) + (size_t)11520 * 1024, 2048, 2048, 1024}; SchedMem S{bx}; EpiMem E{ws, p.out};
            pg8::gemm_phase<EpiMem, SchedMem>((PG8_LAS unsigned char*)lds, g, S, E, nullptr); }
        else p2_lora(p, bx - 64, G - 64, tid, wave, lane);
    }
    xcd_barrier(xbar);
#ifndef PROBE_DUP
#define PROBE_DUP 0
#endif
    for (int rep = (PROBE_DUP == 2 ? 0 : 1); rep < 2; ++rep)
    for (int it = bx; it < 256; it += G) rwkv_run(p, lds, tid, wave, lane, 0, it, 2048 / CH);
    for (int rep = (PROBE_DUP == 3 ? 0 : 1); rep < 2; ++rep)
    for (int it = bx * 16; it < 4096; it += G * 16) rwkv_run(p, lds, tid, wave, lane, 1, it, 4);
    for (int rep = (PROBE_DUP == 4 ? 0 : 1); rep < 2; ++rep) { const bool st = (rep == 1) || (p.zero != 0);
        if (bx < 128) rglru_item(p, lds, tid, wave, lane, 0, bx, st); else { rglru_item(p, lds, tid, wave, lane, 1, bx - 128, st); rglru_item(p, lds, tid, wave, lane, 1, bx, st); } }
    { const bool st = true;
        LAS unsigned* slot = (LAS unsigned*)(lds + LDS_BYTES - 16); unsigned* ctr = (unsigned*)(ws + WS_CTR);
        for (;;) {
            if (tid == 0) *slot = atomicAdd(ctr, 1u);
            __syncthreads();
            const unsigned it = *slot;
            __syncthreads();
            if (it >= 1024u) break;
            if ((it & 1u) == 0u) xattn_sample_item(p, lds, tid, wave, lane, (int)(it >> 1), st); else xattn_prompt_item(p, lds, tid, wave, lane, (int)(it >> 1), st);
        } }
    xcd_barrier(xbar);
    p4_post(p, tid, G, true);
    xcd_barrier(xbar);
    { pg8::Gemm g{(const pg8::bf16_t*)(ws + WS_Z), (const pg8::bf16_t*)(ws + WS_WBR), 3 * NT, 3072, 1024}; SchedTail S{bx}; EpiTail E{ws};
      pg8::gemm_phase<EpiTail, SchedTail>((PG8_LAS unsigned char*)lds, g, S, E, nullptr);
      if (bx < 192) { pg8::Gemm g4 = g; g4.nt = 4; SchedBrS S2{bx}; EpiPart E2{ws}; pg8::gemm_phase<EpiPart, SchedBrS>((PG8_LAS unsigned char*)lds, g4, S2, E2, nullptr); } }
    xcd_barrier(xbar);
    p5_sum(p, tid, G);
    { pg8::Gemm g{(const pg8::bf16_t*)(ws + WS_MERGED), (const pg8::bf16_t*)(ws + WS_WOUT), NPT, 1024, 1024}; pg8::StaticOrder S; S.init(NPT, 1024, G, bx); EpiOut E{opq(p.in[I_XP]), opq(p.in[I_XS]), p.out};
      pg8::gemm_phase<EpiOut, pg8::StaticOrder>((PG8_LAS unsigned char*)lds, g, S, E, nullptr); }
    xcd_barrier(xbar);
    if (bx < 16) { pg8::Gemm g{(const pg8::bf16_t*)(ws + WS_MERGED), (const pg8::bf16_t*)(ws + WS_WOUT), NT, 1024, 1024}; SchedOutS S{bx}; EpiOut E{opq(p.in[I_XP]), opq(p.in[I_XS]), p.out};
      pg8::gemm_phase<EpiOut, SchedOutS>((PG8_LAS unsigned char*)lds, g, S, E, nullptr); }
    else p6_norm(p, 0, NPT, bx - 16, G - 16, wave, lane);
    xcd_barrier(xbar);
    p6_norm(p, NPT, NT, bx, G, wave, lane);
#undef p
}
}

extern "C" void kernel_launch(void* const* d_in, const int* in_sizes, int n_in, void* d_out, int out_size, void* d_ws, size_t ws_size, hipStream_t stream) {
    static int grid = 0;
    if (grid == 0) {
        if (n_in != 35 || (size_t)out_size != mk::O_END || ws_size < mk::WS_END) { fprintf(stderr, "kernel_launch: unexpected shapes: n_in %d out %d ws %zu\n", n_in, out_size, ws_size); grid = -1; return; }
        int dev = 0, cus = 0, per_cu = 0;
        hipGetDevice(&dev); hipDeviceGetAttribute(&cus, hipDeviceAttributeMultiprocessorCount, dev);
        hipFuncSetAttribute((const void*)mk::fwd, hipFuncAttributeMaxDynamicSharedMemorySize, mk::LDS_BYTES);
        hipOccupancyMaxActiveBlocksPerMultiprocessor(&per_cu, (const void*)mk::fwd, 512, mk::LDS_BYTES);
        if (per_cu < 1) { fprintf(stderr, "kernel_launch: occupancy query says %d blocks per CU\n", per_cu); per_cu = 1; }
        grid = cus * 1;
        (void)hipGetLastError();
    }
    if (grid < 0) return;
    mk::Params p{};
    for (int i = 0; i < 35; ++i) p.in[i] = (const float*)d_in[i];
    p.out = (float*)d_out; p.ws = (unsigned char*)d_ws;
    void* args[] = {&p};
    hipError_t e = hipLaunchCooperativeKernel((const void*)mk::fwd, dim3(grid), dim3(512), args, mk::LDS_BYTES, stream);
    if (e != hipSuccess) fprintf(stderr, "cooperative launch failed: %s (grid %d)\n", hipGetErrorString(e), grid);
}
```

```cpp
#include <hip/hip_cooperative_groups.h>
#include <cstdio>
#include <hip/hip_runtime.h>
namespace pg8 {
#define PG8_LAS __attribute__((address_space(3)))
typedef unsigned short bf16_t;
typedef short bf16x8 __attribute__((ext_vector_type(8)));
typedef float f32x4 __attribute__((ext_vector_type(4)));
typedef unsigned u32x4 __attribute__((ext_vector_type(4)));
constexpr int BM = 256, BK = 64, HALF = 128, HTB = HALF * BK * 2  , STAGE_BYTES = 8 * HTB, NXCD = 8, WGM = 8;

__host__ __device__ __forceinline__ int lds_byte(int r, int c) { const int st = (r >> 4) * 2 + (c >> 5), rr = r & 15, cc = c & 31, ob = rr * 64 + cc * 2; return st * 1024 + (ob ^ (((ob >> 9) & 1) << 5)); }
__host__ __device__ __forceinline__ void stage_rc(int b, int& R, int& C) { const int st = b / 1024, sb = b % 1024, swz = sb ^ (((sb >> 9) & 1) << 5); R = (st >> 1) * 16 + swz / 64; C = (st & 1) * 32 + (swz % 64) / 2; }
__host__ __device__ __forceinline__ int perm32(int rho) { const int n = rho >> 4, i = rho & 15; return 8 * (i >> 2) + 4 * n + (i & 3); }

struct Unit { int pm, pn, ko; };
struct Gemm { const bf16_t* A; const bf16_t* Bt; int M, N, K, nt; };

struct StaticOrder {
    int nM, nN, nwg, G, c;
    __host__ __device__ void init(int M, int N, int G_, int c_) { nM = M / BM; nN = N / BM; nwg = nM * nN; G = G_; c = c_; }
    __host__ __device__ bool next(int i, Unit& u) const {
        const long L = (long)i * G + c; if (L >= nwg) return false;
        int wgid = (int)L; { const int q = nwg / NXCD, r = nwg % NXCD, xcd = wgid % NXCD, off = wgid / NXCD; wgid = (xcd < r ? xcd * (q + 1) : r * (q + 1) + (xcd - r) * q) + off; }
        const int nig = WGM * nN, gid = wgid / nig, fm = gid * WGM, gsz = (nM - fm) < WGM ? (nM - fm) : WGM;
        u.pm = fm + ((wgid % nig) % gsz); u.pn = (wgid % nig) / gsz; return true;
    }
    __device__ __forceinline__ void a_ready(const Unit&) const {}
    __device__ __forceinline__ void done(const Unit&) const {}
};
struct CountedOrder : StaticOrder {
    const unsigned* ready; unsigned need; unsigned* tmo;
    __device__ __forceinline__ void a_ready(const Unit& u) const {
        if (threadIdx.x < 64) {
            const unsigned long long t0 = __builtin_amdgcn_s_memrealtime(); unsigned polls = 0;
            while ((unsigned)__builtin_amdgcn_readfirstlane(__hip_atomic_load(ready + 64 * u.pm, __ATOMIC_RELAXED, __HIP_MEMORY_SCOPE_AGENT)) < need) {
                if ((++polls & 255u) == 0u && __builtin_amdgcn_readfirstlane(__hip_atomic_load(tmo, __ATOMIC_RELAXED, __HIP_MEMORY_SCOPE_AGENT)) != 0u) break;
                if (__builtin_amdgcn_s_memrealtime() - t0 > 2000000ull) {
                    if (threadIdx.x == 0) { unsigned expect = 0u; __hip_atomic_compare_exchange_strong(tmo + 1, &expect, 0x600u | (unsigned)(u.pm & 0xff), __ATOMIC_RELAXED, __ATOMIC_RELAXED, __HIP_MEMORY_SCOPE_AGENT); __hip_atomic_store(tmo, 1u, __ATOMIC_RELAXED, __HIP_MEMORY_SCOPE_AGENT); }
                    break; }
                __builtin_amdgcn_s_sleep(2); }
            __builtin_amdgcn_fence(__ATOMIC_ACQUIRE, "agent");
            asm volatile("s_waitcnt vmcnt(0)" ::: "memory");
        }
#if !defined(BROKEN_HOOK_NO_BARRIER)
        asm volatile("" ::: "memory"); __builtin_amdgcn_s_barrier(); asm volatile("" ::: "memory");
#endif
    }
};

__device__ __forceinline__ unsigned cvt_pk_bf16(float lo, float hi) { unsigned r; asm volatile("v_cvt_pk_bf16_f32 %0, %1, %2" : "=v"(r) : "v"(lo), "v"(hi)); return r; }
typedef float f32x2 __attribute__((ext_vector_type(2)));
__device__ __forceinline__ f32x2 gelu_pk(f32x2 v) {
    const f32x2 av = __builtin_elementwise_abs(v), d = av * 0.2316418882f + 1.0f;
    f32x2 t; t.x = __builtin_amdgcn_rcpf(d.x); t.y = __builtin_amdgcn_rcpf(d.y);
    f32x2 q = t * 0.5307027145f + (-0.7265760135f); q = q * t + 0.7107068705f; q = q * t + (-0.142248368f); q = q * t + 0.127414796f; q = q * t;
    const f32x2 s = (v * v) * (-0.72134752044f);
    f32x2 e; e.x = __builtin_amdgcn_exp2f(s.x); e.y = __builtin_amdgcn_exp2f(s.y);
    const f32x2 m = v * (q * e), r = v - m;
    f32x2 o; o.x = v.x < 0.f ? m.x : r.x; o.y = v.y < 0.f ? m.y : r.y; return o;
}

struct EpiF32 {
    static constexpr bool PERM = false, AFTER_DRAIN = false;
    float* C; int ldc; const float* bias;
    __device__ __forceinline__ void operator()(const f32x4 (&acc)[2][2][4][2], const Unit& u, int wr, int wc, int fr, int fq) const {
        const int row0 = u.pm * BM + wr * 64 + fr, col0 = u.pn * BM + wc * 32 + 4 * fq;
        f32x4 bv[2][2];
#pragma unroll
        for (int bj = 0; bj < 2; ++bj)
#pragma unroll
            for (int n = 0; n < 2; ++n) bv[bj][n] = bias ? *(const f32x4*)(bias + col0 + bj * HALF + n * 16) : (f32x4){0.f, 0.f, 0.f, 0.f};
#pragma unroll
        for (int ai = 0; ai < 2; ++ai)
#pragma unroll
            for (int m = 0; m < 4; ++m) { float* rowp = C + (size_t)(row0 + ai * HALF + m * 16) * ldc + col0;
#pragma unroll
                for (int bj = 0; bj < 2; ++bj)
#pragma unroll
                    for (int n = 0; n < 2; ++n) *(f32x4*)(rowp + bj * HALF + n * 16) = acc[ai][bj][m][n] + bv[bj][n]; }
    }
};
template <int ACT  > struct EpiBf16 {
    static constexpr bool PERM = true, AFTER_DRAIN = false;
    bf16_t* O; int ldc; const float* bias; int split_cols; size_t split_stride;
    __device__ __forceinline__ void operator()(const f32x4 (&acc)[2][2][4][2], const Unit& u, int wr, int wc, int fr, int fq) const {
        const int row0 = u.pm * BM + wr * 64 + fr; int colt = u.pn * BM; bf16_t* base = O;
        if (split_cols) { const int t = colt / split_cols; base += (size_t)t * split_stride; colt -= t * split_cols; }
        const int col0 = colt + wc * 32 + 8 * fq, bcol0 = u.pn * BM + wc * 32 + 8 * fq;
        f32x4 bv[2][2];
#pragma unroll
        for (int bj = 0; bj < 2; ++bj)
#pragma unroll
            for (int n = 0; n < 2; ++n) bv[bj][n] = bias ? *(const f32x4*)(bias + bcol0 + bj * HALF + 4 * n) : (f32x4){0.f, 0.f, 0.f, 0.f};
#pragma unroll
        for (int ai = 0; ai < 2; ++ai)
#pragma unroll
            for (int m = 0; m < 4; ++m) { bf16_t* rowp = base + (size_t)(row0 + ai * HALF + m * 16) * ldc + col0;
#pragma unroll
                for (int bj = 0; bj < 2; ++bj) { f32x4 v0 = acc[ai][bj][m][0] + bv[bj][0], v1 = acc[ai][bj][m][1] + bv[bj][1];
                    if (ACT == 1) { f32x2 a = gelu_pk((f32x2){v0[0], v0[1]}), b = gelu_pk((f32x2){v0[2], v0[3]}), c = gelu_pk((f32x2){v1[0], v1[1]}), d = gelu_pk((f32x2){v1[2], v1[3]});
                        v0 = (f32x4){a.x, a.y, b.x, b.y}; v1 = (f32x4){c.x, c.y, d.x, d.y}; }
                    if (ACT == 2) {
#pragma unroll
                        for (int j = 0; j < 4; ++j) { v0[j] = 0.5f * v0[j] * (1.0f + erff(v0[j] * 0.70710678f)); v1[j] = 0.5f * v1[j] * (1.0f + erff(v1[j] * 0.70710678f)); } }
                    u32x4 w; w.x = cvt_pk_bf16(v0[0], v0[1]); w.y = cvt_pk_bf16(v0[2], v0[3]); w.z = cvt_pk_bf16(v1[0], v1[1]); w.w = cvt_pk_bf16(v1[2], v1[3]);
                    *(u32x4*)(rowp + bj * HALF) = w; } }
    }
};

struct PanelStats {
    unsigned* xbuf;
    unsigned* cnt;
    unsigned* tmo;
    int ntn; float eps;
    unsigned code;
    __device__ __forceinline__ bool run(const f32x4 (&v)[2][2][4][2], const Unit& u, int wr, int wc, int fr, int fq, PG8_LAS unsigned char* lds, int wid, int lane) const {
        typedef float f32x2v __attribute__((ext_vector_type(2)));
        PG8_LAS f32x2v* P = (PG8_LAS f32x2v*)lds;
        PG8_LAS f32x2v* S = (PG8_LAS f32x2v*)(lds + 8192);
        PG8_LAS unsigned* flag = (PG8_LAS unsigned*)(lds + 8192 + 2048);
#pragma unroll
        for (int ai = 0; ai < 2; ++ai)
#pragma unroll
            for (int m = 0; m < 4; ++m) {
                float s = 0.f;
#pragma unroll
                for (int bj = 0; bj < 2; ++bj)
#pragma unroll
                    for (int n = 0; n < 2; ++n) { const f32x4 x = v[ai][bj][m][n]; s += (x[0] + x[1]) + (x[2] + x[3]); }
                s += __shfl_xor(s, 16); s += __shfl_xor(s, 32);
                const float mw = s * (1.0f / 64.0f); float q = 0.f;
#pragma unroll
                for (int bj = 0; bj < 2; ++bj)
#pragma unroll
                    for (int n = 0; n < 2; ++n) { const f32x4 d = v[ai][bj][m][n] - mw; q += (d[0] * d[0] + d[1] * d[1]) + (d[2] * d[2] + d[3] * d[3]); }
                q += __shfl_xor(q, 16); q += __shfl_xor(q, 32);
                if (fq == 0) P[(ai * HALF + wr * 64 + m * 16 + fr) * 4 + wc] = (f32x2v){mw, q};
            }
        asm volatile("s_waitcnt lgkmcnt(0)" ::: "memory"); __builtin_amdgcn_s_barrier(); asm volatile("" ::: "memory");
#if defined(BROKEN_NO_WAIT)
        if (blockIdx.x >= 64) { const long long t0 = clock64(); while (clock64() - t0 < 60000) __builtin_amdgcn_s_sleep(8); }
#endif
        const int row = wid * 32 + (lane & 31);
        if (lane < 32) {
            const f32x2v a = P[row * 4 + 0], b = P[row * 4 + 1], c = P[row * 4 + 2], d = P[row * 4 + 3];
            const float mt = (a.x + b.x + c.x + d.x) * 0.25f;
            const float da = a.x - mt, db = b.x - mt, dc = c.x - mt, dd = d.x - mt;
            const float m2 = (a.y + b.y) + (c.y + d.y) + 64.0f * ((da * da + db * db) + (dc * dc + dd * dd));
            unsigned long long* slot = (unsigned long long*)xbuf + ((size_t)(u.pm * BM + row) * 4 + u.pn);
            __hip_atomic_store(slot, ((unsigned long long)__float_as_uint(m2) << 32) | __float_as_uint(mt), __ATOMIC_RELAXED, __HIP_MEMORY_SCOPE_AGENT);
        }
        asm volatile("s_waitcnt vmcnt(0)" ::: "memory");
        if (lane == 0) __hip_atomic_fetch_add(cnt + 64 * u.pm, 1u, __ATOMIC_RELAXED, __HIP_MEMORY_SCOPE_AGENT);
        if (wid == 0) {
            bool dead = false; const unsigned long long t0 = __builtin_amdgcn_s_memrealtime(); const unsigned want = 8u * (unsigned)ntn;
            for (;;) {
#if defined(BROKEN_NO_WAIT)
                break;
#endif
                if ((unsigned)__builtin_amdgcn_readfirstlane(__hip_atomic_load(cnt + 64 * u.pm, __ATOMIC_RELAXED, __HIP_MEMORY_SCOPE_AGENT)) >= want) break;
                if (__builtin_amdgcn_s_memrealtime() - t0 > 2000000ull) {
                    if (lane == 0) { unsigned expect = 0u; __hip_atomic_compare_exchange_strong(tmo + 1, &expect, code | (unsigned)(u.pm & 0xff), __ATOMIC_RELAXED, __ATOMIC_RELAXED, __HIP_MEMORY_SCOPE_AGENT);
                                     __hip_atomic_store(tmo, 1u, __ATOMIC_RELAXED, __HIP_MEMORY_SCOPE_AGENT); }
                    dead = true; break; }
                __builtin_amdgcn_s_sleep(2);
            }
            __builtin_amdgcn_fence(__ATOMIC_ACQUIRE, "agent");
            if (lane == 0) flag[0] = dead ? 1u : 0u;
        }
        asm volatile("s_waitcnt vmcnt(0) lgkmcnt(0)" ::: "memory"); __builtin_amdgcn_s_barrier(); asm volatile("" ::: "memory");
        const bool bad = flag[0] != 0u;
        if (lane < 32) {
            const unsigned long long* slot = (const unsigned long long*)xbuf + (size_t)(u.pm * BM + row) * 4; float mt[4], m2[4]; float ms = 0.f;
#pragma unroll
            for (int t = 0; t < 4; ++t) { if (t < ntn) { const unsigned long long w = __hip_atomic_load(slot + t, __ATOMIC_RELAXED, __HIP_MEMORY_SCOPE_AGENT); mt[t] = __uint_as_float((unsigned)w); m2[t] = __uint_as_float((unsigned)(w >> 32)); } else { mt[t] = 0.f; m2[t] = 0.f; } ms += mt[t]; }
            const float mean = ms / (float)ntn; float q = 0.f;
#pragma unroll
            for (int t = 0; t < 4; ++t) if (t < ntn) { const float dm = mt[t] - mean; q += m2[t] + 256.0f * dm * dm; }
            S[row] = (f32x2v){mean, 1.0f / sqrtf(q / (256.0f * (float)ntn) + eps)};
        }
        asm volatile("s_waitcnt lgkmcnt(0)" ::: "memory"); __builtin_amdgcn_s_barrier(); asm volatile("" ::: "memory");
        return bad;
    }
};
struct EpiLnRes {
    static constexpr bool PERM = false, AFTER_DRAIN = true;
    const float* base; float* out; int ldc; const float* bias; PanelStats st; unsigned poison;
    __device__ __forceinline__ void refuse(size_t i0, size_t stride, int M, int N) const { const float q = __builtin_nanf(""); for (size_t i = i0; i < (size_t)M * N; i += stride) out[(i / N) * ldc + i % N] = q;
        if (i0 == 0) { unsigned expect = 0u; __hip_atomic_compare_exchange_strong(st.tmo + 1, &expect, 0x7f0u, __ATOMIC_RELAXED, __ATOMIC_RELAXED, __HIP_MEMORY_SCOPE_AGENT); __hip_atomic_store(st.tmo, 1u, __ATOMIC_RELAXED, __HIP_MEMORY_SCOPE_AGENT); } }
    __device__ __forceinline__ void fused(f32x4 (&acc)[2][2][4][2], const Unit& u, int wr, int wc, int fr, int fq, PG8_LAS unsigned char* lds, int wid, int lane) const {
        typedef float f32x2v __attribute__((ext_vector_type(2)));
        const PG8_LAS f32x2v* S = (const PG8_LAS f32x2v*)(lds + 8192);
        const int col0 = u.pn * BM + wc * 32 + 4 * fq;
#pragma unroll
        for (int bj = 0; bj < 2; ++bj)
#pragma unroll
            for (int n = 0; n < 2; ++n) { const f32x4 bv = bias ? *(const f32x4*)(bias + col0 + bj * HALF + n * 16) : (f32x4){0.f, 0.f, 0.f, 0.f};
#pragma unroll
                for (int ai = 0; ai < 2; ++ai)
#pragma unroll
                    for (int m = 0; m < 4; ++m) acc[ai][bj][m][n] += bv; }
        const bool bad = st.run(acc, u, wr, wc, fr, fq, lds, wid, lane) || poison != 0u;
        const float qnan = __builtin_nanf("");
#pragma unroll
        for (int ai = 0; ai < 2; ++ai)
#pragma unroll
            for (int m = 0; m < 4; ++m) { const int r = ai * HALF + wr * 64 + m * 16 + fr; const f32x2v sr = S[r]; const size_t off = (size_t)(u.pm * BM + r) * ldc + col0;
#pragma unroll
                for (int bj = 0; bj < 2; ++bj)
#pragma unroll
                    for (int n = 0; n < 2; ++n) { const f32x4 bs = *(const f32x4*)(base + off + bj * HALF + n * 16); f32x4 o = bs + (acc[ai][bj][m][n] - sr.x) * sr.y;
                        if (bad) o = (f32x4){qnan, qnan, qnan, qnan}; *(f32x4*)(out + off + bj * HALF + n * 16) = o; }
                asm volatile("" ::: "memory"); }
    }
};
struct EpiLnResLn {
    static constexpr bool PERM = false, AFTER_DRAIN = true;
    const float* base; float* out; bf16_t* xn; int ldc; const float* bias; PanelStats st1, st2; unsigned poison;
    __device__ __forceinline__ void refuse(size_t i0, size_t stride, int M, int N) const { const float q = __builtin_nanf(""); for (size_t i = i0; i < (size_t)M * N; i += stride) { const size_t o = (i / N) * ldc + i % N; out[o] = q; xn[o] = (bf16_t)0x7fc0u; }
        if (i0 == 0) { unsigned expect = 0u; __hip_atomic_compare_exchange_strong(st1.tmo + 1, &expect, 0x7f0u, __ATOMIC_RELAXED, __ATOMIC_RELAXED, __HIP_MEMORY_SCOPE_AGENT); __hip_atomic_store(st1.tmo, 1u, __ATOMIC_RELAXED, __HIP_MEMORY_SCOPE_AGENT); } }
    __device__ __forceinline__ void fused(f32x4 (&acc)[2][2][4][2], const Unit& u, int wr, int wc, int fr, int fq, PG8_LAS unsigned char* lds, int wid, int lane) const {
        typedef float f32x2v __attribute__((ext_vector_type(2))); typedef unsigned u32x2v __attribute__((ext_vector_type(2)));
        const PG8_LAS f32x2v* S = (const PG8_LAS f32x2v*)(lds + 8192);
        const int col0 = u.pn * BM + wc * 32 + 4 * fq;
#pragma unroll
        for (int bj = 0; bj < 2; ++bj)
#pragma unroll
            for (int n = 0; n < 2; ++n) { const f32x4 bv = bias ? *(const f32x4*)(bias + col0 + bj * HALF + n * 16) : (f32x4){0.f, 0.f, 0.f, 0.f};
#pragma unroll
                for (int ai = 0; ai < 2; ++ai)
#pragma unroll
                    for (int m = 0; m < 4; ++m) acc[ai][bj][m][n] += bv; }
        bool bad = st1.run(acc, u, wr, wc, fr, fq, lds, wid, lane) || poison != 0u;
        const float qnan = __builtin_nanf("");
#pragma unroll
        for (int ai = 0; ai < 2; ++ai)
#pragma unroll
            for (int m = 0; m < 4; ++m) { const int r = ai * HALF + wr * 64 + m * 16 + fr; const f32x2v sr = S[r]; const size_t off = (size_t)(u.pm * BM + r) * ldc + col0;
#pragma unroll
                for (int bj = 0; bj < 2; ++bj)
#pragma unroll
                    for (int n = 0; n < 2; ++n) { const f32x4 bs = *(const f32x4*)(base + off + bj * HALF + n * 16); acc[ai][bj][m][n] = bs + (acc[ai][bj][m][n] - sr.x) * sr.y; }
                asm volatile("" : "+v"(acc[ai][0][m][0]), "+v"(acc[ai][0][m][1]), "+v"(acc[ai][1][m][0]), "+v"(acc[ai][1][m][1]));
                if (m & 1) asm volatile("" ::: "memory"); }
        const bool bad1 = bad;
        bad = st2.run(acc, u, wr, wc, fr, fq, lds, wid, lane) || bad;
#pragma unroll
        for (int ai = 0; ai < 2; ++ai)
#pragma unroll
            for (int m = 0; m < 4; ++m) { const int r = ai * HALF + wr * 64 + m * 16 + fr; const f32x2v sr = S[r]; const size_t off = (size_t)(u.pm * BM + r) * ldc + col0;
#pragma unroll
                for (int bj = 0; bj < 2; ++bj)
#pragma unroll
                    for (int n = 0; n < 2; ++n) { const f32x4 x1 = acc[ai][bj][m][n]; *(f32x4*)(out + off + bj * HALF + n * 16) = bad1 ? (f32x4){qnan, qnan, qnan, qnan} : x1;
                        const f32x4 o = (x1 - sr.x) * sr.y; u32x2v w; w.x = cvt_pk_bf16(o[0], o[1]); w.y = cvt_pk_bf16(o[2], o[3]);
                        if (bad) { w.x = 0x7fc07fc0u; w.y = 0x7fc07fc0u; } *(u32x2v*)(xn + off + bj * HALF + n * 16) = w; }
                asm volatile("" ::: "memory"); }
    }
};

template <class Epi, class Sched, bool STAMP = false>
__device__ __forceinline__ void gemm_phase(PG8_LAS unsigned char* lds, const Gemm g, const Sched& S, const Epi& E, unsigned long long* stamps) {
    const int tid = threadIdx.x, wid = __builtin_amdgcn_readfirstlane(tid >> 6), lane = tid & 63, wr = wid >> 2, wc = wid & 3, fr = lane & 15, fq = lane >> 4;
    const int K = g.K, nt = g.nt ? g.nt : K / BK;
    int ts_lo = 0, ts_hi = 0, nts = 0; const unsigned long long rt_entry = STAMP ? (unsigned long long)wall_clock64() : 0ull;
#define PG8_STAMP() do { if (STAMP && wid == 0 && nts < 64) { const unsigned long long _c = (unsigned long long)clock64(); \
        ts_lo = (lane == nts) ? (int)(unsigned)_c : ts_lo; ts_hi = (lane == nts) ? (int)(unsigned)(_c >> 32) : ts_hi; ++nts; } } while (0)
    PG8_STAMP();
    unsigned voffA[2], voffB[2];
#pragma unroll
    for (int i = 0; i < 2; ++i) { int R, C; stage_rc(tid * 16 + i * 8192, R, C); const int Rb = Epi::PERM ? ((R & ~31) + perm32(R & 31)) : R;
        voffA[i] = (unsigned)(R * K + C) * 2u; voffB[i] = (unsigned)(Rb * K + C) * 2u; }
    const size_t kstep = (size_t)(BK * 2);
    const size_t hstep = (size_t)HALF * K * 2;
    const size_t tstep = 2 * hstep;
    const unsigned ldsw = (unsigned)wid * 1024u;
    const int aoff = lds_byte(wr * 64 + fr, fq * 8), boff = lds_byte(wc * 32 + fr, fq * 8);
#define PG8_SA(b, h) (((b) * 2 + (h)) * HTB)
#define PG8_SB(b, h) ((4 + (b) * 2 + (h)) * HTB)
#define PG8_STAGE(bufoff, gbase, voff) do { _Pragma("unroll") for (int _i = 0; _i < 2; ++_i) \
        __builtin_amdgcn_global_load_lds((const unsigned*)((const char*)(gbase) + (voff)[_i]), (PG8_LAS unsigned*)(lds + (bufoff) + ldsw + _i * 8192), 16, 0, 0); } while (0)
#define PG8_LDA(dst, b, h) do { _Pragma("unroll") for (int m = 0; m < 4; ++m) _Pragma("unroll") for (int k = 0; k < 2; ++k) dst[m][k] = *(const PG8_LAS bf16x8*)(lds + PG8_SA(b, h) + aoff + m * 2048 + k * 1024); } while (0)
#define PG8_LDB(dst, b, h) do { _Pragma("unroll") for (int n = 0; n < 2; ++n) _Pragma("unroll") for (int k = 0; k < 2; ++k) dst[n][k] = *(const PG8_LAS bf16x8*)(lds + PG8_SB(b, h) + boff + n * 2048 + k * 1024); } while (0)
#define PG8_MMA(ai, bj, At, Bt) do { __builtin_amdgcn_s_setprio(1); _Pragma("unroll") for (int m = 0; m < 4; ++m) _Pragma("unroll") for (int n = 0; n < 2; ++n) _Pragma("unroll") for (int k = 0; k < 2; ++k) \
        acc[ai][bj][m][n] = __builtin_amdgcn_mfma_f32_16x16x32_bf16(Bt[n][k], At[m][k], acc[ai][bj][m][n], 0, 0, 0); __builtin_amdgcn_s_setprio(0); } while (0)
#define PG8_WAIT_V(n) asm volatile("s_waitcnt vmcnt(" #n ")" ::: "memory")
#define PG8_WAIT_L(n) asm volatile("s_waitcnt lgkmcnt(" #n ")" ::: "memory")
#define PG8_BAR __builtin_amdgcn_s_barrier()
#define PG8_SCHED __builtin_amdgcn_sched_barrier(0)
    Unit cur{0, 0, 0}, nxt{0, 0, 0}; int ui = 0;
    if (!S.next(0, cur)) return;
    f32x4 acc[2][2][4][2];
#pragma unroll
    for (int a = 0; a < 2; ++a)
#pragma unroll
        for (int b = 0; b < 2; ++b)
#pragma unroll
            for (int m = 0; m < 4; ++m)
#pragma unroll
                for (int n = 0; n < 2; ++n) acc[a][b][m][n] = (f32x4){0.f, 0.f, 0.f, 0.f};
    bf16x8 At[4][2], B0[2][2], B1[2][2];
    const char* cA = (const char*)g.A + (size_t)cur.pm * tstep + (size_t)cur.ko * 2; const char* cB = (const char*)g.Bt + (size_t)cur.pn * tstep + (size_t)cur.ko * 2;
    S.a_ready(cur);
    PG8_STAGE(PG8_SB(0, 0), cB, voffB); PG8_STAGE(PG8_SA(0, 0), cA, voffA); PG8_STAGE(PG8_SB(0, 1), cB + hstep, voffB); PG8_STAGE(PG8_SA(0, 1), cA + hstep, voffA);
    if (wr == 1) PG8_BAR;
    PG8_WAIT_V(4); PG8_BAR;
    PG8_STAGE(PG8_SB(1, 0), cB + kstep, voffB); PG8_STAGE(PG8_SA(1, 0), cA + kstep, voffA); PG8_STAGE(PG8_SB(1, 1), cB + hstep + kstep, voffB);
    PG8_WAIT_V(6); PG8_BAR;
    PG8_STAMP();
    for (;;) {
        const bool has_next = S.next(ui + 1, nxt);
        const char* nA = has_next ? (const char*)g.A + (size_t)nxt.pm * tstep + (size_t)nxt.ko * 2 : cA; const char* nB = has_next ? (const char*)g.Bt + (size_t)nxt.pn * tstep + (size_t)nxt.ko * 2 : cB;
        for (int t = 0; t < nt; t += 2) {
            const bool last = (t == nt - 2);
            const char* a1 = cA + (size_t)(t + 1) * kstep;
            const char* a2 = last ? nA : cA + (size_t)(t + 2) * kstep; const char* b2 = last ? nB : cB + (size_t)(t + 2) * kstep;
            const char* a3 = a2 + kstep; const char* b3 = b2 + kstep;
            if (last && has_next) S.a_ready(nxt);
            PG8_LDB(B0, 0, 0); PG8_SCHED; PG8_LDA(At, 0, 0); PG8_STAGE(PG8_SA(1, 1), a1 + hstep, voffA);
            PG8_WAIT_L(8); PG8_BAR; PG8_WAIT_L(0); PG8_MMA(0, 0, At, B0); PG8_BAR; PG8_SCHED;
            PG8_LDB(B1, 0, 1); PG8_STAGE(PG8_SB(0, 0), b2, voffB);
            PG8_BAR; PG8_WAIT_L(0); PG8_MMA(0, 1, At, B1); PG8_BAR;
            PG8_LDA(At, 0, 1); PG8_STAGE(PG8_SA(0, 0), a2, voffA);
            PG8_BAR; PG8_WAIT_L(0); PG8_MMA(1, 0, At, B0); PG8_BAR; PG8_SCHED;
            PG8_STAGE(PG8_SB(0, 1), b2 + hstep, voffB);
            PG8_WAIT_V(6); PG8_BAR; PG8_MMA(1, 1, At, B1); PG8_BAR;
            PG8_LDB(B0, 1, 0); PG8_SCHED; PG8_LDA(At, 1, 0); PG8_STAGE(PG8_SA(0, 1), a2 + hstep, voffA);
            PG8_WAIT_L(8); PG8_BAR; PG8_WAIT_L(0); PG8_MMA(0, 0, At, B0); PG8_BAR; PG8_SCHED;
            PG8_LDB(B1, 1, 1); PG8_STAGE(PG8_SB(1, 0), b3, voffB);
            PG8_BAR; PG8_WAIT_L(0); PG8_MMA(0, 1, At, B1); PG8_BAR;
            PG8_LDA(At, 1, 1); PG8_STAGE(PG8_SA(1, 0), a3, voffA);
            PG8_BAR; PG8_WAIT_L(0); PG8_MMA(1, 0, At, B0); PG8_BAR; PG8_SCHED;
            PG8_STAGE(PG8_SB(1, 1), b3 + hstep, voffB);
            PG8_WAIT_V(6); PG8_BAR; PG8_MMA(1, 1, At, B1); PG8_BAR;
        }
        PG8_STAMP();
        if constexpr (!Epi::AFTER_DRAIN) { E(acc, cur, wr, wc, fr, fq); S.done(cur); }
        PG8_STAMP();
        if (!has_next) break;
        if (!Epi::keep(nxt))
#pragma unroll
        for (int a = 0; a < 2; ++a)
#pragma unroll
            for (int b = 0; b < 2; ++b)
#pragma unroll
                for (int m = 0; m < 4; ++m)
#pragma unroll
                    for (int n = 0; n < 2; ++n) acc[a][b][m][n] = (f32x4){0.f, 0.f, 0.f, 0.f};
        cur = nxt; cA = nA; cB = nB; ++ui;
    }
    PG8_WAIT_V(0);
    if (wr == 0) PG8_BAR;
    PG8_BAR;
    if constexpr (Epi::AFTER_DRAIN) { E.fused(acc, cur, wr, wc, fr, fq, lds, wid, lane); S.done(cur); }
    PG8_STAMP();
    if (STAMP && wid == 0) { stamps[lane] = lane < nts ? (((unsigned long long)(unsigned)ts_hi << 32) | (unsigned)ts_lo) : 0ull;
        if (lane == 62) stamps[62] = rt_entry; if (lane == 63) stamps[63] = (unsigned long long)wall_clock64(); }
#undef PG8_STAMP
#undef PG8_SA
#undef PG8_SB
#undef PG8_STAGE
#undef PG8_LDA
#undef PG8_LDB
#undef PG8_MMA
#undef PG8_WAIT_V
#undef PG8_WAIT_L
#undef PG8_BAR
#undef PG8_SCHED
}
}

namespace mk {
namespace cg = cooperative_groups;
#define LAS __attribute__((address_space(3)))
typedef unsigned short bf16;
typedef short bf16x8 __attribute__((ext_vector_type(8)));
typedef float f32x4 __attribute__((ext_vector_type(4)));
typedef float f32x2 __attribute__((ext_vector_type(2)));
typedef unsigned u32x4 __attribute__((ext_vector_type(4)));
typedef unsigned u32x2 __attribute__((ext_vector_type(2)));

constexpr int NT = 17408, NPT = 16384, DM = 1024;
constexpr size_t MiB = 1u << 20;
constexpr size_t WS_WIN = 0, WS_WBR = 28 * MiB, WS_WOUT = 34 * MiB, WS_WDEC = 36 * MiB, WS_WAAA = WS_WDEC + 131072, WS_WRGA = WS_WAAA + 131072, WS_WRGX = WS_WRGA + 131072;
constexpr size_t WS_XN = 38 * MiB, WS_U = 76 * MiB, WS_Z = 178 * MiB, WS_XB = 280 * MiB, WS_Q = 314 * MiB, WS_G = 348 * MiB, WS_XWA = 450 * MiB;
constexpr size_t WS_MK = 459 * MiB, WS_MVT = 463 * MiB, WS_BONUS = 467 * MiB, WS_STATS = 469 * MiB, WS_CTR = 474 * MiB, WS_END = 475 * MiB;
constexpr size_t WS_ORAW = WS_XN, WS_P = WS_U, WS_MERGED = WS_XB;
constexpr size_t ZSTRIDE = (size_t)NT * DM;
constexpr int LDS_BYTES = 147456;
constexpr size_t O_Y = 0, O_RWP = 17825792, O_SHP = O_RWP + 524288, O_LRP = O_SHP + 25600, O_CVP = O_LRP + 8192, O_MKP = O_CVP + 24576, O_MVP = O_MKP + 2097152,
                 O_RWS = O_MVP + 2097152, O_SHS = O_RWS + 8388608, O_LRS = O_SHS + 409600, O_CVS = O_LRS + 131072, O_END = O_CVS + 393216;

struct Params { const float* in[35]; float* out; unsigned char* ws; int zero; int pad; };
#define PREF const __attribute__((address_space(4))) Params&
typedef const __attribute__((address_space(4))) Params CParams;
__device__ __forceinline__ CParams* launder(CParams* x) { asm volatile("" : "+s"(x)); return x; }
enum { I_XP = 0, I_XS, I_MEM, I_SRW, I_SSH, I_SLRU, I_SCV, I_CK, I_CV, I_GN, I_WIN, I_MU, I_W0, I_WDEC, I_A0, I_WAAA, I_KK, I_KA, I_RK, I_GNG, I_GNB, I_CW, I_CB, I_WRGA, I_BRGA, I_WRGX, I_BRGX, I_LAM, I_GMEM, I_WMEM, I_WBA, I_WBB, I_WBC, I_WOUT, I_GF };

__device__ __forceinline__ unsigned f2bf(float f) { unsigned u = __builtin_bit_cast(unsigned, f); return (u + 0x7fffu + ((u >> 16) & 1u)) >> 16; }
__device__ __forceinline__ unsigned pk2(float lo, float hi) { unsigned r; asm("v_cvt_pk_bf16_f32 %0, %1, %2" : "=v"(r) : "v"(lo), "v"(hi)); return r; }
__device__ __forceinline__ float bf2f(unsigned b) { return __builtin_bit_cast(float, b << 16); }
__device__ __forceinline__ float bflo(unsigned w) { return __builtin_bit_cast(float, w << 16); }
__device__ __forceinline__ float bfhi(unsigned w) { return __builtin_bit_cast(float, w & 0xffff0000u); }
__device__ __forceinline__ const float* opq(const float* x) { asm volatile("" : "+s"(x)); return x; }
__device__ __forceinline__ float sigm(float x) { return __builtin_amdgcn_rcpf(1.0f + __builtin_amdgcn_exp2f(x * -1.44269504f)); }
#define LDS_WAIT() asm volatile("s_waitcnt lgkmcnt(0)" ::: "memory")
template <int CTRL> __device__ __forceinline__ float dppf(float x) { return __builtin_bit_cast(float, __builtin_amdgcn_update_dpp(0, __builtin_bit_cast(int, x), CTRL, 0xF, 0xF, true)); }
__device__ __forceinline__ float row16_sum(float x) { x += dppf<0xB1>(x); x += dppf<0x4E>(x); x += dppf<0x141>(x); x += dppf<0x140>(x); return x; }
__device__ __forceinline__ float row16_max(float x) { x = fmaxf(x, dppf<0xB1>(x)); x = fmaxf(x, dppf<0x4E>(x)); x = fmaxf(x, dppf<0x141>(x)); x = fmaxf(x, dppf<0x140>(x)); return x; }
__device__ __forceinline__ float rdl(float x, int l) { return __builtin_bit_cast(float, __builtin_amdgcn_readlane(__builtin_bit_cast(int, x), l)); }
__device__ __forceinline__ float wave_sum(float x) { x = row16_sum(x); return (rdl(x, 0) + rdl(x, 16)) + (rdl(x, 32) + rdl(x, 48)); }
__device__ __forceinline__ float wave_max(float x) { x = row16_max(x); x = fmaxf(x, __shfl_xor(x, 16)); x = fmaxf(x, __shfl_xor(x, 32)); return x; }

struct EpiMain {
    static constexpr bool PERM = true, AFTER_DRAIN = false;
    static __device__ __forceinline__ bool keep(const pg8::Unit&) { return false; }
    unsigned char* ws;
    __device__ __forceinline__ void operator()(const pg8::f32x4 (&acc)[2][2][4][2], const pg8::Unit& u, int wr, int wc, int fr, int fq) const {
        const int pn = u.pn, row0 = u.pm * 256 + wr * 64 + fr;
        if (pn == 44) {
            float* X = (float*)(ws + WS_XWA);
#pragma unroll
            for (int ai = 0; ai < 2; ++ai)
#pragma unroll
                for (int m = 0; m < 4; ++m) { float* rp = X + (size_t)(row0 + ai * 128 + m * 16) * 128 + wc * 32 + 8 * fq;
                    *(f32x4*)rp = acc[ai][0][m][0]; *(f32x4*)(rp + 4) = acc[ai][0][m][1]; }
            return;
        }
        bf16* base; int ld, colt, act;
        if (pn < 12) { base = (bf16*)(ws + WS_U); ld = 3072; colt = pn * 256; act = 0; }
        else if (pn < 16) { base = (bf16*)(ws + WS_Z); ld = 1024; colt = (pn - 12) * 256; act = 1; }
        else if (pn < 20) { base = (bf16*)(ws + WS_XB); ld = 1024; colt = (pn - 16) * 256; act = 0; }
        else if (pn < 24) { base = (bf16*)(ws + WS_Z) + ZSTRIDE; ld = 1024; colt = (pn - 20) * 256; act = 1; }
        else if (pn < 28) { base = (bf16*)(ws + WS_Q); ld = 1024; colt = (pn - 24) * 256; act = 0; }
        else if (pn < 32) { base = (bf16*)(ws + WS_Z) + 2 * ZSTRIDE; ld = 1024; colt = (pn - 28) * 256; act = 1; }
        else { base = (bf16*)(ws + WS_G); ld = 3072; colt = (pn - 32) * 256; act = 2; }
        const int col0 = colt + wc * 32 + 8 * fq;
#pragma unroll
        for (int ai = 0; ai < 2; ++ai)
#pragma unroll
            for (int m = 0; m < 4; ++m) { bf16* rowp = base + (size_t)(row0 + ai * 128 + m * 16) * ld + col0;
#pragma unroll
                for (int bj = 0; bj < 2; ++bj) { pg8::f32x4 v0 = acc[ai][bj][m][0], v1 = acc[ai][bj][m][1];
                    if (act) {
#pragma unroll
                        for (int j = 0; j < 4; ++j) { const float s0 = sigm(v0[j]), s1 = sigm(v1[j]); v0[j] = act == 1 ? v0[j] * s0 : s0; v1[j] = act == 1 ? v1[j] * s1 : s1; } }
                    u32x4 w; w.x = pk2(v0[0], v0[1]); w.y = pk2(v0[2], v0[3]); w.z = pk2(v1[0], v1[1]); w.w = pk2(v1[2], v1[3]);
                    *(u32x4*)(rowp + bj * 128) = w; } }
    }
};
struct EpiMem {
    static constexpr bool PERM = false, AFTER_DRAIN = false;
    static __device__ __forceinline__ bool keep(const pg8::Unit&) { return false; }
    unsigned char* ws; float* out;
    __device__ __forceinline__ void operator()(const pg8::f32x4 (&acc)[2][2][4][2], const pg8::Unit& u, int wr, int wc, int fr, int fq) const {
        const int row0 = u.pm * 256 + wr * 64 + fr; const bool isv = u.pn >= 4; const int colt = (u.pn & 3) * 256 + wc * 32 + 4 * fq;
        float* of = out + (isv ? O_MVP : O_MKP); bf16* MK = (bf16*)(ws + WS_MK); bf16* MVT = (bf16*)(ws + WS_MVT);
#pragma unroll
        for (int ai = 0; ai < 2; ++ai)
#pragma unroll
            for (int m = 0; m < 4; ++m) { const int r = row0 + ai * 128 + m * 16;
#pragma unroll
                for (int bj = 0; bj < 2; ++bj)
#pragma unroll
                    for (int n = 0; n < 2; ++n) { const int c = colt + bj * 128 + n * 16; const pg8::f32x4 v = acc[ai][bj][m][n];
                        *(f32x4*)(of + (size_t)r * 1024 + c) = v;
                        if (!isv) { u32x2 w; w.x = pk2(v[0], v[1]); w.y = pk2(v[2], v[3]); *(u32x2*)(MK + (size_t)r * 1024 + c) = w; }
                        else { const int b = r >> 8, mem = r & 255, head = c >> 8, d = c & 255; bf16* q = MVT + ((size_t)((b * 4 + head) * 256 + d)) * 256 + mem;
                            q[0] = (bf16)f2bf(v[0]); q[256] = (bf16)f2bf(v[1]); q[512] = (bf16)f2bf(v[2]); q[768] = (bf16)f2bf(v[3]); } } }
    }
};
struct SchedMem { int c;
    __device__ bool next(int i, pg8::Unit& u) const { if (i != 0 || c >= 64) return false; u.pm = c >> 3; u.pn = c & 7; return true; }
    __device__ __forceinline__ void a_ready(const pg8::Unit&) const {}
    __device__ __forceinline__ void done(const pg8::Unit&) const {}
};
struct EpiTail {
    static constexpr bool PERM = true, AFTER_DRAIN = false;
    static __device__ __forceinline__ bool keep(const pg8::Unit& nxt) { return (nxt.pn >> 2) != 0; }
    unsigned char* ws;
    __device__ __forceinline__ void operator()(pg8::f32x4 (&acc)[2][2][4][2], const pg8::Unit& u, int wr, int wc, int fr, int fq) const {
        const int br = u.pn >> 2, pmm = u.pm - br * 68, pnn = u.pn & 3;
        const int row0 = pmm * 256 + wr * 64 + fr, col0 = pnn * 256 + wc * 32 + 8 * fq;
        const bf16* gbase = (const bf16*)(ws + WS_G) + (size_t)row0 * 3072 + br * 1024 + col0; const int hoff = br < 2 ? 1024 : 0; const bool last = br == 2;
#define MK_CLAMP8(g, f0, f1) pg8::f32x4 f0 = {fmaxf(bflo(g.x), 1e-20f), fmaxf(bfhi(g.x), 1e-20f), fmaxf(bflo(g.y), 1e-20f), fmaxf(bfhi(g.y), 1e-20f)}, f1 = {fmaxf(bflo(g.z), 1e-20f), fmaxf(bfhi(g.z), 1e-20f), fmaxf(bflo(g.w), 1e-20f), fmaxf(bfhi(g.w), 1e-20f)}
#pragma unroll
        for (int ai = 0; ai < 2; ++ai)
#pragma unroll
            for (int m = 0; m < 4; ++m) {
#pragma unroll
                for (int bj = 0; bj < 2; ++bj) { const bf16* gp = gbase + (size_t)(ai * 128 + m * 16) * 3072 + bj * 128; const u32x4 g = *(const u32x4*)gp, h = *(const u32x4*)(gp + hoff);
                    MK_CLAMP8(g, f0, f1); MK_CLAMP8(h, d0, d1);
#pragma unroll
                    for (int j = 0; j < 4; ++j) { d0[j] = last ? 1.0f : __builtin_amdgcn_rcpf(d0[j]); d1[j] = last ? 1.0f : __builtin_amdgcn_rcpf(d1[j]); }
                    acc[ai][bj][m][0] *= f0 * d0; acc[ai][bj][m][1] *= f1 * d1; }
                asm volatile("" ::: "memory"); }
#undef MK_CLAMP8
        if (last) { bf16* mbase = (bf16*)(ws + WS_MERGED) + (size_t)row0 * 1024 + col0;
#pragma unroll
            for (int ai = 0; ai < 2; ++ai)
#pragma unroll
                for (int m = 0; m < 4; ++m)
#pragma unroll
                    for (int bj = 0; bj < 2; ++bj) { const pg8::f32x4 v0 = acc[ai][bj][m][0], v1 = acc[ai][bj][m][1];
                        u32x4 w; w.x = pk2(v0[0], v0[1]); w.y = pk2(v0[2], v0[3]); w.z = pk2(v1[0], v1[1]); w.w = pk2(v1[2], v1[3]); *(u32x4*)(mbase + (size_t)(ai * 128 + m * 16) * 1024 + bj * 128) = w; } }
    }
};
struct SchedTail { int c;
    __device__ bool next(int i, pg8::Unit& u) const { if (i >= 3) return false; const int t = (c & 7) * 32 + (c >> 3); u.pm = i * 68 + (t >> 2); u.pn = i * 4 + (t & 3); return true; }
    __device__ __forceinline__ void a_ready(const pg8::Unit&) const {}
    __device__ __forceinline__ void done(const pg8::Unit&) const {}
};
struct EpiPart {
    static constexpr bool PERM = false, AFTER_DRAIN = false;
    static __device__ __forceinline__ bool keep(const pg8::Unit&) { return false; }
    unsigned char* ws;
    __device__ __forceinline__ void operator()(const pg8::f32x4 (&acc)[2][2][4][2], const pg8::Unit& u, int wr, int wc, int fr, int fq) const {
        const int br = u.pn >> 2, pmm = u.pm - br * 68 - 64, pnn = u.pn & 3, kq = u.ko >> 8;
        const int row0 = pmm * 256 + wr * 64 + fr, col0 = pnn * 256 + wc * 32 + 4 * fq;
        float* P = (float*)(ws + WS_P) + (size_t)(kq * 3 + br) * 1048576;
#pragma unroll
        for (int ai = 0; ai < 2; ++ai)
#pragma unroll
            for (int m = 0; m < 4; ++m) { float* rowp = P + (size_t)(row0 + ai * 128 + m * 16) * 1024 + col0;
#pragma unroll
                for (int bj = 0; bj < 2; ++bj)
#pragma unroll
                    for (int n = 0; n < 2; ++n) *(f32x4*)(rowp + bj * 128 + n * 16) = acc[ai][bj][m][n]; }
    }
};
struct SchedBrS { int c;
    __device__ bool next(int i, pg8::Unit& u) const { if (i != 0 || c >= 192) return false; const int kq = c & 3, idx = c >> 2, br = idx >> 4, t = idx & 15; u.pm = br * 68 + 64 + (t >> 2); u.pn = br * 4 + (t & 3); u.ko = kq * 256; return true; }
    __device__ __forceinline__ void a_ready(const pg8::Unit&) const {}
    __device__ __forceinline__ void done(const pg8::Unit&) const {}
};
struct SchedOutS { int c;
    __device__ bool next(int i, pg8::Unit& u) const { if (i != 0 || c >= 64) return false; const int t = c >> 2; u.pm = 64 + (t >> 2); u.pn = t & 3; u.ko = (c & 3) * 256; return true; }
    __device__ __forceinline__ void a_ready(const pg8::Unit&) const {}
    __device__ __forceinline__ void done(const pg8::Unit&) const {}
};
constexpr size_t WS_YP = WS_P + 48 * MiB;
struct EpiPartY {
    static constexpr bool PERM = false, AFTER_DRAIN = false;
    static __device__ __forceinline__ bool keep(const pg8::Unit&) { return false; }
    unsigned char* ws;
    __device__ __forceinline__ void operator()(const pg8::f32x4 (&acc)[2][2][4][2], const pg8::Unit& u, int wr, int wc, int fr, int fq) const {
        const int row0 = (u.pm - 64) * 256 + wr * 64 + fr, col0 = u.pn * 256 + wc * 32 + 4 * fq; float* P = (float*)(ws + WS_YP) + (size_t)(u.ko >> 8) * 1048576;
#pragma unroll
        for (int ai = 0; ai < 2; ++ai)
#pragma unroll
            for (int m = 0; m < 4; ++m) { float* rowp = P + (size_t)(row0 + ai * 128 + m * 16) * 1024 + col0;
#pragma unroll
                for (int bj = 0; bj < 2; ++bj)
#pragma unroll
                    for (int n = 0; n < 2; ++n) *(f32x4*)(rowp + bj * 128 + n * 16) = acc[ai][bj][m][n]; }
    }
};
struct EpiOut {
    static constexpr bool PERM = false, AFTER_DRAIN = false;
    static __device__ __forceinline__ bool keep(const pg8::Unit&) { return false; }
    const float* xp; const float* xs; float* out;
    __device__ __forceinline__ void operator()(const pg8::f32x4 (&acc)[2][2][4][2], const pg8::Unit& u, int wr, int wc, int fr, int fq) const {
        const int row0 = u.pm * 256 + wr * 64 + fr, col0 = u.pn * 256 + wc * 32 + 4 * fq;
#pragma unroll
        for (int ai = 0; ai < 2; ++ai)
#pragma unroll
            for (int m = 0; m < 4; ++m) { const int r = row0 + ai * 128 + m * 16; const float* xr = (r < NPT ? xp + (size_t)r * 1024 : xs + (size_t)(r - NPT) * 1024) + col0; float* orow = out + (size_t)r * 1024 + col0;
#pragma unroll
                for (int bj = 0; bj < 2; ++bj)
#pragma unroll
                    for (int n = 0; n < 2; ++n) *(f32x4*)(orow + bj * 128 + n * 16) = *(const f32x4*)(xr + bj * 128 + n * 16) + acc[ai][bj][m][n]; }
    }
};

__device__ __forceinline__ void transpose_item(const float* W, int K, int N, bf16* WT, int row_off, LAS float* scr, int item, int lane) {
    const int nblk = N / 32, kb = item / nblk, nb = item % nblk, k0 = 64 * kb, n0 = 32 * nb;
    float tv[32];
#pragma unroll
    for (int i = 0; i < 32; ++i) tv[i] = W[(size_t)(k0 + 2 * i + (lane >> 5)) * N + n0 + (lane & 31)];
#pragma unroll
    for (int i = 0; i < 32; ++i) scr[(2 * i + (lane >> 5)) * 33 + (lane & 31)] = tv[i];
    LDS_WAIT();
    const int c = lane & 7;
#pragma unroll
    for (int j = 0; j < 4; ++j) { const int n = (lane >> 3) + 8 * j; const LAS float* s = scr + (8 * c) * 33 + n;
        u32x4 o; o.x = pk2(s[0 * 33], s[1 * 33]); o.y = pk2(s[2 * 33], s[3 * 33]); o.z = pk2(s[4 * 33], s[5 * 33]); o.w = pk2(s[6 * 33], s[7 * 33]);
        *(u32x4*)(WT + (size_t)(row_off + n0 + n) * K + k0 + 8 * c) = o; }
    LDS_WAIT();
}
__device__ __forceinline__ void rms_row_to_bf16(const float* xrow, const float* g, bf16* orow, int lane) {
    const f32x4* xr = (const f32x4*)xrow + lane; const f32x4* gr = (const f32x4*)g + lane;
    f32x4 v[4]; float s = 0.f;
#pragma unroll
    for (int j = 0; j < 4; ++j) { v[j] = xr[64 * j]; s += (v[j].x * v[j].x + v[j].y * v[j].y) + (v[j].z * v[j].z + v[j].w * v[j].w); }
    const float rstd = rsqrtf(wave_sum(s) * (1.f / 1024.f) + 1e-6f);
    unsigned long long* o8 = (unsigned long long*)orow + lane;
#pragma unroll
    for (int j = 0; j < 4; ++j) { const f32x4 gg = gr[64 * j]; o8[64 * j] = (unsigned long long)pk2(v[j].x * rstd * gg.x, v[j].y * rstd * gg.y) | ((unsigned long long)pk2(v[j].z * rstd * gg.z, v[j].w * rstd * gg.w) << 32); }
}
__device__ __forceinline__ void p0_prologue(PREF p, LAS unsigned char* lds, int tid, int wave, int lane, int G) {
    unsigned char* ws = p.ws;
    LAS float* scr = (LAS float*)(lds + wave * 16384);
    const int gw = blockIdx.x * 8 + wave, NGW = G * 8;
    bf16* WIN = (bf16*)(ws + WS_WIN);
    constexpr int I_IN = 16 * 356, I_MM = 16 * 64, I_B = 16 * 32, I_L = 32, I_R = 2;
    constexpr int NITEMS = I_IN + I_MM + 4 * I_B + 2 * I_L + 32 * I_R;
    for (int it = gw; it < NITEMS; it += NGW) {
        int r = it;
        if (r < I_IN) { const int n0 = 32 * (r % 356); const int dst = n0 < 3072 ? n0 : (n0 < 3200 ? 11264 + n0 - 3072 : n0 - 128); transpose_item(p.in[I_WIN], 1024, 11392, WIN, dst - n0, scr, r, lane); continue; } r -= I_IN;
        if (r < I_MM) { transpose_item(p.in[I_WMEM], 1024, 2048, WIN + (size_t)11520 * 1024, 0, scr, r, lane); continue; } r -= I_MM;
        if (r < 3 * I_B) { const int br = r / I_B; const float* wa = opq(p.in[I_WBA]); const float* wb = opq(p.in[I_WBB]); const float* wc = opq(p.in[I_WBC]); transpose_item(br == 0 ? wa : (br == 1 ? wb : wc), 1024, 1024, (bf16*)(ws + WS_WBR) + (size_t)br * 1024 * 1024, 0, scr, r - br * I_B, lane); continue; } r -= 3 * I_B;
        if (r < I_B) { transpose_item(p.in[I_WOUT], 1024, 1024, (bf16*)(ws + WS_WOUT), 0, scr, r, lane); continue; } r -= I_B;
        if (r < I_L) { transpose_item(p.in[I_WDEC], 64, 1024, (bf16*)(ws + WS_WDEC), 0, scr, r, lane); continue; } r -= I_L;
        if (r < I_L) { transpose_item(p.in[I_WAAA], 64, 1024, (bf16*)(ws + WS_WAAA), 0, scr, r, lane); continue; } r -= I_L;
        { const int which = r / 32, rr = r % 32, g = rr >> 1, sub = rr & 1;
          const float* ra = opq(p.in[I_WRGA]); const float* rx = opq(p.in[I_WRGX]); transpose_item((which ? rx : ra) + g * 4096, 64, 64, (bf16*)(ws + (which ? WS_WRGX : WS_WRGA)) + g * 4096, 0, scr, sub, lane); }
    }
    if (blockIdx.x == 0) for (int i = tid; i < 8192; i += 512) ((unsigned*)(ws + WS_CTR))[i] = 0u;
    { u32x4* z = (u32x4*)(WIN + (size_t)11392 * 1024); const u32x4 zero = {0u, 0u, 0u, 0u}; for (int i = blockIdx.x * 512 + tid; i < 128 * 1024 / 8; i += G * 512) z[i] = zero; }
    bf16* XN = (bf16*)(ws + WS_XN);
    const float* pxp = opq(p.in[I_XP]); const float* pxs = opq(p.in[I_XS]); const float* pmem = opq(p.in[I_MEM]); const float* pgn = opq(p.in[I_GN]); const float* pgm = opq(p.in[I_GMEM]);
    for (int m0 = gw; m0 < NT + 2048; m0 += 2 * NGW) {
        const float* src[2]; const float* g[2]; bf16* dst[2]; f32x4 v[2][4]; float ss[2];
#pragma unroll
        for (int q = 0; q < 2; ++q) { int m = m0 + q * NGW; if (m >= NT + 2048) m = m0;
            if (m < NPT) { src[q] = pxp + (size_t)m * 1024; g[q] = pgn; } else if (m < NT) { src[q] = pxs + (size_t)(m - NPT) * 1024; g[q] = pgn; } else { src[q] = pmem + (size_t)(m - NT) * 1024; g[q] = pgm; }
            dst[q] = XN + (size_t)m * 1024; }
#pragma unroll
        for (int q = 0; q < 2; ++q) { const f32x4* xr = (const f32x4*)src[q] + lane; float s2 = 0.f;
#pragma unroll
            for (int j = 0; j < 4; ++j) { v[q][j] = xr[64 * j]; }
#pragma unroll
            for (int j = 0; j < 4; ++j) s2 += (v[q][j].x * v[q][j].x + v[q][j].y * v[q][j].y) + (v[q][j].z * v[q][j].z + v[q][j].w * v[q][j].w);
            ss[q] = s2; }
#pragma unroll
        for (int q = 0; q < 2; ++q) { const float rstd = rsqrtf(wave_sum(ss[q]) * (1.f / 1024.f) + 1e-6f); const f32x4* gr = (const f32x4*)g[q] + lane; unsigned long long* o8 = (unsigned long long*)dst[q] + lane;
#pragma unroll
            for (int j = 0; j < 4; ++j) { const f32x4 gg = gr[64 * j]; o8[64 * j] = (unsigned long long)pk2(v[q][j].x * rstd * gg.x, v[q][j].y * rstd * gg.y) | ((unsigned long long)pk2(v[q][j].z * rstd * gg.z, v[q][j].w * rstd * gg.w) << 32); } }
    }
}

__device__ __forceinline__ bf16x8 pack8(const float (&x)[8]) { u32x4 w; w.x = pk2(x[0], x[1]); w.y = pk2(x[2], x[3]); w.z = pk2(x[4], x[5]); w.w = pk2(x[6], x[7]); return __builtin_bit_cast(bf16x8, w); }
__device__ __forceinline__ void p2_lora(PREF p, int vb, int NB, int tid, int wave, int lane) {
    unsigned char* ws = p.ws;
    const float* XWA = (const float*)(ws + WS_XWA); const bf16* U = (const bf16*)(ws + WS_U); const bf16* XB = (const bf16*)(ws + WS_XB);
    const bf16* WDEC = (const bf16*)(ws + WS_WDEC); const bf16* WAAA = (const bf16*)(ws + WS_WAAA);
    bf16* E = (bf16*)p.out; bf16* A = E + ZSTRIDE;
    const float* mu = p.in[I_MU]; const float* w0 = p.in[I_W0]; const float* a0 = p.in[I_A0]; const float* ssh = p.in[I_SSH];
    const int trow = lane & 15, kg = lane >> 4;
    for (int item = vb * 8 + wave; item < NT / 16; item += NB * 8) {
        const int tok = item * 16 + trow; const bool prm = tok < NPT; const int s = prm ? (tok & 2047) : ((tok - NPT) & 7); const int bs = (tok - NPT) >> 3;
        bf16x8 Aw[2], Aa[2];
#pragma unroll
        for (int ks = 0; ks < 2; ++ks) { const int k0 = 32 * ks + 8 * kg; float xw[8], xa[8];
#pragma unroll
            for (int hlf = 0; hlf < 2; ++hlf) {
                const f32x4 cw = *(const f32x4*)(XWA + (size_t)tok * 128 + k0 + 4 * hlf), ca = *(const f32x4*)(XWA + (size_t)tok * 128 + 64 + k0 + 4 * hlf);
                f32x4 pw = {0.f, 0.f, 0.f, 0.f}, pa = {0.f, 0.f, 0.f, 0.f};
                if (s > 0) { pw = *(const f32x4*)(XWA + (size_t)(tok - 1) * 128 + k0 + 4 * hlf); pa = *(const f32x4*)(XWA + (size_t)(tok - 1) * 128 + 64 + k0 + 4 * hlf); }
                else if (!prm) { pw = *(const f32x4*)(ssh + (size_t)bs * 3200 + 3072 + k0 + 4 * hlf); pa = *(const f32x4*)(ssh + (size_t)bs * 3200 + 3136 + k0 + 4 * hlf); }
                const f32x4 mw = *(const f32x4*)(mu + 3072 + k0 + 4 * hlf), ma = *(const f32x4*)(mu + 3136 + k0 + 4 * hlf);
#pragma unroll
                for (int j = 0; j < 4; ++j) { const float xs = cw[j] + (pw[j] - cw[j]) * mw[j]; xw[4 * hlf + j] = 1.0f - 2.0f / (1.0f + __expf(2.0f * xs)); xa[4 * hlf + j] = ca[j] + (pa[j] - ca[j]) * ma[j]; }
            }
            Aw[ks] = pack8(xw); Aa[ks] = pack8(xa); }
        const size_t orow = (size_t)(item * 16 + trow) * 1024 + 4 * kg;
#pragma unroll 4
        for (int ct = 0; ct < 64; ++ct) { const int n = 16 * ct + trow;
            const bf16x8 bd0 = *(const bf16x8*)(WDEC + n * 64 + 8 * kg), bd1 = *(const bf16x8*)(WDEC + n * 64 + 32 + 8 * kg), ba0 = *(const bf16x8*)(WAAA + n * 64 + 8 * kg), ba1 = *(const bf16x8*)(WAAA + n * 64 + 32 + 8 * kg);
            f32x4 ad = {0.f, 0.f, 0.f, 0.f}, aa = {0.f, 0.f, 0.f, 0.f};
            ad = __builtin_amdgcn_mfma_f32_16x16x32_bf16(bd0, Aw[0], ad, 0, 0, 0); ad = __builtin_amdgcn_mfma_f32_16x16x32_bf16(bd1, Aw[1], ad, 0, 0, 0);
            aa = __builtin_amdgcn_mfma_f32_16x16x32_bf16(ba0, Aa[0], aa, 0, 0, 0); aa = __builtin_amdgcn_mfma_f32_16x16x32_bf16(ba1, Aa[1], aa, 0, 0, 0);
            const f32x4 w0v = *(const f32x4*)(w0 + 16 * ct + 4 * kg), a0v = *(const f32x4*)(a0 + 16 * ct + 4 * kg);
            u32x2 ev, av; ev.x = pk2(0.60653066f * sigm(w0v[0] + ad[0]), 0.60653066f * sigm(w0v[1] + ad[1])); ev.y = pk2(0.60653066f * sigm(w0v[2] + ad[2]), 0.60653066f * sigm(w0v[3] + ad[3]));
            av.x = pk2(sigm(a0v[0] + aa[0]), sigm(a0v[1] + aa[1])); av.y = pk2(sigm(a0v[2] + aa[2]), sigm(a0v[3] + aa[3]));
            *(u32x2*)(E + orow + 16 * ct) = ev; *(u32x2*)(A + orow + 16 * ct) = av; }
    }
    float* out = p.out; const int gt = vb * 512 + tid, ngt = NB * 512;
    for (int i = gt; i < 136 * 3200; i += ngt) { const int b = i / 3200, c = i - b * 3200; const int tok = b < 8 ? b * 2048 + 2047 : NPT + (b - 8) * 8 + 7;
        const float v = c < 3072 ? bf2f(U[(size_t)tok * 3072 + c]) : XWA[(size_t)tok * 128 + c - 3072];
        out[(b < 8 ? O_SHP + (size_t)b * 3200 : O_SHS + (size_t)(b - 8) * 3200) + c] = v; }
    for (int i = gt; i < 136 * 3072; i += ngt) { const int b = i / 3072, r = i - b * 3072, j = r >> 10, c = r & 1023; const int tok = b < 8 ? b * 2048 + 2045 + j : NPT + (b - 8) * 8 + 5 + j;
        out[(b < 8 ? O_CVP + (size_t)b * 3072 : O_CVS + (size_t)(b - 8) * 3072) + r] = bf2f(XB[(size_t)tok * 1024 + c]); }
}

constexpr int CH = 32;
constexpr int BUF_F = 6 * CH * 64;
constexpr int RW_LDS_OST = 2 * BUF_F * 4;
constexpr int OST_F = CH * 128;
struct Seg { int tok0, h, half; bool first, last; const float* S0; float* Sout; const float* shift0; };
__device__ __forceinline__ Seg get_seg(const float* srw, const float* ssh, float* out, int mode, int it0, int c, int j) {
    Seg g;
    if (mode == 0) { const int b = it0 >> 5; g.h = (it0 >> 1) & 15; g.half = it0 & 1; g.tok0 = b * 2048 + CH * c + 8 * j; g.first = (c == 0 && j == 0); g.last = (c == 2048 / CH - 1 && j == 3);
        g.S0 = nullptr; g.shift0 = nullptr; g.Sout = out + O_RWP + (size_t)(b * 16 + g.h) * 4096; }
    else { const int it = it0 + 4 * c + j, b = it >> 5; g.h = (it >> 1) & 15; g.half = it & 1; g.tok0 = NPT + b * 8; g.first = true; g.last = true;
        g.S0 = srw + (size_t)(b * 16 + g.h) * 4096; g.shift0 = ssh + (size_t)b * 3200; g.Sout = out + O_RWS + (size_t)(b * 16 + g.h) * 4096; }
    return g;
}
__device__ __forceinline__ void rwkv_prep(PREF p, LAS float* buf, const Seg g, int lw, int lane) {
    unsigned char* ws = p.ws;
    const bf16* U = (const bf16*)(ws + WS_U); const bf16* E = (const bf16*)p.out; const bf16* A = E + ZSTRIDE; float* BON = (float*)(ws + WS_BONUS);
    const int C = g.h * 64 + lane;
    const float mur = p.in[I_MU][C], muk = p.in[I_MU][1024 + C], muv = p.in[I_MU][2048 + C], kkc = p.in[I_KK][C], kac = p.in[I_KA][C], rkc = p.in[I_RK][C];
    float pr = 0.f, pk = 0.f, pv = 0.f;
    if (g.first) { if (g.shift0) { pr = g.shift0[C]; pk = g.shift0[1024 + C]; pv = g.shift0[2048 + C]; } }
    else { const bf16* up = U + (size_t)(g.tok0 - 1) * 3072 + C; pr = bf2f(up[0]); pk = bf2f(up[1024]); pv = bf2f(up[2048]); }
    bf16 ur[8], uk[8], uv[8], ee[8], aa[8];
#pragma unroll
    for (int i = 0; i < 8; ++i) { const size_t tok = (size_t)(g.tok0 + i); const bf16* up = U + tok * 3072 + C; ur[i] = up[0]; uk[i] = up[1024]; uv[i] = up[2048]; ee[i] = E[tok * 1024 + C]; aa[i] = A[tok * 1024 + C]; }
    float r8[8], kr8[8], kp8[8], v8[8], a8[8], dc8[8], xs[8], ys[8];
#pragma unroll
    for (int i = 0; i < 8; ++i) {
        const float fr = bf2f(ur[i]), fk = bf2f(uk[i]), fv = bf2f(uv[i]), e = bf2f(ee[i]), a = bf2f(aa[i]);
        const float r = fr + (pr - fr) * mur, k = fk + (pk - fk) * muk, v = fv + (pv - fv) * muv; pr = fr; pk = fk; pv = fv;
        const float kr = k * kkc, kp = k * (1.0f + (a - 1.0f) * kac);
        r8[i] = r; kr8[i] = kr; kp8[i] = kp; v8[i] = v; a8[i] = a; dc8[i] = __expf(-e); xs[i] = kr * kr; ys[i] = r * kp * rkc; }
    const bool b0 = (lane & 1) != 0, b1 = (lane & 2) != 0, b2 = (lane & 4) != 0, b3 = (lane & 8) != 0;
    float w8[8], u4[4], p2[2], f;
#pragma unroll
    for (int j = 0; j < 8; ++j) { const float keep = b0 ? ys[j] : xs[j], send = b0 ? xs[j] : ys[j]; w8[j] = keep + dppf<0xB1>(send); }
#pragma unroll
    for (int j = 0; j < 4; ++j) { const float keep = b1 ? w8[2 * j + 1] : w8[2 * j], send = b1 ? w8[2 * j] : w8[2 * j + 1]; u4[j] = keep + dppf<0x4E>(send); }
#pragma unroll
    for (int j = 0; j < 2; ++j) { const float keep = b2 ? u4[2 * j + 1] : u4[2 * j], send = b2 ? u4[2 * j] : u4[2 * j + 1];
        const int si = __builtin_bit_cast(int, send); int t = __builtin_amdgcn_update_dpp(si, si, 0x104, 0xF, 0x5, false); t = __builtin_amdgcn_update_dpp(t, si, 0x114, 0xF, 0xA, false);
        p2[j] = keep + __builtin_bit_cast(float, t); }
    { const float keep = b3 ? p2[1] : p2[0], send = b3 ? p2[0] : p2[1]; f = keep + dppf<0x128>(send); }
    f += __shfl_xor(f, 16); f += __shfl_xor(f, 32);
#pragma unroll
    for (int i = 0; i < 8; ++i) {
        const int s = 8 * lw + i; const float ss = rdl(f, 2 * i); const float kk = kr8[i] * __builtin_amdgcn_rsqf(ss + 1e-12f);
        LAS float* bp = buf + s * 64 + lane;
        bp[0] = dc8[i]; bp[CH * 64] = kk * a8[i]; bp[2 * CH * 64] = kp8[i]; bp[3 * CH * 64] = kk; bp[4 * CH * 64] = r8[i]; bp[5 * CH * 64] = v8[i]; }
    if (g.half == 0 && lane < 16 && b0) BON[(size_t)(g.tok0 + (lane >> 1)) * 16 + g.h] = f;
}
__device__ __forceinline__ void rwkv_oout(PREF p, const LAS float* ost, const Seg g, int ltid) {
    unsigned char* ws = p.ws; bf16* ORAW = (bf16*)(ws + WS_ORAW); float* ST = (float*)(ws + WS_STATS);
    const int s = ltid >> 3, q = ltid & 7;
    f32x4 o; { const LAS f32x4* pp = (const LAS f32x4*)(ost + s * 128 + q * 16);
      const f32x4 a0 = pp[0], a1 = pp[1], b0 = pp[2], b1 = pp[3]; o.x = (a0.x + a0.z) + (a1.x + a1.z); o.y = (a0.y + a0.w) + (a1.y + a1.w); o.z = (b0.x + b0.z) + (b1.x + b1.z); o.w = (b0.y + b0.w) + (b1.y + b1.w); }
    float sm = (o.x + o.y) + (o.z + o.w), sq = (o.x * o.x + o.y * o.y) + (o.z * o.z + o.w * o.w);
    sm += dppf<0xB1>(sm); sq += dppf<0xB1>(sq); sm += dppf<0x4E>(sm); sq += dppf<0x4E>(sq); sm += dppf<0x141>(sm); sq += dppf<0x141>(sq);
    const size_t tok = (size_t)(g.tok0 + (s & 7)); u32x2 w; w.x = pk2(o.x, o.y); w.y = pk2(o.z, o.w); *(u32x2*)(ORAW + tok * 1024 + g.h * 64 + 32 * g.half + 4 * q) = w;
    if (q == 0) *(f32x2*)(ST + ((tok * 16 + g.h) * 2 + g.half) * 2) = (f32x2){sm, sq};
}
struct ScanOps { f32x4 w4, b4, k4, kk4, r4; f32x2 v2; };
__device__ __forceinline__ ScanOps scan_load(const LAS float* buf, int s, int kl, int voff) { ScanOps o; const LAS float* bp = buf + s * 64 + 4 * kl;
    o.w4 = *(const LAS f32x4*)bp; o.b4 = *(const LAS f32x4*)(bp + CH * 64); o.k4 = *(const LAS f32x4*)(bp + 2 * CH * 64); o.kk4 = *(const LAS f32x4*)(bp + 3 * CH * 64); o.r4 = *(const LAS f32x4*)(bp + 4 * CH * 64);
    o.v2 = *(const LAS f32x2*)(buf + 5 * CH * 64 + s * 64 + voff); return o; }
__device__ __forceinline__ void rwkv_run(PREF p, LAS unsigned char* lds, int tid, int wave, int lane, int mode, int it0, int nch) {
    LAS float* bufs = (LAS float*)lds; LAS float* osts = (LAS float*)(lds + RW_LDS_OST);
    const float* srw = p.in[I_SRW]; const float* ssh = p.in[I_SSH]; float* out = p.out;
    const bool scan = wave < 4; const int rl = lane >> 4, kl = lane & 15, roff = 8 * wave + 2 * rl;
    f32x4 Sa = {0.f, 0.f, 0.f, 0.f}, Sb = Sa; f32x4 Na[4], Nb[4], Ma[4], Mb[4];
#pragma unroll
    for (int j = 0; j < 4; ++j) { Na[j] = Sa; Nb[j] = Sa; Ma[j] = Sa; Mb[j] = Sa; }
    if (scan) {
#pragma unroll
        for (int j = 0; j < 4; ++j) { const Seg g = get_seg(srw, ssh, out, mode, it0, 0, j); if (g.S0) { const int row = 32 * g.half + roff; Na[j] = *(const f32x4*)(g.S0 + row * 64 + 4 * kl); Nb[j] = *(const f32x4*)(g.S0 + (row + 1) * 64 + 4 * kl); } } }
    else rwkv_prep(p, bufs, get_seg(srw, ssh, out, mode, it0, 0, wave - 4), wave - 4, lane);
    __syncthreads();
    for (int c = 0; c < nch; ++c) {
        if (scan) {
            const LAS float* buf = bufs + (c & 1) * BUF_F; LAS float* ost = osts + (c & 1) * OST_F;
            ScanOps cur = scan_load(buf, 0, kl, 32 * get_seg(srw, ssh, out, mode, it0, c, 0).half + roff);
            if (c + 1 < nch) {
#pragma unroll
                for (int j = 0; j < 4; ++j) { const Seg n = get_seg(srw, ssh, out, mode, it0, c + 1, j); if (n.S0) { const int row = 32 * n.half + roff; Ma[j] = *(const f32x4*)(n.S0 + row * 64 + 4 * kl); Mb[j] = *(const f32x4*)(n.S0 + (row + 1) * 64 + 4 * kl); } } }
#pragma unroll
            for (int j = 0; j < 4; ++j) {
                const Seg g = get_seg(srw, ssh, out, mode, it0, c, j);
                if (g.first) { Sa = Na[j]; Sb = Nb[j]; }
                const int nh = get_seg(srw, ssh, out, mode, it0, c, j < 3 ? j + 1 : j).half;
#pragma unroll
                for (int i = 0; i < 8; ++i) {
                    const int s = 8 * j + i;
                    const int sn = s + 1 < CH ? s + 1 : s; const ScanOps nxt = scan_load(buf, sn, kl, 32 * (i == 7 && j < 3 ? nh : g.half) + roff);
                    const f32x2 kkL = __builtin_shufflevector(cur.kk4, cur.kk4, 0, 1), kkH = __builtin_shufflevector(cur.kk4, cur.kk4, 2, 3), wL = __builtin_shufflevector(cur.w4, cur.w4, 0, 1), wH = __builtin_shufflevector(cur.w4, cur.w4, 2, 3);
                    const f32x2 bL = __builtin_shufflevector(cur.b4, cur.b4, 0, 1), bH = __builtin_shufflevector(cur.b4, cur.b4, 2, 3), kL = __builtin_shufflevector(cur.k4, cur.k4, 0, 1), kH = __builtin_shufflevector(cur.k4, cur.k4, 2, 3);
                    const f32x2 rL = __builtin_shufflevector(cur.r4, cur.r4, 0, 1), rH = __builtin_shufflevector(cur.r4, cur.r4, 2, 3);
                    f32x2 SaL = __builtin_shufflevector(Sa, Sa, 0, 1), SaH = __builtin_shufflevector(Sa, Sa, 2, 3), SbL = __builtin_shufflevector(Sb, Sb, 0, 1), SbH = __builtin_shufflevector(Sb, Sb, 2, 3);
                    f32x2 ta = SaL * kkL; ta = __builtin_elementwise_fma(SaH, kkH, ta); f32x2 tb = SbL * kkL; tb = __builtin_elementwise_fma(SbH, kkH, tb);
                    float sa0 = ta.x + ta.y, sa1 = tb.x + tb.y;
                    sa0 += dppf<0xB1>(sa0); sa1 += dppf<0xB1>(sa1); sa0 += dppf<0x4E>(sa0); sa1 += dppf<0x4E>(sa1); sa0 += dppf<0x141>(sa0); sa1 += dppf<0x141>(sa1); sa0 += dppf<0x140>(sa0); sa1 += dppf<0x140>(sa1);
                    const f32x2 na = {-sa0, -sa0}, nb = {-sa1, -sa1}, va = {cur.v2.x, cur.v2.x}, vb = {cur.v2.y, cur.v2.y};
                    SaL = __builtin_elementwise_fma(va, kL, __builtin_elementwise_fma(na, bL, SaL * wL)); SaH = __builtin_elementwise_fma(va, kH, __builtin_elementwise_fma(na, bH, SaH * wH));
                    SbL = __builtin_elementwise_fma(vb, kL, __builtin_elementwise_fma(nb, bL, SbL * wL)); SbH = __builtin_elementwise_fma(vb, kH, __builtin_elementwise_fma(nb, bH, SbH * wH));
                    Sa = __builtin_shufflevector(SaL, SaH, 0, 1, 2, 3); Sb = __builtin_shufflevector(SbL, SbH, 0, 1, 2, 3);
                    f32x2 oa = SaL * rL; oa = __builtin_elementwise_fma(SaH, rH, oa); f32x2 ob = SbL * rL; ob = __builtin_elementwise_fma(SbH, rH, ob);
                    float o0 = oa.x + oa.y, o1 = ob.x + ob.y;
                    asm volatile("" : "+v"(o0), "+v"(o1));
                    o0 += dppf<0xB1>(o0); o1 += dppf<0xB1>(o1); o0 += dppf<0x4E>(o0); o1 += dppf<0x4E>(o1);
                    if ((kl & 3) == 0) *(LAS f32x2*)(ost + s * 128 + roff * 4 + (kl >> 2) * 2) = (f32x2){o0, o1};
                    cur = nxt;
                }
                if (g.last) { const int row = 32 * g.half + roff; *(f32x4*)(g.Sout + row * 64 + 4 * kl) = Sa; *(f32x4*)(g.Sout + (row + 1) * 64 + 4 * kl) = Sb; }
            }
#pragma unroll
            for (int j = 0; j < 4; ++j) { Na[j] = Ma[j]; Nb[j] = Mb[j]; }
        } else {
            if (c + 1 < nch) rwkv_prep(p, bufs + ((c + 1) & 1) * BUF_F, get_seg(srw, ssh, out, mode, it0, c + 1, wave - 4), wave - 4, lane);
            if (c >= 1) rwkv_oout(p, osts + ((c - 1) & 1) * OST_F, get_seg(srw, ssh, out, mode, it0, c - 1, (tid - 256) >> 6), tid - 256);
        }
        __syncthreads();
    }
    if (!scan) rwkv_oout(p, osts + ((nch - 1) & 1) * OST_F, get_seg(srw, ssh, out, mode, it0, nch - 1, (tid - 256) >> 6), tid - 256);
    __syncthreads();
}

__device__ __forceinline__ void rglru_item(PREF p, LAS unsigned char* lds, int tid, int wave, int lane, int mode, int item, bool st) {
    unsigned char* ws = p.ws; const bf16* XB = (const bf16*)(ws + WS_XB); bf16* ZB = (bf16*)(ws + WS_Z) + ZSTRIDE;
    LAS float* XC = (LAS float*)lds; LAS float* GR = XC + 64 * 65; LAS float* GI = GR + 64 * 65; LAS bf16* XCB = (LAS bf16*)(GI + 64 * 65); LAS float* TOT = (LAS float*)(XCB + 64 * 72); LAS float* HC = TOT + 1024;
    const int c = tid & 63, sg = tid >> 6;
    const int g = mode ? (item >> 4) : (item & 15), bb = mode ? (8 * (item & 15) + sg) : (item >> 4), C = g * 64 + c;
    const int nchunk = mode ? 1 : 32; const int rowtok = mode ? (NPT + bb * 8) : (bb * 2048 + 8 * sg);
    const float cw0 = p.in[I_CW][C], cw1 = p.in[I_CW][1024 + C], cw2 = p.in[I_CW][2048 + C], cw3 = p.in[I_CW][3072 + C], cb = p.in[I_CB][C];
    const float sp = log1pf(__expf(-p.in[I_LAM][C]));
    const bf16* WT = (const bf16*)(ws + (wave >= 4 ? WS_WRGX : WS_WRGA)) + g * 4096; const float* bra = opq(p.in[I_BRGA]); const float* brx = opq(p.in[I_BRGX]); const float* bias = (wave >= 4 ? brx : bra) + g * 64;
    const int trow = lane & 15, kg = lane >> 4, tt = wave & 3;
    bf16x8 wb0[4], wb1[4]; float bn[4];
#pragma unroll
    for (int ct = 0; ct < 4; ++ct) { const int n = 16 * ct + trow; wb0[ct] = *(const bf16x8*)(WT + n * 64 + 8 * kg); wb1[ct] = *(const bf16x8*)(WT + n * 64 + 32 + 8 * kg); bn[ct] = bias[n]; }
    float hin = 0.f; float e0 = 0.f, e1 = 0.f, e2 = 0.f;
    if (mode) { hin = p.in[I_SLRU][(size_t)bb * 1024 + C]; const float* cv = p.in[I_SCV] + (size_t)bb * 3072 + C; e0 = cv[0]; e1 = cv[1024]; e2 = cv[2048]; }
    else { if (tid < 64) HC[c] = 0.f; if (sg > 0) { const bf16* xp = XB + (size_t)(rowtok - 3) * 1024 + C; e0 = bf2f(xp[0]); e1 = bf2f(xp[1024]); e2 = bf2f(xp[2048]); } }
    bf16 xn[8], zn[8];
#pragma unroll
    for (int i = 0; i < 8; ++i) { xn[i] = XB[(size_t)(rowtok + i) * 1024 + C]; zn[i] = ZB[(size_t)(rowtok + i) * 1024 + C]; }
    for (int k = 0; k < nchunk; ++k) {
        const int tok = rowtok + 64 * k;
        float zb[8];
#pragma unroll
        for (int i = 0; i < 8; ++i) { const float e3 = bf2f(xn[i]); zb[i] = bf2f(zn[i]); const float xc = cb + e0 * cw0 + e1 * cw1 + e2 * cw2 + e3 * cw3;
            XC[(sg * 8 + i) * 65 + c] = xc; XCB[(sg * 8 + i) * 72 + c] = (bf16)f2bf(xc); e0 = e1; e1 = e2; e2 = e3; }
        if (k + 1 < nchunk) {
            const bf16* xp = XB + (size_t)(tok + 64 - 3) * 1024 + C; e0 = bf2f(xp[0]); e1 = bf2f(xp[1024]); e2 = bf2f(xp[2048]);
#pragma unroll
            for (int i = 0; i < 8; ++i) { xn[i] = XB[(size_t)(tok + 64 + i) * 1024 + C]; zn[i] = ZB[(size_t)(tok + 64 + i) * 1024 + C]; } }
        __syncthreads();
        { LAS float* GO = wave >= 4 ? GI : GR;
          const bf16x8 a0 = *(const LAS bf16x8*)(XCB + (16 * tt + trow) * 72 + 8 * kg), a1 = *(const LAS bf16x8*)(XCB + (16 * tt + trow) * 72 + 32 + 8 * kg);
#pragma unroll
          for (int ct = 0; ct < 4; ++ct) { const int n = 16 * ct + trow;
              f32x4 acc = {0.f, 0.f, 0.f, 0.f}; acc = __builtin_amdgcn_mfma_f32_16x16x32_bf16(a0, wb0[ct], acc, 0, 0, 0); acc = __builtin_amdgcn_mfma_f32_16x16x32_bf16(a1, wb1[ct], acc, 0, 0, 0);
#pragma unroll
              for (int r = 0; r < 4; ++r) GO[(16 * tt + 4 * kg + r) * 65 + n] = sigm(acc[r] + bn[ct]); } }
        __syncthreads();
        float hl[8], cm[8]; { float h = 0.f, cum = 1.f;
#pragma unroll
          for (int i = 0; i < 8; ++i) { const int s = sg * 8 + i; const float gr = GR[s * 65 + c], gi = GI[s * 65 + c], xc = XC[s * 65 + c];
              const float la = -8.0f * gr * sp, x2 = 2.0f * la;
              const float om = -x2 * (1.0f + x2 * 0.5f * (1.0f + x2 * (1.0f / 3.0f) * (1.0f + x2 * 0.25f * (1.0f + x2 * 0.2f * (1.0f + x2 * (1.0f / 6.0f) * (1.0f + x2 * (1.0f / 7.0f)))))));
              const float a = __expf(la), b = sqrtf(om) * gi * xc;
              h = a * h + b; cum *= a; hl[i] = h; cm[i] = cum; }
          if (!mode) { TOT[sg * 64 + c] = cum; TOT[512 + sg * 64 + c] = h; } }
        if (!mode) __syncthreads();
        { float h = hin;
          if (!mode) { h = HC[(k & 1) * 64 + c]; for (int j = 0; j < sg; ++j) h = TOT[j * 64 + c] * h + TOT[512 + j * 64 + c]; }
          if (st) {
#pragma unroll
              for (int i = 0; i < 8; ++i) ZB[(size_t)(tok + i) * 1024 + C] = (bf16)f2bf((hl[i] + cm[i] * h) * zb[i]); }
          const float hn = hl[7] + cm[7] * h;
          if (mode) p.out[O_LRS + (size_t)bb * 1024 + C] = hn;
          else if (sg == 7) { HC[((k + 1) & 1) * 64 + c] = hn; if (k == nchunk - 1) p.out[O_LRP + (size_t)bb * 1024 + C] = hn; } }
    }
    __syncthreads();
}

constexpr int XA_STG = 128 * 528, XA_PL = 8448;
__device__ __forceinline__ void xa_stage(LAS unsigned char* lds, const bf16* src, size_t ld, int tid) {
#pragma unroll
    for (int i = 0; i < 8; ++i) { const int e = tid + 512 * i, row = e >> 5, seg = e & 31; *(LAS u32x4*)(lds + row * 528 + seg * 16) = *(const u32x4*)(src + (size_t)row * ld + seg * 8); }
}
__device__ __forceinline__ void xattn_prompt_item(PREF p, LAS unsigned char* lds, int tid, int wave, int lane, int item, bool st) {
    unsigned char* ws = p.ws; const bf16* Q = (const bf16*)(ws + WS_Q); const bf16* MK = (const bf16*)(ws + WS_MK); const bf16* MVT = (const bf16*)(ws + WS_MVT); bf16* ZC = (bf16*)(ws + WS_Z) + 2 * ZSTRIDE;
    LAS bf16* PL = (LAS bf16*)(lds + XA_STG + wave * XA_PL);
    const int qb = item & 15, head = (item >> 4) & 3, b = item >> 6, tok0 = b * 2048 + 128 * qb + 16 * wave, trow = lane & 15, kg = lane >> 4;
    bf16x8 qf[8];
#pragma unroll
    for (int ks = 0; ks < 8; ++ks) qf[ks] = *(const bf16x8*)(Q + (size_t)(tok0 + trow) * 1024 + head * 256 + 32 * ks + 8 * kg);
    f32x4 S[16];
#pragma unroll
    for (int hk = 0; hk < 2; ++hk) {
        __syncthreads();
        xa_stage(lds, MK + (size_t)(b * 256 + 128 * hk) * 1024 + head * 256, 1024, tid);
        __syncthreads();
#pragma unroll
        for (int mt = 0; mt < 8; ++mt) { f32x4 acc = {0.f, 0.f, 0.f, 0.f}; const LAS unsigned char* kp = lds + (16 * mt + trow) * 528 + kg * 16;
#pragma unroll
            for (int ks = 0; ks < 8; ++ks) acc = __builtin_amdgcn_mfma_f32_16x16x32_bf16(qf[ks], *(const LAS bf16x8*)(kp + ks * 64), acc, 0, 0, 0);
            S[8 * hk + mt] = acc; }
    }
    f32x4 mx = S[0];
#pragma unroll
    for (int mt = 1; mt < 16; ++mt) { mx.x = fmaxf(mx.x, S[mt].x); mx.y = fmaxf(mx.y, S[mt].y); mx.z = fmaxf(mx.z, S[mt].z); mx.w = fmaxf(mx.w, S[mt].w); }
    mx.x = row16_max(mx.x); mx.y = row16_max(mx.y); mx.z = row16_max(mx.z); mx.w = row16_max(mx.w);
    f32x4 sm = {0.f, 0.f, 0.f, 0.f};
#pragma unroll
    for (int mt = 0; mt < 16; ++mt) { f32x4 e; e.x = __expf((S[mt].x - mx.x) * 0.0625f); e.y = __expf((S[mt].y - mx.y) * 0.0625f); e.z = __expf((S[mt].z - mx.z) * 0.0625f); e.w = __expf((S[mt].w - mx.w) * 0.0625f);
        sm += e; const int col = 16 * mt + trow;
        PL[(4 * kg + 0) * 264 + col] = (bf16)f2bf(e.x); PL[(4 * kg + 1) * 264 + col] = (bf16)f2bf(e.y); PL[(4 * kg + 2) * 264 + col] = (bf16)f2bf(e.z); PL[(4 * kg + 3) * 264 + col] = (bf16)f2bf(e.w); }
    sm.x = row16_sum(sm.x); sm.y = row16_sum(sm.y); sm.z = row16_sum(sm.z); sm.w = row16_sum(sm.w);
    const f32x4 inv = {1.0f / sm.x, 1.0f / sm.y, 1.0f / sm.z, 1.0f / sm.w};
    LDS_WAIT();
    bf16x8 pf[8];
#pragma unroll
    for (int ks = 0; ks < 8; ++ks) pf[ks] = *(const LAS bf16x8*)(PL + trow * 264 + 32 * ks + 8 * kg);
#pragma unroll
    for (int hv = 0; hv < 2; ++hv) {
        __syncthreads();
        xa_stage(lds, MVT + ((size_t)((b * 4 + head) * 256 + 128 * hv)) * 256, 256, tid);
        __syncthreads();
#pragma unroll
        for (int dt = 0; dt < 8; ++dt) { f32x4 acc = {0.f, 0.f, 0.f, 0.f}; const LAS unsigned char* vp = lds + (16 * dt + trow) * 528 + kg * 16;
#pragma unroll
            for (int ks = 0; ks < 8; ++ks) acc = __builtin_amdgcn_mfma_f32_16x16x32_bf16(pf[ks], *(const LAS bf16x8*)(vp + ks * 64), acc, 0, 0, 0);
            acc = acc * inv; const int col = head * 256 + 128 * hv + 16 * dt + trow;
#pragma unroll
            for (int r = 0; r < 4; ++r) { bf16* zp = ZC + (size_t)(tok0 + 4 * kg + r) * 1024 + col; const bf16 nv = (bf16)f2bf(acc[r] * bf2f(*zp)); if (st) *zp = nv; } }
    }
    __syncthreads();
}

__device__ __forceinline__ void xattn_sample_item(PREF p, LAS unsigned char* lds, int tid, int wave, int lane, int item, bool st) {
    unsigned char* ws = p.ws; const bf16* Q = (const bf16*)(ws + WS_Q); bf16* ZC = (bf16*)(ws + WS_Z) + 2 * ZSTRIDE;
    LAS float* QS = (LAS float*)lds; LAS float* SC = QS + 2048; LAS float* PART = SC + 2048;
    const int b = item >> 2, head = item & 3, tok0 = NPT + b * 8;
    for (int i = tid; i < 2048; i += 512) QS[i] = bf2f(Q[(size_t)(tok0 + (i >> 8)) * 1024 + head * 256 + (i & 255)]);
    __syncthreads();
    const float* Vc = p.in[I_CV] + ((size_t)b * 256 * 4 + head) * 256 + 4 * lane;
    { const int kl = lane & 15, rq = lane >> 4; const float* Kc = p.in[I_CK] + ((size_t)b * 256 * 4 + head) * 256 + 4 * kl;
      f32x4 q[8][4];
#pragma unroll
      for (int i = 0; i < 8; ++i)
#pragma unroll
          for (int j = 0; j < 4; ++j) q[i][j] = *(const LAS f32x4*)(QS + i * 256 + 64 * j + 4 * kl);
#pragma unroll 2
      for (int r = 0; r < 8; ++r) { const int m = 32 * wave + 4 * r + rq; const f32x4* kp = (const f32x4*)(Kc + (size_t)m * 1024);
          const f32x4 k0 = kp[0], k1 = kp[16], k2 = kp[32], k3 = kp[48];
#pragma unroll
          for (int i = 0; i < 8; ++i) { f32x4 t = q[i][0] * k0 + q[i][1] * k1 + q[i][2] * k2 + q[i][3] * k3; float d = row16_sum((t.x + t.y) + (t.z + t.w));
              if (kl == i) SC[i * 256 + m] = d * 0.0625f; } } }
    __syncthreads();
    { float v[4]; float mx = -3.0e38f;
#pragma unroll
      for (int j = 0; j < 4; ++j) { v[j] = SC[wave * 256 + lane + 64 * j]; mx = fmaxf(mx, v[j]); }
      mx = wave_max(mx); float sm = 0.f;
#pragma unroll
      for (int j = 0; j < 4; ++j) { v[j] = __expf(v[j] - mx); sm += v[j]; }
      sm = wave_sum(sm); const float inv = 1.0f / sm;
#pragma unroll
      for (int j = 0; j < 4; ++j) SC[wave * 256 + lane + 64 * j] = v[j] * inv; }
    __syncthreads();
    { f32x4 acc[8];
#pragma unroll
      for (int i = 0; i < 8; ++i) acc[i] = (f32x4){0.f, 0.f, 0.f, 0.f};
#pragma unroll 8
      for (int r = 0; r < 32; ++r) { const int m = 32 * wave + r; const f32x4 vv = *(const f32x4*)(Vc + (size_t)m * 1024);
#pragma unroll
          for (int i = 0; i < 8; ++i) acc[i] += SC[i * 256 + m] * vv; }
#pragma unroll
      for (int i = 0; i < 8; ++i) *(LAS f32x4*)(PART + (wave * 8 + i) * 256 + 4 * lane) = acc[i]; }
    __syncthreads();
    { const int q = tid >> 6, d = 4 * (tid & 63); f32x4 s = {0.f, 0.f, 0.f, 0.f};
#pragma unroll
      for (int w = 0; w < 8; ++w) s += *(const LAS f32x4*)(PART + (w * 8 + q) * 256 + d);
      u32x2* zp = (u32x2*)(ZC + (size_t)(tok0 + q) * 1024 + head * 256 + d); const u32x2 z = *zp;
      u32x2 o; o.x = pk2(s.x * bflo(z.x), s.y * bfhi(z.x)); o.y = pk2(s.z * bflo(z.y), s.w * bfhi(z.y)); if (st) *zp = o; }
    __syncthreads();
}

__device__ __forceinline__ void p4_post(PREF p, int tid, int G, bool stw) {
    unsigned char* ws = p.ws; const bf16* ORAW = (const bf16*)(ws + WS_ORAW); const bf16* U = (const bf16*)(ws + WS_U); bf16* ZA = (bf16*)(ws + WS_Z);
    const float* ST = (const float*)(ws + WS_STATS); const float* BON = (const float*)(ws + WS_BONUS);
    const float* muv = p.in[I_MU] + 2048; const float* gng = p.in[I_GNG]; const float* gnb = p.in[I_GNB]; const float* ssh = p.in[I_SSH];
    for (int i = blockIdx.x * 512 + tid; i < NT * 128; i += G * 512) {
        const int tok = i >> 7, c0 = (i & 127) * 8, h = c0 >> 6; const bool prm = tok < NPT; const int s = prm ? (tok & 2047) : ((tok - NPT) & 7); const int bs = (tok - NPT) >> 3;
        const f32x4 st = *(const f32x4*)(ST + ((size_t)tok * 16 + h) * 4);
        const float mean = (st.x + st.z) * (1.f / 64.f), var = (st.y + st.w) * (1.f / 64.f) - mean * mean, rstd = rsqrtf(fmaxf(var, 0.f) + 64e-5f), bon = BON[(size_t)tok * 16 + h];
        const u32x4 o = *(const u32x4*)(ORAW + (size_t)tok * 1024 + c0), z = *(const u32x4*)(ZA + (size_t)tok * 1024 + c0), vc = *(const u32x4*)(U + (size_t)tok * 3072 + 2048 + c0);
        float pv[8];
        if (s > 0) { const u32x4 vp = *(const u32x4*)(U + (size_t)(tok - 1) * 3072 + 2048 + c0); pv[0] = bflo(vp.x); pv[1] = bfhi(vp.x); pv[2] = bflo(vp.y); pv[3] = bfhi(vp.y); pv[4] = bflo(vp.z); pv[5] = bfhi(vp.z); pv[6] = bflo(vp.w); pv[7] = bfhi(vp.w); }
        else if (!prm) {
#pragma unroll
            for (int j = 0; j < 8; ++j) pv[j] = ssh[(size_t)bs * 3200 + 2048 + c0 + j]; }
        else {
#pragma unroll
            for (int j = 0; j < 8; ++j) pv[j] = 0.f; }
        const unsigned ow[4] = {o.x, o.y, o.z, o.w}, zw[4] = {z.x, z.y, z.z, z.w}, vw[4] = {vc.x, vc.y, vc.z, vc.w}; unsigned rw[4];
#pragma unroll
        for (int j = 0; j < 4; ++j) { float r2[2];
#pragma unroll
            for (int e = 0; e < 2; ++e) { const int c = c0 + 2 * j + e; const float ov = e ? bfhi(ow[j]) : bflo(ow[j]), zv = e ? bfhi(zw[j]) : bflo(zw[j]), uv = e ? bfhi(vw[j]) : bflo(vw[j]);
                const float v = uv + (pv[2 * j + e] - uv) * muv[c]; r2[e] = ((ov - mean) * rstd * gng[c] + gnb[c] + bon * v) * zv; }
            rw[j] = pk2(r2[0], r2[1]); }
        if (stw) *(u32x4*)(ZA + (size_t)tok * 1024 + c0) = (u32x4){rw[0], rw[1], rw[2], rw[3]};
    }
}
__device__ __forceinline__ void p5_sum(PREF p, int tid, int G) {
    unsigned char* ws = p.ws; const float* P = (const float*)(ws + WS_P); const bf16* Gt = (const bf16*)(ws + WS_G); bf16* M = (bf16*)(ws + WS_MERGED);
    for (int i = blockIdx.x * 512 + tid; i < 1024 * 128; i += G * 512) { const int rs = i >> 7, c0 = (i & 127) * 8; const size_t tok = (size_t)(NPT + rs);
        float o[8];
#pragma unroll
        for (int j = 0; j < 8; ++j) o[j] = 0.f;
#pragma unroll
        for (int br = 0; br < 3; ++br) { f32x4 a0 = {0.f, 0.f, 0.f, 0.f}, a1 = a0;
#pragma unroll
            for (int kq = 0; kq < 4; ++kq) { const float* pp = P + (size_t)(kq * 3 + br) * 1048576 + (size_t)rs * 1024 + c0; a0 += *(const f32x4*)pp; a1 += *(const f32x4*)(pp + 4); }
            const u32x4 g = *(const u32x4*)(Gt + tok * 3072 + br * 1024 + c0);
            o[0] += a0.x * bflo(g.x); o[1] += a0.y * bfhi(g.x); o[2] += a0.z * bflo(g.y); o[3] += a0.w * bfhi(g.y); o[4] += a1.x * bflo(g.z); o[5] += a1.y * bfhi(g.z); o[6] += a1.z * bflo(g.w); o[7] += a1.w * bfhi(g.w); }
        *(u32x4*)(M + tok * 1024 + c0) = (u32x4){pk2(o[0], o[1]), pk2(o[2], o[3]), pk2(o[4], o[5]), pk2(o[6], o[7])}; }
}
__device__ __forceinline__ void p6_norm(PREF p, int r0, int r1, int vb, int nvb, int wave, int lane) {
    const f32x4* gf = (const f32x4*)p.in[I_GF] + lane;
    for (int m = r0 + vb * 8 + wave; m < r1; m += nvb * 8) { f32x4* xr = (f32x4*)(p.out + (size_t)m * 1024) + lane; f32x4 v[4]; float s = 0.f;
#pragma unroll
        for (int j = 0; j < 4; ++j) { v[j] = xr[64 * j]; s += (v[j].x * v[j].x + v[j].y * v[j].y) + (v[j].z * v[j].z + v[j].w * v[j].w); }
        const float rstd = rsqrtf(wave_sum(s) * (1.f / 1024.f) + 1e-6f);
#pragma unroll
        for (int j = 0; j < 4; ++j) xr[64 * j] = v[j] * rstd * gf[64 * j]; }
}

__device__ __forceinline__ void p6s_norm(PREF p, int vb, int nvb, int wave, int lane) {
    const f32x4* gf = (const f32x4*)p.in[I_GF] + lane; const float* YP = (const float*)(p.ws + WS_YP);
    for (int m = vb * 8 + wave; m < 1024; m += nvb * 8) { const f32x4* xr = (const f32x4*)(p.in[I_XS] + (size_t)m * 1024) + lane; f32x4 v[4]; float s = 0.f;
#pragma unroll
        for (int j = 0; j < 4; ++j) { v[j] = xr[64 * j];
#pragma unroll
            for (int kq = 0; kq < 4; ++kq) v[j] += ((const f32x4*)(YP + (size_t)kq * 1048576 + (size_t)m * 1024) + lane)[64 * j];
            s += (v[j].x * v[j].x + v[j].y * v[j].y) + (v[j].z * v[j].z + v[j].w * v[j].w); }
        const float rstd = rsqrtf(wave_sum(s) * (1.f / 1024.f) + 1e-6f); f32x4* orow = (f32x4*)(p.out + (size_t)(NPT + m) * 1024) + lane;
#pragma unroll
        for (int j = 0; j < 4; ++j) orow[64 * j] = v[j] * rstd * gf[64 * j]; }
}

#define XB_TMO      128
#define XB_XCNT(j)  (256  + 64 * (j))
#define XB_XSUB(j)  (1280 + 64 * (j))
#define XB_XGEN(j)  (2304 + 64 * (j))
#define XB_TOP      3328
#define XB_TOPGEN   3392
#define XCD_BAR_WORDS 3456
#define XB_SPIN_CAP (1u << 18)

__device__ __forceinline__ unsigned xb_ld(unsigned* p)              { return __hip_atomic_load(p, __ATOMIC_RELAXED, __HIP_MEMORY_SCOPE_AGENT); }
__device__ __forceinline__ unsigned xb_add(unsigned* p, unsigned v) { return __hip_atomic_fetch_add(p, v, __ATOMIC_RELAXED, __HIP_MEMORY_SCOPE_AGENT); }
__device__ __forceinline__ unsigned xb_xcc_id() { return (unsigned)__builtin_amdgcn_s_getreg((3 << 11) | 20) & 0xFu; }
#define XB_SPIN(cond, bar) do { unsigned _sp = 0; while (cond) { __builtin_amdgcn_s_sleep(1); \
    if ((++_sp & 255u) == 0u) { if (xb_ld(&(bar)[XB_TMO])) break; if (_sp > XB_SPIN_CAP) { atomicAdd(&(bar)[XB_TMO], 1u); break; } } } } while (0)

struct XcdBarrier {
    unsigned* bar; unsigned x;
    volatile LAS unsigned* st;
};

__device__ __forceinline__ XcdBarrier xcd_barrier_post(unsigned* bar, volatile LAS unsigned* st) {
    XcdBarrier b; b.bar = bar; b.x = xb_xcc_id(); b.st = st;
    if (threadIdx.x == 0) (void)xb_add(&bar[XB_XCNT(b.x)], 1u);
    return b;
}
__device__ __forceinline__ void xcd_barrier_complete(unsigned* bar, unsigned x, unsigned& nloc, unsigned& nx) {
    const unsigned G = gridDim.x * gridDim.y * gridDim.z;
    unsigned sum, cnt, mine, sp = 0u;
    for (;;) {
        sum = 0u; cnt = 0u; mine = 0u;
#pragma unroll
        for (unsigned j = 0; j < 16; ++j) { const unsigned c = xb_ld(&bar[XB_XCNT(j)]); sum += c; cnt += (c > 0u) ? 1u : 0u; mine = (j == x) ? c : mine; }
        if (sum == G) break;
        __builtin_amdgcn_s_sleep(1);
        if ((++sp & 255u) == 0u) { if (xb_ld(&bar[XB_TMO])) break; if (sp > XB_SPIN_CAP) { atomicAdd(&bar[XB_TMO], 1u); break; } }
    }
    nloc = mine > 0u ? mine : 1u; nx = cnt > 0u ? cnt : 1u;
}

__device__ __forceinline__ void xcd_barrier(const XcdBarrier& b) {
    asm volatile("s_waitcnt vmcnt(0)" ::: "memory");
    __syncthreads();
    if (threadIdx.x == 0) {
        unsigned* bar = b.bar;
        __builtin_amdgcn_s_waitcnt(0);
        unsigned nloc = b.st[0], nx = b.st[1];
        if (nloc == 0u) { xcd_barrier_complete(bar, b.x, nloc, nx); b.st[0] = nloc; b.st[1] = nx; }
        const unsigned old = xb_add(&bar[XB_XSUB(b.x)], 1u);
        const unsigned gen = old / nloc;
        if (old + 1u == (gen + 1u) * nloc) {
            __builtin_amdgcn_fence(__ATOMIC_RELEASE, "agent");
            asm volatile("s_waitcnt vmcnt(0)" ::: "memory");
            const unsigned og = xb_add(&bar[XB_TOP], 1u);
            const unsigned tg = og / nx;
            if (og + 1u == (tg + 1u) * nx) xb_add(&bar[XB_TOPGEN], 1u);
            else XB_SPIN(xb_ld(&bar[XB_TOPGEN]) == tg, bar);
            __builtin_amdgcn_fence(__ATOMIC_ACQUIRE, "agent");
            xb_add(&bar[XB_XGEN(b.x)], 1u);
            asm volatile("s_waitcnt vmcnt(0)" ::: "memory");
        } else {
            XB_SPIN(xb_ld(&bar[XB_XGEN(b.x)]) == gen, bar);
            __builtin_amdgcn_fence(__ATOMIC_ACQUIRE, "agent");
            asm volatile("s_waitcnt vmcnt(0)" ::: "memory");
        }
    }
    __syncthreads();
}

#ifndef MK_LAST_PHASE
#define MK_LAST_PHASE 99
#endif
__global__ void __launch_bounds__(512, 2) fwd(Params p_arg) {
    extern __shared__ __attribute__((aligned(16))) unsigned char lds_raw[];
    LAS unsigned char* lds = (LAS unsigned char*)lds_raw;
    cg::grid_group grid = cg::this_grid();
    const int tid = threadIdx.x, lane = tid & 63, wave = __builtin_amdgcn_readfirstlane(tid >> 6), G = gridDim.x, bx = blockIdx.x;
    CParams* kp = (CParams*)__builtin_amdgcn_kernarg_segment_ptr();
    unsigned char* ws = kp->ws;
#define p (*launder(kp))
    if (tid < 8) ((LAS unsigned*)(lds + LDS_BYTES - 32))[tid] = 0u;
    __syncthreads();
#ifndef PROBE_DUP
#define PROBE_DUP 0
#endif
#define REP(n) for (int rep_ = (PROBE_DUP == (n) ? 0 : 1); rep_ < 2; ++rep_)
    REP(10) { p0_prologue(p, lds, tid, wave, lane, G); __syncthreads(); }
    grid.sync();
    const XcdBarrier xbar = xcd_barrier_post((unsigned*)(ws + WS_CTR) + 1024, (volatile LAS unsigned*)(lds + LDS_BYTES - 32));
    REP(1) { pg8::Gemm g{(const pg8::bf16_t*)(ws + WS_XN), (const pg8::bf16_t*)(ws + WS_WIN), NT, 11520, 1024}; pg8::StaticOrder S; S.init(NT, 11520, G, bx); EpiMain E{ws};
      pg8::gemm_phase<EpiMain, pg8::StaticOrder>((PG8_LAS unsigned char*)lds, g, S, E, nullptr); }
    xcd_barrier(xbar);
    REP(7) if (G >= 128) {
        if (bx < 64) { pg8::Gemm g{(const pg8::bf16_t*)(ws + WS_XN) + (size_t)NT * 1024, (const pg8::bf16_t*)(ws + WS_WIN) + (size_t)11520 * 1024, 2048, 2048, 1024}; SchedMem S{bx}; EpiMem E{ws, p.out};
            pg8::gemm_phase<EpiMem, SchedMem>((PG8_LAS unsigned char*)lds, g, S, E, nullptr); }
        else p2_lora(p, bx - 64, G - 64, tid, wave, lane);
    }
    xcd_barrier(xbar);
#ifndef PROBE_DUP
#define PROBE_DUP 0
#endif
    for (int rep = (PROBE_DUP == 2 ? 0 : 1); rep < 2; ++rep)
    for (int it = bx; it < 256; it += G) rwkv_run(p, lds, tid, wave, lane, 0, it, 2048 / CH);
    for (int rep = (PROBE_DUP == 3 ? 0 : 1); rep < 2; ++rep)
    for (int it = bx * 16; it < 4096; it += G * 16) rwkv_run(p, lds, tid, wave, lane, 1, it, 4);
    for (int rep = (PROBE_DUP == 4 ? 0 : 1); rep < 2; ++rep) { const bool st = (rep == 1) || (p.zero != 0);
        if (bx < 128) rglru_item(p, lds, tid, wave, lane, 0, bx, st); else { rglru_item(p, lds, tid, wave, lane, 1, bx - 128, st); rglru_item(p, lds, tid, wave, lane, 1, bx, st); } }
    { const bool st = true;
        LAS unsigned* slot = (LAS unsigned*)(lds + LDS_BYTES - 16); unsigned* ctr = (unsigned*)(ws + WS_CTR);
        for (;;) {
            if (tid == 0) *slot = atomicAdd(ctr, 1u);
            __syncthreads();
            const unsigned it = *slot;
            __syncthreads();
            if (it >= 1024u) break;
            if ((it & 1u) == 0u) xattn_sample_item(p, lds, tid, wave, lane, (int)(it >> 1), st); else xattn_prompt_item(p, lds, tid, wave, lane, (int)(it >> 1), st);
        } }
    xcd_barrier(xbar);
    p4_post(p, tid, G, true);
    xcd_barrier(xbar);
    { pg8::Gemm g{(const pg8::bf16_t*)(ws + WS_Z), (const pg8::bf16_t*)(ws + WS_WBR), 3 * NT, 3072, 1024}; SchedTail S{bx}; EpiTail E{ws};
      pg8::gemm_phase<EpiTail, SchedTail>((PG8_LAS unsigned char*)lds, g, S, E, nullptr);
      if (bx < 192) { pg8::Gemm g4 = g; g4.nt = 4; SchedBrS S2{bx}; EpiPart E2{ws}; pg8::gemm_phase<EpiPart, SchedBrS>((PG8_LAS unsigned char*)lds, g4, S2, E2, nullptr); } }
    xcd_barrier(xbar);
    p5_sum(p, tid, G);
    { pg8::Gemm g{(const pg8::bf16_t*)(ws + WS_MERGED), (const pg8::bf16_t*)(ws + WS_WOUT), NPT, 1024, 1024}; pg8::StaticOrder S; S.init(NPT, 1024, G, bx); EpiOut E{opq(p.in[I_XP]), opq(p.in[I_XS]), p.out};
      pg8::gemm_phase<EpiOut, pg8::StaticOrder>((PG8_LAS unsigned char*)lds, g, S, E, nullptr); }
    xcd_barrier(xbar);
    if (bx < 64) { pg8::Gemm g{(const pg8::bf16_t*)(ws + WS_MERGED), (const pg8::bf16_t*)(ws + WS_WOUT), NT, 1024, 1024, 4}; SchedOutS S{bx}; EpiPartY E{ws};
      pg8::gemm_phase<EpiPartY, SchedOutS>((PG8_LAS unsigned char*)lds, g, S, E, nullptr);
      p6_norm(p, 0, NPT, bx, 448, wave, lane); }
    else { p6_norm(p, 0, NPT, 64 + 2 * (bx - 64), 448, wave, lane); p6_norm(p, 0, NPT, 65 + 2 * (bx - 64), 448, wave, lane); }
    xcd_barrier(xbar);
    p6s_norm(p, bx, G, wave, lane);
#undef p
}
}

extern "C" void kernel_launch(void* const* d_in, const int* in_sizes, int n_in, void* d_out, int out_size, void* d_ws, size_t ws_size, hipStream_t stream) {
    static int grid = 0;
    if (grid == 0) {
        if (n_in != 35 || (size_t)out_size != mk::O_END || ws_size < mk::WS_END) { fprintf(stderr, "kernel_launch: unexpected shapes: n_in %d out %d ws %zu\n", n_in, out_size, ws_size); grid = -1; return; }
        int dev = 0, cus = 0, per_cu = 0;
        hipGetDevice(&dev); hipDeviceGetAttribute(&cus, hipDeviceAttributeMultiprocessorCount, dev);
        hipFuncSetAttribute((const void*)mk::fwd, hipFuncAttributeMaxDynamicSharedMemorySize, mk::LDS_BYTES);
        hipOccupancyMaxActiveBlocksPerMultiprocessor(&per_cu, (const void*)mk::fwd, 512, mk::LDS_BYTES);
        if (per_cu < 1) { fprintf(stderr, "kernel_launch: occupancy query says %d blocks per CU\n", per_cu); per_cu = 1; }
        grid = cus * 1;
        (void)hipGetLastError();
    }
    if (grid < 0) return;
    mk::Params p{};
    for (int i = 0; i < 35; ++i) p.in[i] = (const float*)d_in[i];
    p.out = (float*)d_out; p.ws = (unsigned char*)d_ws;
    void* args[] = {&p};
    hipError_t e = hipLaunchCooperativeKernel((const void*)mk::fwd, dim3(grid), dim3(512), args, mk::LDS_BYTES, stream);
    if (e != hipSuccess) fprintf(stderr, "cooperative launch failed: %s (grid %d)\n", hipGetErrorString(e), grid);
}
```

```cpp
#include <hip/hip_cooperative_groups.h>
#include <cstdio>
#include <hip/hip_runtime.h>
namespace pg8 {
#define PG8_LAS __attribute__((address_space(3)))
typedef unsigned short bf16_t;
typedef short bf16x8 __attribute__((ext_vector_type(8)));
typedef float f32x4 __attribute__((ext_vector_type(4)));
typedef unsigned u32x4 __attribute__((ext_vector_type(4)));
constexpr int BM = 256, BK = 64, HALF = 128, HTB = HALF * BK * 2  , STAGE_BYTES = 8 * HTB, NXCD = 8, WGM = 8;

__host__ __device__ __forceinline__ int lds_byte(int r, int c) { const int st = (r >> 4) * 2 + (c >> 5), rr = r & 15, cc = c & 31, ob = rr * 64 + cc * 2; return st * 1024 + (ob ^ (((ob >> 9) & 1) << 5)); }
__host__ __device__ __forceinline__ void stage_rc(int b, int& R, int& C) { const int st = b / 1024, sb = b % 1024, swz = sb ^ (((sb >> 9) & 1) << 5); R = (st >> 1) * 16 + swz / 64; C = (st & 1) * 32 + (swz % 64) / 2; }
__host__ __device__ __forceinline__ int perm32(int rho) { const int n = rho >> 4, i = rho & 15; return 8 * (i >> 2) + 4 * n + (i & 3); }

struct Unit { int pm, pn, ko; };
struct Gemm { const bf16_t* A; const bf16_t* Bt; int M, N, K, nt; };

struct StaticOrder {
    int nM, nN, nwg, G, c;
    __host__ __device__ void init(int M, int N, int G_, int c_) { nM = M / BM; nN = N / BM; nwg = nM * nN; G = G_; c = c_; }
    __host__ __device__ bool next(int i, Unit& u) const {
        const long L = (long)i * G + c; if (L >= nwg) return false;
        int wgid = (int)L; { const int q = nwg / NXCD, r = nwg % NXCD, xcd = wgid % NXCD, off = wgid / NXCD; wgid = (xcd < r ? xcd * (q + 1) : r * (q + 1) + (xcd - r) * q) + off; }
        const int nig = WGM * nN, gid = wgid / nig, fm = gid * WGM, gsz = (nM - fm) < WGM ? (nM - fm) : WGM;
        u.pm = fm + ((wgid % nig) % gsz); u.pn = (wgid % nig) / gsz; return true;
    }
    __device__ __forceinline__ void a_ready(const Unit&) const {}
    __device__ __forceinline__ void done(const Unit&) const {}
};
struct CountedOrder : StaticOrder {
    const unsigned* ready; unsigned need; unsigned* tmo;
    __device__ __forceinline__ void a_ready(const Unit& u) const {
        if (threadIdx.x < 64) {
            const unsigned long long t0 = __builtin_amdgcn_s_memrealtime(); unsigned polls = 0;
            while ((unsigned)__builtin_amdgcn_readfirstlane(__hip_atomic_load(ready + 64 * u.pm, __ATOMIC_RELAXED, __HIP_MEMORY_SCOPE_AGENT)) < need) {
                if ((++polls & 255u) == 0u && __builtin_amdgcn_readfirstlane(__hip_atomic_load(tmo, __ATOMIC_RELAXED, __HIP_MEMORY_SCOPE_AGENT)) != 0u) break;
                if (__builtin_amdgcn_s_memrealtime() - t0 > 2000000ull) {
                    if (threadIdx.x == 0) { unsigned expect = 0u; __hip_atomic_compare_exchange_strong(tmo + 1, &expect, 0x600u | (unsigned)(u.pm & 0xff), __ATOMIC_RELAXED, __ATOMIC_RELAXED, __HIP_MEMORY_SCOPE_AGENT); __hip_atomic_store(tmo, 1u, __ATOMIC_RELAXED, __HIP_MEMORY_SCOPE_AGENT); }
                    break; }
                __builtin_amdgcn_s_sleep(2); }
            __builtin_amdgcn_fence(__ATOMIC_ACQUIRE, "agent");
            asm volatile("s_waitcnt vmcnt(0)" ::: "memory");
        }
#if !defined(BROKEN_HOOK_NO_BARRIER)
        asm volatile("" ::: "memory"); __builtin_amdgcn_s_barrier(); asm volatile("" ::: "memory");
#endif
    }
};

__device__ __forceinline__ unsigned cvt_pk_bf16(float lo, float hi) { unsigned r; asm volatile("v_cvt_pk_bf16_f32 %0, %1, %2" : "=v"(r) : "v"(lo), "v"(hi)); return r; }
typedef float f32x2 __attribute__((ext_vector_type(2)));
__device__ __forceinline__ f32x2 gelu_pk(f32x2 v) {
    const f32x2 av = __builtin_elementwise_abs(v), d = av * 0.2316418882f + 1.0f;
    f32x2 t; t.x = __builtin_amdgcn_rcpf(d.x); t.y = __builtin_amdgcn_rcpf(d.y);
    f32x2 q = t * 0.5307027145f + (-0.7265760135f); q = q * t + 0.7107068705f; q = q * t + (-0.142248368f); q = q * t + 0.127414796f; q = q * t;
    const f32x2 s = (v * v) * (-0.72134752044f);
    f32x2 e; e.x = __builtin_amdgcn_exp2f(s.x); e.y = __builtin_amdgcn_exp2f(s.y);
    const f32x2 m = v * (q * e), r = v - m;
    f32x2 o; o.x = v.x < 0.f ? m.x : r.x; o.y = v.y < 0.f ? m.y : r.y; return o;
}

struct EpiF32 {
    static constexpr bool PERM = false, AFTER_DRAIN = false;
    float* C; int ldc; const float* bias;
    __device__ __forceinline__ void operator()(const f32x4 (&acc)[2][2][4][2], const Unit& u, int wr, int wc, int fr, int fq) const {
        const int row0 = u.pm * BM + wr * 64 + fr, col0 = u.pn * BM + wc * 32 + 4 * fq;
        f32x4 bv[2][2];
#pragma unroll
        for (int bj = 0; bj < 2; ++bj)
#pragma unroll
            for (int n = 0; n < 2; ++n) bv[bj][n] = bias ? *(const f32x4*)(bias + col0 + bj * HALF + n * 16) : (f32x4){0.f, 0.f, 0.f, 0.f};
#pragma unroll
        for (int ai = 0; ai < 2; ++ai)
#pragma unroll
            for (int m = 0; m < 4; ++m) { float* rowp = C + (size_t)(row0 + ai * HALF + m * 16) * ldc + col0;
#pragma unroll
                for (int bj = 0; bj < 2; ++bj)
#pragma unroll
                    for (int n = 0; n < 2; ++n) *(f32x4*)(rowp + bj * HALF + n * 16) = acc[ai][bj][m][n] + bv[bj][n]; }
    }
};
template <int ACT  > struct EpiBf16 {
    static constexpr bool PERM = true, AFTER_DRAIN = false;
    bf16_t* O; int ldc; const float* bias; int split_cols; size_t split_stride;
    __device__ __forceinline__ void operator()(const f32x4 (&acc)[2][2][4][2], const Unit& u, int wr, int wc, int fr, int fq) const {
        const int row0 = u.pm * BM + wr * 64 + fr; int colt = u.pn * BM; bf16_t* base = O;
        if (split_cols) { const int t = colt / split_cols; base += (size_t)t * split_stride; colt -= t * split_cols; }
        const int col0 = colt + wc * 32 + 8 * fq, bcol0 = u.pn * BM + wc * 32 + 8 * fq;
        f32x4 bv[2][2];
#pragma unroll
        for (int bj = 0; bj < 2; ++bj)
#pragma unroll
            for (int n = 0; n < 2; ++n) bv[bj][n] = bias ? *(const f32x4*)(bias + bcol0 + bj * HALF + 4 * n) : (f32x4){0.f, 0.f, 0.f, 0.f};
#pragma unroll
        for (int ai = 0; ai < 2; ++ai)
#pragma unroll
            for (int m = 0; m < 4; ++m) { bf16_t* rowp = base + (size_t)(row0 + ai * HALF + m * 16) * ldc + col0;
#pragma unroll
                for (int bj = 0; bj < 2; ++bj) { f32x4 v0 = acc[ai][bj][m][0] + bv[bj][0], v1 = acc[ai][bj][m][1] + bv[bj][1];
                    if (ACT == 1) { f32x2 a = gelu_pk((f32x2){v0[0], v0[1]}), b = gelu_pk((f32x2){v0[2], v0[3]}), c = gelu_pk((f32x2){v1[0], v1[1]}), d = gelu_pk((f32x2){v1[2], v1[3]});
                        v0 = (f32x4){a.x, a.y, b.x, b.y}; v1 = (f32x4){c.x, c.y, d.x, d.y}; }
                    if (ACT == 2) {
#pragma unroll
                        for (int j = 0; j < 4; ++j) { v0[j] = 0.5f * v0[j] * (1.0f + erff(v0[j] * 0.70710678f)); v1[j] = 0.5f * v1[j] * (1.0f + erff(v1[j] * 0.70710678f)); } }
                    u32x4 w; w.x = cvt_pk_bf16(v0[0], v0[1]); w.y = cvt_pk_bf16(v0[2], v0[3]); w.z = cvt_pk_bf16(v1[0], v1[1]); w.w = cvt_pk_bf16(v1[2], v1[3]);
                    *(u32x4*)(rowp + bj * HALF) = w; } }
    }
};

struct PanelStats {
    unsigned* xbuf;
    unsigned* cnt;
    unsigned* tmo;
    int ntn; float eps;
    unsigned code;
    __device__ __forceinline__ bool run(const f32x4 (&v)[2][2][4][2], const Unit& u, int wr, int wc, int fr, int fq, PG8_LAS unsigned char* lds, int wid, int lane) const {
        typedef float f32x2v __attribute__((ext_vector_type(2)));
        PG8_LAS f32x2v* P = (PG8_LAS f32x2v*)lds;
        PG8_LAS f32x2v* S = (PG8_LAS f32x2v*)(lds + 8192);
        PG8_LAS unsigned* flag = (PG8_LAS unsigned*)(lds + 8192 + 2048);
#pragma unroll
        for (int ai = 0; ai < 2; ++ai)
#pragma unroll
            for (int m = 0; m < 4; ++m) {
                float s = 0.f;
#pragma unroll
                for (int bj = 0; bj < 2; ++bj)
#pragma unroll
                    for (int n = 0; n < 2; ++n) { const f32x4 x = v[ai][bj][m][n]; s += (x[0] + x[1]) + (x[2] + x[3]); }
                s += __shfl_xor(s, 16); s += __shfl_xor(s, 32);
                const float mw = s * (1.0f / 64.0f); float q = 0.f;
#pragma unroll
                for (int bj = 0; bj < 2; ++bj)
#pragma unroll
                    for (int n = 0; n < 2; ++n) { const f32x4 d = v[ai][bj][m][n] - mw; q += (d[0] * d[0] + d[1] * d[1]) + (d[2] * d[2] + d[3] * d[3]); }
                q += __shfl_xor(q, 16); q += __shfl_xor(q, 32);
                if (fq == 0) P[(ai * HALF + wr * 64 + m * 16 + fr) * 4 + wc] = (f32x2v){mw, q};
            }
        asm volatile("s_waitcnt lgkmcnt(0)" ::: "memory"); __builtin_amdgcn_s_barrier(); asm volatile("" ::: "memory");
#if defined(BROKEN_NO_WAIT)
        if (blockIdx.x >= 64) { const long long t0 = clock64(); while (clock64() - t0 < 60000) __builtin_amdgcn_s_sleep(8); }
#endif
        const int row = wid * 32 + (lane & 31);
        if (lane < 32) {
            const f32x2v a = P[row * 4 + 0], b = P[row * 4 + 1], c = P[row * 4 + 2], d = P[row * 4 + 3];
            const float mt = (a.x + b.x + c.x + d.x) * 0.25f;
            const float da = a.x - mt, db = b.x - mt, dc = c.x - mt, dd = d.x - mt;
            const float m2 = (a.y + b.y) + (c.y + d.y) + 64.0f * ((da * da + db * db) + (dc * dc + dd * dd));
            unsigned long long* slot = (unsigned long long*)xbuf + ((size_t)(u.pm * BM + row) * 4 + u.pn);
            __hip_atomic_store(slot, ((unsigned long long)__float_as_uint(m2) << 32) | __float_as_uint(mt), __ATOMIC_RELAXED, __HIP_MEMORY_SCOPE_AGENT);
        }
        asm volatile("s_waitcnt vmcnt(0)" ::: "memory");
        if (lane == 0) __hip_atomic_fetch_add(cnt + 64 * u.pm, 1u, __ATOMIC_RELAXED, __HIP_MEMORY_SCOPE_AGENT);
        if (wid == 0) {
            bool dead = false; const unsigned long long t0 = __builtin_amdgcn_s_memrealtime(); const unsigned want = 8u * (unsigned)ntn;
            for (;;) {
#if defined(BROKEN_NO_WAIT)
                break;
#endif
                if ((unsigned)__builtin_amdgcn_readfirstlane(__hip_atomic_load(cnt + 64 * u.pm, __ATOMIC_RELAXED, __HIP_MEMORY_SCOPE_AGENT)) >= want) break;
                if (__builtin_amdgcn_s_memrealtime() - t0 > 2000000ull) {
                    if (lane == 0) { unsigned expect = 0u; __hip_atomic_compare_exchange_strong(tmo + 1, &expect, code | (unsigned)(u.pm & 0xff), __ATOMIC_RELAXED, __ATOMIC_RELAXED, __HIP_MEMORY_SCOPE_AGENT);
                                     __hip_atomic_store(tmo, 1u, __ATOMIC_RELAXED, __HIP_MEMORY_SCOPE_AGENT); }
                    dead = true; break; }
                __builtin_amdgcn_s_sleep(2);
            }
            __builtin_amdgcn_fence(__ATOMIC_ACQUIRE, "agent");
            if (lane == 0) flag[0] = dead ? 1u : 0u;
        }
        asm volatile("s_waitcnt vmcnt(0) lgkmcnt(0)" ::: "memory"); __builtin_amdgcn_s_barrier(); asm volatile("" ::: "memory");
        const bool bad = flag[0] != 0u;
        if (lane < 32) {
            const unsigned long long* slot = (const unsigned long long*)xbuf + (size_t)(u.pm * BM + row) * 4; float mt[4], m2[4]; float ms = 0.f;
#pragma unroll
            for (int t = 0; t < 4; ++t) { if (t < ntn) { const unsigned long long w = __hip_atomic_load(slot + t, __ATOMIC_RELAXED, __HIP_MEMORY_SCOPE_AGENT); mt[t] = __uint_as_float((unsigned)w); m2[t] = __uint_as_float((unsigned)(w >> 32)); } else { mt[t] = 0.f; m2[t] = 0.f; } ms += mt[t]; }
            const float mean = ms / (float)ntn; float q = 0.f;
#pragma unroll
            for (int t = 0; t < 4; ++t) if (t < ntn) { const float dm = mt[t] - mean; q += m2[t] + 256.0f * dm * dm; }
            S[row] = (f32x2v){mean, 1.0f / sqrtf(q / (256.0f * (float)ntn) + eps)};
        }
        asm volatile("s_waitcnt lgkmcnt(0)" ::: "memory"); __builtin_amdgcn_s_barrier(); asm volatile("" ::: "memory");
        return bad;
    }
};
struct EpiLnRes {
    static constexpr bool PERM = false, AFTER_DRAIN = true;
    const float* base; float* out; int ldc; const float* bias; PanelStats st; unsigned poison;
    __device__ __forceinline__ void refuse(size_t i0, size_t stride, int M, int N) const { const float q = __builtin_nanf(""); for (size_t i = i0; i < (size_t)M * N; i += stride) out[(i / N) * ldc + i % N] = q;
        if (i0 == 0) { unsigned expect = 0u; __hip_atomic_compare_exchange_strong(st.tmo + 1, &expect, 0x7f0u, __ATOMIC_RELAXED, __ATOMIC_RELAXED, __HIP_MEMORY_SCOPE_AGENT); __hip_atomic_store(st.tmo, 1u, __ATOMIC_RELAXED, __HIP_MEMORY_SCOPE_AGENT); } }
    __device__ __forceinline__ void fused(f32x4 (&acc)[2][2][4][2], const Unit& u, int wr, int wc, int fr, int fq, PG8_LAS unsigned char* lds, int wid, int lane) const {
        typedef float f32x2v __attribute__((ext_vector_type(2)));
        const PG8_LAS f32x2v* S = (const PG8_LAS f32x2v*)(lds + 8192);
        const int col0 = u.pn * BM + wc * 32 + 4 * fq;
#pragma unroll
        for (int bj = 0; bj < 2; ++bj)
#pragma unroll
            for (int n = 0; n < 2; ++n) { const f32x4 bv = bias ? *(const f32x4*)(bias + col0 + bj * HALF + n * 16) : (f32x4){0.f, 0.f, 0.f, 0.f};
#pragma unroll
                for (int ai = 0; ai < 2; ++ai)
#pragma unroll
                    for (int m = 0; m < 4; ++m) acc[ai][bj][m][n] += bv; }
        const bool bad = st.run(acc, u, wr, wc, fr, fq, lds, wid, lane) || poison != 0u;
        const float qnan = __builtin_nanf("");
#pragma unroll
        for (int ai = 0; ai < 2; ++ai)
#pragma unroll
            for (int m = 0; m < 4; ++m) { const int r = ai * HALF + wr * 64 + m * 16 + fr; const f32x2v sr = S[r]; const size_t off = (size_t)(u.pm * BM + r) * ldc + col0;
#pragma unroll
                for (int bj = 0; bj < 2; ++bj)
#pragma unroll
                    for (int n = 0; n < 2; ++n) { const f32x4 bs = *(const f32x4*)(base + off + bj * HALF + n * 16); f32x4 o = bs + (acc[ai][bj][m][n] - sr.x) * sr.y;
                        if (bad) o = (f32x4){qnan, qnan, qnan, qnan}; *(f32x4*)(out + off + bj * HALF + n * 16) = o; }
                asm volatile("" ::: "memory"); }
    }
};
struct EpiLnResLn {
    static constexpr bool PERM = false, AFTER_DRAIN = true;
    const float* base; float* out; bf16_t* xn; int ldc; const float* bias; PanelStats st1, st2; unsigned poison;
    __device__ __forceinline__ void refuse(size_t i0, size_t stride, int M, int N) const { const float q = __builtin_nanf(""); for (size_t i = i0; i < (size_t)M * N; i += stride) { const size_t o = (i / N) * ldc + i % N; out[o] = q; xn[o] = (bf16_t)0x7fc0u; }
        if (i0 == 0) { unsigned expect = 0u; __hip_atomic_compare_exchange_strong(st1.tmo + 1, &expect, 0x7f0u, __ATOMIC_RELAXED, __ATOMIC_RELAXED, __HIP_MEMORY_SCOPE_AGENT); __hip_atomic_store(st1.tmo, 1u, __ATOMIC_RELAXED, __HIP_MEMORY_SCOPE_AGENT); } }
    __device__ __forceinline__ void fused(f32x4 (&acc)[2][2][4][2], const Unit& u, int wr, int wc, int fr, int fq, PG8_LAS unsigned char* lds, int wid, int lane) const {
        typedef float f32x2v __attribute__((ext_vector_type(2))); typedef unsigned u32x2v __attribute__((ext_vector_type(2)));
        const PG8_LAS f32x2v* S = (const PG8_LAS f32x2v*)(lds + 8192);
        const int col0 = u.pn * BM + wc * 32 + 4 * fq;
#pragma unroll
        for (int bj = 0; bj < 2; ++bj)
#pragma unroll
            for (int n = 0; n < 2; ++n) { const f32x4 bv = bias ? *(const f32x4*)(bias + col0 + bj * HALF + n * 16) : (f32x4){0.f, 0.f, 0.f, 0.f};
#pragma unroll
                for (int ai = 0; ai < 2; ++ai)
#pragma unroll
                    for (int m = 0; m < 4; ++m) acc[ai][bj][m][n] += bv; }
        bool bad = st1.run(acc, u, wr, wc, fr, fq, lds, wid, lane) || poison != 0u;
        const float qnan = __builtin_nanf("");
#pragma unroll
        for (int ai = 0; ai < 2; ++ai)
#pragma unroll
            for (int m = 0; m < 4; ++m) { const int r = ai * HALF + wr * 64 + m * 16 + fr; const f32x2v sr = S[r]; const size_t off = (size_t)(u.pm * BM + r) * ldc + col0;
#pragma unroll
                for (int bj = 0; bj < 2; ++bj)
#pragma unroll
                    for (int n = 0; n < 2; ++n) { const f32x4 bs = *(const f32x4*)(base + off + bj * HALF + n * 16); acc[ai][bj][m][n] = bs + (acc[ai][bj][m][n] - sr.x) * sr.y; }
                asm volatile("" : "+v"(acc[ai][0][m][0]), "+v"(acc[ai][0][m][1]), "+v"(acc[ai][1][m][0]), "+v"(acc[ai][1][m][1]));
                if (m & 1) asm volatile("" ::: "memory"); }
        const bool bad1 = bad;
        bad = st2.run(acc, u, wr, wc, fr, fq, lds, wid, lane) || bad;
#pragma unroll
        for (int ai = 0; ai < 2; ++ai)
#pragma unroll
            for (int m = 0; m < 4; ++m) { const int r = ai * HALF + wr * 64 + m * 16 + fr; const f32x2v sr = S[r]; const size_t off = (size_t)(u.pm * BM + r) * ldc + col0;
#pragma unroll
                for (int bj = 0; bj < 2; ++bj)
#pragma unroll
                    for (int n = 0; n < 2; ++n) { const f32x4 x1 = acc[ai][bj][m][n]; *(f32x4*)(out + off + bj * HALF + n * 16) = bad1 ? (f32x4){qnan, qnan, qnan, qnan} : x1;
                        const f32x4 o = (x1 - sr.x) * sr.y; u32x2v w; w.x = cvt_pk_bf16(o[0], o[1]); w.y = cvt_pk_bf16(o[2], o[3]);
                        if (bad) { w.x = 0x7fc07fc0u; w.y = 0x7fc07fc0u; } *(u32x2v*)(xn + off + bj * HALF + n * 16) = w; }
                asm volatile("" ::: "memory"); }
    }
};

template <class Epi, class Sched, bool STAMP = false>
__device__ __forceinline__ void gemm_phase(PG8_LAS unsigned char* lds, const Gemm g, const Sched& S, const Epi& E, unsigned long long* stamps) {
    const int tid = threadIdx.x, wid = __builtin_amdgcn_readfirstlane(tid >> 6), lane = tid & 63, wr = wid >> 2, wc = wid & 3, fr = lane & 15, fq = lane >> 4;
    const int K = g.K, nt = g.nt ? g.nt : K / BK;
    int ts_lo = 0, ts_hi = 0, nts = 0; const unsigned long long rt_entry = STAMP ? (unsigned long long)wall_clock64() : 0ull;
#define PG8_STAMP() do { if (STAMP && wid == 0 && nts < 64) { const unsigned long long _c = (unsigned long long)clock64(); \
        ts_lo = (lane == nts) ? (int)(unsigned)_c : ts_lo; ts_hi = (lane == nts) ? (int)(unsigned)(_c >> 32) : ts_hi; ++nts; } } while (0)
    PG8_STAMP();
    unsigned voffA[2], voffB[2];
#pragma unroll
    for (int i = 0; i < 2; ++i) { int R, C; stage_rc(tid * 16 + i * 8192, R, C); const int Rb = Epi::PERM ? ((R & ~31) + perm32(R & 31)) : R;
        voffA[i] = (unsigned)(R * K + C) * 2u; voffB[i] = (unsigned)(Rb * K + C) * 2u; }
    const size_t kstep = (size_t)(BK * 2);
    const size_t hstep = (size_t)HALF * K * 2;
    const size_t tstep = 2 * hstep;
    const unsigned ldsw = (unsigned)wid * 1024u;
    const int aoff = lds_byte(wr * 64 + fr, fq * 8), boff = lds_byte(wc * 32 + fr, fq * 8);
#define PG8_SA(b, h) (((b) * 2 + (h)) * HTB)
#define PG8_SB(b, h) ((4 + (b) * 2 + (h)) * HTB)
#define PG8_STAGE(bufoff, gbase, voff) do { _Pragma("unroll") for (int _i = 0; _i < 2; ++_i) \
        __builtin_amdgcn_global_load_lds((const unsigned*)((const char*)(gbase) + (voff)[_i]), (PG8_LAS unsigned*)(lds + (bufoff) + ldsw + _i * 8192), 16, 0, 0); } while (0)
#define PG8_LDA(dst, b, h) do { _Pragma("unroll") for (int m = 0; m < 4; ++m) _Pragma("unroll") for (int k = 0; k < 2; ++k) dst[m][k] = *(const PG8_LAS bf16x8*)(lds + PG8_SA(b, h) + aoff + m * 2048 + k * 1024); } while (0)
#define PG8_LDB(dst, b, h) do { _Pragma("unroll") for (int n = 0; n < 2; ++n) _Pragma("unroll") for (int k = 0; k < 2; ++k) dst[n][k] = *(const PG8_LAS bf16x8*)(lds + PG8_SB(b, h) + boff + n * 2048 + k * 1024); } while (0)
#define PG8_MMA(ai, bj, At, Bt) do { __builtin_amdgcn_s_setprio(1); _Pragma("unroll") for (int m = 0; m < 4; ++m) _Pragma("unroll") for (int n = 0; n < 2; ++n) _Pragma("unroll") for (int k = 0; k < 2; ++k) \
        acc[ai][bj][m][n] = __builtin_amdgcn_mfma_f32_16x16x32_bf16(Bt[n][k], At[m][k], acc[ai][bj][m][n], 0, 0, 0); __builtin_amdgcn_s_setprio(0); } while (0)
#define PG8_WAIT_V(n) asm volatile("s_waitcnt vmcnt(" #n ")" ::: "memory")
#define PG8_WAIT_L(n) asm volatile("s_waitcnt lgkmcnt(" #n ")" ::: "memory")
#define PG8_BAR __builtin_amdgcn_s_barrier()
#define PG8_SCHED __builtin_amdgcn_sched_barrier(0)
    Unit cur{0, 0, 0}, nxt{0, 0, 0}; int ui = 0;
    if (!S.next(0, cur)) return;
    f32x4 acc[2][2][4][2];
#pragma unroll
    for (int a = 0; a < 2; ++a)
#pragma unroll
        for (int b = 0; b < 2; ++b)
#pragma unroll
            for (int m = 0; m < 4; ++m)
#pragma unroll
                for (int n = 0; n < 2; ++n) acc[a][b][m][n] = (f32x4){0.f, 0.f, 0.f, 0.f};
    bf16x8 At[4][2], B0[2][2], B1[2][2];
    const char* cA = (const char*)g.A + (size_t)cur.pm * tstep + (size_t)cur.ko * 2; const char* cB = (const char*)g.Bt + (size_t)cur.pn * tstep + (size_t)cur.ko * 2;
    S.a_ready(cur);
    PG8_STAGE(PG8_SB(0, 0), cB, voffB); PG8_STAGE(PG8_SA(0, 0), cA, voffA); PG8_STAGE(PG8_SB(0, 1), cB + hstep, voffB); PG8_STAGE(PG8_SA(0, 1), cA + hstep, voffA);
    if (wr == 1) PG8_BAR;
    PG8_WAIT_V(4); PG8_BAR;
    PG8_STAGE(PG8_SB(1, 0), cB + kstep, voffB); PG8_STAGE(PG8_SA(1, 0), cA + kstep, voffA); PG8_STAGE(PG8_SB(1, 1), cB + hstep + kstep, voffB);
    PG8_WAIT_V(6); PG8_BAR;
    PG8_STAMP();
    for (;;) {
        const bool has_next = S.next(ui + 1, nxt);
        const char* nA = has_next ? (const char*)g.A + (size_t)nxt.pm * tstep + (size_t)nxt.ko * 2 : cA; const char* nB = has_next ? (const char*)g.Bt + (size_t)nxt.pn * tstep + (size_t)nxt.ko * 2 : cB;
        for (int t = 0; t < nt; t += 2) {
            const bool last = (t == nt - 2);
            const char* a1 = cA + (size_t)(t + 1) * kstep;
            const char* a2 = last ? nA : cA + (size_t)(t + 2) * kstep; const char* b2 = last ? nB : cB + (size_t)(t + 2) * kstep;
            const char* a3 = a2 + kstep; const char* b3 = b2 + kstep;
            if (last && has_next) S.a_ready(nxt);
            PG8_LDB(B0, 0, 0); PG8_SCHED; PG8_LDA(At, 0, 0); PG8_STAGE(PG8_SA(1, 1), a1 + hstep, voffA);
            PG8_WAIT_L(8); PG8_BAR; PG8_WAIT_L(0); PG8_MMA(0, 0, At, B0); PG8_BAR; PG8_SCHED;
            PG8_LDB(B1, 0, 1); PG8_STAGE(PG8_SB(0, 0), b2, voffB);
            PG8_BAR; PG8_WAIT_L(0); PG8_MMA(0, 1, At, B1); PG8_BAR;
            PG8_LDA(At, 0, 1); PG8_STAGE(PG8_SA(0, 0), a2, voffA);
            PG8_BAR; PG8_WAIT_L(0); PG8_MMA(1, 0, At, B0); PG8_BAR; PG8_SCHED;
            PG8_STAGE(PG8_SB(0, 1), b2 + hstep, voffB);
            PG8_WAIT_V(6); PG8_BAR; PG8_MMA(1, 1, At, B1); PG8_BAR;
            PG8_LDB(B0, 1, 0); PG8_SCHED; PG8_LDA(At, 1, 0); PG8_STAGE(PG8_SA(0, 1), a2 + hstep, voffA);
            PG8_WAIT_L(8); PG8_BAR; PG8_WAIT_L(0); PG8_MMA(0, 0, At, B0); PG8_BAR; PG8_SCHED;
            PG8_LDB(B1, 1, 1); PG8_STAGE(PG8_SB(1, 0), b3, voffB);
            PG8_BAR; PG8_WAIT_L(0); PG8_MMA(0, 1, At, B1); PG8_BAR;
            PG8_LDA(At, 1, 1); PG8_STAGE(PG8_SA(1, 0), a3, voffA);
            PG8_BAR; PG8_WAIT_L(0); PG8_MMA(1, 0, At, B0); PG8_BAR; PG8_SCHED;
            PG8_STAGE(PG8_SB(1, 1), b3 + hstep, voffB);
            PG8_WAIT_V(6); PG8_BAR; PG8_MMA(1, 1, At, B1); PG8_BAR;
        }
        PG8_STAMP();
        if constexpr (!Epi::AFTER_DRAIN) { E(acc, cur, wr, wc, fr, fq); S.done(cur); }
        PG8_STAMP();
        if (!has_next) break;
        if (!Epi::keep(nxt))
#pragma unroll
        for (int a = 0; a < 2; ++a)
#pragma unroll
            for (int b = 0; b < 2; ++b)
#pragma unroll
                for (int m = 0; m < 4; ++m)
#pragma unroll
                    for (int n = 0; n < 2; ++n) acc[a][b][m][n] = (f32x4){0.f, 0.f, 0.f, 0.f};
        cur = nxt; cA = nA; cB = nB; ++ui;
    }
    PG8_WAIT_V(0);
    if (wr == 0) PG8_BAR;
    PG8_BAR;
    if constexpr (Epi::AFTER_DRAIN) { E.fused(acc, cur, wr, wc, fr, fq, lds, wid, lane); S.done(cur); }
    PG8_STAMP();
    if (STAMP && wid == 0) { stamps[lane] = lane < nts ? (((unsigned long long)(unsigned)ts_hi << 32) | (unsigned)ts_lo) : 0ull;
        if (lane == 62) stamps[62] = rt_entry; if (lane == 63) stamps[63] = (unsigned long long)wall_clock64(); }
#undef PG8_STAMP
#undef PG8_SA
#undef PG8_SB
#undef PG8_STAGE
#undef PG8_LDA
#undef PG8_LDB
#undef PG8_MMA
#undef PG8_WAIT_V
#undef PG8_WAIT_L
#undef PG8_BAR
#undef PG8_SCHED
}
}

namespace mk {
namespace cg = cooperative_groups;
#define LAS __attribute__((address_space(3)))
typedef unsigned short bf16;
typedef short bf16x8 __attribute__((ext_vector_type(8)));
typedef float f32x4 __attribute__((ext_vector_type(4)));
typedef float f32x2 __attribute__((ext_vector_type(2)));
typedef unsigned u32x4 __attribute__((ext_vector_type(4)));
typedef unsigned u32x2 __attribute__((ext_vector_type(2)));

constexpr int NT = 17408, NPT = 16384, DM = 1024;
constexpr size_t MiB = 1u << 20;
constexpr size_t WS_WIN = 0, WS_WBR = 28 * MiB, WS_WOUT = 34 * MiB, WS_WDEC = 36 * MiB, WS_WAAA = WS_WDEC + 131072, WS_WRGA = WS_WAAA + 131072, WS_WRGX = WS_WRGA + 131072;
constexpr size_t WS_XN = 38 * MiB, WS_U = 76 * MiB, WS_Z = 178 * MiB, WS_XB = 280 * MiB, WS_Q = 314 * MiB, WS_G = 348 * MiB, WS_XWA = 450 * MiB;
constexpr size_t WS_MK = 459 * MiB, WS_MVT = 463 * MiB, WS_BONUS = 467 * MiB, WS_STATS = 469 * MiB, WS_CTR = 474 * MiB, WS_END = 475 * MiB;
constexpr size_t WS_ORAW = WS_XN, WS_P = WS_U, WS_MERGED = WS_XB;
constexpr size_t ZSTRIDE = (size_t)NT * DM;
constexpr int LDS_BYTES = 147456;
constexpr size_t O_Y = 0, O_RWP = 17825792, O_SHP = O_RWP + 524288, O_LRP = O_SHP + 25600, O_CVP = O_LRP + 8192, O_MKP = O_CVP + 24576, O_MVP = O_MKP + 2097152,
                 O_RWS = O_MVP + 2097152, O_SHS = O_RWS + 8388608, O_LRS = O_SHS + 409600, O_CVS = O_LRS + 131072, O_END = O_CVS + 393216;

struct Params { const float* in[35]; float* out; unsigned char* ws; int zero; int pad; };
#define PREF const __attribute__((address_space(4))) Params&
typedef const __attribute__((address_space(4))) Params CParams;
__device__ __forceinline__ CParams* launder(CParams* x) { asm volatile("" : "+s"(x)); return x; }
enum { I_XP = 0, I_XS, I_MEM, I_SRW, I_SSH, I_SLRU, I_SCV, I_CK, I_CV, I_GN, I_WIN, I_MU, I_W0, I_WDEC, I_A0, I_WAAA, I_KK, I_KA, I_RK, I_GNG, I_GNB, I_CW, I_CB, I_WRGA, I_BRGA, I_WRGX, I_BRGX, I_LAM, I_GMEM, I_WMEM, I_WBA, I_WBB, I_WBC, I_WOUT, I_GF };

__device__ __forceinline__ unsigned f2bf(float f) { unsigned u = __builtin_bit_cast(unsigned, f); return (u + 0x7fffu + ((u >> 16) & 1u)) >> 16; }
__device__ __forceinline__ unsigned pk2(float lo, float hi) { unsigned r; asm("v_cvt_pk_bf16_f32 %0, %1, %2" : "=v"(r) : "v"(lo), "v"(hi)); return r; }
__device__ __forceinline__ float bf2f(unsigned b) { return __builtin_bit_cast(float, b << 16); }
__device__ __forceinline__ float bflo(unsigned w) { return __builtin_bit_cast(float, w << 16); }
__device__ __forceinline__ float bfhi(unsigned w) { return __builtin_bit_cast(float, w & 0xffff0000u); }
__device__ __forceinline__ const float* opq(const float* x) { asm volatile("" : "+s"(x)); return x; }
__device__ __forceinline__ float sigm(float x) { return __builtin_amdgcn_rcpf(1.0f + __builtin_amdgcn_exp2f(x * -1.44269504f)); }
#define LDS_WAIT() asm volatile("s_waitcnt lgkmcnt(0)" ::: "memory")
template <int CTRL> __device__ __forceinline__ float dppf(float x) { return __builtin_bit_cast(float, __builtin_amdgcn_update_dpp(0, __builtin_bit_cast(int, x), CTRL, 0xF, 0xF, true)); }
__device__ __forceinline__ float row16_sum(float x) { x += dppf<0xB1>(x); x += dppf<0x4E>(x); x += dppf<0x141>(x); x += dppf<0x140>(x); return x; }
__device__ __forceinline__ float row16_max(float x) { x = fmaxf(x, dppf<0xB1>(x)); x = fmaxf(x, dppf<0x4E>(x)); x = fmaxf(x, dppf<0x141>(x)); x = fmaxf(x, dppf<0x140>(x)); return x; }
__device__ __forceinline__ float rdl(float x, int l) { return __builtin_bit_cast(float, __builtin_amdgcn_readlane(__builtin_bit_cast(int, x), l)); }
__device__ __forceinline__ float wave_sum(float x) { x = row16_sum(x); return (rdl(x, 0) + rdl(x, 16)) + (rdl(x, 32) + rdl(x, 48)); }
__device__ __forceinline__ float wave_max(float x) { x = row16_max(x); x = fmaxf(x, __shfl_xor(x, 16)); x = fmaxf(x, __shfl_xor(x, 32)); return x; }

struct EpiMain {
    static constexpr bool PERM = true, AFTER_DRAIN = false;
    static __device__ __forceinline__ bool keep(const pg8::Unit&) { return false; }
    unsigned char* ws;
    __device__ __forceinline__ void operator()(const pg8::f32x4 (&acc)[2][2][4][2], const pg8::Unit& u, int wr, int wc, int fr, int fq) const {
        const int pn = u.pn, row0 = u.pm * 256 + wr * 64 + fr;
        if (pn == 44) {
            float* X = (float*)(ws + WS_XWA);
#pragma unroll
            for (int ai = 0; ai < 2; ++ai)
#pragma unroll
                for (int m = 0; m < 4; ++m) { float* rp = X + (size_t)(row0 + ai * 128 + m * 16) * 128 + wc * 32 + 8 * fq;
                    *(f32x4*)rp = acc[ai][0][m][0]; *(f32x4*)(rp + 4) = acc[ai][0][m][1]; }
            return;
        }
        bf16* base; int ld, colt, act;
        if (pn < 12) { base = (bf16*)(ws + WS_U); ld = 3072; colt = pn * 256; act = 0; }
        else if (pn < 16) { base = (bf16*)(ws + WS_Z); ld = 1024; colt = (pn - 12) * 256; act = 1; }
        else if (pn < 20) { base = (bf16*)(ws + WS_XB); ld = 1024; colt = (pn - 16) * 256; act = 0; }
        else if (pn < 24) { base = (bf16*)(ws + WS_Z) + ZSTRIDE; ld = 1024; colt = (pn - 20) * 256; act = 1; }
        else if (pn < 28) { base = (bf16*)(ws + WS_Q); ld = 1024; colt = (pn - 24) * 256; act = 0; }
        else if (pn < 32) { base = (bf16*)(ws + WS_Z) + 2 * ZSTRIDE; ld = 1024; colt = (pn - 28) * 256; act = 1; }
        else { base = (bf16*)(ws + WS_G); ld = 3072; colt = (pn - 32) * 256; act = 2; }
        const int col0 = colt + wc * 32 + 8 * fq;
#pragma unroll
        for (int ai = 0; ai < 2; ++ai)
#pragma unroll
            for (int m = 0; m < 4; ++m) { bf16* rowp = base + (size_t)(row0 + ai * 128 + m * 16) * ld + col0;
#pragma unroll
                for (int bj = 0; bj < 2; ++bj) { pg8::f32x4 v0 = acc[ai][bj][m][0], v1 = acc[ai][bj][m][1];
                    if (act) {
#pragma unroll
                        for (int j = 0; j < 4; ++j) { const float s0 = sigm(v0[j]), s1 = sigm(v1[j]); v0[j] = act == 1 ? v0[j] * s0 : s0; v1[j] = act == 1 ? v1[j] * s1 : s1; } }
                    u32x4 w; w.x = pk2(v0[0], v0[1]); w.y = pk2(v0[2], v0[3]); w.z = pk2(v1[0], v1[1]); w.w = pk2(v1[2], v1[3]);
                    *(u32x4*)(rowp + bj * 128) = w; } }
    }
};
struct EpiMem {
    static constexpr bool PERM = false, AFTER_DRAIN = false;
    static __device__ __forceinline__ bool keep(const pg8::Unit&) { return false; }
    unsigned char* ws; float* out;
    __device__ __forceinline__ void operator()(const pg8::f32x4 (&acc)[2][2][4][2], const pg8::Unit& u, int wr, int wc, int fr, int fq) const {
        const int row0 = u.pm * 256 + wr * 64 + fr; const bool isv = u.pn >= 4; const int colt = (u.pn & 3) * 256 + wc * 32 + 4 * fq;
        float* of = out + (isv ? O_MVP : O_MKP); bf16* MK = (bf16*)(ws + WS_MK); bf16* MVT = (bf16*)(ws + WS_MVT);
#pragma unroll
        for (int ai = 0; ai < 2; ++ai)
#pragma unroll
            for (int m = 0; m < 4; ++m) { const int r = row0 + ai * 128 + m * 16;
#pragma unroll
                for (int bj = 0; bj < 2; ++bj)
#pragma unroll
                    for (int n = 0; n < 2; ++n) { const int c = colt + bj * 128 + n * 16; const pg8::f32x4 v = acc[ai][bj][m][n];
                        *(f32x4*)(of + (size_t)r * 1024 + c) = v;
                        if (!isv) { u32x2 w; w.x = pk2(v[0], v[1]); w.y = pk2(v[2], v[3]); *(u32x2*)(MK + (size_t)r * 1024 + c) = w; }
                        else { const int b = r >> 8, mem = r & 255, head = c >> 8, d = c & 255; bf16* q = MVT + ((size_t)((b * 4 + head) * 256 + d)) * 256 + mem;
                            q[0] = (bf16)f2bf(v[0]); q[256] = (bf16)f2bf(v[1]); q[512] = (bf16)f2bf(v[2]); q[768] = (bf16)f2bf(v[3]); } } }
    }
};
struct SchedMem { int c;
    __device__ bool next(int i, pg8::Unit& u) const { if (i != 0 || c >= 64) return false; u.pm = c >> 3; u.pn = c & 7; return true; }
    __device__ __forceinline__ void a_ready(const pg8::Unit&) const {}
    __device__ __forceinline__ void done(const pg8::Unit&) const {}
};
struct EpiTail {
    static constexpr bool PERM = true, AFTER_DRAIN = false;
    static __device__ __forceinline__ bool keep(const pg8::Unit& nxt) { return (nxt.pn >> 2) != 0; }
    unsigned char* ws;
    __device__ __forceinline__ void operator()(pg8::f32x4 (&acc)[2][2][4][2], const pg8::Unit& u, int wr, int wc, int fr, int fq) const {
        const int br = u.pn >> 2, pmm = u.pm - br * 68, pnn = u.pn & 3;
        const int row0 = pmm * 256 + wr * 64 + fr, col0 = pnn * 256 + wc * 32 + 8 * fq;
        const bf16* gbase = (const bf16*)(ws + WS_G) + (size_t)row0 * 3072 + br * 1024 + col0; const int hoff = br < 2 ? 1024 : 0; const bool last = br == 2;
#define MK_CLAMP8(g, f0, f1) pg8::f32x4 f0 = {fmaxf(bflo(g.x), 1e-20f), fmaxf(bfhi(g.x), 1e-20f), fmaxf(bflo(g.y), 1e-20f), fmaxf(bfhi(g.y), 1e-20f)}, f1 = {fmaxf(bflo(g.z), 1e-20f), fmaxf(bfhi(g.z), 1e-20f), fmaxf(bflo(g.w), 1e-20f), fmaxf(bfhi(g.w), 1e-20f)}
#pragma unroll
        for (int ai = 0; ai < 2; ++ai)
#pragma unroll
            for (int m = 0; m < 4; ++m) {
#pragma unroll
                for (int bj = 0; bj < 2; ++bj) { const bf16* gp = gbase + (size_t)(ai * 128 + m * 16) * 3072 + bj * 128; const u32x4 g = *(const u32x4*)gp, h = *(const u32x4*)(gp + hoff);
                    MK_CLAMP8(g, f0, f1); MK_CLAMP8(h, d0, d1);
#pragma unroll
                    for (int j = 0; j < 4; ++j) { d0[j] = last ? 1.0f : __builtin_amdgcn_rcpf(d0[j]); d1[j] = last ? 1.0f : __builtin_amdgcn_rcpf(d1[j]); }
                    acc[ai][bj][m][0] *= f0 * d0; acc[ai][bj][m][1] *= f1 * d1; }
                asm volatile("" ::: "memory"); }
#undef MK_CLAMP8
        if (last) { bf16* mbase = (bf16*)(ws + WS_MERGED) + (size_t)row0 * 1024 + col0;
#pragma unroll
            for (int ai = 0; ai < 2; ++ai)
#pragma unroll
                for (int m = 0; m < 4; ++m)
#pragma unroll
                    for (int bj = 0; bj < 2; ++bj) { const pg8::f32x4 v0 = acc[ai][bj][m][0], v1 = acc[ai][bj][m][1];
                        u32x4 w; w.x = pk2(v0[0], v0[1]); w.y = pk2(v0[2], v0[3]); w.z = pk2(v1[0], v1[1]); w.w = pk2(v1[2], v1[3]); *(u32x4*)(mbase + (size_t)(ai * 128 + m * 16) * 1024 + bj * 128) = w; } }
    }
};
struct SchedTail { int c;
    __device__ bool next(int i, pg8::Unit& u) const { if (i >= 3) return false; const int t = (c & 7) * 32 + (c >> 3); u.pm = i * 68 + (t >> 2); u.pn = i * 4 + (t & 3); return true; }
    __device__ __forceinline__ void a_ready(const pg8::Unit&) const {}
    __device__ __forceinline__ void done(const pg8::Unit&) const {}
};
struct EpiPart {
    static constexpr bool PERM = false, AFTER_DRAIN = false;
    static __device__ __forceinline__ bool keep(const pg8::Unit&) { return false; }
    unsigned char* ws;
    __device__ __forceinline__ void operator()(const pg8::f32x4 (&acc)[2][2][4][2], const pg8::Unit& u, int wr, int wc, int fr, int fq) const {
        const int br = u.pn >> 2, pmm = u.pm - br * 68 - 64, pnn = u.pn & 3, kq = u.ko >> 8;
        const int row0 = pmm * 256 + wr * 64 + fr, col0 = pnn * 256 + wc * 32 + 4 * fq;
        float* P = (float*)(ws + WS_P) + (size_t)(kq * 3 + br) * 1048576;
#pragma unroll
        for (int ai = 0; ai < 2; ++ai)
#pragma unroll
            for (int m = 0; m < 4; ++m) { float* rowp = P + (size_t)(row0 + ai * 128 + m * 16) * 1024 + col0;
#pragma unroll
                for (int bj = 0; bj < 2; ++bj)
#pragma unroll
                    for (int n = 0; n < 2; ++n) *(f32x4*)(rowp + bj * 128 + n * 16) = acc[ai][bj][m][n]; }
    }
};
struct SchedBrS { int c;
    __device__ bool next(int i, pg8::Unit& u) const { if (i != 0 || c >= 192) return false; const int kq = c & 3, idx = c >> 2, br = idx >> 4, t = idx & 15; u.pm = br * 68 + 64 + (t >> 2); u.pn = br * 4 + (t & 3); u.ko = kq * 256; return true; }
    __device__ __forceinline__ void a_ready(const pg8::Unit&) const {}
    __device__ __forceinline__ void done(const pg8::Unit&) const {}
};
struct SchedOutS { int c;
    __device__ bool next(int i, pg8::Unit& u) const { if (i != 0 || c >= 64) return false; const int t = c >> 2; u.pm = 64 + (t >> 2); u.pn = t & 3; u.ko = (c & 3) * 256; return true; }
    __device__ __forceinline__ void a_ready(const pg8::Unit&) const {}
    __device__ __forceinline__ void done(const pg8::Unit&) const {}
};
constexpr size_t WS_YP = WS_P + 48 * MiB;
struct EpiPartY {
    static constexpr bool PERM = false, AFTER_DRAIN = false;
    static __device__ __forceinline__ bool keep(const pg8::Unit&) { return false; }
    unsigned char* ws;
    __device__ __forceinline__ void operator()(const pg8::f32x4 (&acc)[2][2][4][2], const pg8::Unit& u, int wr, int wc, int fr, int fq) const {
        const int row0 = (u.pm - 64) * 256 + wr * 64 + fr, col0 = u.pn * 256 + wc * 32 + 4 * fq; float* P = (float*)(ws + WS_YP) + (size_t)(u.ko >> 8) * 1048576;
#pragma unroll
        for (int ai = 0; ai < 2; ++ai)
#pragma unroll
            for (int m = 0; m < 4; ++m) { float* rowp = P + (size_t)(row0 + ai * 128 + m * 16) * 1024 + col0;
#pragma unroll
                for (int bj = 0; bj < 2; ++bj)
#pragma unroll
                    for (int n = 0; n < 2; ++n) *(f32x4*)(rowp + bj * 128 + n * 16) = acc[ai][bj][m][n]; }
    }
};
struct EpiOut {
    static constexpr bool PERM = false, AFTER_DRAIN = false;
    static __device__ __forceinline__ bool keep(const pg8::Unit&) { return false; }
    const float* xp; const float* xs; float* out;
    __device__ __forceinline__ void operator()(const pg8::f32x4 (&acc)[2][2][4][2], const pg8::Unit& u, int wr, int wc, int fr, int fq) const {
        const int row0 = u.pm * 256 + wr * 64 + fr, col0 = u.pn * 256 + wc * 32 + 4 * fq;
#pragma unroll
        for (int ai = 0; ai < 2; ++ai)
#pragma unroll
            for (int m = 0; m < 4; ++m) { const int r = row0 + ai * 128 + m * 16; const float* xr = (r < NPT ? xp + (size_t)r * 1024 : xs + (size_t)(r - NPT) * 1024) + col0; float* orow = out + (size_t)r * 1024 + col0;
#pragma unroll
                for (int bj = 0; bj < 2; ++bj)
#pragma unroll
                    for (int n = 0; n < 2; ++n) *(f32x4*)(orow + bj * 128 + n * 16) = *(const f32x4*)(xr + bj * 128 + n * 16) + acc[ai][bj][m][n]; }
    }
};

__device__ __forceinline__ void transpose_item(const float* W, int K, int N, bf16* WT, int row_off, LAS float* scr, int item, int lane) {
    const int nblk = N / 32, kb = item / nblk, nb = item % nblk, k0 = 64 * kb, n0 = 32 * nb;
    float tv[32];
#pragma unroll
    for (int i = 0; i < 32; ++i) tv[i] = W[(size_t)(k0 + 2 * i + (lane >> 5)) * N + n0 + (lane & 31)];
#pragma unroll
    for (int i = 0; i < 32; ++i) scr[(2 * i + (lane >> 5)) * 33 + (lane & 31)] = tv[i];
    LDS_WAIT();
    const int c = lane & 7;
#pragma unroll
    for (int j = 0; j < 4; ++j) { const int n = (lane >> 3) + 8 * j; const LAS float* s = scr + (8 * c) * 33 + n;
        u32x4 o; o.x = pk2(s[0 * 33], s[1 * 33]); o.y = pk2(s[2 * 33], s[3 * 33]); o.z = pk2(s[4 * 33], s[5 * 33]); o.w = pk2(s[6 * 33], s[7 * 33]);
        *(u32x4*)(WT + (size_t)(row_off + n0 + n) * K + k0 + 8 * c) = o; }
    LDS_WAIT();
}
__device__ __forceinline__ void rms_row_to_bf16(const float* xrow, const float* g, bf16* orow, int lane) {
    const f32x4* xr = (const f32x4*)xrow + lane; const f32x4* gr = (const f32x4*)g + lane;
    f32x4 v[4]; float s = 0.f;
#pragma unroll
    for (int j = 0; j < 4; ++j) { v[j] = xr[64 * j]; s += (v[j].x * v[j].x + v[j].y * v[j].y) + (v[j].z * v[j].z + v[j].w * v[j].w); }
    const float rstd = rsqrtf(wave_sum(s) * (1.f / 1024.f) + 1e-6f);
    unsigned long long* o8 = (unsigned long long*)orow + lane;
#pragma unroll
    for (int j = 0; j < 4; ++j) { const f32x4 gg = gr[64 * j]; o8[64 * j] = (unsigned long long)pk2(v[j].x * rstd * gg.x, v[j].y * rstd * gg.y) | ((unsigned long long)pk2(v[j].z * rstd * gg.z, v[j].w * rstd * gg.w) << 32); }
}
__device__ __forceinline__ void p0_prologue(PREF p, LAS unsigned char* lds, int tid, int wave, int lane, int G) {
    unsigned char* ws = p.ws;
    LAS float* scr = (LAS float*)(lds + wave * 16384);
    const int gw = blockIdx.x * 8 + wave, NGW = G * 8;
    bf16* WIN = (bf16*)(ws + WS_WIN);
    constexpr int I_IN = 16 * 356, I_MM = 16 * 64, I_B = 16 * 32, I_L = 32, I_R = 2;
    constexpr int NITEMS = I_IN + I_MM + 4 * I_B + 2 * I_L + 32 * I_R;
    for (int it = gw; it < NITEMS; it += NGW) {
        int r = it;
        if (r < I_IN) { const int n0 = 32 * (r % 356); const int dst = n0 < 3072 ? n0 : (n0 < 3200 ? 11264 + n0 - 3072 : n0 - 128); transpose_item(p.in[I_WIN], 1024, 11392, WIN, dst - n0, scr, r, lane); continue; } r -= I_IN;
        if (r < I_MM) { transpose_item(p.in[I_WMEM], 1024, 2048, WIN + (size_t)11520 * 1024, 0, scr, r, lane); continue; } r -= I_MM;
        if (r < 3 * I_B) { const int br = r / I_B; const float* wa = opq(p.in[I_WBA]); const float* wb = opq(p.in[I_WBB]); const float* wc = opq(p.in[I_WBC]); transpose_item(br == 0 ? wa : (br == 1 ? wb : wc), 1024, 1024, (bf16*)(ws + WS_WBR) + (size_t)br * 1024 * 1024, 0, scr, r - br * I_B, lane); continue; } r -= 3 * I_B;
        if (r < I_B) { transpose_item(p.in[I_WOUT], 1024, 1024, (bf16*)(ws + WS_WOUT), 0, scr, r, lane); continue; } r -= I_B;
        if (r < I_L) { transpose_item(p.in[I_WDEC], 64, 1024, (bf16*)(ws + WS_WDEC), 0, scr, r, lane); continue; } r -= I_L;
        if (r < I_L) { transpose_item(p.in[I_WAAA], 64, 1024, (bf16*)(ws + WS_WAAA), 0, scr, r, lane); continue; } r -= I_L;
        { const int which = r / 32, rr = r % 32, g = rr >> 1, sub = rr & 1;
          const float* ra = opq(p.in[I_WRGA]); const float* rx = opq(p.in[I_WRGX]); transpose_item((which ? rx : ra) + g * 4096, 64, 64, (bf16*)(ws + (which ? WS_WRGX : WS_WRGA)) + g * 4096, 0, scr, sub, lane); }
    }
    if (blockIdx.x == 0) for (int i = tid; i < 8192; i += 512) ((unsigned*)(ws + WS_CTR))[i] = 0u;
    { u32x4* z = (u32x4*)(WIN + (size_t)11392 * 1024); const u32x4 zero = {0u, 0u, 0u, 0u}; for (int i = blockIdx.x * 512 + tid; i < 128 * 1024 / 8; i += G * 512) z[i] = zero; }
    bf16* XN = (bf16*)(ws + WS_XN);
    const float* pxp = opq(p.in[I_XP]); const float* pxs = opq(p.in[I_XS]); const float* pmem = opq(p.in[I_MEM]); const float* pgn = opq(p.in[I_GN]); const float* pgm = opq(p.in[I_GMEM]);
    for (int m0 = gw; m0 < NT + 2048; m0 += 2 * NGW) {
        const float* src[2]; const float* g[2]; bf16* dst[2]; f32x4 v[2][4]; float ss[2];
#pragma unroll
        for (int q = 0; q < 2; ++q) { int m = m0 + q * NGW; if (m >= NT + 2048) m = m0;
            if (m < NPT) { src[q] = pxp + (size_t)m * 1024; g[q] = pgn; } else if (m < NT) { src[q] = pxs + (size_t)(m - NPT) * 1024; g[q] = pgn; } else { src[q] = pmem + (size_t)(m - NT) * 1024; g[q] = pgm; }
            dst[q] = XN + (size_t)m * 1024; }
#pragma unroll
        for (int q = 0; q < 2; ++q) { const f32x4* xr = (const f32x4*)src[q] + lane; float s2 = 0.f;
#pragma unroll
            for (int j = 0; j < 4; ++j) { v[q][j] = xr[64 * j]; }
#pragma unroll
            for (int j = 0; j < 4; ++j) s2 += (v[q][j].x * v[q][j].x + v[q][j].y * v[q][j].y) + (v[q][j].z * v[q][j].z + v[q][j].w * v[q][j].w);
            ss[q] = s2; }
#pragma unroll
        for (int q = 0; q < 2; ++q) { const float rstd = rsqrtf(wave_sum(ss[q]) * (1.f / 1024.f) + 1e-6f); const f32x4* gr = (const f32x4*)g[q] + lane; unsigned long long* o8 = (unsigned long long*)dst[q] + lane;
#pragma unroll
            for (int j = 0; j < 4; ++j) { const f32x4 gg = gr[64 * j]; o8[64 * j] = (unsigned long long)pk2(v[q][j].x * rstd * gg.x, v[q][j].y * rstd * gg.y) | ((unsigned long long)pk2(v[q][j].z * rstd * gg.z, v[q][j].w * rstd * gg.w) << 32); } }
    }
}

__device__ __forceinline__ bf16x8 pack8(const float (&x)[8]) { u32x4 w; w.x = pk2(x[0], x[1]); w.y = pk2(x[2], x[3]); w.z = pk2(x[4], x[5]); w.w = pk2(x[6], x[7]); return __builtin_bit_cast(bf16x8, w); }
__device__ __forceinline__ void p2_lora(PREF p, int vb, int NB, int tid, int wave, int lane) {
    unsigned char* ws = p.ws;
    const float* XWA = (const float*)(ws + WS_XWA); const bf16* U = (const bf16*)(ws + WS_U); const bf16* XB = (const bf16*)(ws + WS_XB);
    const bf16* WDEC = (const bf16*)(ws + WS_WDEC); const bf16* WAAA = (const bf16*)(ws + WS_WAAA);
    bf16* E = (bf16*)p.out; bf16* A = E + ZSTRIDE;
    const float* mu = p.in[I_MU]; const float* w0 = p.in[I_W0]; const float* a0 = p.in[I_A0]; const float* ssh = p.in[I_SSH];
    const int trow = lane & 15, kg = lane >> 4;
    for (int item = vb * 8 + wave; item < NT / 16; item += NB * 8) {
        const int tok = item * 16 + trow; const bool prm = tok < NPT; const int s = prm ? (tok & 2047) : ((tok - NPT) & 7); const int bs = (tok - NPT) >> 3;
        bf16x8 Aw[2], Aa[2];
#pragma unroll
        for (int ks = 0; ks < 2; ++ks) { const int k0 = 32 * ks + 8 * kg; float xw[8], xa[8];
#pragma unroll
            for (int hlf = 0; hlf < 2; ++hlf) {
                const f32x4 cw = *(const f32x4*)(XWA + (size_t)tok * 128 + k0 + 4 * hlf), ca = *(const f32x4*)(XWA + (size_t)tok * 128 + 64 + k0 + 4 * hlf);
                f32x4 pw = {0.f, 0.f, 0.f, 0.f}, pa = {0.f, 0.f, 0.f, 0.f};
                if (s > 0) { pw = *(const f32x4*)(XWA + (size_t)(tok - 1) * 128 + k0 + 4 * hlf); pa = *(const f32x4*)(XWA + (size_t)(tok - 1) * 128 + 64 + k0 + 4 * hlf); }
                else if (!prm) { pw = *(const f32x4*)(ssh + (size_t)bs * 3200 + 3072 + k0 + 4 * hlf); pa = *(const f32x4*)(ssh + (size_t)bs * 3200 + 3136 + k0 + 4 * hlf); }
                const f32x4 mw = *(const f32x4*)(mu + 3072 + k0 + 4 * hlf), ma = *(const f32x4*)(mu + 3136 + k0 + 4 * hlf);
#pragma unroll
                for (int j = 0; j < 4; ++j) { const float xs = cw[j] + (pw[j] - cw[j]) * mw[j]; xw[4 * hlf + j] = 1.0f - 2.0f / (1.0f + __expf(2.0f * xs)); xa[4 * hlf + j] = ca[j] + (pa[j] - ca[j]) * ma[j]; }
            }
            Aw[ks] = pack8(xw); Aa[ks] = pack8(xa); }
        const size_t orow = (size_t)(item * 16 + trow) * 1024 + 4 * kg;
#pragma unroll 4
        for (int ct = 0; ct < 64; ++ct) { const int n = 16 * ct + trow;
            const bf16x8 bd0 = *(const bf16x8*)(WDEC + n * 64 + 8 * kg), bd1 = *(const bf16x8*)(WDEC + n * 64 + 32 + 8 * kg), ba0 = *(const bf16x8*)(WAAA + n * 64 + 8 * kg), ba1 = *(const bf16x8*)(WAAA + n * 64 + 32 + 8 * kg);
            f32x4 ad = {0.f, 0.f, 0.f, 0.f}, aa = {0.f, 0.f, 0.f, 0.f};
            ad = __builtin_amdgcn_mfma_f32_16x16x32_bf16(bd0, Aw[0], ad, 0, 0, 0); ad = __builtin_amdgcn_mfma_f32_16x16x32_bf16(bd1, Aw[1], ad, 0, 0, 0);
            aa = __builtin_amdgcn_mfma_f32_16x16x32_bf16(ba0, Aa[0], aa, 0, 0, 0); aa = __builtin_amdgcn_mfma_f32_16x16x32_bf16(ba1, Aa[1], aa, 0, 0, 0);
            const f32x4 w0v = *(const f32x4*)(w0 + 16 * ct + 4 * kg), a0v = *(const f32x4*)(a0 + 16 * ct + 4 * kg);
            u32x2 ev, av; ev.x = pk2(0.60653066f * sigm(w0v[0] + ad[0]), 0.60653066f * sigm(w0v[1] + ad[1])); ev.y = pk2(0.60653066f * sigm(w0v[2] + ad[2]), 0.60653066f * sigm(w0v[3] + ad[3]));
            av.x = pk2(sigm(a0v[0] + aa[0]), sigm(a0v[1] + aa[1])); av.y = pk2(sigm(a0v[2] + aa[2]), sigm(a0v[3] + aa[3]));
            *(u32x2*)(E + orow + 16 * ct) = ev; *(u32x2*)(A + orow + 16 * ct) = av; }
    }
    float* out = p.out; const int gt = vb * 512 + tid, ngt = NB * 512;
    for (int i = gt; i < 136 * 3200; i += ngt) { const int b = i / 3200, c = i - b * 3200; const int tok = b < 8 ? b * 2048 + 2047 : NPT + (b - 8) * 8 + 7;
        const float v = c < 3072 ? bf2f(U[(size_t)tok * 3072 + c]) : XWA[(size_t)tok * 128 + c - 3072];
        out[(b < 8 ? O_SHP + (size_t)b * 3200 : O_SHS + (size_t)(b - 8) * 3200) + c] = v; }
    for (int i = gt; i < 136 * 3072; i += ngt) { const int b = i / 3072, r = i - b * 3072, j = r >> 10, c = r & 1023; const int tok = b < 8 ? b * 2048 + 2045 + j : NPT + (b - 8) * 8 + 5 + j;
        out[(b < 8 ? O_CVP + (size_t)b * 3072 : O_CVS + (size_t)(b - 8) * 3072) + r] = bf2f(XB[(size_t)tok * 1024 + c]); }
}

constexpr int CH = 32;
constexpr int BUF_F = 6 * CH * 64;
constexpr int RW_LDS_OST = 2 * BUF_F * 4;
constexpr int OST_F = CH * 128;
struct Seg { int tok0, h, half; bool first, last; const float* S0; float* Sout; const float* shift0; };
__device__ __forceinline__ Seg get_seg(const float* srw, const float* ssh, float* out, int mode, int it0, int c, int j) {
    Seg g;
    if (mode == 0) { const int b = it0 >> 5; g.h = (it0 >> 1) & 15; g.half = it0 & 1; g.tok0 = b * 2048 + CH * c + 8 * j; g.first = (c == 0 && j == 0); g.last = (c == 2048 / CH - 1 && j == 3);
        g.S0 = nullptr; g.shift0 = nullptr; g.Sout = out + O_RWP + (size_t)(b * 16 + g.h) * 4096; }
    else { const int it = it0 + 4 * c + j, b = it >> 5; g.h = (it >> 1) & 15; g.half = it & 1; g.tok0 = NPT + b * 8; g.first = true; g.last = true;
        g.S0 = srw + (size_t)(b * 16 + g.h) * 4096; g.shift0 = ssh + (size_t)b * 3200; g.Sout = out + O_RWS + (size_t)(b * 16 + g.h) * 4096; }
    return g;
}
__device__ __forceinline__ void rwkv_prep(PREF p, LAS float* buf, const Seg g, int lw, int lane) {
    unsigned char* ws = p.ws;
    const bf16* U = (const bf16*)(ws + WS_U); const bf16* E = (const bf16*)p.out; const bf16* A = E + ZSTRIDE; float* BON = (float*)(ws + WS_BONUS);
    const int C = g.h * 64 + lane;
    const float mur = p.in[I_MU][C], muk = p.in[I_MU][1024 + C], muv = p.in[I_MU][2048 + C], kkc = p.in[I_KK][C], kac = p.in[I_KA][C], rkc = p.in[I_RK][C];
    float pr = 0.f, pk = 0.f, pv = 0.f;
    if (g.first) { if (g.shift0) { pr = g.shift0[C]; pk = g.shift0[1024 + C]; pv = g.shift0[2048 + C]; } }
    else { const bf16* up = U + (size_t)(g.tok0 - 1) * 3072 + C; pr = bf2f(up[0]); pk = bf2f(up[1024]); pv = bf2f(up[2048]); }
    bf16 ur[8], uk[8], uv[8], ee[8], aa[8];
#pragma unroll
    for (int i = 0; i < 8; ++i) { const size_t tok = (size_t)(g.tok0 + i); const bf16* up = U + tok * 3072 + C; ur[i] = up[0]; uk[i] = up[1024]; uv[i] = up[2048]; ee[i] = E[tok * 1024 + C]; aa[i] = A[tok * 1024 + C]; }
    float r8[8], kr8[8], kp8[8], v8[8], a8[8], dc8[8], xs[8], ys[8];
#pragma unroll
    for (int i = 0; i < 8; ++i) {
        const float fr = bf2f(ur[i]), fk = bf2f(uk[i]), fv = bf2f(uv[i]), e = bf2f(ee[i]), a = bf2f(aa[i]);
        const float r = fr + (pr - fr) * mur, k = fk + (pk - fk) * muk, v = fv + (pv - fv) * muv; pr = fr; pk = fk; pv = fv;
        const float kr = k * kkc, kp = k * (1.0f + (a - 1.0f) * kac);
        r8[i] = r; kr8[i] = kr; kp8[i] = kp; v8[i] = v; a8[i] = a; dc8[i] = __expf(-e); xs[i] = kr * kr; ys[i] = r * kp * rkc; }
    const bool b0 = (lane & 1) != 0, b1 = (lane & 2) != 0, b2 = (lane & 4) != 0, b3 = (lane & 8) != 0;
    float w8[8], u4[4], p2[2], f;
#pragma unroll
    for (int j = 0; j < 8; ++j) { const float keep = b0 ? ys[j] : xs[j], send = b0 ? xs[j] : ys[j]; w8[j] = keep + dppf<0xB1>(send); }
#pragma unroll
    for (int j = 0; j < 4; ++j) { const float keep = b1 ? w8[2 * j + 1] : w8[2 * j], send = b1 ? w8[2 * j] : w8[2 * j + 1]; u4[j] = keep + dppf<0x4E>(send); }
#pragma unroll
    for (int j = 0; j < 2; ++j) { const float keep = b2 ? u4[2 * j + 1] : u4[2 * j], send = b2 ? u4[2 * j] : u4[2 * j + 1];
        const int si = __builtin_bit_cast(int, send); int t = __builtin_amdgcn_update_dpp(si, si, 0x104, 0xF, 0x5, false); t = __builtin_amdgcn_update_dpp(t, si, 0x114, 0xF, 0xA, false);
        p2[j] = keep + __builtin_bit_cast(float, t); }
    { const float keep = b3 ? p2[1] : p2[0], send = b3 ? p2[0] : p2[1]; f = keep + dppf<0x128>(send); }
    f += __shfl_xor(f, 16); f += __shfl_xor(f, 32);
#pragma unroll
    for (int i = 0; i < 8; ++i) {
        const int s = 8 * lw + i; const float ss = rdl(f, 2 * i); const float kk = kr8[i] * __builtin_amdgcn_rsqf(ss + 1e-12f);
        LAS float* bp = buf + s * 64 + lane;
        bp[0] = dc8[i]; bp[CH * 64] = kk * a8[i]; bp[2 * CH * 64] = kp8[i]; bp[3 * CH * 64] = kk; bp[4 * CH * 64] = r8[i]; bp[5 * CH * 64] = v8[i]; }
    if (g.half == 0 && lane < 16 && b0) BON[(size_t)(g.tok0 + (lane >> 1)) * 16 + g.h] = f;
}
__device__ __forceinline__ void rwkv_oout(PREF p, const LAS float* ost, const Seg g, int ltid) {
    unsigned char* ws = p.ws; bf16* ORAW = (bf16*)(ws + WS_ORAW); float* ST = (float*)(ws + WS_STATS);
    const int s = ltid >> 3, q = ltid & 7;
    f32x4 o; { const LAS f32x4* pp = (const LAS f32x4*)(ost + s * 128 + q * 16);
      const f32x4 a0 = pp[0], a1 = pp[1], b0 = pp[2], b1 = pp[3]; o.x = (a0.x + a0.z) + (a1.x + a1.z); o.y = (a0.y + a0.w) + (a1.y + a1.w); o.z = (b0.x + b0.z) + (b1.x + b1.z); o.w = (b0.y + b0.w) + (b1.y + b1.w); }
    float sm = (o.x + o.y) + (o.z + o.w), sq = (o.x * o.x + o.y * o.y) + (o.z * o.z + o.w * o.w);
    sm += dppf<0xB1>(sm); sq += dppf<0xB1>(sq); sm += dppf<0x4E>(sm); sq += dppf<0x4E>(sq); sm += dppf<0x141>(sm); sq += dppf<0x141>(sq);
    const size_t tok = (size_t)(g.tok0 + (s & 7)); u32x2 w; w.x = pk2(o.x, o.y); w.y = pk2(o.z, o.w); *(u32x2*)(ORAW + tok * 1024 + g.h * 64 + 32 * g.half + 4 * q) = w;
    if (q == 0) *(f32x2*)(ST + ((tok * 16 + g.h) * 2 + g.half) * 2) = (f32x2){sm, sq};
}
struct ScanOps { f32x4 w4, b4, k4, kk4, r4; f32x2 v2; };
__device__ __forceinline__ ScanOps scan_load(const LAS float* buf, int s, int kl, int voff) { ScanOps o; const LAS float* bp = buf + s * 64 + 4 * kl;
    o.w4 = *(const LAS f32x4*)bp; o.b4 = *(const LAS f32x4*)(bp + CH * 64); o.k4 = *(const LAS f32x4*)(bp + 2 * CH * 64); o.kk4 = *(const LAS f32x4*)(bp + 3 * CH * 64); o.r4 = *(const LAS f32x4*)(bp + 4 * CH * 64);
    o.v2 = *(const LAS f32x2*)(buf + 5 * CH * 64 + s * 64 + voff); return o; }
__device__ __forceinline__ void rwkv_run(PREF p, LAS unsigned char* lds, int tid, int wave, int lane, int mode, int it0, int nch) {
    LAS float* bufs = (LAS float*)lds; LAS float* osts = (LAS float*)(lds + RW_LDS_OST);
    const float* srw = p.in[I_SRW]; const float* ssh = p.in[I_SSH]; float* out = p.out;
    const bool scan = wave < 4; const int rl = lane >> 4, kl = lane & 15, roff = 8 * wave + 2 * rl;
    f32x4 Sa = {0.f, 0.f, 0.f, 0.f}, Sb = Sa; f32x4 Na[4], Nb[4], Ma[4], Mb[4];
#pragma unroll
    for (int j = 0; j < 4; ++j) { Na[j] = Sa; Nb[j] = Sa; Ma[j] = Sa; Mb[j] = Sa; }
    if (scan) {
#pragma unroll
        for (int j = 0; j < 4; ++j) { const Seg g = get_seg(srw, ssh, out, mode, it0, 0, j); if (g.S0) { const int row = 32 * g.half + roff; Na[j] = *(const f32x4*)(g.S0 + row * 64 + 4 * kl); Nb[j] = *(const f32x4*)(g.S0 + (row + 1) * 64 + 4 * kl); } } }
    else rwkv_prep(p, bufs, get_seg(srw, ssh, out, mode, it0, 0, wave - 4), wave - 4, lane);
    __syncthreads();
    for (int c = 0; c < nch; ++c) {
        if (scan) {
            const LAS float* buf = bufs + (c & 1) * BUF_F; LAS float* ost = osts + (c & 1) * OST_F;
            ScanOps cur = scan_load(buf, 0, kl, 32 * get_seg(srw, ssh, out, mode, it0, c, 0).half + roff);
            if (c + 1 < nch) {
#pragma unroll
                for (int j = 0; j < 4; ++j) { const Seg n = get_seg(srw, ssh, out, mode, it0, c + 1, j); if (n.S0) { const int row = 32 * n.half + roff; Ma[j] = *(const f32x4*)(n.S0 + row * 64 + 4 * kl); Mb[j] = *(const f32x4*)(n.S0 + (row + 1) * 64 + 4 * kl); } } }
#pragma unroll
            for (int j = 0; j < 4; ++j) {
                const Seg g = get_seg(srw, ssh, out, mode, it0, c, j);
                if (g.first) { Sa = Na[j]; Sb = Nb[j]; }
                const int nh = get_seg(srw, ssh, out, mode, it0, c, j < 3 ? j + 1 : j).half;
#pragma unroll
                for (int i = 0; i < 8; ++i) {
                    const int s = 8 * j + i;
                    const int sn = s + 1 < CH ? s + 1 : s; const ScanOps nxt = scan_load(buf, sn, kl, 32 * (i == 7 && j < 3 ? nh : g.half) + roff);
                    const f32x2 kkL = __builtin_shufflevector(cur.kk4, cur.kk4, 0, 1), kkH = __builtin_shufflevector(cur.kk4, cur.kk4, 2, 3), wL = __builtin_shufflevector(cur.w4, cur.w4, 0, 1), wH = __builtin_shufflevector(cur.w4, cur.w4, 2, 3);
                    const f32x2 bL = __builtin_shufflevector(cur.b4, cur.b4, 0, 1), bH = __builtin_shufflevector(cur.b4, cur.b4, 2, 3), kL = __builtin_shufflevector(cur.k4, cur.k4, 0, 1), kH = __builtin_shufflevector(cur.k4, cur.k4, 2, 3);
                    const f32x2 rL = __builtin_shufflevector(cur.r4, cur.r4, 0, 1), rH = __builtin_shufflevector(cur.r4, cur.r4, 2, 3);
                    f32x2 SaL = __builtin_shufflevector(Sa, Sa, 0, 1), SaH = __builtin_shufflevector(Sa, Sa, 2, 3), SbL = __builtin_shufflevector(Sb, Sb, 0, 1), SbH = __builtin_shufflevector(Sb, Sb, 2, 3);
                    f32x2 ta = SaL * kkL; ta = __builtin_elementwise_fma(SaH, kkH, ta); f32x2 tb = SbL * kkL; tb = __builtin_elementwise_fma(SbH, kkH, tb);
                    float sa0 = ta.x + ta.y, sa1 = tb.x + tb.y;
                    sa0 += dppf<0xB1>(sa0); sa1 += dppf<0xB1>(sa1); sa0 += dppf<0x4E>(sa0); sa1 += dppf<0x4E>(sa1); sa0 += dppf<0x141>(sa0); sa1 += dppf<0x141>(sa1); sa0 += dppf<0x140>(sa0); sa1 += dppf<0x140>(sa1);
                    const f32x2 na = {-sa0, -sa0}, nb = {-sa1, -sa1}, va = {cur.v2.x, cur.v2.x}, vb = {cur.v2.y, cur.v2.y};
                    SaL = __builtin_elementwise_fma(va, kL, __builtin_elementwise_fma(na, bL, SaL * wL)); SaH = __builtin_elementwise_fma(va, kH, __builtin_elementwise_fma(na, bH, SaH * wH));
                    SbL = __builtin_elementwise_fma(vb, kL, __builtin_elementwise_fma(nb, bL, SbL * wL)); SbH = __builtin_elementwise_fma(vb, kH, __builtin_elementwise_fma(nb, bH, SbH * wH));
                    Sa = __builtin_shufflevector(SaL, SaH, 0, 1, 2, 3); Sb = __builtin_shufflevector(SbL, SbH, 0, 1, 2, 3);
                    f32x2 oa = SaL * rL; oa = __builtin_elementwise_fma(SaH, rH, oa); f32x2 ob = SbL * rL; ob = __builtin_elementwise_fma(SbH, rH, ob);
                    float o0 = oa.x + oa.y, o1 = ob.x + ob.y;
                    asm volatile("" : "+v"(o0), "+v"(o1));
                    o0 += dppf<0xB1>(o0); o1 += dppf<0xB1>(o1); o0 += dppf<0x4E>(o0); o1 += dppf<0x4E>(o1);
                    if ((kl & 3) == 0) *(LAS f32x2*)(ost + s * 128 + roff * 4 + (kl >> 2) * 2) = (f32x2){o0, o1};
                    cur = nxt;
                }
                if (g.last) { const int row = 32 * g.half + roff; *(f32x4*)(g.Sout + row * 64 + 4 * kl) = Sa; *(f32x4*)(g.Sout + (row + 1) * 64 + 4 * kl) = Sb; }
            }
#pragma unroll
            for (int j = 0; j < 4; ++j) { Na[j] = Ma[j]; Nb[j] = Mb[j]; }
        } else {
            if (c + 1 < nch) rwkv_prep(p, bufs + ((c + 1) & 1) * BUF_F, get_seg(srw, ssh, out, mode, it0, c + 1, wave - 4), wave - 4, lane);
            if (c >= 1) rwkv_oout(p, osts + ((c - 1) & 1) * OST_F, get_seg(srw, ssh, out, mode, it0, c - 1, (tid - 256) >> 6), tid - 256);
        }
        __syncthreads();
    }
    if (!scan) rwkv_oout(p, osts + ((nch - 1) & 1) * OST_F, get_seg(srw, ssh, out, mode, it0, nch - 1, (tid - 256) >> 6), tid - 256);
    __syncthreads();
}

template <int MODE> __device__ __forceinline__ void rglru_item(PREF p, LAS unsigned char* lds, int tid, int wave, int lane, int item, bool st) {
    asm volatile("" : "+v"(tid), "+v"(lane));
    constexpr int TPT = MODE ? 8 : 16, RC = 8 * TPT;
    unsigned char* ws = p.ws; const bf16* XB = (const bf16*)(ws + WS_XB); bf16* ZB = (bf16*)(ws + WS_Z) + ZSTRIDE;
    LAS float* XC = (LAS float*)lds; LAS float* GR = XC + RC * 65; LAS float* GI = GR + RC * 65; LAS bf16* XCB = (LAS bf16*)(GI + RC * 65); LAS float* TOT = (LAS float*)(XCB + RC * 72); LAS float* HC = TOT + 1024;
    const int c = tid & 63, sg = tid >> 6;
    const int g = MODE ? (item >> 4) : (item & 15), bb = MODE ? (8 * (item & 15) + sg) : (item >> 4), C = g * 64 + c;
    constexpr int nchunk = MODE ? 1 : 2048 / RC; const int rowtok = MODE ? (NPT + bb * 8) : (bb * 2048 + TPT * sg);
    const float cw0 = p.in[I_CW][C], cw1 = p.in[I_CW][1024 + C], cw2 = p.in[I_CW][2048 + C], cw3 = p.in[I_CW][3072 + C], cb = p.in[I_CB][C];
    const float sp = log1pf(__expf(-p.in[I_LAM][C]));
    const bf16* WT = (const bf16*)(ws + (wave >= 4 ? WS_WRGX : WS_WRGA)) + g * 4096; const float* bra = opq(p.in[I_BRGA]); const float* brx = opq(p.in[I_BRGX]); const float* bias = (wave >= 4 ? brx : bra) + g * 64;
    const int trow = lane & 15, kg = lane >> 4;
    bf16x8 wb0[4], wb1[4]; float bn[4];
#pragma unroll
    for (int ct = 0; ct < 4; ++ct) { const int n = 16 * ct + trow; wb0[ct] = *(const bf16x8*)(WT + n * 64 + 8 * kg); wb1[ct] = *(const bf16x8*)(WT + n * 64 + 32 + 8 * kg); bn[ct] = bias[n]; }
    float hin = 0.f; float e0 = 0.f, e1 = 0.f, e2 = 0.f;
    if (MODE) { hin = p.in[I_SLRU][(size_t)bb * 1024 + C]; const float* cv = p.in[I_SCV] + (size_t)bb * 3072 + C; e0 = cv[0]; e1 = cv[1024]; e2 = cv[2048]; }
    else { if (tid < 64) HC[c] = 0.f; if (sg > 0) { const bf16* xp = XB + (size_t)(rowtok - 3) * 1024 + C; e0 = bf2f(xp[0]); e1 = bf2f(xp[1024]); e2 = bf2f(xp[2048]); } }
    bf16 xn[TPT], zn[TPT];
#pragma unroll
    for (int i = 0; i < TPT; ++i) { xn[i] = XB[(size_t)(rowtok + i) * 1024 + C]; zn[i] = ZB[(size_t)(rowtok + i) * 1024 + C]; }
    for (int k = 0; k < nchunk; ++k) {
        const int tok = rowtok + RC * k;
        float zb[TPT];
#pragma unroll
        for (int i = 0; i < TPT; ++i) { const float e3 = bf2f(xn[i]); zb[i] = bf2f(zn[i]); const float xc = cb + e0 * cw0 + e1 * cw1 + e2 * cw2 + e3 * cw3;
            XC[(sg * TPT + i) * 65 + c] = xc; XCB[(sg * TPT + i) * 72 + c] = (bf16)f2bf(xc); e0 = e1; e1 = e2; e2 = e3; }
        if (k + 1 < nchunk) {
            const bf16* xp = XB + (size_t)(tok + RC - 3) * 1024 + C; e0 = bf2f(xp[0]); e1 = bf2f(xp[1024]); e2 = bf2f(xp[2048]);
#pragma unroll
            for (int i = 0; i < TPT; ++i) { xn[i] = XB[(size_t)(tok + RC + i) * 1024 + C]; zn[i] = ZB[(size_t)(tok + RC + i) * 1024 + C]; } }
        __syncthreads();
        { LAS float* GO = wave >= 4 ? GI : GR;
#pragma unroll
          for (int u = 0; u < RC / 64; ++u) { const int tt = (wave & 3) + 4 * u;
            const bf16x8 a0 = *(const LAS bf16x8*)(XCB + (16 * tt + trow) * 72 + 8 * kg), a1 = *(const LAS bf16x8*)(XCB + (16 * tt + trow) * 72 + 32 + 8 * kg);
#pragma unroll
            for (int ct = 0; ct < 4; ++ct) { const int n = 16 * ct + trow;
                f32x4 acc = {0.f, 0.f, 0.f, 0.f}; acc = __builtin_amdgcn_mfma_f32_16x16x32_bf16(a0, wb0[ct], acc, 0, 0, 0); acc = __builtin_amdgcn_mfma_f32_16x16x32_bf16(a1, wb1[ct], acc, 0, 0, 0);
#pragma unroll
                for (int r = 0; r < 4; ++r) GO[(16 * tt + 4 * kg + r) * 65 + n] = sigm(acc[r] + bn[ct]); } } }
        __syncthreads();
        float hl[TPT], cm[TPT]; { float h = 0.f, cum = 1.f;
#pragma unroll
          for (int i = 0; i < TPT; ++i) { const int s = sg * TPT + i; const float gr = GR[s * 65 + c], gi = GI[s * 65 + c], xc = XC[s * 65 + c];
              const float la = -8.0f * gr * sp, x2 = 2.0f * la;
              const float om = -x2 * (1.0f + x2 * 0.5f * (1.0f + x2 * (1.0f / 3.0f) * (1.0f + x2 * 0.25f * (1.0f + x2 * 0.2f * (1.0f + x2 * (1.0f / 6.0f) * (1.0f + x2 * (1.0f / 7.0f)))))));
              const float a = __expf(la), b = sqrtf(om) * gi * xc;
              h = a * h + b; cum *= a; hl[i] = h; cm[i] = cum; }
          if (!MODE) { TOT[sg * 64 + c] = cum; TOT[512 + sg * 64 + c] = h; } }
        if (!MODE) __syncthreads();
        { float h = hin;
          if (!MODE) { h = HC[(k & 1) * 64 + c]; for (int j = 0; j < sg; ++j) h = TOT[j * 64 + c] * h + TOT[512 + j * 64 + c]; }
          if (st) {
#pragma unroll
              for (int i = 0; i < TPT; ++i) ZB[(size_t)(tok + i) * 1024 + C] = (bf16)f2bf((hl[i] + cm[i] * h) * zb[i]); }
          const float hn = hl[TPT - 1] + cm[TPT - 1] * h;
          if (MODE) p.out[O_LRS + (size_t)bb * 1024 + C] = hn;
          else if (sg == 7) { HC[((k + 1) & 1) * 64 + c] = hn; if (k == nchunk - 1) p.out[O_LRP + (size_t)bb * 1024 + C] = hn; } }
    }
    __syncthreads();
}

constexpr int XA_STG = 128 * 528, XA_PL = 8448;
__device__ __forceinline__ void xa_stage(LAS unsigned char* lds, const bf16* src, size_t ld, int tid) {
#pragma unroll
    for (int i = 0; i < 8; ++i) { const int e = tid + 512 * i, row = e >> 5, seg = e & 31; *(LAS u32x4*)(lds + row * 528 + seg * 16) = *(const u32x4*)(src + (size_t)row * ld + seg * 8); }
}
__device__ __forceinline__ void xattn_prompt_item(PREF p, LAS unsigned char* lds, int tid, int wave, int lane, int item, bool st) {
    unsigned char* ws = p.ws; const bf16* Q = (const bf16*)(ws + WS_Q); const bf16* MK = (const bf16*)(ws + WS_MK); const bf16* MVT = (const bf16*)(ws + WS_MVT); bf16* ZC = (bf16*)(ws + WS_Z) + 2 * ZSTRIDE;
    LAS bf16* PL = (LAS bf16*)(lds + XA_STG + wave * XA_PL);
    const int qb = item & 15, head = (item >> 4) & 3, b = item >> 6, tok0 = b * 2048 + 128 * qb + 16 * wave, trow = lane & 15, kg = lane >> 4;
    bf16x8 qf[8];
#pragma unroll
    for (int ks = 0; ks < 8; ++ks) qf[ks] = *(const bf16x8*)(Q + (size_t)(tok0 + trow) * 1024 + head * 256 + 32 * ks + 8 * kg);
    f32x4 S[16];
#pragma unroll
    for (int hk = 0; hk < 2; ++hk) {
        __syncthreads();
        xa_stage(lds, MK + (size_t)(b * 256 + 128 * hk) * 1024 + head * 256, 1024, tid);
        __syncthreads();
#pragma unroll
        for (int mt = 0; mt < 8; ++mt) { f32x4 acc = {0.f, 0.f, 0.f, 0.f}; const LAS unsigned char* kp = lds + (16 * mt + trow) * 528 + kg * 16;
#pragma unroll
            for (int ks = 0; ks < 8; ++ks) acc = __builtin_amdgcn_mfma_f32_16x16x32_bf16(qf[ks], *(const LAS bf16x8*)(kp + ks * 64), acc, 0, 0, 0);
            S[8 * hk + mt] = acc; }
    }
    f32x4 mx = S[0];
#pragma unroll
    for (int mt = 1; mt < 16; ++mt) { mx.x = fmaxf(mx.x, S[mt].x); mx.y = fmaxf(mx.y, S[mt].y); mx.z = fmaxf(mx.z, S[mt].z); mx.w = fmaxf(mx.w, S[mt].w); }
    mx.x = row16_max(mx.x); mx.y = row16_max(mx.y); mx.z = row16_max(mx.z); mx.w = row16_max(mx.w);
    f32x4 sm = {0.f, 0.f, 0.f, 0.f};
#pragma unroll
    for (int mt = 0; mt < 16; ++mt) { f32x4 e; e.x = __expf((S[mt].x - mx.x) * 0.0625f); e.y = __expf((S[mt].y - mx.y) * 0.0625f); e.z = __expf((S[mt].z - mx.z) * 0.0625f); e.w = __expf((S[mt].w - mx.w) * 0.0625f);
        sm += e; const int col = 16 * mt + trow;
        PL[(4 * kg + 0) * 264 + col] = (bf16)f2bf(e.x); PL[(4 * kg + 1) * 264 + col] = (bf16)f2bf(e.y); PL[(4 * kg + 2) * 264 + col] = (bf16)f2bf(e.z); PL[(4 * kg + 3) * 264 + col] = (bf16)f2bf(e.w); }
    sm.x = row16_sum(sm.x); sm.y = row16_sum(sm.y); sm.z = row16_sum(sm.z); sm.w = row16_sum(sm.w);
    const f32x4 inv = {1.0f / sm.x, 1.0f / sm.y, 1.0f / sm.z, 1.0f / sm.w};
    LDS_WAIT();
    bf16x8 pf[8];
#pragma unroll
    for (int ks = 0; ks < 8; ++ks) pf[ks] = *(const LAS bf16x8*)(PL + trow * 264 + 32 * ks + 8 * kg);
#pragma unroll
    for (int hv = 0; hv < 2; ++hv) {
        __syncthreads();
        xa_stage(lds, MVT + ((size_t)((b * 4 + head) * 256 + 128 * hv)) * 256, 256, tid);
        __syncthreads();
#pragma unroll
        for (int dt = 0; dt < 8; ++dt) { f32x4 acc = {0.f, 0.f, 0.f, 0.f}; const LAS unsigned char* vp = lds + (16 * dt + trow) * 528 + kg * 16;
#pragma unroll
            for (int ks = 0; ks < 8; ++ks) acc = __builtin_amdgcn_mfma_f32_16x16x32_bf16(pf[ks], *(const LAS bf16x8*)(vp + ks * 64), acc, 0, 0, 0);
            acc = acc * inv; const int col = head * 256 + 128 * hv + 16 * dt + trow;
#pragma unroll
            for (int r = 0; r < 4; ++r) { bf16* zp = ZC + (size_t)(tok0 + 4 * kg + r) * 1024 + col; const bf16 nv = (bf16)f2bf(acc[r] * bf2f(*zp)); if (st) *zp = nv; } }
    }
    __syncthreads();
}

__device__ __forceinline__ void xattn_sample_item(PREF p, LAS unsigned char* lds, int tid, int wave, int lane, int item, bool st) {
    unsigned char* ws = p.ws; const bf16* Q = (const bf16*)(ws + WS_Q); bf16* ZC = (bf16*)(ws + WS_Z) + 2 * ZSTRIDE;
    LAS float* QS = (LAS float*)lds; LAS float* SC = QS + 2048; LAS float* PART = SC + 2048;
    const int b = item >> 2, head = item & 3, tok0 = NPT + b * 8;
    for (int i = tid; i < 2048; i += 512) QS[i] = bf2f(Q[(size_t)(tok0 + (i >> 8)) * 1024 + head * 256 + (i & 255)]);
    __syncthreads();
    const float* Vc = p.in[I_CV] + ((size_t)b * 256 * 4 + head) * 256 + 4 * lane;
    { const int kl = lane & 15, rq = lane >> 4; const float* Kc = p.in[I_CK] + ((size_t)b * 256 * 4 + head) * 256 + 4 * kl;
      f32x4 q[8][4];
#pragma unroll
      for (int i = 0; i < 8; ++i)
#pragma unroll
          for (int j = 0; j < 4; ++j) q[i][j] = *(const LAS f32x4*)(QS + i * 256 + 64 * j + 4 * kl);
#pragma unroll 2
      for (int r = 0; r < 8; ++r) { const int m = 32 * wave + 4 * r + rq; const f32x4* kp = (const f32x4*)(Kc + (size_t)m * 1024);
          const f32x4 k0 = kp[0], k1 = kp[16], k2 = kp[32], k3 = kp[48];
#pragma unroll
          for (int i = 0; i < 8; ++i) { f32x4 t = q[i][0] * k0 + q[i][1] * k1 + q[i][2] * k2 + q[i][3] * k3; float d = row16_sum((t.x + t.y) + (t.z + t.w));
              if (kl == i) SC[i * 256 + m] = d * 0.0625f; } } }
    __syncthreads();
    { float v[4]; float mx = -3.0e38f;
#pragma unroll
      for (int j = 0; j < 4; ++j) { v[j] = SC[wave * 256 + lane + 64 * j]; mx = fmaxf(mx, v[j]); }
      mx = wave_max(mx); float sm = 0.f;
#pragma unroll
      for (int j = 0; j < 4; ++j) { v[j] = __expf(v[j] - mx); sm += v[j]; }
      sm = wave_sum(sm); const float inv = 1.0f / sm;
#pragma unroll
      for (int j = 0; j < 4; ++j) SC[wave * 256 + lane + 64 * j] = v[j] * inv; }
    __syncthreads();
    { f32x4 acc[8];
#pragma unroll
      for (int i = 0; i < 8; ++i) acc[i] = (f32x4){0.f, 0.f, 0.f, 0.f};
#pragma unroll 8
      for (int r = 0; r < 32; ++r) { const int m = 32 * wave + r; const f32x4 vv = *(const f32x4*)(Vc + (size_t)m * 1024);
#pragma unroll
          for (int i = 0; i < 8; ++i) acc[i] += SC[i * 256 + m] * vv; }
#pragma unroll
      for (int i = 0; i < 8; ++i) *(LAS f32x4*)(PART + (wave * 8 + i) * 256 + 4 * lane) = acc[i]; }
    __syncthreads();
    { const int q = tid >> 6, d = 4 * (tid & 63); f32x4 s = {0.f, 0.f, 0.f, 0.f};
#pragma unroll
      for (int w = 0; w < 8; ++w) s += *(const LAS f32x4*)(PART + (w * 8 + q) * 256 + d);
      u32x2* zp = (u32x2*)(ZC + (size_t)(tok0 + q) * 1024 + head * 256 + d); const u32x2 z = *zp;
      u32x2 o; o.x = pk2(s.x * bflo(z.x), s.y * bfhi(z.x)); o.y = pk2(s.z * bflo(z.y), s.w * bfhi(z.y)); if (st) *zp = o; }
    __syncthreads();
}

__device__ __forceinline__ void p4_post(PREF p, int tid, int G, bool stw) {
    unsigned char* ws = p.ws; const bf16* ORAW = (const bf16*)(ws + WS_ORAW); const bf16* U = (const bf16*)(ws + WS_U); bf16* ZA = (bf16*)(ws + WS_Z);
    const float* ST = (const float*)(ws + WS_STATS); const float* BON = (const float*)(ws + WS_BONUS);
    const float* muv = p.in[I_MU] + 2048; const float* gng = p.in[I_GNG]; const float* gnb = p.in[I_GNB]; const float* ssh = p.in[I_SSH];
    for (int i = blockIdx.x * 512 + tid; i < NT * 128; i += G * 512) {
        const int tok = i >> 7, c0 = (i & 127) * 8, h = c0 >> 6; const bool prm = tok < NPT; const int s = prm ? (tok & 2047) : ((tok - NPT) & 7); const int bs = (tok - NPT) >> 3;
        const f32x4 st = *(const f32x4*)(ST + ((size_t)tok * 16 + h) * 4);
        const float mean = (st.x + st.z) * (1.f / 64.f), var = (st.y + st.w) * (1.f / 64.f) - mean * mean, rstd = rsqrtf(fmaxf(var, 0.f) + 64e-5f), bon = BON[(size_t)tok * 16 + h];
        const u32x4 o = *(const u32x4*)(ORAW + (size_t)tok * 1024 + c0), z = *(const u32x4*)(ZA + (size_t)tok * 1024 + c0), vc = *(const u32x4*)(U + (size_t)tok * 3072 + 2048 + c0);
        float pv[8];
        if (s > 0) { const u32x4 vp = *(const u32x4*)(U + (size_t)(tok - 1) * 3072 + 2048 + c0); pv[0] = bflo(vp.x); pv[1] = bfhi(vp.x); pv[2] = bflo(vp.y); pv[3] = bfhi(vp.y); pv[4] = bflo(vp.z); pv[5] = bfhi(vp.z); pv[6] = bflo(vp.w); pv[7] = bfhi(vp.w); }
        else if (!prm) {
#pragma unroll
            for (int j = 0; j < 8; ++j) pv[j] = ssh[(size_t)bs * 3200 + 2048 + c0 + j]; }
        else {
#pragma unroll
            for (int j = 0; j < 8; ++j) pv[j] = 0.f; }
        const unsigned ow[4] = {o.x, o.y, o.z, o.w}, zw[4] = {z.x, z.y, z.z, z.w}, vw[4] = {vc.x, vc.y, vc.z, vc.w}; unsigned rw[4];
#pragma unroll
        for (int j = 0; j < 4; ++j) { float r2[2];
#pragma unroll
            for (int e = 0; e < 2; ++e) { const int c = c0 + 2 * j + e; const float ov = e ? bfhi(ow[j]) : bflo(ow[j]), zv = e ? bfhi(zw[j]) : bflo(zw[j]), uv = e ? bfhi(vw[j]) : bflo(vw[j]);
                const float v = uv + (pv[2 * j + e] - uv) * muv[c]; r2[e] = ((ov - mean) * rstd * gng[c] + gnb[c] + bon * v) * zv; }
            rw[j] = pk2(r2[0], r2[1]); }
        if (stw) *(u32x4*)(ZA + (size_t)tok * 1024 + c0) = (u32x4){rw[0], rw[1], rw[2], rw[3]};
    }
}
__device__ __forceinline__ void p5_sum(PREF p, int tid, int G) {
    unsigned char* ws = p.ws; const float* P = (const float*)(ws + WS_P); const bf16* Gt = (const bf16*)(ws + WS_G); bf16* M = (bf16*)(ws + WS_MERGED);
    for (int i = blockIdx.x * 512 + tid; i < 1024 * 128; i += G * 512) { const int rs = i >> 7, c0 = (i & 127) * 8; const size_t tok = (size_t)(NPT + rs);
        float o[8];
#pragma unroll
        for (int j = 0; j < 8; ++j) o[j] = 0.f;
#pragma unroll
        for (int br = 0; br < 3; ++br) { f32x4 a0 = {0.f, 0.f, 0.f, 0.f}, a1 = a0;
#pragma unroll
            for (int kq = 0; kq < 4; ++kq) { const float* pp = P + (size_t)(kq * 3 + br) * 1048576 + (size_t)rs * 1024 + c0; a0 += *(const f32x4*)pp; a1 += *(const f32x4*)(pp + 4); }
            const u32x4 g = *(const u32x4*)(Gt + tok * 3072 + br * 1024 + c0);
            o[0] += a0.x * bflo(g.x); o[1] += a0.y * bfhi(g.x); o[2] += a0.z * bflo(g.y); o[3] += a0.w * bfhi(g.y); o[4] += a1.x * bflo(g.z); o[5] += a1.y * bfhi(g.z); o[6] += a1.z * bflo(g.w); o[7] += a1.w * bfhi(g.w); }
        *(u32x4*)(M + tok * 1024 + c0) = (u32x4){pk2(o[0], o[1]), pk2(o[2], o[3]), pk2(o[4], o[5]), pk2(o[6], o[7])}; }
}
__device__ __forceinline__ void p6_norm(PREF p, int r0, int r1, int vb, int nvb, int wave, int lane) {
    const f32x4* gf = (const f32x4*)p.in[I_GF] + lane;
    for (int m = r0 + vb * 8 + wave; m < r1; m += nvb * 8) { f32x4* xr = (f32x4*)(p.out + (size_t)m * 1024) + lane; f32x4 v[4]; float s = 0.f;
#pragma unroll
        for (int j = 0; j < 4; ++j) { v[j] = xr[64 * j]; s += (v[j].x * v[j].x + v[j].y * v[j].y) + (v[j].z * v[j].z + v[j].w * v[j].w); }
        const float rstd = rsqrtf(wave_sum(s) * (1.f / 1024.f) + 1e-6f);
#pragma unroll
        for (int j = 0; j < 4; ++j) xr[64 * j] = v[j] * rstd * gf[64 * j]; }
}

__device__ __forceinline__ void p6s_norm(PREF p, int vb, int nvb, int wave, int lane) {
    const f32x4* gf = (const f32x4*)p.in[I_GF] + lane; const float* YP = (const float*)(p.ws + WS_YP);
    for (int m = vb * 8 + wave; m < 1024; m += nvb * 8) { const f32x4* xr = (const f32x4*)(p.in[I_XS] + (size_t)m * 1024) + lane; f32x4 v[4]; float s = 0.f;
#pragma unroll
        for (int j = 0; j < 4; ++j) { v[j] = xr[64 * j];
#pragma unroll
            for (int kq = 0; kq < 4; ++kq) v[j] += ((const f32x4*)(YP + (size_t)kq * 1048576 + (size_t)m * 1024) + lane)[64 * j];
            s += (v[j].x * v[j].x + v[j].y * v[j].y) + (v[j].z * v[j].z + v[j].w * v[j].w); }
        const float rstd = rsqrtf(wave_sum(s) * (1.f / 1024.f) + 1e-6f); f32x4* orow = (f32x4*)(p.out + (size_t)(NPT + m) * 1024) + lane;
#pragma unroll
        for (int j = 0; j < 4; ++j) orow[64 * j] = v[j] * rstd * gf[64 * j]; }
}

#define XB_TMO      128
#define XB_XCNT(j)  (256  + 64 * (j))
#define XB_XSUB(j)  (1280 + 64 * (j))
#define XB_XGEN(j)  (2304 + 64 * (j))
#define XB_TOP      3328
#define XB_TOPGEN   3392
#define XCD_BAR_WORDS 3456
#define XB_SPIN_CAP (1u << 18)

__device__ __forceinline__ unsigned xb_ld(unsigned* p)              { return __hip_atomic_load(p, __ATOMIC_RELAXED, __HIP_MEMORY_SCOPE_AGENT); }
__device__ __forceinline__ unsigned xb_add(unsigned* p, unsigned v) { return __hip_atomic_fetch_add(p, v, __ATOMIC_RELAXED, __HIP_MEMORY_SCOPE_AGENT); }
__device__ __forceinline__ unsigned xb_xcc_id() { return (unsigned)__builtin_amdgcn_s_getreg((3 << 11) | 20) & 0xFu; }
#define XB_SPIN(cond, bar) do { unsigned _sp = 0; while (cond) { __builtin_amdgcn_s_sleep(1); \
    if ((++_sp & 255u) == 0u) { if (xb_ld(&(bar)[XB_TMO])) break; if (_sp > XB_SPIN_CAP) { atomicAdd(&(bar)[XB_TMO], 1u); break; } } } } while (0)

struct XcdBarrier {
    unsigned* bar; unsigned x;
    volatile LAS unsigned* st;
};

__device__ __forceinline__ XcdBarrier xcd_barrier_post(unsigned* bar, volatile LAS unsigned* st) {
    XcdBarrier b; b.bar = bar; b.x = xb_xcc_id(); b.st = st;
    if (threadIdx.x == 0) (void)xb_add(&bar[XB_XCNT(b.x)], 1u);
    return b;
}
__device__ __forceinline__ void xcd_barrier_complete(unsigned* bar, unsigned x, unsigned& nloc, unsigned& nx) {
    const unsigned G = gridDim.x * gridDim.y * gridDim.z;
    unsigned sum, cnt, mine, sp = 0u;
    for (;;) {
        sum = 0u; cnt = 0u; mine = 0u;
#pragma unroll
        for (unsigned j = 0; j < 16; ++j) { const unsigned c = xb_ld(&bar[XB_XCNT(j)]); sum += c; cnt += (c > 0u) ? 1u : 0u; mine = (j == x) ? c : mine; }
        if (sum == G) break;
        __builtin_amdgcn_s_sleep(1);
        if ((++sp & 255u) == 0u) { if (xb_ld(&bar[XB_TMO])) break; if (sp > XB_SPIN_CAP) { atomicAdd(&bar[XB_TMO], 1u); break; } }
    }
    nloc = mine > 0u ? mine : 1u; nx = cnt > 0u ? cnt : 1u;
}

__device__ __forceinline__ void xcd_barrier(const XcdBarrier& b) {
    asm volatile("s_waitcnt vmcnt(0)" ::: "memory");
    __syncthreads();
    if (threadIdx.x == 0) {
        unsigned* bar = b.bar;
        __builtin_amdgcn_s_waitcnt(0);
        unsigned nloc = b.st[0], nx = b.st[1];
        if (nloc == 0u) { xcd_barrier_complete(bar, b.x, nloc, nx); b.st[0] = nloc; b.st[1] = nx; }
        const unsigned old = xb_add(&bar[XB_XSUB(b.x)], 1u);
        const unsigned gen = old / nloc;
        if (old + 1u == (gen + 1u) * nloc) {
            __builtin_amdgcn_fence(__ATOMIC_RELEASE, "agent");
            asm volatile("s_waitcnt vmcnt(0)" ::: "memory");
            const unsigned og = xb_add(&bar[XB_TOP], 1u);
            const unsigned tg = og / nx;
            if (og + 1u == (tg + 1u) * nx) xb_add(&bar[XB_TOPGEN], 1u);
            else XB_SPIN(xb_ld(&bar[XB_TOPGEN]) == tg, bar);
            __builtin_amdgcn_fence(__ATOMIC_ACQUIRE, "agent");
            xb_add(&bar[XB_XGEN(b.x)], 1u);
            asm volatile("s_waitcnt vmcnt(0)" ::: "memory");
        } else {
            XB_SPIN(xb_ld(&bar[XB_XGEN(b.x)]) == gen, bar);
            __builtin_amdgcn_fence(__ATOMIC_ACQUIRE, "agent");
            asm volatile("s_waitcnt vmcnt(0)" ::: "memory");
        }
    }
    __syncthreads();
}

#ifndef MK_LAST_PHASE
#define MK_LAST_PHASE 99
#endif
__global__ void __launch_bounds__(512, 2) fwd(Params p_arg) {
    extern __shared__ __attribute__((aligned(16))) unsigned char lds_raw[];
    LAS unsigned char* lds = (LAS unsigned char*)lds_raw;
    cg::grid_group grid = cg::this_grid();
    const int tid = threadIdx.x, lane = tid & 63, wave = __builtin_amdgcn_readfirstlane(tid >> 6), G = gridDim.x, bx = blockIdx.x;
    CParams* kp = (CParams*)__builtin_amdgcn_kernarg_segment_ptr();
    unsigned char* ws = kp->ws;
#define p (*launder(kp))
    if (tid < 8) ((LAS unsigned*)(lds + LDS_BYTES - 32))[tid] = 0u;
    __syncthreads();
#ifndef PROBE_DUP
#define PROBE_DUP 0
#endif
#define REP(n) for (int rep_ = (PROBE_DUP == (n) ? 0 : 1); rep_ < 2; ++rep_)
    REP(10) { p0_prologue(p, lds, tid, wave, lane, G); __syncthreads(); }
    grid.sync();
    const XcdBarrier xbar = xcd_barrier_post((unsigned*)(ws + WS_CTR) + 1024, (volatile LAS unsigned*)(lds + LDS_BYTES - 32));
    REP(1) { pg8::Gemm g{(const pg8::bf16_t*)(ws + WS_XN), (const pg8::bf16_t*)(ws + WS_WIN), NT, 11520, 1024}; pg8::StaticOrder S; S.init(NT, 11520, G, bx); EpiMain E{ws};
      pg8::gemm_phase<EpiMain, pg8::StaticOrder>((PG8_LAS unsigned char*)lds, g, S, E, nullptr); }
    xcd_barrier(xbar);
    REP(7) if (G >= 128) {
        if (bx < 64) { pg8::Gemm g{(const pg8::bf16_t*)(ws + WS_XN) + (size_t)NT * 1024, (const pg8::bf16_t*)(ws + WS_WIN) + (size_t)11520 * 1024, 2048, 2048, 1024}; SchedMem S{bx}; EpiMem E{ws, p.out};
            pg8::gemm_phase<EpiMem, SchedMem>((PG8_LAS unsigned char*)lds, g, S, E, nullptr); }
        else p2_lora(p, bx - 64, G - 64, tid, wave, lane);
    }
    xcd_barrier(xbar);
#ifndef PROBE_DUP
#define PROBE_DUP 0
#endif
    for (int rep = (PROBE_DUP == 2 ? 0 : 1); rep < 2; ++rep)
    for (int it = bx; it < 256; it += G) rwkv_run(p, lds, tid, wave, lane, 0, it, 2048 / CH);
    for (int rep = (PROBE_DUP == 3 ? 0 : 1); rep < 2; ++rep)
    for (int it = bx * 16; it < 4096; it += G * 16) rwkv_run(p, lds, tid, wave, lane, 1, it, 4);
    for (int rep = (PROBE_DUP == 4 ? 0 : 1); rep < 2; ++rep) { const bool st = (rep == 1) || (p.zero != 0);
        if (bx < 128) rglru_item<0>(p, lds, tid, wave, lane, bx, st); else { rglru_item<1>(p, lds, tid, wave, lane, bx - 128, st); rglru_item<1>(p, lds, tid, wave, lane, bx, st); } }
    { const bool st = true;
        LAS unsigned* slot = (LAS unsigned*)(lds + LDS_BYTES - 16); unsigned* ctr = (unsigned*)(ws + WS_CTR);
        for (;;) {
            if (tid == 0) *slot = atomicAdd(ctr, 1u);
            __syncthreads();
            const unsigned it = *slot;
            __syncthreads();
            if (it >= 1024u) break;
            if ((it & 1u) == 0u) xattn_sample_item(p, lds, tid, wave, lane, (int)(it >> 1), st); else xattn_prompt_item(p, lds, tid, wave, lane, (int)(it >> 1), st);
        } }
    xcd_barrier(xbar);
    p4_post(p, tid, G, true);
    xcd_barrier(xbar);
    { pg8::Gemm g{(const pg8::bf16_t*)(ws + WS_Z), (const pg8::bf16_t*)(ws + WS_WBR), 3 * NT, 3072, 1024}; SchedTail S{bx}; EpiTail E{ws};
      pg8::gemm_phase<EpiTail, SchedTail>((PG8_LAS unsigned char*)lds, g, S, E, nullptr);
      if (bx < 192) { pg8::Gemm g4 = g; g4.nt = 4; SchedBrS S2{bx}; EpiPart E2{ws}; pg8::gemm_phase<EpiPart, SchedBrS>((PG8_LAS unsigned char*)lds, g4, S2, E2, nullptr); } }
    xcd_barrier(xbar);
    p5_sum(p, tid, G);
    { pg8::Gemm g{(const pg8::bf16_t*)(ws + WS_MERGED), (const pg8::bf16_t*)(ws + WS_WOUT), NPT, 1024, 1024}; pg8::StaticOrder S; S.init(NPT, 1024, G, bx); EpiOut E{opq(p.in[I_XP]), opq(p.in[I_XS]), p.out};
      pg8::gemm_phase<EpiOut, pg8::StaticOrder>((PG8_LAS unsigned char*)lds, g, S, E, nullptr); }
    xcd_barrier(xbar);
    if (bx < 64) { pg8::Gemm g{(const pg8::bf16_t*)(ws + WS_MERGED), (const pg8::bf16_t*)(ws + WS_WOUT), NT, 1024, 1024, 4}; SchedOutS S{bx}; EpiPartY E{ws};
      pg8::gemm_phase<EpiPartY, SchedOutS>((PG8_LAS unsigned char*)lds, g, S, E, nullptr);
      p6_norm(p, 0, NPT, bx, 448, wave, lane); }
    else { p6_norm(p, 0, NPT, 64 + 2 * (bx - 64), 448, wave, lane); p6_norm(p, 0, NPT, 65 + 2 * (bx - 64), 448, wave, lane); }
    xcd_barrier(xbar);
    p6s_norm(p, bx, G, wave, lane);
#undef p
}
}

extern "C" void kernel_launch(void* const* d_in, const int* in_sizes, int n_in, void* d_out, int out_size, void* d_ws, size_t ws_size, hipStream_t stream) {
    static int grid = 0;
    if (grid == 0) {
        if (n_in != 35 || (size_t)out_size != mk::O_END || ws_size < mk::WS_END) { fprintf(stderr, "kernel_launch: unexpected shapes: n_in %d out %d ws %zu\n", n_in, out_size, ws_size); grid = -1; return; }
        int dev = 0, cus = 0, per_cu = 0;
        hipGetDevice(&dev); hipDeviceGetAttribute(&cus, hipDeviceAttributeMultiprocessorCount, dev);
        hipFuncSetAttribute((const void*)mk::fwd, hipFuncAttributeMaxDynamicSharedMemorySize, mk::LDS_BYTES);
        hipOccupancyMaxActiveBlocksPerMultiprocessor(&per_cu, (const void*)mk::fwd, 512, mk::LDS_BYTES);
        if (per_cu < 1) { fprintf(stderr, "kernel_launch: occupancy query says %d blocks per CU\n", per_cu); per_cu = 1; }
        grid = cus * 1;
        (void)hipGetLastError();
    }
    if (grid < 0) return;
    mk::Params p{};
    for (int i = 0; i < 35; ++i) p.in[i] = (const float*)d_in[i];
    p.out = (float*)d_out; p.ws = (unsigned char*)d_ws;
    void* args[] = {&p};
    hipError_t e = hipLaunchCooperativeKernel((const void*)mk::fwd, dim3(grid), dim3(512), args, mk::LDS_BYTES, stream);
    if (e != hipSuccess) fprintf(stderr, "cooperative launch failed: %s (grid %d)\n", hipGetErrorString(e), grid);
}
```

```cpp
#include <hip/hip_cooperative_groups.h>
#include <cstdio>
#include <hip/hip_runtime.h>
namespace pg8 {
#define PG8_LAS __attribute__((address_space(3)))
typedef unsigned short bf16_t;
typedef short bf16x8 __attribute__((ext_vector_type(8)));
typedef float f32x4 __attribute__((ext_vector_type(4)));
typedef unsigned u32x4 __attribute__((ext_vector_type(4)));
constexpr int BM = 256, BK = 64, HALF = 128, HTB = HALF * BK * 2  , STAGE_BYTES = 8 * HTB, NXCD = 8, WGM = 8;

__host__ __device__ __forceinline__ int lds_byte(int r, int c) { const int st = (r >> 4) * 2 + (c >> 5), rr = r & 15, cc = c & 31, ob = rr * 64 + cc * 2; return st * 1024 + (ob ^ (((ob >> 9) & 1) << 5)); }
__host__ __device__ __forceinline__ void stage_rc(int b, int& R, int& C) { const int st = b / 1024, sb = b % 1024, swz = sb ^ (((sb >> 9) & 1) << 5); R = (st >> 1) * 16 + swz / 64; C = (st & 1) * 32 + (swz % 64) / 2; }
__host__ __device__ __forceinline__ int perm32(int rho) { const int n = rho >> 4, i = rho & 15; return 8 * (i >> 2) + 4 * n + (i & 3); }

struct Unit { int pm, pn, ko; };
struct Gemm { const bf16_t* A; const bf16_t* Bt; int M, N, K, nt; };

struct StaticOrder {
    int nM, nN, nwg, G, c;
    __host__ __device__ void init(int M, int N, int G_, int c_) { nM = M / BM; nN = N / BM; nwg = nM * nN; G = G_; c = c_; }
    __host__ __device__ bool next(int i, Unit& u) const {
        const long L = (long)i * G + c; if (L >= nwg) return false;
        int wgid = (int)L; { const int q = nwg / NXCD, r = nwg % NXCD, xcd = wgid % NXCD, off = wgid / NXCD; wgid = (xcd < r ? xcd * (q + 1) : r * (q + 1) + (xcd - r) * q) + off; }
        const int nig = WGM * nN, gid = wgid / nig, fm = gid * WGM, gsz = (nM - fm) < WGM ? (nM - fm) : WGM;
        u.pm = fm + ((wgid % nig) % gsz); u.pn = (wgid % nig) / gsz; return true;
    }
    __device__ __forceinline__ void a_ready(const Unit&) const {}
    __device__ __forceinline__ void done(const Unit&) const {}
};
struct CountedOrder : StaticOrder {
    const unsigned* ready; unsigned need; unsigned* tmo;
    __device__ __forceinline__ void a_ready(const Unit& u) const {
        if (threadIdx.x < 64) {
            const unsigned long long t0 = __builtin_amdgcn_s_memrealtime(); unsigned polls = 0;
            while ((unsigned)__builtin_amdgcn_readfirstlane(__hip_atomic_load(ready + 64 * u.pm, __ATOMIC_RELAXED, __HIP_MEMORY_SCOPE_AGENT)) < need) {
                if ((++polls & 255u) == 0u && __builtin_amdgcn_readfirstlane(__hip_atomic_load(tmo, __ATOMIC_RELAXED, __HIP_MEMORY_SCOPE_AGENT)) != 0u) break;
                if (__builtin_amdgcn_s_memrealtime() - t0 > 2000000ull) {
                    if (threadIdx.x == 0) { unsigned expect = 0u; __hip_atomic_compare_exchange_strong(tmo + 1, &expect, 0x600u | (unsigned)(u.pm & 0xff), __ATOMIC_RELAXED, __ATOMIC_RELAXED, __HIP_MEMORY_SCOPE_AGENT); __hip_atomic_store(tmo, 1u, __ATOMIC_RELAXED, __HIP_MEMORY_SCOPE_AGENT); }
                    break; }
                __builtin_amdgcn_s_sleep(2); }
            __builtin_amdgcn_fence(__ATOMIC_ACQUIRE, "agent");
            asm volatile("s_waitcnt vmcnt(0)" ::: "memory");
        }
#if !defined(BROKEN_HOOK_NO_BARRIER)
        asm volatile("" ::: "memory"); __builtin_amdgcn_s_barrier(); asm volatile("" ::: "memory");
#endif
    }
};

__device__ __forceinline__ unsigned cvt_pk_bf16(float lo, float hi) { unsigned r; asm volatile("v_cvt_pk_bf16_f32 %0, %1, %2" : "=v"(r) : "v"(lo), "v"(hi)); return r; }
typedef float f32x2 __attribute__((ext_vector_type(2)));
__device__ __forceinline__ f32x2 gelu_pk(f32x2 v) {
    const f32x2 av = __builtin_elementwise_abs(v), d = av * 0.2316418882f + 1.0f;
    f32x2 t; t.x = __builtin_amdgcn_rcpf(d.x); t.y = __builtin_amdgcn_rcpf(d.y);
    f32x2 q = t * 0.5307027145f + (-0.7265760135f); q = q * t + 0.7107068705f; q = q * t + (-0.142248368f); q = q * t + 0.127414796f; q = q * t;
    const f32x2 s = (v * v) * (-0.72134752044f);
    f32x2 e; e.x = __builtin_amdgcn_exp2f(s.x); e.y = __builtin_amdgcn_exp2f(s.y);
    const f32x2 m = v * (q * e), r = v - m;
    f32x2 o; o.x = v.x < 0.f ? m.x : r.x; o.y = v.y < 0.f ? m.y : r.y; return o;
}

struct EpiF32 {
    static constexpr bool PERM = false, AFTER_DRAIN = false;
    float* C; int ldc; const float* bias;
    __device__ __forceinline__ void operator()(const f32x4 (&acc)[2][2][4][2], const Unit& u, int wr, int wc, int fr, int fq) const {
        const int row0 = u.pm * BM + wr * 64 + fr, col0 = u.pn * BM + wc * 32 + 4 * fq;
        f32x4 bv[2][2];
#pragma unroll
        for (int bj = 0; bj < 2; ++bj)
#pragma unroll
            for (int n = 0; n < 2; ++n) bv[bj][n] = bias ? *(const f32x4*)(bias + col0 + bj * HALF + n * 16) : (f32x4){0.f, 0.f, 0.f, 0.f};
#pragma unroll
        for (int ai = 0; ai < 2; ++ai)
#pragma unroll
            for (int m = 0; m < 4; ++m) { float* rowp = C + (size_t)(row0 + ai * HALF + m * 16) * ldc + col0;
#pragma unroll
                for (int bj = 0; bj < 2; ++bj)
#pragma unroll
                    for (int n = 0; n < 2; ++n) *(f32x4*)(rowp + bj * HALF + n * 16) = acc[ai][bj][m][n] + bv[bj][n]; }
    }
};
template <int ACT  > struct EpiBf16 {
    static constexpr bool PERM = true, AFTER_DRAIN = false;
    bf16_t* O; int ldc; const float* bias; int split_cols; size_t split_stride;
    __device__ __forceinline__ void operator()(const f32x4 (&acc)[2][2][4][2], const Unit& u, int wr, int wc, int fr, int fq) const {
        const int row0 = u.pm * BM + wr * 64 + fr; int colt = u.pn * BM; bf16_t* base = O;
        if (split_cols) { const int t = colt / split_cols; base += (size_t)t * split_stride; colt -= t * split_cols; }
        const int col0 = colt + wc * 32 + 8 * fq, bcol0 = u.pn * BM + wc * 32 + 8 * fq;
        f32x4 bv[2][2];
#pragma unroll
        for (int bj = 0; bj < 2; ++bj)
#pragma unroll
            for (int n = 0; n < 2; ++n) bv[bj][n] = bias ? *(const f32x4*)(bias + bcol0 + bj * HALF + 4 * n) : (f32x4){0.f, 0.f, 0.f, 0.f};
#pragma unroll
        for (int ai = 0; ai < 2; ++ai)
#pragma unroll
            for (int m = 0; m < 4; ++m) { bf16_t* rowp = base + (size_t)(row0 + ai * HALF + m * 16) * ldc + col0;
#pragma unroll
                for (int bj = 0; bj < 2; ++bj) { f32x4 v0 = acc[ai][bj][m][0] + bv[bj][0], v1 = acc[ai][bj][m][1] + bv[bj][1];
                    if (ACT == 1) { f32x2 a = gelu_pk((f32x2){v0[0], v0[1]}), b = gelu_pk((f32x2){v0[2], v0[3]}), c = gelu_pk((f32x2){v1[0], v1[1]}), d = gelu_pk((f32x2){v1[2], v1[3]});
                        v0 = (f32x4){a.x, a.y, b.x, b.y}; v1 = (f32x4){c.x, c.y, d.x, d.y}; }
                    if (ACT == 2) {
#pragma unroll
                        for (int j = 0; j < 4; ++j) { v0[j] = 0.5f * v0[j] * (1.0f + erff(v0[j] * 0.70710678f)); v1[j] = 0.5f * v1[j] * (1.0f + erff(v1[j] * 0.70710678f)); } }
                    u32x4 w; w.x = cvt_pk_bf16(v0[0], v0[1]); w.y = cvt_pk_bf16(v0[2], v0[3]); w.z = cvt_pk_bf16(v1[0], v1[1]); w.w = cvt_pk_bf16(v1[2], v1[3]);
                    *(u32x4*)(rowp + bj * HALF) = w; } }
    }
};

struct PanelStats {
    unsigned* xbuf;
    unsigned* cnt;
    unsigned* tmo;
    int ntn; float eps;
    unsigned code;
    __device__ __forceinline__ bool run(const f32x4 (&v)[2][2][4][2], const Unit& u, int wr, int wc, int fr, int fq, PG8_LAS unsigned char* lds, int wid, int lane) const {
        typedef float f32x2v __attribute__((ext_vector_type(2)));
        PG8_LAS f32x2v* P = (PG8_LAS f32x2v*)lds;
        PG8_LAS f32x2v* S = (PG8_LAS f32x2v*)(lds + 8192);
        PG8_LAS unsigned* flag = (PG8_LAS unsigned*)(lds + 8192 + 2048);
#pragma unroll
        for (int ai = 0; ai < 2; ++ai)
#pragma unroll
            for (int m = 0; m < 4; ++m) {
                float s = 0.f;
#pragma unroll
                for (int bj = 0; bj < 2; ++bj)
#pragma unroll
                    for (int n = 0; n < 2; ++n) { const f32x4 x = v[ai][bj][m][n]; s += (x[0] + x[1]) + (x[2] + x[3]); }
                s += __shfl_xor(s, 16); s += __shfl_xor(s, 32);
                const float mw = s * (1.0f / 64.0f); float q = 0.f;
#pragma unroll
                for (int bj = 0; bj < 2; ++bj)
#pragma unroll
                    for (int n = 0; n < 2; ++n) { const f32x4 d = v[ai][bj][m][n] - mw; q += (d[0] * d[0] + d[1] * d[1]) + (d[2] * d[2] + d[3] * d[3]); }
                q += __shfl_xor(q, 16); q += __shfl_xor(q, 32);
                if (fq == 0) P[(ai * HALF + wr * 64 + m * 16 + fr) * 4 + wc] = (f32x2v){mw, q};
            }
        asm volatile("s_waitcnt lgkmcnt(0)" ::: "memory"); __builtin_amdgcn_s_barrier(); asm volatile("" ::: "memory");
#if defined(BROKEN_NO_WAIT)
        if (blockIdx.x >= 64) { const long long t0 = clock64(); while (clock64() - t0 < 60000) __builtin_amdgcn_s_sleep(8); }
#endif
        const int row = wid * 32 + (lane & 31);
        if (lane < 32) {
            const f32x2v a = P[row * 4 + 0], b = P[row * 4 + 1], c = P[row * 4 + 2], d = P[row * 4 + 3];
            const float mt = (a.x + b.x + c.x + d.x) * 0.25f;
            const float da = a.x - mt, db = b.x - mt, dc = c.x - mt, dd = d.x - mt;
            const float m2 = (a.y + b.y) + (c.y + d.y) + 64.0f * ((da * da + db * db) + (dc * dc + dd * dd));
            unsigned long long* slot = (unsigned long long*)xbuf + ((size_t)(u.pm * BM + row) * 4 + u.pn);
            __hip_atomic_store(slot, ((unsigned long long)__float_as_uint(m2) << 32) | __float_as_uint(mt), __ATOMIC_RELAXED, __HIP_MEMORY_SCOPE_AGENT);
        }
        asm volatile("s_waitcnt vmcnt(0)" ::: "memory");
        if (lane == 0) __hip_atomic_fetch_add(cnt + 64 * u.pm, 1u, __ATOMIC_RELAXED, __HIP_MEMORY_SCOPE_AGENT);
        if (wid == 0) {
            bool dead = false; const unsigned long long t0 = __builtin_amdgcn_s_memrealtime(); const unsigned want = 8u * (unsigned)ntn;
            for (;;) {
#if defined(BROKEN_NO_WAIT)
                break;
#endif
                if ((unsigned)__builtin_amdgcn_readfirstlane(__hip_atomic_load(cnt + 64 * u.pm, __ATOMIC_RELAXED, __HIP_MEMORY_SCOPE_AGENT)) >= want) break;
                if (__builtin_amdgcn_s_memrealtime() - t0 > 2000000ull) {
                    if (lane == 0) { unsigned expect = 0u; __hip_atomic_compare_exchange_strong(tmo + 1, &expect, code | (unsigned)(u.pm & 0xff), __ATOMIC_RELAXED, __ATOMIC_RELAXED, __HIP_MEMORY_SCOPE_AGENT);
                                     __hip_atomic_store(tmo, 1u, __ATOMIC_RELAXED, __HIP_MEMORY_SCOPE_AGENT); }
                    dead = true; break; }
                __builtin_amdgcn_s_sleep(2);
            }
            __builtin_amdgcn_fence(__ATOMIC_ACQUIRE, "agent");
            if (lane == 0) flag[0] = dead ? 1u : 0u;
        }
        asm volatile("s_waitcnt vmcnt(0) lgkmcnt(0)" ::: "memory"); __builtin_amdgcn_s_barrier(); asm volatile("" ::: "memory");
        const bool bad = flag[0] != 0u;
        if (lane < 32) {
            const unsigned long long* slot = (const unsigned long long*)xbuf + (size_t)(u.pm * BM + row) * 4; float mt[4], m2[4]; float ms = 0.f;
#pragma unroll
            for (int t = 0; t < 4; ++t) { if (t < ntn) { const unsigned long long w = __hip_atomic_load(slot + t, __ATOMIC_RELAXED, __HIP_MEMORY_SCOPE_AGENT); mt[t] = __uint_as_float((unsigned)w); m2[t] = __uint_as_float((unsigned)(w >> 32)); } else { mt[t] = 0.f; m2[t] = 0.f; } ms += mt[t]; }
            const float mean = ms / (float)ntn; float q = 0.f;
#pragma unroll
            for (int t = 0; t < 4; ++t) if (t < ntn) { const float dm = mt[t] - mean; q += m2[t] + 256.0f * dm * dm; }
            S[row] = (f32x2v){mean, 1.0f / sqrtf(q / (256.0f * (float)ntn) + eps)};
        }
        asm volatile("s_waitcnt lgkmcnt(0)" ::: "memory"); __builtin_amdgcn_s_barrier(); asm volatile("" ::: "memory");
        return bad;
    }
};
struct EpiLnRes {
    static constexpr bool PERM = false, AFTER_DRAIN = true;
    const float* base; float* out; int ldc; const float* bias; PanelStats st; unsigned poison;
    __device__ __forceinline__ void refuse(size_t i0, size_t stride, int M, int N) const { const float q = __builtin_nanf(""); for (size_t i = i0; i < (size_t)M * N; i += stride) out[(i / N) * ldc + i % N] = q;
        if (i0 == 0) { unsigned expect = 0u; __hip_atomic_compare_exchange_strong(st.tmo + 1, &expect, 0x7f0u, __ATOMIC_RELAXED, __ATOMIC_RELAXED, __HIP_MEMORY_SCOPE_AGENT); __hip_atomic_store(st.tmo, 1u, __ATOMIC_RELAXED, __HIP_MEMORY_SCOPE_AGENT); } }
    __device__ __forceinline__ void fused(f32x4 (&acc)[2][2][4][2], const Unit& u, int wr, int wc, int fr, int fq, PG8_LAS unsigned char* lds, int wid, int lane) const {
        typedef float f32x2v __attribute__((ext_vector_type(2)));
        const PG8_LAS f32x2v* S = (const PG8_LAS f32x2v*)(lds + 8192);
        const int col0 = u.pn * BM + wc * 32 + 4 * fq;
#pragma unroll
        for (int bj = 0; bj < 2; ++bj)
#pragma unroll
            for (int n = 0; n < 2; ++n) { const f32x4 bv = bias ? *(const f32x4*)(bias + col0 + bj * HALF + n * 16) : (f32x4){0.f, 0.f, 0.f, 0.f};
#pragma unroll
                for (int ai = 0; ai < 2; ++ai)
#pragma unroll
                    for (int m = 0; m < 4; ++m) acc[ai][bj][m][n] += bv; }
        const bool bad = st.run(acc, u, wr, wc, fr, fq, lds, wid, lane) || poison != 0u;
        const float qnan = __builtin_nanf("");
#pragma unroll
        for (int ai = 0; ai < 2; ++ai)
#pragma unroll
            for (int m = 0; m < 4; ++m) { const int r = ai * HALF + wr * 64 + m * 16 + fr; const f32x2v sr = S[r]; const size_t off = (size_t)(u.pm * BM + r) * ldc + col0;
#pragma unroll
                for (int bj = 0; bj < 2; ++bj)
#pragma unroll
                    for (int n = 0; n < 2; ++n) { const f32x4 bs = *(const f32x4*)(base + off + bj * HALF + n * 16); f32x4 o = bs + (acc[ai][bj][m][n] - sr.x) * sr.y;
                        if (bad) o = (f32x4){qnan, qnan, qnan, qnan}; *(f32x4*)(out + off + bj * HALF + n * 16) = o; }
                asm volatile("" ::: "memory"); }
    }
};
struct EpiLnResLn {
    static constexpr bool PERM = false, AFTER_DRAIN = true;
    const float* base; float* out; bf16_t* xn; int ldc; const float* bias; PanelStats st1, st2; unsigned poison;
    __device__ __forceinline__ void refuse(size_t i0, size_t stride, int M, int N) const { const float q = __builtin_nanf(""); for (size_t i = i0; i < (size_t)M * N; i += stride) { const size_t o = (i / N) * ldc + i % N; out[o] = q; xn[o] = (bf16_t)0x7fc0u; }
        if (i0 == 0) { unsigned expect = 0u; __hip_atomic_compare_exchange_strong(st1.tmo + 1, &expect, 0x7f0u, __ATOMIC_RELAXED, __ATOMIC_RELAXED, __HIP_MEMORY_SCOPE_AGENT); __hip_atomic_store(st1.tmo, 1u, __ATOMIC_RELAXED, __HIP_MEMORY_SCOPE_AGENT); } }
    __device__ __forceinline__ void fused(f32x4 (&acc)[2][2][4][2], const Unit& u, int wr, int wc, int fr, int fq, PG8_LAS unsigned char* lds, int wid, int lane) const {
        typedef float f32x2v __attribute__((ext_vector_type(2))); typedef unsigned u32x2v __attribute__((ext_vector_type(2)));
        const PG8_LAS f32x2v* S = (const PG8_LAS f32x2v*)(lds + 8192);
        const int col0 = u.pn * BM + wc * 32 + 4 * fq;
#pragma unroll
        for (int bj = 0; bj < 2; ++bj)
#pragma unroll
            for (int n = 0; n < 2; ++n) { const f32x4 bv = bias ? *(const f32x4*)(bias + col0 + bj * HALF + n * 16) : (f32x4){0.f, 0.f, 0.f, 0.f};
#pragma unroll
                for (int ai = 0; ai < 2; ++ai)
#pragma unroll
                    for (int m = 0; m < 4; ++m) acc[ai][bj][m][n] += bv; }
        bool bad = st1.run(acc, u, wr, wc, fr, fq, lds, wid, lane) || poison != 0u;
        const float qnan = __builtin_nanf("");
#pragma unroll
        for (int ai = 0; ai < 2; ++ai)
#pragma unroll
            for (int m = 0; m < 4; ++m) { const int r = ai * HALF + wr * 64 + m * 16 + fr; const f32x2v sr = S[r]; const size_t off = (size_t)(u.pm * BM + r) * ldc + col0;
#pragma unroll
                for (int bj = 0; bj < 2; ++bj)
#pragma unroll
                    for (int n = 0; n < 2; ++n) { const f32x4 bs = *(const f32x4*)(base + off + bj * HALF + n * 16); acc[ai][bj][m][n] = bs + (acc[ai][bj][m][n] - sr.x) * sr.y; }
                asm volatile("" : "+v"(acc[ai][0][m][0]), "+v"(acc[ai][0][m][1]), "+v"(acc[ai][1][m][0]), "+v"(acc[ai][1][m][1]));
                if (m & 1) asm volatile("" ::: "memory"); }
        const bool bad1 = bad;
        bad = st2.run(acc, u, wr, wc, fr, fq, lds, wid, lane) || bad;
#pragma unroll
        for (int ai = 0; ai < 2; ++ai)
#pragma unroll
            for (int m = 0; m < 4; ++m) { const int r = ai * HALF + wr * 64 + m * 16 + fr; const f32x2v sr = S[r]; const size_t off = (size_t)(u.pm * BM + r) * ldc + col0;
#pragma unroll
                for (int bj = 0; bj < 2; ++bj)
#pragma unroll
                    for (int n = 0; n < 2; ++n) { const f32x4 x1 = acc[ai][bj][m][n]; *(f32x4*)(out + off + bj * HALF + n * 16) = bad1 ? (f32x4){qnan, qnan, qnan, qnan} : x1;
                        const f32x4 o = (x1 - sr.x) * sr.y; u32x2v w; w.x = cvt_pk_bf16(o[0], o[1]); w.y = cvt_pk_bf16(o[2], o[3]);
                        if (bad) { w.x = 0x7fc07fc0u; w.y = 0x7fc07fc0u; } *(u32x2v*)(xn + off + bj * HALF + n * 16) = w; }
                asm volatile("" ::: "memory"); }
    }
};

template <class Epi, class Sched, bool STAMP = false>
__device__ __forceinline__ void gemm_phase(PG8_LAS unsigned char* lds, const Gemm g, const Sched& S, const Epi& E, unsigned long long* stamps) {
    const int tid = threadIdx.x, wid = __builtin_amdgcn_readfirstlane(tid >> 6), lane = tid & 63, wr = wid >> 2, wc = wid & 3, fr = lane & 15, fq = lane >> 4;
    const int K = g.K, nt = g.nt ? g.nt : K / BK;
    int ts_lo = 0, ts_hi = 0, nts = 0; const unsigned long long rt_entry = STAMP ? (unsigned long long)wall_clock64() : 0ull;
#define PG8_STAMP() do { if (STAMP && wid == 0 && nts < 64) { const unsigned long long _c = (unsigned long long)clock64(); \
        ts_lo = (lane == nts) ? (int)(unsigned)_c : ts_lo; ts_hi = (lane == nts) ? (int)(unsigned)(_c >> 32) : ts_hi; ++nts; } } while (0)
    PG8_STAMP();
    unsigned voffA[2], voffB[2];
#pragma unroll
    for (int i = 0; i < 2; ++i) { int R, C; stage_rc(tid * 16 + i * 8192, R, C); const int Rb = Epi::PERM ? ((R & ~31) + perm32(R & 31)) : R;
        voffA[i] = (unsigned)(R * K + C) * 2u; voffB[i] = (unsigned)(Rb * K + C) * 2u; }
    const size_t kstep = (size_t)(BK * 2);
    const size_t hstep = (size_t)HALF * K * 2;
    const size_t tstep = 2 * hstep;
    const unsigned ldsw = (unsigned)wid * 1024u;
    const int aoff = lds_byte(wr * 64 + fr, fq * 8), boff = lds_byte(wc * 32 + fr, fq * 8);
#define PG8_SA(b, h) (((b) * 2 + (h)) * HTB)
#define PG8_SB(b, h) ((4 + (b) * 2 + (h)) * HTB)
#define PG8_STAGE(bufoff, gbase, voff) do { _Pragma("unroll") for (int _i = 0; _i < 2; ++_i) \
        __builtin_amdgcn_global_load_lds((const unsigned*)((const char*)(gbase) + (voff)[_i]), (PG8_LAS unsigned*)(lds + (bufoff) + ldsw + _i * 8192), 16, 0, 0); } while (0)
#define PG8_LDA(dst, b, h) do { _Pragma("unroll") for (int m = 0; m < 4; ++m) _Pragma("unroll") for (int k = 0; k < 2; ++k) dst[m][k] = *(const PG8_LAS bf16x8*)(lds + PG8_SA(b, h) + aoff + m * 2048 + k * 1024); } while (0)
#define PG8_LDB(dst, b, h) do { _Pragma("unroll") for (int n = 0; n < 2; ++n) _Pragma("unroll") for (int k = 0; k < 2; ++k) dst[n][k] = *(const PG8_LAS bf16x8*)(lds + PG8_SB(b, h) + boff + n * 2048 + k * 1024); } while (0)
#define PG8_MMA(ai, bj, At, Bt) do { __builtin_amdgcn_s_setprio(1); _Pragma("unroll") for (int m = 0; m < 4; ++m) _Pragma("unroll") for (int n = 0; n < 2; ++n) _Pragma("unroll") for (int k = 0; k < 2; ++k) \
        acc[ai][bj][m][n] = __builtin_amdgcn_mfma_f32_16x16x32_bf16(Bt[n][k], At[m][k], acc[ai][bj][m][n], 0, 0, 0); __builtin_amdgcn_s_setprio(0); } while (0)
#define PG8_WAIT_V(n) asm volatile("s_waitcnt vmcnt(" #n ")" ::: "memory")
#define PG8_WAIT_L(n) asm volatile("s_waitcnt lgkmcnt(" #n ")" ::: "memory")
#define PG8_BAR __builtin_amdgcn_s_barrier()
#define PG8_SCHED __builtin_amdgcn_sched_barrier(0)
    Unit cur{0, 0, 0}, nxt{0, 0, 0}; int ui = 0;
    if (!S.next(0, cur)) return;
    f32x4 acc[2][2][4][2];
#pragma unroll
    for (int a = 0; a < 2; ++a)
#pragma unroll
        for (int b = 0; b < 2; ++b)
#pragma unroll
            for (int m = 0; m < 4; ++m)
#pragma unroll
                for (int n = 0; n < 2; ++n) acc[a][b][m][n] = (f32x4){0.f, 0.f, 0.f, 0.f};
    bf16x8 At[4][2], B0[2][2], B1[2][2];
    const char* cA = (const char*)g.A + (size_t)cur.pm * tstep + (size_t)cur.ko * 2; const char* cB = (const char*)g.Bt + (size_t)cur.pn * tstep + (size_t)cur.ko * 2;
    S.a_ready(cur);
    PG8_STAGE(PG8_SB(0, 0), cB, voffB); PG8_STAGE(PG8_SA(0, 0), cA, voffA); PG8_STAGE(PG8_SB(0, 1), cB + hstep, voffB); PG8_STAGE(PG8_SA(0, 1), cA + hstep, voffA);
    if (wr == 1) PG8_BAR;
    PG8_WAIT_V(4); PG8_BAR;
    PG8_STAGE(PG8_SB(1, 0), cB + kstep, voffB); PG8_STAGE(PG8_SA(1, 0), cA + kstep, voffA); PG8_STAGE(PG8_SB(1, 1), cB + hstep + kstep, voffB);
    PG8_WAIT_V(6); PG8_BAR;
    PG8_STAMP();
    for (;;) {
        const bool has_next = S.next(ui + 1, nxt);
        const char* nA = has_next ? (const char*)g.A + (size_t)nxt.pm * tstep + (size_t)nxt.ko * 2 : cA; const char* nB = has_next ? (const char*)g.Bt + (size_t)nxt.pn * tstep + (size_t)nxt.ko * 2 : cB;
        for (int t = 0; t < nt; t += 2) {
            const bool last = (t == nt - 2);
            const char* a1 = cA + (size_t)(t + 1) * kstep;
            const char* a2 = last ? nA : cA + (size_t)(t + 2) * kstep; const char* b2 = last ? nB : cB + (size_t)(t + 2) * kstep;
            const char* a3 = a2 + kstep; const char* b3 = b2 + kstep;
            if (last && has_next) S.a_ready(nxt);
            PG8_LDB(B0, 0, 0); PG8_SCHED; PG8_LDA(At, 0, 0); PG8_STAGE(PG8_SA(1, 1), a1 + hstep, voffA);
            PG8_WAIT_L(8); PG8_BAR; PG8_WAIT_L(0); PG8_MMA(0, 0, At, B0); PG8_BAR; PG8_SCHED;
            PG8_LDB(B1, 0, 1); PG8_STAGE(PG8_SB(0, 0), b2, voffB);
            PG8_BAR; PG8_WAIT_L(0); PG8_MMA(0, 1, At, B1); PG8_BAR;
            PG8_LDA(At, 0, 1); PG8_STAGE(PG8_SA(0, 0), a2, voffA);
            PG8_BAR; PG8_WAIT_L(0); PG8_MMA(1, 0, At, B0); PG8_BAR; PG8_SCHED;
            PG8_STAGE(PG8_SB(0, 1), b2 + hstep, voffB);
            PG8_WAIT_V(6); PG8_BAR; PG8_MMA(1, 1, At, B1); PG8_BAR;
            PG8_LDB(B0, 1, 0); PG8_SCHED; PG8_LDA(At, 1, 0); PG8_STAGE(PG8_SA(0, 1), a2 + hstep, voffA);
            PG8_WAIT_L(8); PG8_BAR; PG8_WAIT_L(0); PG8_MMA(0, 0, At, B0); PG8_BAR; PG8_SCHED;
            PG8_LDB(B1, 1, 1); PG8_STAGE(PG8_SB(1, 0), b3, voffB);
            PG8_BAR; PG8_WAIT_L(0); PG8_MMA(0, 1, At, B1); PG8_BAR;
            PG8_LDA(At, 1, 1); PG8_STAGE(PG8_SA(1, 0), a3, voffA);
            PG8_BAR; PG8_WAIT_L(0); PG8_MMA(1, 0, At, B0); PG8_BAR; PG8_SCHED;
            PG8_STAGE(PG8_SB(1, 1), b3 + hstep, voffB);
            PG8_WAIT_V(6); PG8_BAR; PG8_MMA(1, 1, At, B1); PG8_BAR;
        }
        PG8_STAMP();
        if constexpr (!Epi::AFTER_DRAIN) { E(acc, cur, wr, wc, fr, fq); S.done(cur); }
        PG8_STAMP();
        if (!has_next) break;
        if (!Epi::keep(nxt))
#pragma unroll
        for (int a = 0; a < 2; ++a)
#pragma unroll
            for (int b = 0; b < 2; ++b)
#pragma unroll
                for (int m = 0; m < 4; ++m)
#pragma unroll
                    for (int n = 0; n < 2; ++n) acc[a][b][m][n] = (f32x4){0.f, 0.f, 0.f, 0.f};
        cur = nxt; cA = nA; cB = nB; ++ui;
    }
    PG8_WAIT_V(0);
    if (wr == 0) PG8_BAR;
    PG8_BAR;
    if constexpr (Epi::AFTER_DRAIN) { E.fused(acc, cur, wr, wc, fr, fq, lds, wid, lane); S.done(cur); }
    PG8_STAMP();
    if (STAMP && wid == 0) { stamps[lane] = lane < nts ? (((unsigned long long)(unsigned)ts_hi << 32) | (unsigned)ts_lo) : 0ull;
        if (lane == 62) stamps[62] = rt_entry; if (lane == 63) stamps[63] = (unsigned long long)wall_clock64(); }
#undef PG8_STAMP
#undef PG8_SA
#undef PG8_SB
#undef PG8_STAGE
#undef PG8_LDA
#undef PG8_LDB
#undef PG8_MMA
#undef PG8_WAIT_V
#undef PG8_WAIT_L
#undef PG8_BAR
#undef PG8_SCHED
}
}

namespace mk {
namespace cg = cooperative_groups;
#define LAS __attribute__((address_space(3)))
typedef unsigned short bf16;
typedef short bf16x8 __attribute__((ext_vector_type(8)));
typedef float f32x4 __attribute__((ext_vector_type(4)));
typedef float f32x2 __attribute__((ext_vector_type(2)));
typedef unsigned u32x4 __attribute__((ext_vector_type(4)));
typedef unsigned u32x2 __attribute__((ext_vector_type(2)));

constexpr int NT = 17408, NPT = 16384, DM = 1024;
constexpr size_t MiB = 1u << 20;
constexpr size_t WS_WIN = 0, WS_WBR = 28 * MiB, WS_WOUT = 34 * MiB, WS_WDEC = 36 * MiB, WS_WAAA = WS_WDEC + 131072, WS_WRGA = WS_WAAA + 131072, WS_WRGX = WS_WRGA + 131072;
constexpr size_t WS_XN = 38 * MiB, WS_U = 76 * MiB, WS_Z = 178 * MiB, WS_XB = 280 * MiB, WS_Q = 314 * MiB, WS_G = 348 * MiB, WS_XWA = 450 * MiB;
constexpr size_t WS_MK = 459 * MiB, WS_MVT = 463 * MiB, WS_BONUS = 467 * MiB, WS_STATS = 469 * MiB, WS_CTR = 474 * MiB, WS_END = 475 * MiB;
constexpr size_t WS_ORAW = WS_XN, WS_P = WS_U, WS_MERGED = WS_XB;
constexpr size_t ZSTRIDE = (size_t)NT * DM;
constexpr int LDS_BYTES = 147456;
constexpr size_t O_Y = 0, O_RWP = 17825792, O_SHP = O_RWP + 524288, O_LRP = O_SHP + 25600, O_CVP = O_LRP + 8192, O_MKP = O_CVP + 24576, O_MVP = O_MKP + 2097152,
                 O_RWS = O_MVP + 2097152, O_SHS = O_RWS + 8388608, O_LRS = O_SHS + 409600, O_CVS = O_LRS + 131072, O_END = O_CVS + 393216;

struct Params { const float* in[35]; float* out; unsigned char* ws; int zero; int pad; };
#define PREF const __attribute__((address_space(4))) Params&
typedef const __attribute__((address_space(4))) Params CParams;
__device__ __forceinline__ CParams* launder(CParams* x) { asm volatile("" : "+s"(x)); return x; }
enum { I_XP = 0, I_XS, I_MEM, I_SRW, I_SSH, I_SLRU, I_SCV, I_CK, I_CV, I_GN, I_WIN, I_MU, I_W0, I_WDEC, I_A0, I_WAAA, I_KK, I_KA, I_RK, I_GNG, I_GNB, I_CW, I_CB, I_WRGA, I_BRGA, I_WRGX, I_BRGX, I_LAM, I_GMEM, I_WMEM, I_WBA, I_WBB, I_WBC, I_WOUT, I_GF };

__device__ __forceinline__ unsigned f2bf(float f) { unsigned u = __builtin_bit_cast(unsigned, f); return (u + 0x7fffu + ((u >> 16) & 1u)) >> 16; }
__device__ __forceinline__ unsigned pk2(float lo, float hi) { unsigned r; asm("v_cvt_pk_bf16_f32 %0, %1, %2" : "=v"(r) : "v"(lo), "v"(hi)); return r; }
__device__ __forceinline__ float bf2f(unsigned b) { return __builtin_bit_cast(float, b << 16); }
__device__ __forceinline__ float bflo(unsigned w) { return __builtin_bit_cast(float, w << 16); }
__device__ __forceinline__ float bfhi(unsigned w) { return __builtin_bit_cast(float, w & 0xffff0000u); }
__device__ __forceinline__ const float* opq(const float* x) { asm volatile("" : "+s"(x)); return x; }
__device__ __forceinline__ float sigm(float x) { return __builtin_amdgcn_rcpf(1.0f + __builtin_amdgcn_exp2f(x * -1.44269504f)); }
#define LDS_WAIT() asm volatile("s_waitcnt lgkmcnt(0)" ::: "memory")
template <int CTRL> __device__ __forceinline__ float dppf(float x) { return __builtin_bit_cast(float, __builtin_amdgcn_update_dpp(0, __builtin_bit_cast(int, x), CTRL, 0xF, 0xF, true)); }
__device__ __forceinline__ float row16_sum(float x) { x += dppf<0xB1>(x); x += dppf<0x4E>(x); x += dppf<0x141>(x); x += dppf<0x140>(x); return x; }
__device__ __forceinline__ float row16_max(float x) { x = fmaxf(x, dppf<0xB1>(x)); x = fmaxf(x, dppf<0x4E>(x)); x = fmaxf(x, dppf<0x141>(x)); x = fmaxf(x, dppf<0x140>(x)); return x; }
__device__ __forceinline__ float rdl(float x, int l) { return __builtin_bit_cast(float, __builtin_amdgcn_readlane(__builtin_bit_cast(int, x), l)); }
__device__ __forceinline__ float wave_sum(float x) { x = row16_sum(x); return (rdl(x, 0) + rdl(x, 16)) + (rdl(x, 32) + rdl(x, 48)); }
__device__ __forceinline__ float wave_max(float x) { x = row16_max(x); x = fmaxf(x, __shfl_xor(x, 16)); x = fmaxf(x, __shfl_xor(x, 32)); return x; }

struct EpiMain {
    static constexpr bool PERM = true, AFTER_DRAIN = false;
    static __device__ __forceinline__ bool keep(const pg8::Unit&) { return false; }
    unsigned char* ws;
    __device__ __forceinline__ void operator()(const pg8::f32x4 (&acc)[2][2][4][2], const pg8::Unit& u, int wr, int wc, int fr, int fq) const {
        const int pn = u.pn, row0 = u.pm * 256 + wr * 64 + fr;
        if (pn == 44) {
            float* X = (float*)(ws + WS_XWA);
#pragma unroll
            for (int ai = 0; ai < 2; ++ai)
#pragma unroll
                for (int m = 0; m < 4; ++m) { float* rp = X + (size_t)(row0 + ai * 128 + m * 16) * 128 + wc * 32 + 8 * fq;
                    *(f32x4*)rp = acc[ai][0][m][0]; *(f32x4*)(rp + 4) = acc[ai][0][m][1]; }
            return;
        }
        bf16* base; int ld, colt, act;
        if (pn < 12) { base = (bf16*)(ws + WS_U); ld = 3072; colt = pn * 256; act = 0; }
        else if (pn < 16) { base = (bf16*)(ws + WS_Z); ld = 1024; colt = (pn - 12) * 256; act = 1; }
        else if (pn < 20) { base = (bf16*)(ws + WS_XB); ld = 1024; colt = (pn - 16) * 256; act = 0; }
        else if (pn < 24) { base = (bf16*)(ws + WS_Z) + ZSTRIDE; ld = 1024; colt = (pn - 20) * 256; act = 1; }
        else if (pn < 28) { base = (bf16*)(ws + WS_Q); ld = 1024; colt = (pn - 24) * 256; act = 0; }
        else if (pn < 32) { base = (bf16*)(ws + WS_Z) + 2 * ZSTRIDE; ld = 1024; colt = (pn - 28) * 256; act = 1; }
        else { base = (bf16*)(ws + WS_G); ld = 3072; colt = (pn - 32) * 256; act = 2; }
        const int col0 = colt + wc * 32 + 8 * fq;
#pragma unroll
        for (int ai = 0; ai < 2; ++ai)
#pragma unroll
            for (int m = 0; m < 4; ++m) { bf16* rowp = base + (size_t)(row0 + ai * 128 + m * 16) * ld + col0;
#pragma unroll
                for (int bj = 0; bj < 2; ++bj) { pg8::f32x4 v0 = acc[ai][bj][m][0], v1 = acc[ai][bj][m][1];
                    if (act) {
#pragma unroll
                        for (int j = 0; j < 4; ++j) { const float s0 = sigm(v0[j]), s1 = sigm(v1[j]); v0[j] = act == 1 ? v0[j] * s0 : s0; v1[j] = act == 1 ? v1[j] * s1 : s1; } }
                    u32x4 w; w.x = pk2(v0[0], v0[1]); w.y = pk2(v0[2], v0[3]); w.z = pk2(v1[0], v1[1]); w.w = pk2(v1[2], v1[3]);
                    *(u32x4*)(rowp + bj * 128) = w; } }
    }
};
struct EpiMem {
    static constexpr bool PERM = false, AFTER_DRAIN = false;
    static __device__ __forceinline__ bool keep(const pg8::Unit&) { return false; }
    unsigned char* ws; float* out;
    __device__ __forceinline__ void operator()(const pg8::f32x4 (&acc)[2][2][4][2], const pg8::Unit& u, int wr, int wc, int fr, int fq) const {
        const int row0 = u.pm * 256 + wr * 64 + fr; const bool isv = u.pn >= 4; const int colt = (u.pn & 3) * 256 + wc * 32 + 4 * fq;
        float* of = out + (isv ? O_MVP : O_MKP); bf16* MK = (bf16*)(ws + WS_MK); bf16* MVT = (bf16*)(ws + WS_MVT);
#pragma unroll
        for (int ai = 0; ai < 2; ++ai)
#pragma unroll
            for (int m = 0; m < 4; ++m) { const int r = row0 + ai * 128 + m * 16;
#pragma unroll
                for (int bj = 0; bj < 2; ++bj)
#pragma unroll
                    for (int n = 0; n < 2; ++n) { const int c = colt + bj * 128 + n * 16; const pg8::f32x4 v = acc[ai][bj][m][n];
                        *(f32x4*)(of + (size_t)r * 1024 + c) = v;
                        if (!isv) { u32x2 w; w.x = pk2(v[0], v[1]); w.y = pk2(v[2], v[3]); *(u32x2*)(MK + (size_t)r * 1024 + c) = w; }
                        else { const int b = r >> 8, mem = r & 255, head = c >> 8, d = c & 255; bf16* q = MVT + ((size_t)((b * 4 + head) * 256 + d)) * 256 + mem;
                            q[0] = (bf16)f2bf(v[0]); q[256] = (bf16)f2bf(v[1]); q[512] = (bf16)f2bf(v[2]); q[768] = (bf16)f2bf(v[3]); } } }
    }
};
struct SchedMem { int c;
    __device__ bool next(int i, pg8::Unit& u) const { if (i != 0 || c >= 64) return false; u.pm = c >> 3; u.pn = c & 7; return true; }
    __device__ __forceinline__ void a_ready(const pg8::Unit&) const {}
    __device__ __forceinline__ void done(const pg8::Unit&) const {}
};
struct EpiTail {
    static constexpr bool PERM = true, AFTER_DRAIN = false;
    static __device__ __forceinline__ bool keep(const pg8::Unit& nxt) { return (nxt.pn >> 2) != 0; }
    unsigned char* ws;
    __device__ __forceinline__ void operator()(pg8::f32x4 (&acc)[2][2][4][2], const pg8::Unit& u, int wr, int wc, int fr, int fq) const {
        const int br = u.pn >> 2, pmm = u.pm - br * 68, pnn = u.pn & 3;
        const int row0 = pmm * 256 + wr * 64 + fr, col0 = pnn * 256 + wc * 32 + 8 * fq;
        const bf16* gbase = (const bf16*)(ws + WS_G) + (size_t)row0 * 3072 + br * 1024 + col0; const int hoff = br < 2 ? 1024 : 0; const bool last = br == 2;
#define MK_CLAMP8(g, f0, f1) pg8::f32x4 f0 = {fmaxf(bflo(g.x), 1e-20f), fmaxf(bfhi(g.x), 1e-20f), fmaxf(bflo(g.y), 1e-20f), fmaxf(bfhi(g.y), 1e-20f)}, f1 = {fmaxf(bflo(g.z), 1e-20f), fmaxf(bfhi(g.z), 1e-20f), fmaxf(bflo(g.w), 1e-20f), fmaxf(bfhi(g.w), 1e-20f)}
#pragma unroll
        for (int ai = 0; ai < 2; ++ai)
#pragma unroll
            for (int m = 0; m < 4; ++m) {
#pragma unroll
                for (int bj = 0; bj < 2; ++bj) { const bf16* gp = gbase + (size_t)(ai * 128 + m * 16) * 3072 + bj * 128; const u32x4 g = *(const u32x4*)gp, h = *(const u32x4*)(gp + hoff);
                    MK_CLAMP8(g, f0, f1); MK_CLAMP8(h, d0, d1);
#pragma unroll
                    for (int j = 0; j < 4; ++j) { d0[j] = last ? 1.0f : __builtin_amdgcn_rcpf(d0[j]); d1[j] = last ? 1.0f : __builtin_amdgcn_rcpf(d1[j]); }
                    acc[ai][bj][m][0] *= f0 * d0; acc[ai][bj][m][1] *= f1 * d1; }
                asm volatile("" ::: "memory"); }
#undef MK_CLAMP8
        if (last) { bf16* mbase = (bf16*)(ws + WS_MERGED) + (size_t)row0 * 1024 + col0;
#pragma unroll
            for (int ai = 0; ai < 2; ++ai)
#pragma unroll
                for (int m = 0; m < 4; ++m)
#pragma unroll
                    for (int bj = 0; bj < 2; ++bj) { const pg8::f32x4 v0 = acc[ai][bj][m][0], v1 = acc[ai][bj][m][1];
                        u32x4 w; w.x = pk2(v0[0], v0[1]); w.y = pk2(v0[2], v0[3]); w.z = pk2(v1[0], v1[1]); w.w = pk2(v1[2], v1[3]); *(u32x4*)(mbase + (size_t)(ai * 128 + m * 16) * 1024 + bj * 128) = w; } }
    }
};
struct SchedTail { int c;
    __device__ bool next(int i, pg8::Unit& u) const { if (i >= 3) return false; const int t = (c & 7) * 32 + (c >> 3); u.pm = i * 68 + (t >> 2); u.pn = i * 4 + (t & 3); return true; }
    __device__ __forceinline__ void a_ready(const pg8::Unit&) const {}
    __device__ __forceinline__ void done(const pg8::Unit&) const {}
};
struct EpiPart {
    static constexpr bool PERM = false, AFTER_DRAIN = false;
    static __device__ __forceinline__ bool keep(const pg8::Unit&) { return false; }
    unsigned char* ws;
    __device__ __forceinline__ void operator()(const pg8::f32x4 (&acc)[2][2][4][2], const pg8::Unit& u, int wr, int wc, int fr, int fq) const {
        const int br = u.pn >> 2, pmm = u.pm - br * 68 - 64, pnn = u.pn & 3, kq = u.ko >> 8;
        const int row0 = pmm * 256 + wr * 64 + fr, col0 = pnn * 256 + wc * 32 + 4 * fq;
        float* P = (float*)(ws + WS_P) + (size_t)(kq * 3 + br) * 1048576;
#pragma unroll
        for (int ai = 0; ai < 2; ++ai)
#pragma unroll
            for (int m = 0; m < 4; ++m) { float* rowp = P + (size_t)(row0 + ai * 128 + m * 16) * 1024 + col0;
#pragma unroll
                for (int bj = 0; bj < 2; ++bj)
#pragma unroll
                    for (int n = 0; n < 2; ++n) *(f32x4*)(rowp + bj * 128 + n * 16) = acc[ai][bj][m][n]; }
    }
};
struct SchedBrS { int c;
    __device__ bool next(int i, pg8::Unit& u) const { if (i != 0 || c >= 192) return false; const int kq = c & 3, idx = c >> 2, br = idx >> 4, t = idx & 15; u.pm = br * 68 + 64 + (t >> 2); u.pn = br * 4 + (t & 3); u.ko = kq * 256; return true; }
    __device__ __forceinline__ void a_ready(const pg8::Unit&) const {}
    __device__ __forceinline__ void done(const pg8::Unit&) const {}
};
struct SchedOutS { int c;
    __device__ bool next(int i, pg8::Unit& u) const { if (i != 0 || c >= 64) return false; const int t = c >> 2; u.pm = 64 + (t >> 2); u.pn = t & 3; u.ko = (c & 3) * 256; return true; }
    __device__ __forceinline__ void a_ready(const pg8::Unit&) const {}
    __device__ __forceinline__ void done(const pg8::Unit&) const {}
};
constexpr size_t WS_YP = WS_P + 48 * MiB;
struct EpiPartY {
    static constexpr bool PERM = false, AFTER_DRAIN = false;
    static __device__ __forceinline__ bool keep(const pg8::Unit&) { return false; }
    unsigned char* ws;
    __device__ __forceinline__ void operator()(const pg8::f32x4 (&acc)[2][2][4][2], const pg8::Unit& u, int wr, int wc, int fr, int fq) const {
        const int row0 = (u.pm - 64) * 256 + wr * 64 + fr, col0 = u.pn * 256 + wc * 32 + 4 * fq; float* P = (float*)(ws + WS_YP) + (size_t)(u.ko >> 8) * 1048576;
#pragma unroll
        for (int ai = 0; ai < 2; ++ai)
#pragma unroll
            for (int m = 0; m < 4; ++m) { float* rowp = P + (size_t)(row0 + ai * 128 + m * 16) * 1024 + col0;
#pragma unroll
                for (int bj = 0; bj < 2; ++bj)
#pragma unroll
                    for (int n = 0; n < 2; ++n) *(f32x4*)(rowp + bj * 128 + n * 16) = acc[ai][bj][m][n]; }
    }
};
struct EpiOut {
    static constexpr bool PERM = false, AFTER_DRAIN = false;
    static __device__ __forceinline__ bool keep(const pg8::Unit&) { return false; }
    const float* xp; const float* xs; float* out;
    __device__ __forceinline__ void operator()(const pg8::f32x4 (&acc)[2][2][4][2], const pg8::Unit& u, int wr, int wc, int fr, int fq) const {
        const int row0 = u.pm * 256 + wr * 64 + fr, col0 = u.pn * 256 + wc * 32 + 4 * fq;
#pragma unroll
        for (int ai = 0; ai < 2; ++ai)
#pragma unroll
            for (int m = 0; m < 4; ++m) { const int r = row0 + ai * 128 + m * 16; const float* xr = (r < NPT ? xp + (size_t)r * 1024 : xs + (size_t)(r - NPT) * 1024) + col0; float* orow = out + (size_t)r * 1024 + col0;
#pragma unroll
                for (int bj = 0; bj < 2; ++bj)
#pragma unroll
                    for (int n = 0; n < 2; ++n) *(f32x4*)(orow + bj * 128 + n * 16) = *(const f32x4*)(xr + bj * 128 + n * 16) + acc[ai][bj][m][n]; }
    }
};

__device__ __forceinline__ void transpose_item(const float* W, int K, int N, bf16* WT, int row_off, LAS float* scr, int item, int lane) {
    const int nblk = N / 32, kb = item / nblk, nb = item % nblk, k0 = 64 * kb, n0 = 32 * nb;
    float tv[32];
#pragma unroll
    for (int i = 0; i < 32; ++i) tv[i] = W[(size_t)(k0 + 2 * i + (lane >> 5)) * N + n0 + (lane & 31)];
#pragma unroll
    for (int i = 0; i < 32; ++i) scr[(2 * i + (lane >> 5)) * 33 + (lane & 31)] = tv[i];
    LDS_WAIT();
    const int c = lane & 7;
#pragma unroll
    for (int j = 0; j < 4; ++j) { const int n = (lane >> 3) + 8 * j; const LAS float* s = scr + (8 * c) * 33 + n;
        u32x4 o; o.x = pk2(s[0 * 33], s[1 * 33]); o.y = pk2(s[2 * 33], s[3 * 33]); o.z = pk2(s[4 * 33], s[5 * 33]); o.w = pk2(s[6 * 33], s[7 * 33]);
        *(u32x4*)(WT + (size_t)(row_off + n0 + n) * K + k0 + 8 * c) = o; }
    LDS_WAIT();
}
__device__ __forceinline__ void rms_row_to_bf16(const float* xrow, const float* g, bf16* orow, int lane) {
    const f32x4* xr = (const f32x4*)xrow + lane; const f32x4* gr = (const f32x4*)g + lane;
    f32x4 v[4]; float s = 0.f;
#pragma unroll
    for (int j = 0; j < 4; ++j) { v[j] = xr[64 * j]; s += (v[j].x * v[j].x + v[j].y * v[j].y) + (v[j].z * v[j].z + v[j].w * v[j].w); }
    const float rstd = rsqrtf(wave_sum(s) * (1.f / 1024.f) + 1e-6f);
    unsigned long long* o8 = (unsigned long long*)orow + lane;
#pragma unroll
    for (int j = 0; j < 4; ++j) { const f32x4 gg = gr[64 * j]; o8[64 * j] = (unsigned long long)pk2(v[j].x * rstd * gg.x, v[j].y * rstd * gg.y) | ((unsigned long long)pk2(v[j].z * rstd * gg.z, v[j].w * rstd * gg.w) << 32); }
}
__device__ __forceinline__ void p0_prologue(PREF p, LAS unsigned char* lds, int tid, int wave, int lane, int G) {
    unsigned char* ws = p.ws;
    LAS float* scr = (LAS float*)(lds + wave * 16384);
    const int gw = blockIdx.x * 8 + wave, NGW = G * 8;
    bf16* WIN = (bf16*)(ws + WS_WIN);
    constexpr int I_IN = 16 * 356, I_MM = 16 * 64, I_B = 16 * 32, I_L = 32, I_R = 2;
    constexpr int NITEMS = I_IN + I_MM + 4 * I_B + 2 * I_L + 32 * I_R;
    for (int it = gw; it < NITEMS; it += NGW) {
        int r = it;
        if (r < I_IN) { const int n0 = 32 * (r % 356); const int dst = n0 < 3072 ? n0 : (n0 < 3200 ? 11264 + n0 - 3072 : n0 - 128); transpose_item(p.in[I_WIN], 1024, 11392, WIN, dst - n0, scr, r, lane); continue; } r -= I_IN;
        if (r < I_MM) { transpose_item(p.in[I_WMEM], 1024, 2048, WIN + (size_t)11520 * 1024, 0, scr, r, lane); continue; } r -= I_MM;
        if (r < 3 * I_B) { const int br = r / I_B; const float* wa = opq(p.in[I_WBA]); const float* wb = opq(p.in[I_WBB]); const float* wc = opq(p.in[I_WBC]); transpose_item(br == 0 ? wa : (br == 1 ? wb : wc), 1024, 1024, (bf16*)(ws + WS_WBR) + (size_t)br * 1024 * 1024, 0, scr, r - br * I_B, lane); continue; } r -= 3 * I_B;
        if (r < I_B) { transpose_item(p.in[I_WOUT], 1024, 1024, (bf16*)(ws + WS_WOUT), 0, scr, r, lane); continue; } r -= I_B;
        if (r < I_L) { transpose_item(p.in[I_WDEC], 64, 1024, (bf16*)(ws + WS_WDEC), 0, scr, r, lane); continue; } r -= I_L;
        if (r < I_L) { transpose_item(p.in[I_WAAA], 64, 1024, (bf16*)(ws + WS_WAAA), 0, scr, r, lane); continue; } r -= I_L;
        { const int which = r / 32, rr = r % 32, g = rr >> 1, sub = rr & 1;
          const float* ra = opq(p.in[I_WRGA]); const float* rx = opq(p.in[I_WRGX]); transpose_item((which ? rx : ra) + g * 4096, 64, 64, (bf16*)(ws + (which ? WS_WRGX : WS_WRGA)) + g * 4096, 0, scr, sub, lane); }
    }
    { u32x4* z = (u32x4*)(WIN + (size_t)11392 * 1024); const u32x4 zero = {0u, 0u, 0u, 0u}; for (int i = blockIdx.x * 512 + tid; i < 128 * 1024 / 8; i += G * 512) z[i] = zero; }
    bf16* XN = (bf16*)(ws + WS_XN);
    const float* pxp = opq(p.in[I_XP]); const float* pxs = opq(p.in[I_XS]); const float* pmem = opq(p.in[I_MEM]); const float* pgn = opq(p.in[I_GN]); const float* pgm = opq(p.in[I_GMEM]);
    for (int m0 = gw; m0 < NT + 2048; m0 += 2 * NGW) {
        const float* src[2]; const float* g[2]; bf16* dst[2]; f32x4 v[2][4]; float ss[2];
#pragma unroll
        for (int q = 0; q < 2; ++q) { int m = m0 + q * NGW; if (m >= NT + 2048) m = m0;
            if (m < NPT) { src[q] = pxp + (size_t)m * 1024; g[q] = pgn; } else if (m < NT) { src[q] = pxs + (size_t)(m - NPT) * 1024; g[q] = pgn; } else { src[q] = pmem + (size_t)(m - NT) * 1024; g[q] = pgm; }
            dst[q] = XN + (size_t)m * 1024; }
#pragma unroll
        for (int q = 0; q < 2; ++q) { const f32x4* xr = (const f32x4*)src[q] + lane; float s2 = 0.f;
#pragma unroll
            for (int j = 0; j < 4; ++j) { v[q][j] = xr[64 * j]; }
#pragma unroll
            for (int j = 0; j < 4; ++j) s2 += (v[q][j].x * v[q][j].x + v[q][j].y * v[q][j].y) + (v[q][j].z * v[q][j].z + v[q][j].w * v[q][j].w);
            ss[q] = s2; }
#pragma unroll
        for (int q = 0; q < 2; ++q) { const float rstd = rsqrtf(wave_sum(ss[q]) * (1.f / 1024.f) + 1e-6f); const f32x4* gr = (const f32x4*)g[q] + lane; unsigned long long* o8 = (unsigned long long*)dst[q] + lane;
#pragma unroll
            for (int j = 0; j < 4; ++j) { const f32x4 gg = gr[64 * j]; o8[64 * j] = (unsigned long long)pk2(v[q][j].x * rstd * gg.x, v[q][j].y * rstd * gg.y) | ((unsigned long long)pk2(v[q][j].z * rstd * gg.z, v[q][j].w * rstd * gg.w) << 32); } }
    }
}

__device__ __forceinline__ bf16x8 pack8(const float (&x)[8]) { u32x4 w; w.x = pk2(x[0], x[1]); w.y = pk2(x[2], x[3]); w.z = pk2(x[4], x[5]); w.w = pk2(x[6], x[7]); return __builtin_bit_cast(bf16x8, w); }
__device__ __forceinline__ void p2_lora(PREF p, int vb, int NB, int tid, int wave, int lane) {
    unsigned char* ws = p.ws;
    const float* XWA = (const float*)(ws + WS_XWA); const bf16* U = (const bf16*)(ws + WS_U); const bf16* XB = (const bf16*)(ws + WS_XB);
    const bf16* WDEC = (const bf16*)(ws + WS_WDEC); const bf16* WAAA = (const bf16*)(ws + WS_WAAA);
    bf16* E = (bf16*)p.out; bf16* A = E + ZSTRIDE;
    const float* mu = p.in[I_MU]; const float* w0 = p.in[I_W0]; const float* a0 = p.in[I_A0]; const float* ssh = p.in[I_SSH];
    const int trow = lane & 15, kg = lane >> 4;
    for (int item = vb * 8 + wave; item < NT / 16; item += NB * 8) {
        const int tok = item * 16 + trow; const bool prm = tok < NPT; const int s = prm ? (tok & 2047) : ((tok - NPT) & 7); const int bs = (tok - NPT) >> 3;
        bf16x8 Aw[2], Aa[2];
#pragma unroll
        for (int ks = 0; ks < 2; ++ks) { const int k0 = 32 * ks + 8 * kg; float xw[8], xa[8];
#pragma unroll
            for (int hlf = 0; hlf < 2; ++hlf) {
                const f32x4 cw = *(const f32x4*)(XWA + (size_t)tok * 128 + k0 + 4 * hlf), ca = *(const f32x4*)(XWA + (size_t)tok * 128 + 64 + k0 + 4 * hlf);
                f32x4 pw = {0.f, 0.f, 0.f, 0.f}, pa = {0.f, 0.f, 0.f, 0.f};
                if (s > 0) { pw = *(const f32x4*)(XWA + (size_t)(tok - 1) * 128 + k0 + 4 * hlf); pa = *(const f32x4*)(XWA + (size_t)(tok - 1) * 128 + 64 + k0 + 4 * hlf); }
                else if (!prm) { pw = *(const f32x4*)(ssh + (size_t)bs * 3200 + 3072 + k0 + 4 * hlf); pa = *(const f32x4*)(ssh + (size_t)bs * 3200 + 3136 + k0 + 4 * hlf); }
                const f32x4 mw = *(const f32x4*)(mu + 3072 + k0 + 4 * hlf), ma = *(const f32x4*)(mu + 3136 + k0 + 4 * hlf);
#pragma unroll
                for (int j = 0; j < 4; ++j) { const float xs = cw[j] + (pw[j] - cw[j]) * mw[j]; xw[4 * hlf + j] = 1.0f - 2.0f / (1.0f + __expf(2.0f * xs)); xa[4 * hlf + j] = ca[j] + (pa[j] - ca[j]) * ma[j]; }
            }
            Aw[ks] = pack8(xw); Aa[ks] = pack8(xa); }
        const size_t orow = (size_t)(item * 16 + trow) * 1024 + 4 * kg;
#pragma unroll 4
        for (int ct = 0; ct < 64; ++ct) { const int n = 16 * ct + trow;
            const bf16x8 bd0 = *(const bf16x8*)(WDEC + n * 64 + 8 * kg), bd1 = *(const bf16x8*)(WDEC + n * 64 + 32 + 8 * kg), ba0 = *(const bf16x8*)(WAAA + n * 64 + 8 * kg), ba1 = *(const bf16x8*)(WAAA + n * 64 + 32 + 8 * kg);
            f32x4 ad = {0.f, 0.f, 0.f, 0.f}, aa = {0.f, 0.f, 0.f, 0.f};
            ad = __builtin_amdgcn_mfma_f32_16x16x32_bf16(bd0, Aw[0], ad, 0, 0, 0); ad = __builtin_amdgcn_mfma_f32_16x16x32_bf16(bd1, Aw[1], ad, 0, 0, 0);
            aa = __builtin_amdgcn_mfma_f32_16x16x32_bf16(ba0, Aa[0], aa, 0, 0, 0); aa = __builtin_amdgcn_mfma_f32_16x16x32_bf16(ba1, Aa[1], aa, 0, 0, 0);
            const f32x4 w0v = *(const f32x4*)(w0 + 16 * ct + 4 * kg), a0v = *(const f32x4*)(a0 + 16 * ct + 4 * kg);
            u32x2 ev, av; ev.x = pk2(0.60653066f * sigm(w0v[0] + ad[0]), 0.60653066f * sigm(w0v[1] + ad[1])); ev.y = pk2(0.60653066f * sigm(w0v[2] + ad[2]), 0.60653066f * sigm(w0v[3] + ad[3]));
            av.x = pk2(sigm(a0v[0] + aa[0]), sigm(a0v[1] + aa[1])); av.y = pk2(sigm(a0v[2] + aa[2]), sigm(a0v[3] + aa[3]));
            *(u32x2*)(E + orow + 16 * ct) = ev; *(u32x2*)(A + orow + 16 * ct) = av; }
    }
    float* out = p.out; const int gt = vb * 512 + tid, ngt = NB * 512;
    for (int i = gt; i < 136 * 3200; i += ngt) { const int b = i / 3200, c = i - b * 3200; const int tok = b < 8 ? b * 2048 + 2047 : NPT + (b - 8) * 8 + 7;
        const float v = c < 3072 ? bf2f(U[(size_t)tok * 3072 + c]) : XWA[(size_t)tok * 128 + c - 3072];
        out[(b < 8 ? O_SHP + (size_t)b * 3200 : O_SHS + (size_t)(b - 8) * 3200) + c] = v; }
    for (int i = gt; i < 136 * 3072; i += ngt) { const int b = i / 3072, r = i - b * 3072, j = r >> 10, c = r & 1023; const int tok = b < 8 ? b * 2048 + 2045 + j : NPT + (b - 8) * 8 + 5 + j;
        out[(b < 8 ? O_CVP + (size_t)b * 3072 : O_CVS + (size_t)(b - 8) * 3072) + r] = bf2f(XB[(size_t)tok * 1024 + c]); }
}

constexpr int CH = 32;
constexpr int BUF_F = 6 * CH * 64;
constexpr int RW_LDS_OST = 2 * BUF_F * 4;
constexpr int OST_F = CH * 128;
struct Seg { int tok0, h, half; bool first, last; const float* S0; float* Sout; const float* shift0; };
__device__ __forceinline__ Seg get_seg(const float* srw, const float* ssh, float* out, int mode, int it0, int c, int j) {
    Seg g;
    if (mode == 0) { const int b = it0 >> 5; g.h = (it0 >> 1) & 15; g.half = it0 & 1; g.tok0 = b * 2048 + CH * c + 8 * j; g.first = (c == 0 && j == 0); g.last = (c == 2048 / CH - 1 && j == 3);
        g.S0 = nullptr; g.shift0 = nullptr; g.Sout = out + O_RWP + (size_t)(b * 16 + g.h) * 4096; }
    else { const int it = it0 + 4 * c + j, b = it >> 5; g.h = (it >> 1) & 15; g.half = it & 1; g.tok0 = NPT + b * 8; g.first = true; g.last = true;
        g.S0 = srw + (size_t)(b * 16 + g.h) * 4096; g.shift0 = ssh + (size_t)b * 3200; g.Sout = out + O_RWS + (size_t)(b * 16 + g.h) * 4096; }
    return g;
}
__device__ __forceinline__ void rwkv_prep(PREF p, LAS float* buf, const Seg g, int lw, int lane) {
    unsigned char* ws = p.ws;
    const bf16* U = (const bf16*)(ws + WS_U); const bf16* E = (const bf16*)p.out; const bf16* A = E + ZSTRIDE; float* BON = (float*)(ws + WS_BONUS);
    const int C = g.h * 64 + lane;
    const float mur = p.in[I_MU][C], muk = p.in[I_MU][1024 + C], muv = p.in[I_MU][2048 + C], kkc = p.in[I_KK][C], kac = p.in[I_KA][C], rkc = p.in[I_RK][C];
    float pr = 0.f, pk = 0.f, pv = 0.f;
    if (g.first) { if (g.shift0) { pr = g.shift0[C]; pk = g.shift0[1024 + C]; pv = g.shift0[2048 + C]; } }
    else { const bf16* up = U + (size_t)(g.tok0 - 1) * 3072 + C; pr = bf2f(up[0]); pk = bf2f(up[1024]); pv = bf2f(up[2048]); }
    bf16 ur[8], uk[8], uv[8], ee[8], aa[8];
#pragma unroll
    for (int i = 0; i < 8; ++i) { const size_t tok = (size_t)(g.tok0 + i); const bf16* up = U + tok * 3072 + C; ur[i] = up[0]; uk[i] = up[1024]; uv[i] = up[2048]; ee[i] = E[tok * 1024 + C]; aa[i] = A[tok * 1024 + C]; }
    float r8[8], kr8[8], kp8[8], v8[8], a8[8], dc8[8], xs[8], ys[8];
#pragma unroll
    for (int i = 0; i < 8; ++i) {
        const float fr = bf2f(ur[i]), fk = bf2f(uk[i]), fv = bf2f(uv[i]), e = bf2f(ee[i]), a = bf2f(aa[i]);
        const float r = fr + (pr - fr) * mur, k = fk + (pk - fk) * muk, v = fv + (pv - fv) * muv; pr = fr; pk = fk; pv = fv;
        const float kr = k * kkc, kp = k * (1.0f + (a - 1.0f) * kac);
        r8[i] = r; kr8[i] = kr; kp8[i] = kp; v8[i] = v; a8[i] = a; dc8[i] = __expf(-e); xs[i] = kr * kr; ys[i] = r * kp * rkc; }
    const bool b0 = (lane & 1) != 0, b1 = (lane & 2) != 0, b2 = (lane & 4) != 0, b3 = (lane & 8) != 0;
    float w8[8], u4[4], p2[2], f;
#pragma unroll
    for (int j = 0; j < 8; ++j) { const float keep = b0 ? ys[j] : xs[j], send = b0 ? xs[j] : ys[j]; w8[j] = keep + dppf<0xB1>(send); }
#pragma unroll
    for (int j = 0; j < 4; ++j) { const float keep = b1 ? w8[2 * j + 1] : w8[2 * j], send = b1 ? w8[2 * j] : w8[2 * j + 1]; u4[j] = keep + dppf<0x4E>(send); }
#pragma unroll
    for (int j = 0; j < 2; ++j) { const float keep = b2 ? u4[2 * j + 1] : u4[2 * j], send = b2 ? u4[2 * j] : u4[2 * j + 1];
        const int si = __builtin_bit_cast(int, send); int t = __builtin_amdgcn_update_dpp(si, si, 0x104, 0xF, 0x5, false); t = __builtin_amdgcn_update_dpp(t, si, 0x114, 0xF, 0xA, false);
        p2[j] = keep + __builtin_bit_cast(float, t); }
    { const float keep = b3 ? p2[1] : p2[0], send = b3 ? p2[0] : p2[1]; f = keep + dppf<0x128>(send); }
    f += __shfl_xor(f, 16); f += __shfl_xor(f, 32);
#pragma unroll
    for (int i = 0; i < 8; ++i) {
        const int s = 8 * lw + i; const float ss = rdl(f, 2 * i); const float kk = kr8[i] * __builtin_amdgcn_rsqf(ss + 1e-12f);
        LAS float* bp = buf + s * 64 + lane;
        bp[0] = dc8[i]; bp[CH * 64] = kk * a8[i]; bp[2 * CH * 64] = kp8[i]; bp[3 * CH * 64] = kk; bp[4 * CH * 64] = r8[i]; bp[5 * CH * 64] = v8[i]; }
    if (g.half == 0 && lane < 16 && b0) BON[(size_t)(g.tok0 + (lane >> 1)) * 16 + g.h] = f;
}
__device__ __forceinline__ void rwkv_oout(PREF p, const LAS float* ost, const Seg g, int ltid) {
    unsigned char* ws = p.ws; bf16* ORAW = (bf16*)(ws + WS_ORAW); float* ST = (float*)(ws + WS_STATS);
    const int s = ltid >> 3, q = ltid & 7;
    f32x4 o; { const LAS f32x4* pp = (const LAS f32x4*)(ost + s * 128 + q * 16);
      const f32x4 a0 = pp[0], a1 = pp[1], b0 = pp[2], b1 = pp[3]; o.x = (a0.x + a0.z) + (a1.x + a1.z); o.y = (a0.y + a0.w) + (a1.y + a1.w); o.z = (b0.x + b0.z) + (b1.x + b1.z); o.w = (b0.y + b0.w) + (b1.y + b1.w); }
    float sm = (o.x + o.y) + (o.z + o.w), sq = (o.x * o.x + o.y * o.y) + (o.z * o.z + o.w * o.w);
    sm += dppf<0xB1>(sm); sq += dppf<0xB1>(sq); sm += dppf<0x4E>(sm); sq += dppf<0x4E>(sq); sm += dppf<0x141>(sm); sq += dppf<0x141>(sq);
    const size_t tok = (size_t)(g.tok0 + (s & 7)); u32x2 w; w.x = pk2(o.x, o.y); w.y = pk2(o.z, o.w); *(u32x2*)(ORAW + tok * 1024 + g.h * 64 + 32 * g.half + 4 * q) = w;
    if (q == 0) *(f32x2*)(ST + ((tok * 16 + g.h) * 2 + g.half) * 2) = (f32x2){sm, sq};
}
struct ScanOps { f32x4 w4, b4, k4, kk4, r4; f32x2 v2; };
__device__ __forceinline__ ScanOps scan_load(const LAS float* buf, int s, int kl, int voff) { ScanOps o; const LAS float* bp = buf + s * 64 + 4 * kl;
    o.w4 = *(const LAS f32x4*)bp; o.b4 = *(const LAS f32x4*)(bp + CH * 64); o.k4 = *(const LAS f32x4*)(bp + 2 * CH * 64); o.kk4 = *(const LAS f32x4*)(bp + 3 * CH * 64); o.r4 = *(const LAS f32x4*)(bp + 4 * CH * 64);
    o.v2 = *(const LAS f32x2*)(buf + 5 * CH * 64 + s * 64 + voff); return o; }
__device__ __forceinline__ void rwkv_run(PREF p, LAS unsigned char* lds, int tid, int wave, int lane, int mode, int it0, int nch) {
    LAS float* bufs = (LAS float*)lds; LAS float* osts = (LAS float*)(lds + RW_LDS_OST);
    const float* srw = p.in[I_SRW]; const float* ssh = p.in[I_SSH]; float* out = p.out;
    const bool scan = wave < 4; const int rl = lane >> 4, kl = lane & 15, roff = 8 * wave + 2 * rl;
    f32x4 Sa = {0.f, 0.f, 0.f, 0.f}, Sb = Sa; f32x4 Na[4], Nb[4], Ma[4], Mb[4];
#pragma unroll
    for (int j = 0; j < 4; ++j) { Na[j] = Sa; Nb[j] = Sa; Ma[j] = Sa; Mb[j] = Sa; }
    if (scan) {
#pragma unroll
        for (int j = 0; j < 4; ++j) { const Seg g = get_seg(srw, ssh, out, mode, it0, 0, j); if (g.S0) { const int row = 32 * g.half + roff; Na[j] = *(const f32x4*)(g.S0 + row * 64 + 4 * kl); Nb[j] = *(const f32x4*)(g.S0 + (row + 1) * 64 + 4 * kl); } } }
    else rwkv_prep(p, bufs, get_seg(srw, ssh, out, mode, it0, 0, wave - 4), wave - 4, lane);
    __syncthreads();
    for (int c = 0; c < nch; ++c) {
        if (scan) {
            const LAS float* buf = bufs + (c & 1) * BUF_F; LAS float* ost = osts + (c & 1) * OST_F;
            ScanOps cur = scan_load(buf, 0, kl, 32 * get_seg(srw, ssh, out, mode, it0, c, 0).half + roff);
            if (c + 1 < nch) {
#pragma unroll
                for (int j = 0; j < 4; ++j) { const Seg n = get_seg(srw, ssh, out, mode, it0, c + 1, j); if (n.S0) { const int row = 32 * n.half + roff; Ma[j] = *(const f32x4*)(n.S0 + row * 64 + 4 * kl); Mb[j] = *(const f32x4*)(n.S0 + (row + 1) * 64 + 4 * kl); } } }
#pragma unroll
            for (int j = 0; j < 4; ++j) {
                const Seg g = get_seg(srw, ssh, out, mode, it0, c, j);
                if (g.first) { Sa = Na[j]; Sb = Nb[j]; }
                const int nh = get_seg(srw, ssh, out, mode, it0, c, j < 3 ? j + 1 : j).half;
#pragma unroll
                for (int i = 0; i < 8; ++i) {
                    const int s = 8 * j + i;
                    const int sn = s + 1 < CH ? s + 1 : s; const ScanOps nxt = scan_load(buf, sn, kl, 32 * (i == 7 && j < 3 ? nh : g.half) + roff);
                    const f32x2 kkL = __builtin_shufflevector(cur.kk4, cur.kk4, 0, 1), kkH = __builtin_shufflevector(cur.kk4, cur.kk4, 2, 3), wL = __builtin_shufflevector(cur.w4, cur.w4, 0, 1), wH = __builtin_shufflevector(cur.w4, cur.w4, 2, 3);
                    const f32x2 bL = __builtin_shufflevector(cur.b4, cur.b4, 0, 1), bH = __builtin_shufflevector(cur.b4, cur.b4, 2, 3), kL = __builtin_shufflevector(cur.k4, cur.k4, 0, 1), kH = __builtin_shufflevector(cur.k4, cur.k4, 2, 3);
                    const f32x2 rL = __builtin_shufflevector(cur.r4, cur.r4, 0, 1), rH = __builtin_shufflevector(cur.r4, cur.r4, 2, 3);
                    f32x2 SaL = __builtin_shufflevector(Sa, Sa, 0, 1), SaH = __builtin_shufflevector(Sa, Sa, 2, 3), SbL = __builtin_shufflevector(Sb, Sb, 0, 1), SbH = __builtin_shufflevector(Sb, Sb, 2, 3);
                    f32x2 ta = SaL * kkL; ta = __builtin_elementwise_fma(SaH, kkH, ta); f32x2 tb = SbL * kkL; tb = __builtin_elementwise_fma(SbH, kkH, tb);
                    float sa0 = ta.x + ta.y, sa1 = tb.x + tb.y;
                    sa0 += dppf<0xB1>(sa0); sa1 += dppf<0xB1>(sa1); sa0 += dppf<0x4E>(sa0); sa1 += dppf<0x4E>(sa1); sa0 += dppf<0x141>(sa0); sa1 += dppf<0x141>(sa1); sa0 += dppf<0x140>(sa0); sa1 += dppf<0x140>(sa1);
                    const f32x2 na = {-sa0, -sa0}, nb = {-sa1, -sa1}, va = {cur.v2.x, cur.v2.x}, vb = {cur.v2.y, cur.v2.y};
                    SaL = __builtin_elementwise_fma(va, kL, __builtin_elementwise_fma(na, bL, SaL * wL)); SaH = __builtin_elementwise_fma(va, kH, __builtin_elementwise_fma(na, bH, SaH * wH));
                    SbL = __builtin_elementwise_fma(vb, kL, __builtin_elementwise_fma(nb, bL, SbL * wL)); SbH = __builtin_elementwise_fma(vb, kH, __builtin_elementwise_fma(nb, bH, SbH * wH));
                    Sa = __builtin_shufflevector(SaL, SaH, 0, 1, 2, 3); Sb = __builtin_shufflevector(SbL, SbH, 0, 1, 2, 3);
                    f32x2 oa = SaL * rL; oa = __builtin_elementwise_fma(SaH, rH, oa); f32x2 ob = SbL * rL; ob = __builtin_elementwise_fma(SbH, rH, ob);
                    float o0 = oa.x + oa.y, o1 = ob.x + ob.y;
                    asm volatile("" : "+v"(o0), "+v"(o1));
                    o0 += dppf<0xB1>(o0); o1 += dppf<0xB1>(o1); o0 += dppf<0x4E>(o0); o1 += dppf<0x4E>(o1);
                    if ((kl & 3) == 0) *(LAS f32x2*)(ost + s * 128 + roff * 4 + (kl >> 2) * 2) = (f32x2){o0, o1};
                    cur = nxt;
                }
                if (g.last) { const int row = 32 * g.half + roff; *(f32x4*)(g.Sout + row * 64 + 4 * kl) = Sa; *(f32x4*)(g.Sout + (row + 1) * 64 + 4 * kl) = Sb; }
            }
#pragma unroll
            for (int j = 0; j < 4; ++j) { Na[j] = Ma[j]; Nb[j] = Mb[j]; }
        } else {
            if (c + 1 < nch) rwkv_prep(p, bufs + ((c + 1) & 1) * BUF_F, get_seg(srw, ssh, out, mode, it0, c + 1, wave - 4), wave - 4, lane);
            if (c >= 1) rwkv_oout(p, osts + ((c - 1) & 1) * OST_F, get_seg(srw, ssh, out, mode, it0, c - 1, (tid - 256) >> 6), tid - 256);
        }
        __syncthreads();
    }
    if (!scan) rwkv_oout(p, osts + ((nch - 1) & 1) * OST_F, get_seg(srw, ssh, out, mode, it0, nch - 1, (tid - 256) >> 6), tid - 256);
    __syncthreads();
}

template <int MODE> __device__ __forceinline__ void rglru_item(PREF p, LAS unsigned char* lds, int tid, int wave, int lane, int item, bool st) {
    asm volatile("" : "+v"(tid), "+v"(lane));
    constexpr int TPT = MODE ? 8 : 16, RC = 8 * TPT;
    unsigned char* ws = p.ws; const bf16* XB = (const bf16*)(ws + WS_XB); bf16* ZB = (bf16*)(ws + WS_Z) + ZSTRIDE;
    LAS float* XC = (LAS float*)lds; LAS float* GR = XC + RC * 65; LAS float* GI = GR + RC * 65; LAS bf16* XCB = (LAS bf16*)(GI + RC * 65); LAS float* TOT = (LAS float*)(XCB + RC * 72); LAS float* HC = TOT + 1024;
    const int c = tid & 63, sg = tid >> 6;
    const int g = MODE ? (item >> 4) : (item & 15), bb = MODE ? (8 * (item & 15) + sg) : (item >> 4), C = g * 64 + c;
    constexpr int nchunk = MODE ? 1 : 2048 / RC; const int rowtok = MODE ? (NPT + bb * 8) : (bb * 2048 + TPT * sg);
    const float cw0 = p.in[I_CW][C], cw1 = p.in[I_CW][1024 + C], cw2 = p.in[I_CW][2048 + C], cw3 = p.in[I_CW][3072 + C], cb = p.in[I_CB][C];
    const float sp = log1pf(__expf(-p.in[I_LAM][C]));
    const bf16* WT = (const bf16*)(ws + (wave >= 4 ? WS_WRGX : WS_WRGA)) + g * 4096; const float* bra = opq(p.in[I_BRGA]); const float* brx = opq(p.in[I_BRGX]); const float* bias = (wave >= 4 ? brx : bra) + g * 64;
    const int trow = lane & 15, kg = lane >> 4;
    bf16x8 wb0[4], wb1[4]; float bn[4];
#pragma unroll
    for (int ct = 0; ct < 4; ++ct) { const int n = 16 * ct + trow; wb0[ct] = *(const bf16x8*)(WT + n * 64 + 8 * kg); wb1[ct] = *(const bf16x8*)(WT + n * 64 + 32 + 8 * kg); bn[ct] = bias[n]; }
    float hin = 0.f; float e0 = 0.f, e1 = 0.f, e2 = 0.f;
    if (MODE) { hin = p.in[I_SLRU][(size_t)bb * 1024 + C]; const float* cv = p.in[I_SCV] + (size_t)bb * 3072 + C; e0 = cv[0]; e1 = cv[1024]; e2 = cv[2048]; }
    else { if (tid < 64) HC[c] = 0.f; if (sg > 0) { const bf16* xp = XB + (size_t)(rowtok - 3) * 1024 + C; e0 = bf2f(xp[0]); e1 = bf2f(xp[1024]); e2 = bf2f(xp[2048]); } }
    bf16 xn[TPT], zn[TPT];
#pragma unroll
    for (int i = 0; i < TPT; ++i) { xn[i] = XB[(size_t)(rowtok + i) * 1024 + C]; zn[i] = ZB[(size_t)(rowtok + i) * 1024 + C]; }
    for (int k = 0; k < nchunk; ++k) {
        const int tok = rowtok + RC * k;
        float zb[TPT];
#pragma unroll
        for (int i = 0; i < TPT; ++i) { const float e3 = bf2f(xn[i]); zb[i] = bf2f(zn[i]); const float xc = cb + e0 * cw0 + e1 * cw1 + e2 * cw2 + e3 * cw3;
            XC[(sg * TPT + i) * 65 + c] = xc; XCB[(sg * TPT + i) * 72 + c] = (bf16)f2bf(xc); e0 = e1; e1 = e2; e2 = e3; }
        if (k + 1 < nchunk) {
            const bf16* xp = XB + (size_t)(tok + RC - 3) * 1024 + C; e0 = bf2f(xp[0]); e1 = bf2f(xp[1024]); e2 = bf2f(xp[2048]);
#pragma unroll
            for (int i = 0; i < TPT; ++i) { xn[i] = XB[(size_t)(tok + RC + i) * 1024 + C]; zn[i] = ZB[(size_t)(tok + RC + i) * 1024 + C]; } }
        __syncthreads();
        { LAS float* GO = wave >= 4 ? GI : GR;
#pragma unroll
          for (int u = 0; u < RC / 64; ++u) { const int tt = (wave & 3) + 4 * u;
            const bf16x8 a0 = *(const LAS bf16x8*)(XCB + (16 * tt + trow) * 72 + 8 * kg), a1 = *(const LAS bf16x8*)(XCB + (16 * tt + trow) * 72 + 32 + 8 * kg);
#pragma unroll
            for (int ct = 0; ct < 4; ++ct) { const int n = 16 * ct + trow;
                f32x4 acc = {0.f, 0.f, 0.f, 0.f}; acc = __builtin_amdgcn_mfma_f32_16x16x32_bf16(a0, wb0[ct], acc, 0, 0, 0); acc = __builtin_amdgcn_mfma_f32_16x16x32_bf16(a1, wb1[ct], acc, 0, 0, 0);
#pragma unroll
                for (int r = 0; r < 4; ++r) GO[(16 * tt + 4 * kg + r) * 65 + n] = sigm(acc[r] + bn[ct]); } } }
        __syncthreads();
        float hl[TPT], cm[TPT]; { float h = 0.f, cum = 1.f;
#pragma unroll
          for (int i = 0; i < TPT; ++i) { const int s = sg * TPT + i; const float gr = GR[s * 65 + c], gi = GI[s * 65 + c], xc = XC[s * 65 + c];
              const float la = -8.0f * gr * sp, x2 = 2.0f * la;
              const float om = -x2 * (1.0f + x2 * 0.5f * (1.0f + x2 * (1.0f / 3.0f) * (1.0f + x2 * 0.25f * (1.0f + x2 * 0.2f * (1.0f + x2 * (1.0f / 6.0f) * (1.0f + x2 * (1.0f / 7.0f)))))));
              const float a = __expf(la), b = sqrtf(om) * gi * xc;
              h = a * h + b; cum *= a; hl[i] = h; cm[i] = cum; }
          if (!MODE) { TOT[sg * 64 + c] = cum; TOT[512 + sg * 64 + c] = h; } }
        if (!MODE) __syncthreads();
        { float h = hin;
          if (!MODE) { h = HC[(k & 1) * 64 + c]; for (int j = 0; j < sg; ++j) h = TOT[j * 64 + c] * h + TOT[512 + j * 64 + c]; }
          if (st) {
#pragma unroll
              for (int i = 0; i < TPT; ++i) ZB[(size_t)(tok + i) * 1024 + C] = (bf16)f2bf((hl[i] + cm[i] * h) * zb[i]); }
          const float hn = hl[TPT - 1] + cm[TPT - 1] * h;
          if (MODE) p.out[O_LRS + (size_t)bb * 1024 + C] = hn;
          else if (sg == 7) { HC[((k + 1) & 1) * 64 + c] = hn; if (k == nchunk - 1) p.out[O_LRP + (size_t)bb * 1024 + C] = hn; } }
    }
    __syncthreads();
}

constexpr int XA_STG = 128 * 528, XA_PL = 8448;
__device__ __forceinline__ void xa_stage(LAS unsigned char* lds, const bf16* src, size_t ld, int tid) {
#pragma unroll
    for (int i = 0; i < 8; ++i) { const int e = tid + 512 * i, row = e >> 5, seg = e & 31; *(LAS u32x4*)(lds + row * 528 + seg * 16) = *(const u32x4*)(src + (size_t)row * ld + seg * 8); }
}
__device__ __forceinline__ void xattn_prompt_item(PREF p, LAS unsigned char* lds, int tid, int wave, int lane, int item, bool st) {
    unsigned char* ws = p.ws; const bf16* Q = (const bf16*)(ws + WS_Q); const bf16* MK = (const bf16*)(ws + WS_MK); const bf16* MVT = (const bf16*)(ws + WS_MVT); bf16* ZC = (bf16*)(ws + WS_Z) + 2 * ZSTRIDE;
    LAS bf16* PL = (LAS bf16*)(lds + XA_STG + wave * XA_PL);
    const int qb = item & 15, head = (item >> 4) & 3, b = item >> 6, tok0 = b * 2048 + 128 * qb + 16 * wave, trow = lane & 15, kg = lane >> 4;
    bf16x8 qf[8];
#pragma unroll
    for (int ks = 0; ks < 8; ++ks) qf[ks] = *(const bf16x8*)(Q + (size_t)(tok0 + trow) * 1024 + head * 256 + 32 * ks + 8 * kg);
    f32x4 S[16];
#pragma unroll
    for (int hk = 0; hk < 2; ++hk) {
        __syncthreads();
        xa_stage(lds, MK + (size_t)(b * 256 + 128 * hk) * 1024 + head * 256, 1024, tid);
        __syncthreads();
#pragma unroll
        for (int mt = 0; mt < 8; ++mt) { f32x4 acc = {0.f, 0.f, 0.f, 0.f}; const LAS unsigned char* kp = lds + (16 * mt + trow) * 528 + kg * 16;
#pragma unroll
            for (int ks = 0; ks < 8; ++ks) acc = __builtin_amdgcn_mfma_f32_16x16x32_bf16(qf[ks], *(const LAS bf16x8*)(kp + ks * 64), acc, 0, 0, 0);
            S[8 * hk + mt] = acc; }
    }
    f32x4 mx = S[0];
#pragma unroll
    for (int mt = 1; mt < 16; ++mt) { mx.x = fmaxf(mx.x, S[mt].x); mx.y = fmaxf(mx.y, S[mt].y); mx.z = fmaxf(mx.z, S[mt].z); mx.w = fmaxf(mx.w, S[mt].w); }
    mx.x = row16_max(mx.x); mx.y = row16_max(mx.y); mx.z = row16_max(mx.z); mx.w = row16_max(mx.w);
    f32x4 sm = {0.f, 0.f, 0.f, 0.f};
#pragma unroll
    for (int mt = 0; mt < 16; ++mt) { f32x4 e; e.x = __expf((S[mt].x - mx.x) * 0.0625f); e.y = __expf((S[mt].y - mx.y) * 0.0625f); e.z = __expf((S[mt].z - mx.z) * 0.0625f); e.w = __expf((S[mt].w - mx.w) * 0.0625f);
        sm += e; const int col = 16 * mt + trow;
        PL[(4 * kg + 0) * 264 + col] = (bf16)f2bf(e.x); PL[(4 * kg + 1) * 264 + col] = (bf16)f2bf(e.y); PL[(4 * kg + 2) * 264 + col] = (bf16)f2bf(e.z); PL[(4 * kg + 3) * 264 + col] = (bf16)f2bf(e.w); }
    sm.x = row16_sum(sm.x); sm.y = row16_sum(sm.y); sm.z = row16_sum(sm.z); sm.w = row16_sum(sm.w);
    const f32x4 inv = {1.0f / sm.x, 1.0f / sm.y, 1.0f / sm.z, 1.0f / sm.w};
    LDS_WAIT();
    bf16x8 pf[8];
#pragma unroll
    for (int ks = 0; ks < 8; ++ks) pf[ks] = *(const LAS bf16x8*)(PL + trow * 264 + 32 * ks + 8 * kg);
#pragma unroll
    for (int hv = 0; hv < 2; ++hv) {
        __syncthreads();
        xa_stage(lds, MVT + ((size_t)((b * 4 + head) * 256 + 128 * hv)) * 256, 256, tid);
        __syncthreads();
#pragma unroll
        for (int dt = 0; dt < 8; ++dt) { f32x4 acc = {0.f, 0.f, 0.f, 0.f}; const LAS unsigned char* vp = lds + (16 * dt + trow) * 528 + kg * 16;
#pragma unroll
            for (int ks = 0; ks < 8; ++ks) acc = __builtin_amdgcn_mfma_f32_16x16x32_bf16(pf[ks], *(const LAS bf16x8*)(vp + ks * 64), acc, 0, 0, 0);
            acc = acc * inv; const int col = head * 256 + 128 * hv + 16 * dt + trow;
#pragma unroll
            for (int r = 0; r < 4; ++r) { bf16* zp = ZC + (size_t)(tok0 + 4 * kg + r) * 1024 + col; const bf16 nv = (bf16)f2bf(acc[r] * bf2f(*zp)); if (st) *zp = nv; } }
    }
    __syncthreads();
}

__device__ __forceinline__ void xattn_sample_item(PREF p, LAS unsigned char* lds, int tid, int wave, int lane, int item, bool st) {
    unsigned char* ws = p.ws; const bf16* Q = (const bf16*)(ws + WS_Q); bf16* ZC = (bf16*)(ws + WS_Z) + 2 * ZSTRIDE;
    LAS float* QS = (LAS float*)lds; LAS float* SC = QS + 2048; LAS float* PART = SC + 2048;
    const int b = item >> 2, head = item & 3, tok0 = NPT + b * 8;
    for (int i = tid; i < 2048; i += 512) QS[i] = bf2f(Q[(size_t)(tok0 + (i >> 8)) * 1024 + head * 256 + (i & 255)]);
    __syncthreads();
    const float* Vc = p.in[I_CV] + ((size_t)b * 256 * 4 + head) * 256 + 4 * lane;
    { const int kl = lane & 15, rq = lane >> 4; const float* Kc = p.in[I_CK] + ((size_t)b * 256 * 4 + head) * 256 + 4 * kl;
      f32x4 q[8][4];
#pragma unroll
      for (int i = 0; i < 8; ++i)
#pragma unroll
          for (int j = 0; j < 4; ++j) q[i][j] = *(const LAS f32x4*)(QS + i * 256 + 64 * j + 4 * kl);
#pragma unroll 2
      for (int r = 0; r < 8; ++r) { const int m = 32 * wave + 4 * r + rq; const f32x4* kp = (const f32x4*)(Kc + (size_t)m * 1024);
          const f32x4 k0 = kp[0], k1 = kp[16], k2 = kp[32], k3 = kp[48];
#pragma unroll
          for (int i = 0; i < 8; ++i) { f32x4 t = q[i][0] * k0 + q[i][1] * k1 + q[i][2] * k2 + q[i][3] * k3; float d = row16_sum((t.x + t.y) + (t.z + t.w));
              if (kl == i) SC[i * 256 + m] = d * 0.0625f; } } }
    __syncthreads();
    { float v[4]; float mx = -3.0e38f;
#pragma unroll
      for (int j = 0; j < 4; ++j) { v[j] = SC[wave * 256 + lane + 64 * j]; mx = fmaxf(mx, v[j]); }
      mx = wave_max(mx); float sm = 0.f;
#pragma unroll
      for (int j = 0; j < 4; ++j) { v[j] = __expf(v[j] - mx); sm += v[j]; }
      sm = wave_sum(sm); const float inv = 1.0f / sm;
#pragma unroll
      for (int j = 0; j < 4; ++j) SC[wave * 256 + lane + 64 * j] = v[j] * inv; }
    __syncthreads();
    { f32x4 acc[8];
#pragma unroll
      for (int i = 0; i < 8; ++i) acc[i] = (f32x4){0.f, 0.f, 0.f, 0.f};
#pragma unroll 8
      for (int r = 0; r < 32; ++r) { const int m = 32 * wave + r; const f32x4 vv = *(const f32x4*)(Vc + (size_t)m * 1024);
#pragma unroll
          for (int i = 0; i < 8; ++i) acc[i] += SC[i * 256 + m] * vv; }
#pragma unroll
      for (int i = 0; i < 8; ++i) *(LAS f32x4*)(PART + (wave * 8 + i) * 256 + 4 * lane) = acc[i]; }
    __syncthreads();
    { const int q = tid >> 6, d = 4 * (tid & 63); f32x4 s = {0.f, 0.f, 0.f, 0.f};
#pragma unroll
      for (int w = 0; w < 8; ++w) s += *(const LAS f32x4*)(PART + (w * 8 + q) * 256 + d);
      u32x2* zp = (u32x2*)(ZC + (size_t)(tok0 + q) * 1024 + head * 256 + d); const u32x2 z = *zp;
      u32x2 o; o.x = pk2(s.x * bflo(z.x), s.y * bfhi(z.x)); o.y = pk2(s.z * bflo(z.y), s.w * bfhi(z.y)); if (st) *zp = o; }
    __syncthreads();
}

__device__ __forceinline__ void p4_post(PREF p, int tid, int G, bool stw) {
    unsigned char* ws = p.ws; const bf16* ORAW = (const bf16*)(ws + WS_ORAW); const bf16* U = (const bf16*)(ws + WS_U); bf16* ZA = (bf16*)(ws + WS_Z);
    const float* ST = (const float*)(ws + WS_STATS); const float* BON = (const float*)(ws + WS_BONUS);
    const float* muv = p.in[I_MU] + 2048; const float* gng = p.in[I_GNG]; const float* gnb = p.in[I_GNB]; const float* ssh = p.in[I_SSH];
    for (int i = blockIdx.x * 512 + tid; i < NT * 128; i += G * 512) {
        const int tok = i >> 7, c0 = (i & 127) * 8, h = c0 >> 6; const bool prm = tok < NPT; const int s = prm ? (tok & 2047) : ((tok - NPT) & 7); const int bs = (tok - NPT) >> 3;
        const f32x4 st = *(const f32x4*)(ST + ((size_t)tok * 16 + h) * 4);
        const float mean = (st.x + st.z) * (1.f / 64.f), var = (st.y + st.w) * (1.f / 64.f) - mean * mean, rstd = rsqrtf(fmaxf(var, 0.f) + 64e-5f), bon = BON[(size_t)tok * 16 + h];
        const u32x4 o = *(const u32x4*)(ORAW + (size_t)tok * 1024 + c0), z = *(const u32x4*)(ZA + (size_t)tok * 1024 + c0), vc = *(const u32x4*)(U + (size_t)tok * 3072 + 2048 + c0);
        float pv[8];
        if (s > 0) { const u32x4 vp = *(const u32x4*)(U + (size_t)(tok - 1) * 3072 + 2048 + c0); pv[0] = bflo(vp.x); pv[1] = bfhi(vp.x); pv[2] = bflo(vp.y); pv[3] = bfhi(vp.y); pv[4] = bflo(vp.z); pv[5] = bfhi(vp.z); pv[6] = bflo(vp.w); pv[7] = bfhi(vp.w); }
        else if (!prm) {
#pragma unroll
            for (int j = 0; j < 8; ++j) pv[j] = ssh[(size_t)bs * 3200 + 2048 + c0 + j]; }
        else {
#pragma unroll
            for (int j = 0; j < 8; ++j) pv[j] = 0.f; }
        const unsigned ow[4] = {o.x, o.y, o.z, o.w}, zw[4] = {z.x, z.y, z.z, z.w}, vw[4] = {vc.x, vc.y, vc.z, vc.w}; unsigned rw[4];
#pragma unroll
        for (int j = 0; j < 4; ++j) { float r2[2];
#pragma unroll
            for (int e = 0; e < 2; ++e) { const int c = c0 + 2 * j + e; const float ov = e ? bfhi(ow[j]) : bflo(ow[j]), zv = e ? bfhi(zw[j]) : bflo(zw[j]), uv = e ? bfhi(vw[j]) : bflo(vw[j]);
                const float v = uv + (pv[2 * j + e] - uv) * muv[c]; r2[e] = ((ov - mean) * rstd * gng[c] + gnb[c] + bon * v) * zv; }
            rw[j] = pk2(r2[0], r2[1]); }
        if (stw) *(u32x4*)(ZA + (size_t)tok * 1024 + c0) = (u32x4){rw[0], rw[1], rw[2], rw[3]};
    }
}
__device__ __forceinline__ void p5_sum(PREF p, int tid, int G) {
    unsigned char* ws = p.ws; const float* P = (const float*)(ws + WS_P); const bf16* Gt = (const bf16*)(ws + WS_G); bf16* M = (bf16*)(ws + WS_MERGED);
    for (int i = blockIdx.x * 512 + tid; i < 1024 * 128; i += G * 512) { const int rs = i >> 7, c0 = (i & 127) * 8; const size_t tok = (size_t)(NPT + rs);
        float o[8];
#pragma unroll
        for (int j = 0; j < 8; ++j) o[j] = 0.f;
#pragma unroll
        for (int br = 0; br < 3; ++br) { f32x4 a0 = {0.f, 0.f, 0.f, 0.f}, a1 = a0;
#pragma unroll
            for (int kq = 0; kq < 4; ++kq) { const float* pp = P + (size_t)(kq * 3 + br) * 1048576 + (size_t)rs * 1024 + c0; a0 += *(const f32x4*)pp; a1 += *(const f32x4*)(pp + 4); }
            const u32x4 g = *(const u32x4*)(Gt + tok * 3072 + br * 1024 + c0);
            o[0] += a0.x * bflo(g.x); o[1] += a0.y * bfhi(g.x); o[2] += a0.z * bflo(g.y); o[3] += a0.w * bfhi(g.y); o[4] += a1.x * bflo(g.z); o[5] += a1.y * bfhi(g.z); o[6] += a1.z * bflo(g.w); o[7] += a1.w * bfhi(g.w); }
        *(u32x4*)(M + tok * 1024 + c0) = (u32x4){pk2(o[0], o[1]), pk2(o[2], o[3]), pk2(o[4], o[5]), pk2(o[6], o[7])}; }
}
__device__ __forceinline__ void p6_norm(PREF p, int r0, int r1, int vb, int nvb, int wave, int lane) {
    const f32x4* gf = (const f32x4*)p.in[I_GF] + lane;
    for (int m = r0 + vb * 8 + wave; m < r1; m += nvb * 8) { f32x4* xr = (f32x4*)(p.out + (size_t)m * 1024) + lane; f32x4 v[4]; float s = 0.f;
#pragma unroll
        for (int j = 0; j < 4; ++j) { v[j] = xr[64 * j]; s += (v[j].x * v[j].x + v[j].y * v[j].y) + (v[j].z * v[j].z + v[j].w * v[j].w); }
        const float rstd = rsqrtf(wave_sum(s) * (1.f / 1024.f) + 1e-6f);
#pragma unroll
        for (int j = 0; j < 4; ++j) xr[64 * j] = v[j] * rstd * gf[64 * j]; }
}

__device__ __forceinline__ void p6s_norm(PREF p, int vb, int nvb, int wave, int lane) {
    const f32x4* gf = (const f32x4*)p.in[I_GF] + lane; const float* YP = (const float*)(p.ws + WS_YP);
    for (int m = vb * 8 + wave; m < 1024; m += nvb * 8) { const f32x4* xr = (const f32x4*)(p.in[I_XS] + (size_t)m * 1024) + lane; f32x4 v[4]; float s = 0.f;
#pragma unroll
        for (int j = 0; j < 4; ++j) { v[j] = xr[64 * j];
#pragma unroll
            for (int kq = 0; kq < 4; ++kq) v[j] += ((const f32x4*)(YP + (size_t)kq * 1048576 + (size_t)m * 1024) + lane)[64 * j];
            s += (v[j].x * v[j].x + v[j].y * v[j].y) + (v[j].z * v[j].z + v[j].w * v[j].w); }
        const float rstd = rsqrtf(wave_sum(s) * (1.f / 1024.f) + 1e-6f); f32x4* orow = (f32x4*)(p.out + (size_t)(NPT + m) * 1024) + lane;
#pragma unroll
        for (int j = 0; j < 4; ++j) orow[64 * j] = v[j] * rstd * gf[64 * j]; }
}

#define XB_TMO      128
#define XB_XCNT(j)  (256  + 64 * (j))
#define XB_XSUB(j)  (1280 + 64 * (j))
#define XB_XGEN(j)  (2304 + 64 * (j))
#define XB_TOP      3328
#define XB_TOPGEN   3392
#define XCD_BAR_WORDS 3456
#define XB_SPIN_CAP (1u << 18)

__device__ __forceinline__ unsigned xb_ld(unsigned* p)              { return __hip_atomic_load(p, __ATOMIC_RELAXED, __HIP_MEMORY_SCOPE_AGENT); }
__device__ __forceinline__ unsigned xb_add(unsigned* p, unsigned v) { return __hip_atomic_fetch_add(p, v, __ATOMIC_RELAXED, __HIP_MEMORY_SCOPE_AGENT); }
__device__ __forceinline__ unsigned xb_xcc_id() { return (unsigned)__builtin_amdgcn_s_getreg((3 << 11) | 20) & 0xFu; }
#define XB_SPIN(cond, bar) do { unsigned _sp = 0; while (cond) { __builtin_amdgcn_s_sleep(1); \
    if ((++_sp & 255u) == 0u) { if (xb_ld(&(bar)[XB_TMO])) break; if (_sp > XB_SPIN_CAP) { atomicAdd(&(bar)[XB_TMO], 1u); break; } } } } while (0)

struct XcdBarrier {
    unsigned* bar; unsigned x;
    volatile LAS unsigned* st;
};

__device__ __forceinline__ XcdBarrier xcd_barrier_post(unsigned* bar, volatile LAS unsigned* st) {
    XcdBarrier b; b.bar = bar; b.x = xb_xcc_id(); b.st = st;
    if (threadIdx.x == 0) (void)xb_add(&bar[XB_XCNT(b.x)], 1u);
    return b;
}
__device__ __forceinline__ void xcd_barrier_complete(unsigned* bar, unsigned x, unsigned& nloc, unsigned& nx) {
    const unsigned G = gridDim.x * gridDim.y * gridDim.z;
    unsigned sum, cnt, mine, sp = 0u;
    for (;;) {
        sum = 0u; cnt = 0u; mine = 0u;
#pragma unroll
        for (unsigned j = 0; j < 16; ++j) { const unsigned c = xb_ld(&bar[XB_XCNT(j)]); sum += c; cnt += (c > 0u) ? 1u : 0u; mine = (j == x) ? c : mine; }
        if (sum == G) break;
        __builtin_amdgcn_s_sleep(1);
        if ((++sp & 255u) == 0u) { if (xb_ld(&bar[XB_TMO])) break; if (sp > XB_SPIN_CAP) { atomicAdd(&bar[XB_TMO], 1u); break; } }
    }
    nloc = mine > 0u ? mine : 1u; nx = cnt > 0u ? cnt : 1u;
}

__device__ __forceinline__ void xcd_barrier(const XcdBarrier& b) {
    asm volatile("s_waitcnt vmcnt(0)" ::: "memory");
    __syncthreads();
    if (threadIdx.x == 0) {
        unsigned* bar = b.bar;
        __builtin_amdgcn_s_waitcnt(0);
        unsigned nloc = b.st[0], nx = b.st[1];
        if (nloc == 0u) { xcd_barrier_complete(bar, b.x, nloc, nx); b.st[0] = nloc; b.st[1] = nx; }
        const unsigned old = xb_add(&bar[XB_XSUB(b.x)], 1u);
        const unsigned gen = old / nloc;
        if (old + 1u == (gen + 1u) * nloc) {
            __builtin_amdgcn_fence(__ATOMIC_RELEASE, "agent");
            asm volatile("s_waitcnt vmcnt(0)" ::: "memory");
            const unsigned og = xb_add(&bar[XB_TOP], 1u);
            const unsigned tg = og / nx;
            if (og + 1u == (tg + 1u) * nx) xb_add(&bar[XB_TOPGEN], 1u);
            else XB_SPIN(xb_ld(&bar[XB_TOPGEN]) == tg, bar);
            __builtin_amdgcn_fence(__ATOMIC_ACQUIRE, "agent");
            xb_add(&bar[XB_XGEN(b.x)], 1u);
            asm volatile("s_waitcnt vmcnt(0)" ::: "memory");
        } else {
            XB_SPIN(xb_ld(&bar[XB_XGEN(b.x)]) == gen, bar);
            __builtin_amdgcn_fence(__ATOMIC_ACQUIRE, "agent");
            asm volatile("s_waitcnt vmcnt(0)" ::: "memory");
        }
    }
    __syncthreads();
}

#ifndef MK_LAST_PHASE
#define MK_LAST_PHASE 99
#endif
__global__ void __launch_bounds__(512, 2) fwd(Params p_arg) {
    extern __shared__ __attribute__((aligned(16))) unsigned char lds_raw[];
    LAS unsigned char* lds = (LAS unsigned char*)lds_raw;
    cg::grid_group grid = cg::this_grid();
    const int tid = threadIdx.x, lane = tid & 63, wave = __builtin_amdgcn_readfirstlane(tid >> 6), G = gridDim.x, bx = blockIdx.x;
    CParams* kp = (CParams*)__builtin_amdgcn_kernarg_segment_ptr();
    unsigned char* ws = kp->ws;
#define p (*launder(kp))
    if (tid < 8) ((LAS unsigned*)(lds + LDS_BYTES - 32))[tid] = 0u;
    __syncthreads();
    const XcdBarrier xbar = xcd_barrier_post((unsigned*)(ws + WS_CTR) + 1024, (volatile LAS unsigned*)(lds + LDS_BYTES - 32));
#ifndef PROBE_DUP
#define PROBE_DUP 0
#endif
#define REP(n) for (int rep_ = (PROBE_DUP == (n) ? 0 : 1); rep_ < 2; ++rep_)
    REP(10) { p0_prologue(p, lds, tid, wave, lane, G); __syncthreads(); }
    if (kp->zero != 0) grid.sync();
    xcd_barrier(xbar);
    REP(1) { pg8::Gemm g{(const pg8::bf16_t*)(ws + WS_XN), (const pg8::bf16_t*)(ws + WS_WIN), NT, 11520, 1024}; pg8::StaticOrder S; S.init(NT, 11520, G, bx); EpiMain E{ws};
      pg8::gemm_phase<EpiMain, pg8::StaticOrder>((PG8_LAS unsigned char*)lds, g, S, E, nullptr); }
    xcd_barrier(xbar);
    REP(7) if (G >= 128) {
        if (bx < 64) { pg8::Gemm g{(const pg8::bf16_t*)(ws + WS_XN) + (size_t)NT * 1024, (const pg8::bf16_t*)(ws + WS_WIN) + (size_t)11520 * 1024, 2048, 2048, 1024}; SchedMem S{bx}; EpiMem E{ws, p.out};
            pg8::gemm_phase<EpiMem, SchedMem>((PG8_LAS unsigned char*)lds, g, S, E, nullptr); }
        else p2_lora(p, bx - 64, G - 64, tid, wave, lane);
    }
    xcd_barrier(xbar);
#ifndef PROBE_DUP
#define PROBE_DUP 0
#endif
    for (int rep = (PROBE_DUP == 2 ? 0 : 1); rep < 2; ++rep)
    for (int it = bx; it < 256; it += G) rwkv_run(p, lds, tid, wave, lane, 0, it, 2048 / CH);
    for (int rep = (PROBE_DUP == 3 ? 0 : 1); rep < 2; ++rep)
    for (int it = bx * 16; it < 4096; it += G * 16) rwkv_run(p, lds, tid, wave, lane, 1, it, 4);
    for (int rep = (PROBE_DUP == 4 ? 0 : 1); rep < 2; ++rep) { const bool st = (rep == 1) || (p.zero != 0);
        if (bx < 128) rglru_item<0>(p, lds, tid, wave, lane, bx, st); else { rglru_item<1>(p, lds, tid, wave, lane, bx - 128, st); rglru_item<1>(p, lds, tid, wave, lane, bx, st); } }
    { const bool st = true;
        LAS unsigned* slot = (LAS unsigned*)(lds + LDS_BYTES - 16); unsigned* ctr = (unsigned*)(ws + WS_CTR);
        for (;;) {
            if (tid == 0) *slot = atomicAdd(ctr, 1u);
            __syncthreads();
            const unsigned it = *slot;
            __syncthreads();
            if (it >= 1024u) break;
            if ((it & 1u) == 0u) xattn_sample_item(p, lds, tid, wave, lane, (int)(it >> 1), st); else xattn_prompt_item(p, lds, tid, wave, lane, (int)(it >> 1), st);
        } }
    xcd_barrier(xbar);
    p4_post(p, tid, G, true);
    xcd_barrier(xbar);
    { pg8::Gemm g{(const pg8::bf16_t*)(ws + WS_Z), (const pg8::bf16_t*)(ws + WS_WBR), 3 * NT, 3072, 1024}; SchedTail S{bx}; EpiTail E{ws};
      pg8::gemm_phase<EpiTail, SchedTail>((PG8_LAS unsigned char*)lds, g, S, E, nullptr);
      if (bx < 192) { pg8::Gemm g4 = g; g4.nt = 4; SchedBrS S2{bx}; EpiPart E2{ws}; pg8::gemm_phase<EpiPart, SchedBrS>((PG8_LAS unsigned char*)lds, g4, S2, E2, nullptr); } }
    xcd_barrier(xbar);
    p5_sum(p, tid, G);
    { pg8::Gemm g{(const pg8::bf16_t*)(ws + WS_MERGED), (const pg8::bf16_t*)(ws + WS_WOUT), NPT, 1024, 1024}; pg8::StaticOrder S; S.init(NPT, 1024, G, bx); EpiOut E{opq(p.in[I_XP]), opq(p.in[I_XS]), p.out};
      pg8::gemm_phase<EpiOut, pg8::StaticOrder>((PG8_LAS unsigned char*)lds, g, S, E, nullptr); }
    xcd_barrier(xbar);
    if (bx < 64) { pg8::Gemm g{(const pg8::bf16_t*)(ws + WS_MERGED), (const pg8::bf16_t*)(ws + WS_WOUT), NT, 1024, 1024, 4}; SchedOutS S{bx}; EpiPartY E{ws};
      pg8::gemm_phase<EpiPartY, SchedOutS>((PG8_LAS unsigned char*)lds, g, S, E, nullptr);
      p6_norm(p, 0, NPT, bx, 448, wave, lane); }
    else { p6_norm(p, 0, NPT, 64 + 2 * (bx - 64), 448, wave, lane); p6_norm(p, 0, NPT, 65 + 2 * (bx - 64), 448, wave, lane); }
    xcd_barrier(xbar);
    p6s_norm(p, bx, G, wave, lane);
#undef p
}
}

extern "C" void kernel_launch(void* const* d_in, const int* in_sizes, int n_in, void* d_out, int out_size, void* d_ws, size_t ws_size, hipStream_t stream) {
    static int grid = 0;
    if (grid == 0) {
        if (n_in != 35 || (size_t)out_size != mk::O_END || ws_size < mk::WS_END) { fprintf(stderr, "kernel_launch: unexpected shapes: n_in %d out %d ws %zu\n", n_in, out_size, ws_size); grid = -1; return; }
        int dev = 0, cus = 0, per_cu = 0;
        hipGetDevice(&dev); hipDeviceGetAttribute(&cus, hipDeviceAttributeMultiprocessorCount, dev);
        hipFuncSetAttribute((const void*)mk::fwd, hipFuncAttributeMaxDynamicSharedMemorySize, mk::LDS_BYTES);
        hipOccupancyMaxActiveBlocksPerMultiprocessor(&per_cu, (const void*)mk::fwd, 512, mk::LDS_BYTES);
        if (per_cu < 1) { fprintf(stderr, "kernel_launch: occupancy query says %d blocks per CU\n", per_cu); per_cu = 1; }
        grid = cus * 1;
        (void)hipGetLastError();
    }
    if (grid < 0) return;
    mk::Params p{};
    for (int i = 0; i < 35; ++i) p.in[i] = (const float*)d_in[i];
    p.out = (float*)d_out; p.ws = (unsigned char*)d_ws;
    (void)hipMemsetAsync((unsigned char*)d_ws + mk::WS_CTR, 0, 32768, stream);
    void* args[] = {&p};
    hipError_t e = hipLaunchCooperativeKernel((const void*)mk::fwd, dim3(grid), dim3(512), args, mk::LDS_BYTES, stream);
    if (e != hipSuccess) fprintf(stderr, "cooperative launch failed: %s (grid %d)\n", hipGetErrorString(e), grid);
}
```

```cpp
#include <hip/hip_cooperative_groups.h>
#include <cstdio>
#include <hip/hip_runtime.h>
namespace pg8 {
#define PG8_LAS __attribute__((address_space(3)))
typedef unsigned short bf16_t;
typedef short bf16x8 __attribute__((ext_vector_type(8)));
typedef float f32x4 __attribute__((ext_vector_type(4)));
typedef unsigned u32x4 __attribute__((ext_vector_type(4)));
constexpr int BM = 256, BK = 64, HALF = 128, HTB = HALF * BK * 2  , STAGE_BYTES = 8 * HTB, NXCD = 8, WGM = 8;

__host__ __device__ __forceinline__ int lds_byte(int r, int c) { const int st = (r >> 4) * 2 + (c >> 5), rr = r & 15, cc = c & 31, ob = rr * 64 + cc * 2; return st * 1024 + (ob ^ (((ob >> 9) & 1) << 5)); }
__host__ __device__ __forceinline__ void stage_rc(int b, int& R, int& C) { const int st = b / 1024, sb = b % 1024, swz = sb ^ (((sb >> 9) & 1) << 5); R = (st >> 1) * 16 + swz / 64; C = (st & 1) * 32 + (swz % 64) / 2; }
__host__ __device__ __forceinline__ int perm32(int rho) { const int n = rho >> 4, i = rho & 15; return 8 * (i >> 2) + 4 * n + (i & 3); }

struct Unit { int pm, pn, ko; };
struct Gemm { const bf16_t* A; const bf16_t* Bt; int M, N, K, nt; };

struct StaticOrder {
    int nM, nN, nwg, G, c;
    __host__ __device__ void init(int M, int N, int G_, int c_) { nM = M / BM; nN = N / BM; nwg = nM * nN; G = G_; c = c_; }
    __host__ __device__ bool next(int i, Unit& u) const {
        const long L = (long)i * G + c; if (L >= nwg) return false;
        int wgid = (int)L; { const int q = nwg / NXCD, r = nwg % NXCD, xcd = wgid % NXCD, off = wgid / NXCD; wgid = (xcd < r ? xcd * (q + 1) : r * (q + 1) + (xcd - r) * q) + off; }
        const int nig = WGM * nN, gid = wgid / nig, fm = gid * WGM, gsz = (nM - fm) < WGM ? (nM - fm) : WGM;
        u.pm = fm + ((wgid % nig) % gsz); u.pn = (wgid % nig) / gsz; return true;
    }
    __device__ __forceinline__ void a_ready(const Unit&) const {}
    __device__ __forceinline__ void done(const Unit&) const {}
};
struct CountedOrder : StaticOrder {
    const unsigned* ready; unsigned need; unsigned* tmo;
    __device__ __forceinline__ void a_ready(const Unit& u) const {
        if (threadIdx.x < 64) {
            const unsigned long long t0 = __builtin_amdgcn_s_memrealtime(); unsigned polls = 0;
            while ((unsigned)__builtin_amdgcn_readfirstlane(__hip_atomic_load(ready + 64 * u.pm, __ATOMIC_RELAXED, __HIP_MEMORY_SCOPE_AGENT)) < need) {
                if ((++polls & 255u) == 0u && __builtin_amdgcn_readfirstlane(__hip_atomic_load(tmo, __ATOMIC_RELAXED, __HIP_MEMORY_SCOPE_AGENT)) != 0u) break;
                if (__builtin_amdgcn_s_memrealtime() - t0 > 2000000ull) {
                    if (threadIdx.x == 0) { unsigned expect = 0u; __hip_atomic_compare_exchange_strong(tmo + 1, &expect, 0x600u | (unsigned)(u.pm & 0xff), __ATOMIC_RELAXED, __ATOMIC_RELAXED, __HIP_MEMORY_SCOPE_AGENT); __hip_atomic_store(tmo, 1u, __ATOMIC_RELAXED, __HIP_MEMORY_SCOPE_AGENT); }
                    break; }
                __builtin_amdgcn_s_sleep(2); }
            __builtin_amdgcn_fence(__ATOMIC_ACQUIRE, "agent");
            asm volatile("s_waitcnt vmcnt(0)" ::: "memory");
        }
#if !defined(BROKEN_HOOK_NO_BARRIER)
        asm volatile("" ::: "memory"); __builtin_amdgcn_s_barrier(); asm volatile("" ::: "memory");
#endif
    }
};

__device__ __forceinline__ unsigned cvt_pk_bf16(float lo, float hi) { unsigned r; asm volatile("v_cvt_pk_bf16_f32 %0, %1, %2" : "=v"(r) : "v"(lo), "v"(hi)); return r; }
typedef float f32x2 __attribute__((ext_vector_type(2)));
__device__ __forceinline__ f32x2 gelu_pk(f32x2 v) {
    const f32x2 av = __builtin_elementwise_abs(v), d = av * 0.2316418882f + 1.0f;
    f32x2 t; t.x = __builtin_amdgcn_rcpf(d.x); t.y = __builtin_amdgcn_rcpf(d.y);
    f32x2 q = t * 0.5307027145f + (-0.7265760135f); q = q * t + 0.7107068705f; q = q * t + (-0.142248368f); q = q * t + 0.127414796f; q = q * t;
    const f32x2 s = (v * v) * (-0.72134752044f);
    f32x2 e; e.x = __builtin_amdgcn_exp2f(s.x); e.y = __builtin_amdgcn_exp2f(s.y);
    const f32x2 m = v * (q * e), r = v - m;
    f32x2 o; o.x = v.x < 0.f ? m.x : r.x; o.y = v.y < 0.f ? m.y : r.y; return o;
}

struct EpiF32 {
    static constexpr bool PERM = false, AFTER_DRAIN = false;
    float* C; int ldc; const float* bias;
    __device__ __forceinline__ void operator()(const f32x4 (&acc)[2][2][4][2], const Unit& u, int wr, int wc, int fr, int fq) const {
        const int row0 = u.pm * BM + wr * 64 + fr, col0 = u.pn * BM + wc * 32 + 4 * fq;
        f32x4 bv[2][2];
#pragma unroll
        for (int bj = 0; bj < 2; ++bj)
#pragma unroll
            for (int n = 0; n < 2; ++n) bv[bj][n] = bias ? *(const f32x4*)(bias + col0 + bj * HALF + n * 16) : (f32x4){0.f, 0.f, 0.f, 0.f};
#pragma unroll
        for (int ai = 0; ai < 2; ++ai)
#pragma unroll
            for (int m = 0; m < 4; ++m) { float* rowp = C + (size_t)(row0 + ai * HALF + m * 16) * ldc + col0;
#pragma unroll
                for (int bj = 0; bj < 2; ++bj)
#pragma unroll
                    for (int n = 0; n < 2; ++n) *(f32x4*)(rowp + bj * HALF + n * 16) = acc[ai][bj][m][n] + bv[bj][n]; }
    }
};
template <int ACT  > struct EpiBf16 {
    static constexpr bool PERM = true, AFTER_DRAIN = false;
    bf16_t* O; int ldc; const float* bias; int split_cols; size_t split_stride;
    __device__ __forceinline__ void operator()(const f32x4 (&acc)[2][2][4][2], const Unit& u, int wr, int wc, int fr, int fq) const {
        const int row0 = u.pm * BM + wr * 64 + fr; int colt = u.pn * BM; bf16_t* base = O;
        if (split_cols) { const int t = colt / split_cols; base += (size_t)t * split_stride; colt -= t * split_cols; }
        const int col0 = colt + wc * 32 + 8 * fq, bcol0 = u.pn * BM + wc * 32 + 8 * fq;
        f32x4 bv[2][2];
#pragma unroll
        for (int bj = 0; bj < 2; ++bj)
#pragma unroll
            for (int n = 0; n < 2; ++n) bv[bj][n] = bias ? *(const f32x4*)(bias + bcol0 + bj * HALF + 4 * n) : (f32x4){0.f, 0.f, 0.f, 0.f};
#pragma unroll
        for (int ai = 0; ai < 2; ++ai)
#pragma unroll
            for (int m = 0; m < 4; ++m) { bf16_t* rowp = base + (size_t)(row0 + ai * HALF + m * 16) * ldc + col0;
#pragma unroll
                for (int bj = 0; bj < 2; ++bj) { f32x4 v0 = acc[ai][bj][m][0] + bv[bj][0], v1 = acc[ai][bj][m][1] + bv[bj][1];
                    if (ACT == 1) { f32x2 a = gelu_pk((f32x2){v0[0], v0[1]}), b = gelu_pk((f32x2){v0[2], v0[3]}), c = gelu_pk((f32x2){v1[0], v1[1]}), d = gelu_pk((f32x2){v1[2], v1[3]});
                        v0 = (f32x4){a.x, a.y, b.x, b.y}; v1 = (f32x4){c.x, c.y, d.x, d.y}; }
                    if (ACT == 2) {
#pragma unroll
                        for (int j = 0; j < 4; ++j) { v0[j] = 0.5f * v0[j] * (1.0f + erff(v0[j] * 0.70710678f)); v1[j] = 0.5f * v1[j] * (1.0f + erff(v1[j] * 0.70710678f)); } }
                    u32x4 w; w.x = cvt_pk_bf16(v0[0], v0[1]); w.y = cvt_pk_bf16(v0[2], v0[3]); w.z = cvt_pk_bf16(v1[0], v1[1]); w.w = cvt_pk_bf16(v1[2], v1[3]);
                    *(u32x4*)(rowp + bj * HALF) = w; } }
    }
};

struct PanelStats {
    unsigned* xbuf;
    unsigned* cnt;
    unsigned* tmo;
    int ntn; float eps;
    unsigned code;
    __device__ __forceinline__ bool run(const f32x4 (&v)[2][2][4][2], const Unit& u, int wr, int wc, int fr, int fq, PG8_LAS unsigned char* lds, int wid, int lane) const {
        typedef float f32x2v __attribute__((ext_vector_type(2)));
        PG8_LAS f32x2v* P = (PG8_LAS f32x2v*)lds;
        PG8_LAS f32x2v* S = (PG8_LAS f32x2v*)(lds + 8192);
        PG8_LAS unsigned* flag = (PG8_LAS unsigned*)(lds + 8192 + 2048);
#pragma unroll
        for (int ai = 0; ai < 2; ++ai)
#pragma unroll
            for (int m = 0; m < 4; ++m) {
                float s = 0.f;
#pragma unroll
                for (int bj = 0; bj < 2; ++bj)
#pragma unroll
                    for (int n = 0; n < 2; ++n) { const f32x4 x = v[ai][bj][m][n]; s += (x[0] + x[1]) + (x[2] + x[3]); }
                s += __shfl_xor(s, 16); s += __shfl_xor(s, 32);
                const float mw = s * (1.0f / 64.0f); float q = 0.f;
#pragma unroll
                for (int bj = 0; bj < 2; ++bj)
#pragma unroll
                    for (int n = 0; n < 2; ++n) { const f32x4 d = v[ai][bj][m][n] - mw; q += (d[0] * d[0] + d[1] * d[1]) + (d[2] * d[2] + d[3] * d[3]); }
                q += __shfl_xor(q, 16); q += __shfl_xor(q, 32);
                if (fq == 0) P[(ai * HALF + wr * 64 + m * 16 + fr) * 4 + wc] = (f32x2v){mw, q};
            }
        asm volatile("s_waitcnt lgkmcnt(0)" ::: "memory"); __builtin_amdgcn_s_barrier(); asm volatile("" ::: "memory");
#if defined(BROKEN_NO_WAIT)
        if (blockIdx.x >= 64) { const long long t0 = clock64(); while (clock64() - t0 < 60000) __builtin_amdgcn_s_sleep(8); }
#endif
        const int row = wid * 32 + (lane & 31);
        if (lane < 32) {
            const f32x2v a = P[row * 4 + 0], b = P[row * 4 + 1], c = P[row * 4 + 2], d = P[row * 4 + 3];
            const float mt = (a.x + b.x + c.x + d.x) * 0.25f;
            const float da = a.x - mt, db = b.x - mt, dc = c.x - mt, dd = d.x - mt;
            const float m2 = (a.y + b.y) + (c.y + d.y) + 64.0f * ((da * da + db * db) + (dc * dc + dd * dd));
            unsigned long long* slot = (unsigned long long*)xbuf + ((size_t)(u.pm * BM + row) * 4 + u.pn);
            __hip_atomic_store(slot, ((unsigned long long)__float_as_uint(m2) << 32) | __float_as_uint(mt), __ATOMIC_RELAXED, __HIP_MEMORY_SCOPE_AGENT);
        }
        asm volatile("s_waitcnt vmcnt(0)" ::: "memory");
        if (lane == 0) __hip_atomic_fetch_add(cnt + 64 * u.pm, 1u, __ATOMIC_RELAXED, __HIP_MEMORY_SCOPE_AGENT);
        if (wid == 0) {
            bool dead = false; const unsigned long long t0 = __builtin_amdgcn_s_memrealtime(); const unsigned want = 8u * (unsigned)ntn;
            for (;;) {
#if defined(BROKEN_NO_WAIT)
                break;
#endif
                if ((unsigned)__builtin_amdgcn_readfirstlane(__hip_atomic_load(cnt + 64 * u.pm, __ATOMIC_RELAXED, __HIP_MEMORY_SCOPE_AGENT)) >= want) break;
                if (__builtin_amdgcn_s_memrealtime() - t0 > 2000000ull) {
                    if (lane == 0) { unsigned expect = 0u; __hip_atomic_compare_exchange_strong(tmo + 1, &expect, code | (unsigned)(u.pm & 0xff), __ATOMIC_RELAXED, __ATOMIC_RELAXED, __HIP_MEMORY_SCOPE_AGENT);
                                     __hip_atomic_store(tmo, 1u, __ATOMIC_RELAXED, __HIP_MEMORY_SCOPE_AGENT); }
                    dead = true; break; }
                __builtin_amdgcn_s_sleep(2);
            }
            __builtin_amdgcn_fence(__ATOMIC_ACQUIRE, "agent");
            if (lane == 0) flag[0] = dead ? 1u : 0u;
        }
        asm volatile("s_waitcnt vmcnt(0) lgkmcnt(0)" ::: "memory"); __builtin_amdgcn_s_barrier(); asm volatile("" ::: "memory");
        const bool bad = flag[0] != 0u;
        if (lane < 32) {
            const unsigned long long* slot = (const unsigned long long*)xbuf + (size_t)(u.pm * BM + row) * 4; float mt[4], m2[4]; float ms = 0.f;
#pragma unroll
            for (int t = 0; t < 4; ++t) { if (t < ntn) { const unsigned long long w = __hip_atomic_load(slot + t, __ATOMIC_RELAXED, __HIP_MEMORY_SCOPE_AGENT); mt[t] = __uint_as_float((unsigned)w); m2[t] = __uint_as_float((unsigned)(w >> 32)); } else { mt[t] = 0.f; m2[t] = 0.f; } ms += mt[t]; }
            const float mean = ms / (float)ntn; float q = 0.f;
#pragma unroll
            for (int t = 0; t < 4; ++t) if (t < ntn) { const float dm = mt[t] - mean; q += m2[t] + 256.0f * dm * dm; }
            S[row] = (f32x2v){mean, 1.0f / sqrtf(q / (256.0f * (float)ntn) + eps)};
        }
        asm volatile("s_waitcnt lgkmcnt(0)" ::: "memory"); __builtin_amdgcn_s_barrier(); asm volatile("" ::: "memory");
        return bad;
    }
};
struct EpiLnRes {
    static constexpr bool PERM = false, AFTER_DRAIN = true;
    const float* base; float* out; int ldc; const float* bias; PanelStats st; unsigned poison;
    __device__ __forceinline__ void refuse(size_t i0, size_t stride, int M, int N) const { const float q = __builtin_nanf(""); for (size_t i = i0; i < (size_t)M * N; i += stride) out[(i / N) * ldc + i % N] = q;
        if (i0 == 0) { unsigned expect = 0u; __hip_atomic_compare_exchange_strong(st.tmo + 1, &expect, 0x7f0u, __ATOMIC_RELAXED, __ATOMIC_RELAXED, __HIP_MEMORY_SCOPE_AGENT); __hip_atomic_store(st.tmo, 1u, __ATOMIC_RELAXED, __HIP_MEMORY_SCOPE_AGENT); } }
    __device__ __forceinline__ void fused(f32x4 (&acc)[2][2][4][2], const Unit& u, int wr, int wc, int fr, int fq, PG8_LAS unsigned char* lds, int wid, int lane) const {
        typedef float f32x2v __attribute__((ext_vector_type(2)));
        const PG8_LAS f32x2v* S = (const PG8_LAS f32x2v*)(lds + 8192);
        const int col0 = u.pn * BM + wc * 32 + 4 * fq;
#pragma unroll
        for (int bj = 0; bj < 2; ++bj)
#pragma unroll
            for (int n = 0; n < 2; ++n) { const f32x4 bv = bias ? *(const f32x4*)(bias + col0 + bj * HALF + n * 16) : (f32x4){0.f, 0.f, 0.f, 0.f};
#pragma unroll
                for (int ai = 0; ai < 2; ++ai)
#pragma unroll
                    for (int m = 0; m < 4; ++m) acc[ai][bj][m][n] += bv; }
        const bool bad = st.run(acc, u, wr, wc, fr, fq, lds, wid, lane) || poison != 0u;
        const float qnan = __builtin_nanf("");
#pragma unroll
        for (int ai = 0; ai < 2; ++ai)
#pragma unroll
            for (int m = 0; m < 4; ++m) { const int r = ai * HALF + wr * 64 + m * 16 + fr; const f32x2v sr = S[r]; const size_t off = (size_t)(u.pm * BM + r) * ldc + col0;
#pragma unroll
                for (int bj = 0; bj < 2; ++bj)
#pragma unroll
                    for (int n = 0; n < 2; ++n) { const f32x4 bs = *(const f32x4*)(base + off + bj * HALF + n * 16); f32x4 o = bs + (acc[ai][bj][m][n] - sr.x) * sr.y;
                        if (bad) o = (f32x4){qnan, qnan, qnan, qnan}; *(f32x4*)(out + off + bj * HALF + n * 16) = o; }
                asm volatile("" ::: "memory"); }
    }
};
struct EpiLnResLn {
    static constexpr bool PERM = false, AFTER_DRAIN = true;
    const float* base; float* out; bf16_t* xn; int ldc; const float* bias; PanelStats st1, st2; unsigned poison;
    __device__ __forceinline__ void refuse(size_t i0, size_t stride, int M, int N) const { const float q = __builtin_nanf(""); for (size_t i = i0; i < (size_t)M * N; i += stride) { const size_t o = (i / N) * ldc + i % N; out[o] = q; xn[o] = (bf16_t)0x7fc0u; }
        if (i0 == 0) { unsigned expect = 0u; __hip_atomic_compare_exchange_strong(st1.tmo + 1, &expect, 0x7f0u, __ATOMIC_RELAXED, __ATOMIC_RELAXED, __HIP_MEMORY_SCOPE_AGENT); __hip_atomic_store(st1.tmo, 1u, __ATOMIC_RELAXED, __HIP_MEMORY_SCOPE_AGENT); } }
    __device__ __forceinline__ void fused(f32x4 (&acc)[2][2][4][2], const Unit& u, int wr, int wc, int fr, int fq, PG8_LAS unsigned char* lds, int wid, int lane) const {
        typedef float f32x2v __attribute__((ext_vector_type(2))); typedef unsigned u32x2v __attribute__((ext_vector_type(2)));
        const PG8_LAS f32x2v* S = (const PG8_LAS f32x2v*)(lds + 8192);
        const int col0 = u.pn * BM + wc * 32 + 4 * fq;
#pragma unroll
        for (int bj = 0; bj < 2; ++bj)
#pragma unroll
            for (int n = 0; n < 2; ++n) { const f32x4 bv = bias ? *(const f32x4*)(bias + col0 + bj * HALF + n * 16) : (f32x4){0.f, 0.f, 0.f, 0.f};
#pragma unroll
                for (int ai = 0; ai < 2; ++ai)
#pragma unroll
                    for (int m = 0; m < 4; ++m) acc[ai][bj][m][n] += bv; }
        bool bad = st1.run(acc, u, wr, wc, fr, fq, lds, wid, lane) || poison != 0u;
        const float qnan = __builtin_nanf("");
#pragma unroll
        for (int ai = 0; ai < 2; ++ai)
#pragma unroll
            for (int m = 0; m < 4; ++m) { const int r = ai * HALF + wr * 64 + m * 16 + fr; const f32x2v sr = S[r]; const size_t off = (size_t)(u.pm * BM + r) * ldc + col0;
#pragma unroll
                for (int bj = 0; bj < 2; ++bj)
#pragma unroll
                    for (int n = 0; n < 2; ++n) { const f32x4 bs = *(const f32x4*)(base + off + bj * HALF + n * 16); acc[ai][bj][m][n] = bs + (acc[ai][bj][m][n] - sr.x) * sr.y; }
                asm volatile("" : "+v"(acc[ai][0][m][0]), "+v"(acc[ai][0][m][1]), "+v"(acc[ai][1][m][0]), "+v"(acc[ai][1][m][1]));
                if (m & 1) asm volatile("" ::: "memory"); }
        const bool bad1 = bad;
        bad = st2.run(acc, u, wr, wc, fr, fq, lds, wid, lane) || bad;
#pragma unroll
        for (int ai = 0; ai < 2; ++ai)
#pragma unroll
            for (int m = 0; m < 4; ++m) { const int r = ai * HALF + wr * 64 + m * 16 + fr; const f32x2v sr = S[r]; const size_t off = (size_t)(u.pm * BM + r) * ldc + col0;
#pragma unroll
                for (int bj = 0; bj < 2; ++bj)
#pragma unroll
                    for (int n = 0; n < 2; ++n) { const f32x4 x1 = acc[ai][bj][m][n]; *(f32x4*)(out + off + bj * HALF + n * 16) = bad1 ? (f32x4){qnan, qnan, qnan, qnan} : x1;
                        const f32x4 o = (x1 - sr.x) * sr.y; u32x2v w; w.x = cvt_pk_bf16(o[0], o[1]); w.y = cvt_pk_bf16(o[2], o[3]);
                        if (bad) { w.x = 0x7fc07fc0u; w.y = 0x7fc07fc0u; } *(u32x2v*)(xn + off + bj * HALF + n * 16) = w; }
                asm volatile("" ::: "memory"); }
    }
};

template <class Epi, class Sched, bool STAMP = false>
__device__ __forceinline__ void gemm_phase(PG8_LAS unsigned char* lds, const Gemm g, const Sched& S, const Epi& E, unsigned long long* stamps) {
    const int tid = threadIdx.x, wid = __builtin_amdgcn_readfirstlane(tid >> 6), lane = tid & 63, wr = wid >> 2, wc = wid & 3, fr = lane & 15, fq = lane >> 4;
    const int K = g.K, nt = g.nt ? g.nt : K / BK;
    int ts_lo = 0, ts_hi = 0, nts = 0; const unsigned long long rt_entry = STAMP ? (unsigned long long)wall_clock64() : 0ull;
#define PG8_STAMP() do { if (STAMP && wid == 0 && nts < 64) { const unsigned long long _c = (unsigned long long)clock64(); \
        ts_lo = (lane == nts) ? (int)(unsigned)_c : ts_lo; ts_hi = (lane == nts) ? (int)(unsigned)(_c >> 32) : ts_hi; ++nts; } } while (0)
    PG8_STAMP();
    unsigned voffA[2], voffB[2];
#pragma unroll
    for (int i = 0; i < 2; ++i) { int R, C; stage_rc(tid * 16 + i * 8192, R, C); const int Rb = Epi::PERM ? ((R & ~31) + perm32(R & 31)) : R;
        voffA[i] = (unsigned)(R * K + C) * 2u; voffB[i] = (unsigned)(Rb * K + C) * 2u; }
    const size_t kstep = (size_t)(BK * 2);
    const size_t hstep = (size_t)HALF * K * 2;
    const size_t tstep = 2 * hstep;
    const unsigned ldsw = (unsigned)wid * 1024u;
    const int aoff = lds_byte(wr * 64 + fr, fq * 8), boff = lds_byte(wc * 32 + fr, fq * 8);
#define PG8_SA(b, h) (((b) * 2 + (h)) * HTB)
#define PG8_SB(b, h) ((4 + (b) * 2 + (h)) * HTB)
#define PG8_STAGE(bufoff, gbase, voff) do { _Pragma("unroll") for (int _i = 0; _i < 2; ++_i) \
        __builtin_amdgcn_global_load_lds((const unsigned*)((const char*)(gbase) + (voff)[_i]), (PG8_LAS unsigned*)(lds + (bufoff) + ldsw + _i * 8192), 16, 0, 0); } while (0)
#define PG8_LDA(dst, b, h) do { _Pragma("unroll") for (int m = 0; m < 4; ++m) _Pragma("unroll") for (int k = 0; k < 2; ++k) dst[m][k] = *(const PG8_LAS bf16x8*)(lds + PG8_SA(b, h) + aoff + m * 2048 + k * 1024); } while (0)
#define PG8_LDB(dst, b, h) do { _Pragma("unroll") for (int n = 0; n < 2; ++n) _Pragma("unroll") for (int k = 0; k < 2; ++k) dst[n][k] = *(const PG8_LAS bf16x8*)(lds + PG8_SB(b, h) + boff + n * 2048 + k * 1024); } while (0)
#define PG8_MMA(ai, bj, At, Bt) do { __builtin_amdgcn_s_setprio(1); _Pragma("unroll") for (int m = 0; m < 4; ++m) _Pragma("unroll") for (int n = 0; n < 2; ++n) _Pragma("unroll") for (int k = 0; k < 2; ++k) \
        acc[ai][bj][m][n] = __builtin_amdgcn_mfma_f32_16x16x32_bf16(Bt[n][k], At[m][k], acc[ai][bj][m][n], 0, 0, 0); __builtin_amdgcn_s_setprio(0); } while (0)
#define PG8_WAIT_V(n) asm volatile("s_waitcnt vmcnt(" #n ")" ::: "memory")
#define PG8_WAIT_L(n) asm volatile("s_waitcnt lgkmcnt(" #n ")" ::: "memory")
#define PG8_BAR __builtin_amdgcn_s_barrier()
#define PG8_SCHED __builtin_amdgcn_sched_barrier(0)
    Unit cur{0, 0, 0}, nxt{0, 0, 0}; int ui = 0;
    if (!S.next(0, cur)) return;
    f32x4 acc[2][2][4][2];
#pragma unroll
    for (int a = 0; a < 2; ++a)
#pragma unroll
        for (int b = 0; b < 2; ++b)
#pragma unroll
            for (int m = 0; m < 4; ++m)
#pragma unroll
                for (int n = 0; n < 2; ++n) acc[a][b][m][n] = (f32x4){0.f, 0.f, 0.f, 0.f};
    bf16x8 At[4][2], B0[2][2], B1[2][2];
    const char* cA = (const char*)g.A + (size_t)cur.pm * tstep + (size_t)cur.ko * 2; const char* cB = (const char*)g.Bt + (size_t)cur.pn * tstep + (size_t)cur.ko * 2;
    S.a_ready(cur);
    PG8_STAGE(PG8_SB(0, 0), cB, voffB); PG8_STAGE(PG8_SA(0, 0), cA, voffA); PG8_STAGE(PG8_SB(0, 1), cB + hstep, voffB); PG8_STAGE(PG8_SA(0, 1), cA + hstep, voffA);
    if (wr == 1) PG8_BAR;
    PG8_WAIT_V(4); PG8_BAR;
    PG8_STAGE(PG8_SB(1, 0), cB + kstep, voffB); PG8_STAGE(PG8_SA(1, 0), cA + kstep, voffA); PG8_STAGE(PG8_SB(1, 1), cB + hstep + kstep, voffB);
    PG8_WAIT_V(6); PG8_BAR;
    PG8_STAMP();
    for (;;) {
        const bool has_next = S.next(ui + 1, nxt);
        const char* nA = has_next ? (const char*)g.A + (size_t)nxt.pm * tstep + (size_t)nxt.ko * 2 : cA; const char* nB = has_next ? (const char*)g.Bt + (size_t)nxt.pn * tstep + (size_t)nxt.ko * 2 : cB;
        for (int t = 0; t < nt; t += 2) {
            const bool last = (t == nt - 2);
            const char* a1 = cA + (size_t)(t + 1) * kstep;
            const char* a2 = last ? nA : cA + (size_t)(t + 2) * kstep; const char* b2 = last ? nB : cB + (size_t)(t + 2) * kstep;
            const char* a3 = a2 + kstep; const char* b3 = b2 + kstep;
            if (last && has_next) S.a_ready(nxt);
            PG8_LDB(B0, 0, 0); PG8_SCHED; PG8_LDA(At, 0, 0); PG8_STAGE(PG8_SA(1, 1), a1 + hstep, voffA);
            PG8_WAIT_L(8); PG8_BAR; PG8_WAIT_L(0); PG8_MMA(0, 0, At, B0); PG8_BAR; PG8_SCHED;
            PG8_LDB(B1, 0, 1); PG8_STAGE(PG8_SB(0, 0), b2, voffB);
            PG8_BAR; PG8_WAIT_L(0); PG8_MMA(0, 1, At, B1); PG8_BAR;
            PG8_LDA(At, 0, 1); PG8_STAGE(PG8_SA(0, 0), a2, voffA);
            PG8_BAR; PG8_WAIT_L(0); PG8_MMA(1, 0, At, B0); PG8_BAR; PG8_SCHED;
            PG8_STAGE(PG8_SB(0, 1), b2 + hstep, voffB);
            PG8_WAIT_V(6); PG8_BAR; PG8_MMA(1, 1, At, B1); PG8_BAR;
            PG8_LDB(B0, 1, 0); PG8_SCHED; PG8_LDA(At, 1, 0); PG8_STAGE(PG8_SA(0, 1), a2 + hstep, voffA);
            PG8_WAIT_L(8); PG8_BAR; PG8_WAIT_L(0); PG8_MMA(0, 0, At, B0); PG8_BAR; PG8_SCHED;
            PG8_LDB(B1, 1, 1); PG8_STAGE(PG8_SB(1, 0), b3, voffB);
            PG8_BAR; PG8_WAIT_L(0); PG8_MMA(0, 1, At, B1); PG8_BAR;
            PG8_LDA(At, 1, 1); PG8_STAGE(PG8_SA(1, 0), a3, voffA);
            PG8_BAR; PG8_WAIT_L(0); PG8_MMA(1, 0, At, B0); PG8_BAR; PG8_SCHED;
            PG8_STAGE(PG8_SB(1, 1), b3 + hstep, voffB);
            PG8_WAIT_V(6); PG8_BAR; PG8_MMA(1, 1, At, B1); PG8_BAR;
        }
        PG8_STAMP();
        if constexpr (!Epi::AFTER_DRAIN) { E(acc, cur, wr, wc, fr, fq); S.done(cur); }
        PG8_STAMP();
        if (!has_next) break;
        if (!Epi::keep(nxt))
#pragma unroll
        for (int a = 0; a < 2; ++a)
#pragma unroll
            for (int b = 0; b < 2; ++b)
#pragma unroll
                for (int m = 0; m < 4; ++m)
#pragma unroll
                    for (int n = 0; n < 2; ++n) acc[a][b][m][n] = (f32x4){0.f, 0.f, 0.f, 0.f};
        cur = nxt; cA = nA; cB = nB; ++ui;
    }
    PG8_WAIT_V(0);
    if (wr == 0) PG8_BAR;
    PG8_BAR;
    if constexpr (Epi::AFTER_DRAIN) { E.fused(acc, cur, wr, wc, fr, fq, lds, wid, lane); S.done(cur); }
    PG8_STAMP();
    if (STAMP && wid == 0) { stamps[lane] = lane < nts ? (((unsigned long long)(unsigned)ts_hi << 32) | (unsigned)ts_lo) : 0ull;
        if (lane == 62) stamps[62] = rt_entry; if (lane == 63) stamps[63] = (unsigned long long)wall_clock64(); }
#undef PG8_STAMP
#undef PG8_SA
#undef PG8_SB
#undef PG8_STAGE
#undef PG8_LDA
#undef PG8_LDB
#undef PG8_MMA
#undef PG8_WAIT_V
#undef PG8_WAIT_L
#undef PG8_BAR
#undef PG8_SCHED
}
}

namespace mk {
namespace cg = cooperative_groups;
#define LAS __attribute__((address_space(3)))
typedef unsigned short bf16;
typedef short bf16x8 __attribute__((ext_vector_type(8)));
typedef float f32x4 __attribute__((ext_vector_type(4)));
typedef float f32x2 __attribute__((ext_vector_type(2)));
typedef unsigned u32x4 __attribute__((ext_vector_type(4)));
typedef unsigned u32x2 __attribute__((ext_vector_type(2)));

constexpr int NT = 17408, NPT = 16384, DM = 1024;
constexpr size_t MiB = 1u << 20;
constexpr size_t WS_WIN = 0, WS_WBR = 28 * MiB, WS_WOUT = 34 * MiB, WS_WDEC = 36 * MiB, WS_WAAA = WS_WDEC + 131072, WS_WRGA = WS_WAAA + 131072, WS_WRGX = WS_WRGA + 131072;
constexpr size_t WS_XN = 38 * MiB, WS_U = 76 * MiB, WS_Z = 178 * MiB, WS_XB = 280 * MiB, WS_Q = 314 * MiB, WS_G = 348 * MiB, WS_XWA = 450 * MiB;
constexpr size_t WS_MK = 459 * MiB, WS_MVT = 463 * MiB, WS_BONUS = 467 * MiB, WS_STATS = 469 * MiB, WS_CTR = 474 * MiB, WS_END = 475 * MiB;
constexpr size_t WS_ORAW = WS_XN, WS_P = WS_U, WS_MERGED = WS_XB;
constexpr size_t ZSTRIDE = (size_t)NT * DM;
constexpr int LDS_BYTES = 147456;
constexpr size_t O_Y = 0, O_RWP = 17825792, O_SHP = O_RWP + 524288, O_LRP = O_SHP + 25600, O_CVP = O_LRP + 8192, O_MKP = O_CVP + 24576, O_MVP = O_MKP + 2097152,
                 O_RWS = O_MVP + 2097152, O_SHS = O_RWS + 8388608, O_LRS = O_SHS + 409600, O_CVS = O_LRS + 131072, O_END = O_CVS + 393216;

struct Params { const float* in[35]; float* out; unsigned char* ws; int zero; int pad; };
#define PREF const __attribute__((address_space(4))) Params&
typedef const __attribute__((address_space(4))) Params CParams;
__device__ __forceinline__ CParams* launder(CParams* x) { asm volatile("" : "+s"(x)); return x; }
enum { I_XP = 0, I_XS, I_MEM, I_SRW, I_SSH, I_SLRU, I_SCV, I_CK, I_CV, I_GN, I_WIN, I_MU, I_W0, I_WDEC, I_A0, I_WAAA, I_KK, I_KA, I_RK, I_GNG, I_GNB, I_CW, I_CB, I_WRGA, I_BRGA, I_WRGX, I_BRGX, I_LAM, I_GMEM, I_WMEM, I_WBA, I_WBB, I_WBC, I_WOUT, I_GF };

__device__ __forceinline__ unsigned f2bf(float f) { unsigned u = __builtin_bit_cast(unsigned, f); return (u + 0x7fffu + ((u >> 16) & 1u)) >> 16; }
__device__ __forceinline__ unsigned pk2(float lo, float hi) { unsigned r; asm("v_cvt_pk_bf16_f32 %0, %1, %2" : "=v"(r) : "v"(lo), "v"(hi)); return r; }
__device__ __forceinline__ float bf2f(unsigned b) { return __builtin_bit_cast(float, b << 16); }
__device__ __forceinline__ float bflo(unsigned w) { return __builtin_bit_cast(float, w << 16); }
__device__ __forceinline__ float bfhi(unsigned w) { return __builtin_bit_cast(float, w & 0xffff0000u); }
__device__ __forceinline__ const float* opq(const float* x) { asm volatile("" : "+s"(x)); return x; }
__device__ __forceinline__ float sigm(float x) { return __builtin_amdgcn_rcpf(1.0f + __builtin_amdgcn_exp2f(x * -1.44269504f)); }
#define LDS_WAIT() asm volatile("s_waitcnt lgkmcnt(0)" ::: "memory")
template <int CTRL> __device__ __forceinline__ float dppf(float x) { return __builtin_bit_cast(float, __builtin_amdgcn_update_dpp(0, __builtin_bit_cast(int, x), CTRL, 0xF, 0xF, true)); }
__device__ __forceinline__ float row16_sum(float x) { x += dppf<0xB1>(x); x += dppf<0x4E>(x); x += dppf<0x141>(x); x += dppf<0x140>(x); return x; }
__device__ __forceinline__ float row16_max(float x) { x = fmaxf(x, dppf<0xB1>(x)); x = fmaxf(x, dppf<0x4E>(x)); x = fmaxf(x, dppf<0x141>(x)); x = fmaxf(x, dppf<0x140>(x)); return x; }
__device__ __forceinline__ float rdl(float x, int l) { return __builtin_bit_cast(float, __builtin_amdgcn_readlane(__builtin_bit_cast(int, x), l)); }
__device__ __forceinline__ float wave_sum(float x) { x = row16_sum(x); return (rdl(x, 0) + rdl(x, 16)) + (rdl(x, 32) + rdl(x, 48)); }
__device__ __forceinline__ float wave_max(float x) { x = row16_max(x); x = fmaxf(x, __shfl_xor(x, 16)); x = fmaxf(x, __shfl_xor(x, 32)); return x; }

struct EpiMain {
    static constexpr bool PERM = true, AFTER_DRAIN = false;
    static __device__ __forceinline__ bool keep(const pg8::Unit&) { return false; }
    unsigned char* ws;
    __device__ __forceinline__ void operator()(const pg8::f32x4 (&acc)[2][2][4][2], const pg8::Unit& u, int wr, int wc, int fr, int fq) const {
        const int pn = u.pn, row0 = u.pm * 256 + wr * 64 + fr;
        if (pn == 44) {
            float* X = (float*)(ws + WS_XWA);
#pragma unroll
            for (int ai = 0; ai < 2; ++ai)
#pragma unroll
                for (int m = 0; m < 4; ++m) { float* rp = X + (size_t)(row0 + ai * 128 + m * 16) * 128 + wc * 32 + 8 * fq;
                    *(f32x4*)rp = acc[ai][0][m][0]; *(f32x4*)(rp + 4) = acc[ai][0][m][1]; }
            return;
        }
        bf16* base; int ld, colt, act;
        if (pn < 12) { base = (bf16*)(ws + WS_U); ld = 3072; colt = pn * 256; act = 0; }
        else if (pn < 16) { base = (bf16*)(ws + WS_Z); ld = 1024; colt = (pn - 12) * 256; act = 1; }
        else if (pn < 20) { base = (bf16*)(ws + WS_XB); ld = 1024; colt = (pn - 16) * 256; act = 0; }
        else if (pn < 24) { base = (bf16*)(ws + WS_Z) + ZSTRIDE; ld = 1024; colt = (pn - 20) * 256; act = 1; }
        else if (pn < 28) { base = (bf16*)(ws + WS_Q); ld = 1024; colt = (pn - 24) * 256; act = 0; }
        else if (pn < 32) { base = (bf16*)(ws + WS_Z) + 2 * ZSTRIDE; ld = 1024; colt = (pn - 28) * 256; act = 1; }
        else { base = (bf16*)(ws + WS_G); ld = 3072; colt = (pn - 32) * 256; act = 2; }
        const int col0 = colt + wc * 32 + 8 * fq;
#pragma unroll
        for (int ai = 0; ai < 2; ++ai)
#pragma unroll
            for (int m = 0; m < 4; ++m) { bf16* rowp = base + (size_t)(row0 + ai * 128 + m * 16) * ld + col0;
#pragma unroll
                for (int bj = 0; bj < 2; ++bj) { pg8::f32x4 v0 = acc[ai][bj][m][0], v1 = acc[ai][bj][m][1];
                    if (act) {
#pragma unroll
                        for (int j = 0; j < 4; ++j) { const float s0 = sigm(v0[j]), s1 = sigm(v1[j]); v0[j] = act == 1 ? v0[j] * s0 : s0; v1[j] = act == 1 ? v1[j] * s1 : s1; } }
                    u32x4 w; w.x = pk2(v0[0], v0[1]); w.y = pk2(v0[2], v0[3]); w.z = pk2(v1[0], v1[1]); w.w = pk2(v1[2], v1[3]);
                    *(u32x4*)(rowp + bj * 128) = w; } }
    }
};
struct EpiMem {
    static constexpr bool PERM = false, AFTER_DRAIN = false;
    static __device__ __forceinline__ bool keep(const pg8::Unit&) { return false; }
    unsigned char* ws; float* out;
    __device__ __forceinline__ void operator()(const pg8::f32x4 (&acc)[2][2][4][2], const pg8::Unit& u, int wr, int wc, int fr, int fq) const {
        const int row0 = u.pm * 256 + wr * 64 + fr; const bool isv = u.pn >= 4; const int colt = (u.pn & 3) * 256 + wc * 32 + 4 * fq;
        float* of = out + (isv ? O_MVP : O_MKP); bf16* MK = (bf16*)(ws + WS_MK); bf16* MVT = (bf16*)(ws + WS_MVT);
#pragma unroll
        for (int ai = 0; ai < 2; ++ai)
#pragma unroll
            for (int m = 0; m < 4; ++m) { const int r = row0 + ai * 128 + m * 16;
#pragma unroll
                for (int bj = 0; bj < 2; ++bj)
#pragma unroll
                    for (int n = 0; n < 2; ++n) { const int c = colt + bj * 128 + n * 16; const pg8::f32x4 v = acc[ai][bj][m][n];
                        *(f32x4*)(of + (size_t)r * 1024 + c) = v;
                        if (!isv) { u32x2 w; w.x = pk2(v[0], v[1]); w.y = pk2(v[2], v[3]); *(u32x2*)(MK + (size_t)r * 1024 + c) = w; }
                        else { const int b = r >> 8, mem = r & 255, head = c >> 8, d = c & 255; bf16* q = MVT + ((size_t)((b * 4 + head) * 256 + d)) * 256 + mem;
                            q[0] = (bf16)f2bf(v[0]); q[256] = (bf16)f2bf(v[1]); q[512] = (bf16)f2bf(v[2]); q[768] = (bf16)f2bf(v[3]); } } }
    }
};
struct SchedMem { int c;
    __device__ bool next(int i, pg8::Unit& u) const { if (i != 0 || c >= 64) return false; u.pm = c >> 3; u.pn = c & 7; return true; }
    __device__ __forceinline__ void a_ready(const pg8::Unit&) const {}
    __device__ __forceinline__ void done(const pg8::Unit&) const {}
};
struct EpiTail {
    static constexpr bool PERM = true, AFTER_DRAIN = false;
    static __device__ __forceinline__ bool keep(const pg8::Unit& nxt) { return (nxt.pn >> 2) != 0; }
    unsigned char* ws;
    __device__ __forceinline__ void operator()(pg8::f32x4 (&acc)[2][2][4][2], const pg8::Unit& u, int wr, int wc, int fr, int fq) const {
        const int br = u.pn >> 2, pmm = u.pm - br * 68, pnn = u.pn & 3;
        const int row0 = pmm * 256 + wr * 64 + fr, col0 = pnn * 256 + wc * 32 + 8 * fq;
        const bf16* gbase = (const bf16*)(ws + WS_G) + (size_t)row0 * 3072 + br * 1024 + col0; const int hoff = br < 2 ? 1024 : 0; const bool last = br == 2;
#define MK_CLAMP8(g, f0, f1) pg8::f32x4 f0 = {fmaxf(bflo(g.x), 1e-20f), fmaxf(bfhi(g.x), 1e-20f), fmaxf(bflo(g.y), 1e-20f), fmaxf(bfhi(g.y), 1e-20f)}, f1 = {fmaxf(bflo(g.z), 1e-20f), fmaxf(bfhi(g.z), 1e-20f), fmaxf(bflo(g.w), 1e-20f), fmaxf(bfhi(g.w), 1e-20f)}
#pragma unroll
        for (int ai = 0; ai < 2; ++ai)
#pragma unroll
            for (int m = 0; m < 4; ++m) {
#pragma unroll
                for (int bj = 0; bj < 2; ++bj) { const bf16* gp = gbase + (size_t)(ai * 128 + m * 16) * 3072 + bj * 128; const u32x4 g = *(const u32x4*)gp, h = *(const u32x4*)(gp + hoff);
                    MK_CLAMP8(g, f0, f1); MK_CLAMP8(h, d0, d1);
#pragma unroll
                    for (int j = 0; j < 4; ++j) { d0[j] = last ? 1.0f : __builtin_amdgcn_rcpf(d0[j]); d1[j] = last ? 1.0f : __builtin_amdgcn_rcpf(d1[j]); }
                    acc[ai][bj][m][0] *= f0 * d0; acc[ai][bj][m][1] *= f1 * d1; }
                asm volatile("" ::: "memory"); }
#undef MK_CLAMP8
        if (last) { bf16* mbase = (bf16*)(ws + WS_MERGED) + (size_t)row0 * 1024 + col0;
#pragma unroll
            for (int ai = 0; ai < 2; ++ai)
#pragma unroll
                for (int m = 0; m < 4; ++m)
#pragma unroll
                    for (int bj = 0; bj < 2; ++bj) { const pg8::f32x4 v0 = acc[ai][bj][m][0], v1 = acc[ai][bj][m][1];
                        u32x4 w; w.x = pk2(v0[0], v0[1]); w.y = pk2(v0[2], v0[3]); w.z = pk2(v1[0], v1[1]); w.w = pk2(v1[2], v1[3]); *(u32x4*)(mbase + (size_t)(ai * 128 + m * 16) * 1024 + bj * 128) = w; } }
    }
};
struct SchedTail { int c;
    __device__ bool next(int i, pg8::Unit& u) const { if (i >= 3) return false; const int t = (c & 7) * 32 + (c >> 3); u.pm = i * 68 + (t >> 2); u.pn = i * 4 + (t & 3); return true; }
    __device__ __forceinline__ void a_ready(const pg8::Unit&) const {}
    __device__ __forceinline__ void done(const pg8::Unit&) const {}
};
struct EpiPart {
    static constexpr bool PERM = false, AFTER_DRAIN = false;
    static __device__ __forceinline__ bool keep(const pg8::Unit&) { return false; }
    unsigned char* ws;
    __device__ __forceinline__ void operator()(const pg8::f32x4 (&acc)[2][2][4][2], const pg8::Unit& u, int wr, int wc, int fr, int fq) const {
        const int br = u.pn >> 2, pmm = u.pm - br * 68 - 64, pnn = u.pn & 3, kq = u.ko >> 8;
        const int row0 = pmm * 256 + wr * 64 + fr, col0 = pnn * 256 + wc * 32 + 4 * fq;
        float* P = (float*)(ws + WS_P) + (size_t)(kq * 3 + br) * 1048576;
#pragma unroll
        for (int ai = 0; ai < 2; ++ai)
#pragma unroll
            for (int m = 0; m < 4; ++m) { float* rowp = P + (size_t)(row0 + ai * 128 + m * 16) * 1024 + col0;
#pragma unroll
                for (int bj = 0; bj < 2; ++bj)
#pragma unroll
                    for (int n = 0; n < 2; ++n) *(f32x4*)(rowp + bj * 128 + n * 16) = acc[ai][bj][m][n]; }
    }
};
struct SchedBrS { int c;
    __device__ bool next(int i, pg8::Unit& u) const { if (i != 0 || c >= 192) return false; const int kq = c & 3, idx = c >> 2, br = idx >> 4, t = idx & 15; u.pm = br * 68 + 64 + (t >> 2); u.pn = br * 4 + (t & 3); u.ko = kq * 256; return true; }
    __device__ __forceinline__ void a_ready(const pg8::Unit&) const {}
    __device__ __forceinline__ void done(const pg8::Unit&) const {}
};
struct SchedOutS { int c;
    __device__ bool next(int i, pg8::Unit& u) const { if (i != 0 || c >= 64) return false; const int t = c >> 2; u.pm = 64 + (t >> 2); u.pn = t & 3; u.ko = (c & 3) * 256; return true; }
    __device__ __forceinline__ void a_ready(const pg8::Unit&) const {}
    __device__ __forceinline__ void done(const pg8::Unit&) const {}
};
constexpr size_t WS_YP = WS_P + 48 * MiB;
struct EpiPartY {
    static constexpr bool PERM = false, AFTER_DRAIN = false;
    static __device__ __forceinline__ bool keep(const pg8::Unit&) { return false; }
    unsigned char* ws;
    __device__ __forceinline__ void operator()(const pg8::f32x4 (&acc)[2][2][4][2], const pg8::Unit& u, int wr, int wc, int fr, int fq) const {
        const int row0 = (u.pm - 64) * 256 + wr * 64 + fr, col0 = u.pn * 256 + wc * 32 + 4 * fq; float* P = (float*)(ws + WS_YP) + (size_t)(u.ko >> 8) * 1048576;
#pragma unroll
        for (int ai = 0; ai < 2; ++ai)
#pragma unroll
            for (int m = 0; m < 4; ++m) { float* rowp = P + (size_t)(row0 + ai * 128 + m * 16) * 1024 + col0;
#pragma unroll
                for (int bj = 0; bj < 2; ++bj)
#pragma unroll
                    for (int n = 0; n < 2; ++n) *(f32x4*)(rowp + bj * 128 + n * 16) = acc[ai][bj][m][n]; }
    }
};
struct EpiOut {
    static constexpr bool PERM = false, AFTER_DRAIN = false;
    static __device__ __forceinline__ bool keep(const pg8::Unit&) { return false; }
    const float* xp; const float* xs; float* out;
    __device__ __forceinline__ void operator()(const pg8::f32x4 (&acc)[2][2][4][2], const pg8::Unit& u, int wr, int wc, int fr, int fq) const {
        const int row0 = u.pm * 256 + wr * 64 + fr, col0 = u.pn * 256 + wc * 32 + 4 * fq;
#pragma unroll
        for (int ai = 0; ai < 2; ++ai)
#pragma unroll
            for (int m = 0; m < 4; ++m) { const int r = row0 + ai * 128 + m * 16; const float* xr = (r < NPT ? xp + (size_t)r * 1024 : xs + (size_t)(r - NPT) * 1024) + col0; float* orow = out + (size_t)r * 1024 + col0;
#pragma unroll
                for (int bj = 0; bj < 2; ++bj)
#pragma unroll
                    for (int n = 0; n < 2; ++n) *(f32x4*)(orow + bj * 128 + n * 16) = *(const f32x4*)(xr + bj * 128 + n * 16) + acc[ai][bj][m][n]; }
    }
};

__device__ __forceinline__ void transpose_item(const float* W, int K, int N, bf16* WT, int row_off, LAS float* scr, int item, int lane) {
    const int nblk = N / 32, kb = item / nblk, nb = item % nblk, k0 = 64 * kb, n0 = 32 * nb;
    float tv[32];
#pragma unroll
    for (int i = 0; i < 32; ++i) tv[i] = W[(size_t)(k0 + 2 * i + (lane >> 5)) * N + n0 + (lane & 31)];
#pragma unroll
    for (int i = 0; i < 32; ++i) scr[(2 * i + (lane >> 5)) * 33 + (lane & 31)] = tv[i];
    LDS_WAIT();
    const int c = lane & 7;
#pragma unroll
    for (int j = 0; j < 4; ++j) { const int n = (lane >> 3) + 8 * j; const LAS float* s = scr + (8 * c) * 33 + n;
        u32x4 o; o.x = pk2(s[0 * 33], s[1 * 33]); o.y = pk2(s[2 * 33], s[3 * 33]); o.z = pk2(s[4 * 33], s[5 * 33]); o.w = pk2(s[6 * 33], s[7 * 33]);
        *(u32x4*)(WT + (size_t)(row_off + n0 + n) * K + k0 + 8 * c) = o; }
    LDS_WAIT();
}
__device__ __forceinline__ void rms_row_to_bf16(const float* xrow, const float* g, bf16* orow, int lane) {
    const f32x4* xr = (const f32x4*)xrow + lane; const f32x4* gr = (const f32x4*)g + lane;
    f32x4 v[4]; float s = 0.f;
#pragma unroll
    for (int j = 0; j < 4; ++j) { v[j] = xr[64 * j]; s += (v[j].x * v[j].x + v[j].y * v[j].y) + (v[j].z * v[j].z + v[j].w * v[j].w); }
    const float rstd = rsqrtf(wave_sum(s) * (1.f / 1024.f) + 1e-6f);
    unsigned long long* o8 = (unsigned long long*)orow + lane;
#pragma unroll
    for (int j = 0; j < 4; ++j) { const f32x4 gg = gr[64 * j]; o8[64 * j] = (unsigned long long)pk2(v[j].x * rstd * gg.x, v[j].y * rstd * gg.y) | ((unsigned long long)pk2(v[j].z * rstd * gg.z, v[j].w * rstd * gg.w) << 32); }
}
__device__ __forceinline__ void p0_prologue(PREF p, LAS unsigned char* lds, int tid, int wave, int lane, int G) {
    unsigned char* ws = p.ws;
    LAS float* scr = (LAS float*)(lds + wave * 16384);
    const int gw = blockIdx.x * 8 + wave, NGW = G * 8;
    bf16* WIN = (bf16*)(ws + WS_WIN);
    constexpr int I_IN = 16 * 356, I_MM = 16 * 64, I_L = 32;
    constexpr int NITEMS = I_IN + I_MM + 2 * I_L;
    for (int it = gw; it < NITEMS; it += NGW) {
        int r = it;
        if (r < I_IN) { const int n0 = 32 * (r % 356); const int dst = n0 < 3072 ? n0 : (n0 < 3200 ? 11264 + n0 - 3072 : n0 - 128); transpose_item(p.in[I_WIN], 1024, 11392, WIN, dst - n0, scr, r, lane); continue; } r -= I_IN;
        if (r < I_MM) { transpose_item(p.in[I_WMEM], 1024, 2048, WIN + (size_t)11520 * 1024, 0, scr, r, lane); continue; } r -= I_MM;
        if (r < I_L) { transpose_item(p.in[I_WDEC], 64, 1024, (bf16*)(ws + WS_WDEC), 0, scr, r, lane); continue; } r -= I_L;
        transpose_item(p.in[I_WAAA], 64, 1024, (bf16*)(ws + WS_WAAA), 0, scr, r, lane);
    }
    { u32x4* z = (u32x4*)(WIN + (size_t)11392 * 1024); const u32x4 zero = {0u, 0u, 0u, 0u}; for (int i = blockIdx.x * 512 + tid; i < 128 * 1024 / 8; i += G * 512) z[i] = zero; }
    bf16* XN = (bf16*)(ws + WS_XN);
    const float* pxp = opq(p.in[I_XP]); const float* pxs = opq(p.in[I_XS]); const float* pmem = opq(p.in[I_MEM]); const float* pgn = opq(p.in[I_GN]); const float* pgm = opq(p.in[I_GMEM]);
    for (int m0 = gw; m0 < NT + 2048; m0 += 2 * NGW) {
        const float* src[2]; const float* g[2]; bf16* dst[2]; f32x4 v[2][4]; float ss[2];
#pragma unroll
        for (int q = 0; q < 2; ++q) { int m = m0 + q * NGW; if (m >= NT + 2048) m = m0;
            if (m < NPT) { src[q] = pxp + (size_t)m * 1024; g[q] = pgn; } else if (m < NT) { src[q] = pxs + (size_t)(m - NPT) * 1024; g[q] = pgn; } else { src[q] = pmem + (size_t)(m - NT) * 1024; g[q] = pgm; }
            dst[q] = XN + (size_t)m * 1024; }
#pragma unroll
        for (int q = 0; q < 2; ++q) { const f32x4* xr = (const f32x4*)src[q] + lane; float s2 = 0.f;
#pragma unroll
            for (int j = 0; j < 4; ++j) { v[q][j] = xr[64 * j]; }
#pragma unroll
            for (int j = 0; j < 4; ++j) s2 += (v[q][j].x * v[q][j].x + v[q][j].y * v[q][j].y) + (v[q][j].z * v[q][j].z + v[q][j].w * v[q][j].w);
            ss[q] = s2; }
#pragma unroll
        for (int q = 0; q < 2; ++q) { const float rstd = rsqrtf(wave_sum(ss[q]) * (1.f / 1024.f) + 1e-6f); const f32x4* gr = (const f32x4*)g[q] + lane; unsigned long long* o8 = (unsigned long long*)dst[q] + lane;
#pragma unroll
            for (int j = 0; j < 4; ++j) { const f32x4 gg = gr[64 * j]; o8[64 * j] = (unsigned long long)pk2(v[q][j].x * rstd * gg.x, v[q][j].y * rstd * gg.y) | ((unsigned long long)pk2(v[q][j].z * rstd * gg.z, v[q][j].w * rstd * gg.w) << 32); } }
    }
}

__device__ __forceinline__ void p2_weights(PREF p, LAS unsigned char* lds, int vb, int NB, int wave, int lane) {
    unsigned char* ws = p.ws; LAS float* scr = (LAS float*)(lds + wave * 16384);
    constexpr int I_B = 16 * 32, I_R = 2, NITEMS = 4 * I_B + 32 * I_R;
    for (int it = vb * 8 + wave; it < NITEMS; it += NB * 8) {
        int r = it;
        if (r < 3 * I_B) { const int br = r / I_B; const float* wa = opq(p.in[I_WBA]); const float* wb = opq(p.in[I_WBB]); const float* wc = opq(p.in[I_WBC]); transpose_item(br == 0 ? wa : (br == 1 ? wb : wc), 1024, 1024, (bf16*)(ws + WS_WBR) + (size_t)br * 1024 * 1024, 0, scr, r - br * I_B, lane); continue; } r -= 3 * I_B;
        if (r < I_B) { transpose_item(p.in[I_WOUT], 1024, 1024, (bf16*)(ws + WS_WOUT), 0, scr, r, lane); continue; } r -= I_B;
        { const int which = r / 32, rr = r % 32, g = rr >> 1, sub = rr & 1;
          const float* ra = opq(p.in[I_WRGA]); const float* rx = opq(p.in[I_WRGX]); transpose_item((which ? rx : ra) + g * 4096, 64, 64, (bf16*)(ws + (which ? WS_WRGX : WS_WRGA)) + g * 4096, 0, scr, sub, lane); }
    }
}
__device__ __forceinline__ bf16x8 pack8(const float (&x)[8]) { u32x4 w; w.x = pk2(x[0], x[1]); w.y = pk2(x[2], x[3]); w.z = pk2(x[4], x[5]); w.w = pk2(x[6], x[7]); return __builtin_bit_cast(bf16x8, w); }
__device__ __forceinline__ void p2_lora(PREF p, int vb, int NB, int tid, int wave, int lane) {
    unsigned char* ws = p.ws;
    const float* XWA = (const float*)(ws + WS_XWA); const bf16* U = (const bf16*)(ws + WS_U); const bf16* XB = (const bf16*)(ws + WS_XB);
    const bf16* WDEC = (const bf16*)(ws + WS_WDEC); const bf16* WAAA = (const bf16*)(ws + WS_WAAA);
    bf16* E = (bf16*)p.out; bf16* A = E + ZSTRIDE;
    const float* mu = p.in[I_MU]; const float* w0 = p.in[I_W0]; const float* a0 = p.in[I_A0]; const float* ssh = p.in[I_SSH];
    const int trow = lane & 15, kg = lane >> 4;
    for (int item = vb * 8 + wave; item < NT / 16; item += NB * 8) {
        const int tok = item * 16 + trow; const bool prm = tok < NPT; const int s = prm ? (tok & 2047) : ((tok - NPT) & 7); const int bs = (tok - NPT) >> 3;
        bf16x8 Aw[2], Aa[2];
#pragma unroll
        for (int ks = 0; ks < 2; ++ks) { const int k0 = 32 * ks + 8 * kg; float xw[8], xa[8];
#pragma unroll
            for (int hlf = 0; hlf < 2; ++hlf) {
                const f32x4 cw = *(const f32x4*)(XWA + (size_t)tok * 128 + k0 + 4 * hlf), ca = *(const f32x4*)(XWA + (size_t)tok * 128 + 64 + k0 + 4 * hlf);
                f32x4 pw = {0.f, 0.f, 0.f, 0.f}, pa = {0.f, 0.f, 0.f, 0.f};
                if (s > 0) { pw = *(const f32x4*)(XWA + (size_t)(tok - 1) * 128 + k0 + 4 * hlf); pa = *(const f32x4*)(XWA + (size_t)(tok - 1) * 128 + 64 + k0 + 4 * hlf); }
                else if (!prm) { pw = *(const f32x4*)(ssh + (size_t)bs * 3200 + 3072 + k0 + 4 * hlf); pa = *(const f32x4*)(ssh + (size_t)bs * 3200 + 3136 + k0 + 4 * hlf); }
                const f32x4 mw = *(const f32x4*)(mu + 3072 + k0 + 4 * hlf), ma = *(const f32x4*)(mu + 3136 + k0 + 4 * hlf);
#pragma unroll
                for (int j = 0; j < 4; ++j) { const float xs = cw[j] + (pw[j] - cw[j]) * mw[j]; xw[4 * hlf + j] = 1.0f - 2.0f / (1.0f + __expf(2.0f * xs)); xa[4 * hlf + j] = ca[j] + (pa[j] - ca[j]) * ma[j]; }
            }
            Aw[ks] = pack8(xw); Aa[ks] = pack8(xa); }
        const size_t orow = (size_t)(item * 16 + trow) * 1024 + 4 * kg;
#pragma unroll 4
        for (int ct = 0; ct < 64; ++ct) { const int n = 16 * ct + trow;
            const bf16x8 bd0 = *(const bf16x8*)(WDEC + n * 64 + 8 * kg), bd1 = *(const bf16x8*)(WDEC + n * 64 + 32 + 8 * kg), ba0 = *(const bf16x8*)(WAAA + n * 64 + 8 * kg), ba1 = *(const bf16x8*)(WAAA + n * 64 + 32 + 8 * kg);
            f32x4 ad = {0.f, 0.f, 0.f, 0.f}, aa = {0.f, 0.f, 0.f, 0.f};
            ad = __builtin_amdgcn_mfma_f32_16x16x32_bf16(bd0, Aw[0], ad, 0, 0, 0); ad = __builtin_amdgcn_mfma_f32_16x16x32_bf16(bd1, Aw[1], ad, 0, 0, 0);
            aa = __builtin_amdgcn_mfma_f32_16x16x32_bf16(ba0, Aa[0], aa, 0, 0, 0); aa = __builtin_amdgcn_mfma_f32_16x16x32_bf16(ba1, Aa[1], aa, 0, 0, 0);
            const f32x4 w0v = *(const f32x4*)(w0 + 16 * ct + 4 * kg), a0v = *(const f32x4*)(a0 + 16 * ct + 4 * kg);
            u32x2 ev, av; ev.x = pk2(0.60653066f * sigm(w0v[0] + ad[0]), 0.60653066f * sigm(w0v[1] + ad[1])); ev.y = pk2(0.60653066f * sigm(w0v[2] + ad[2]), 0.60653066f * sigm(w0v[3] + ad[3]));
            av.x = pk2(sigm(a0v[0] + aa[0]), sigm(a0v[1] + aa[1])); av.y = pk2(sigm(a0v[2] + aa[2]), sigm(a0v[3] + aa[3]));
            *(u32x2*)(E + orow + 16 * ct) = ev; *(u32x2*)(A + orow + 16 * ct) = av; }
    }
    float* out = p.out; const int gt = vb * 512 + tid, ngt = NB * 512;
    for (int i = gt; i < 136 * 3200; i += ngt) { const int b = i / 3200, c = i - b * 3200; const int tok = b < 8 ? b * 2048 + 2047 : NPT + (b - 8) * 8 + 7;
        const float v = c < 3072 ? bf2f(U[(size_t)tok * 3072 + c]) : XWA[(size_t)tok * 128 + c - 3072];
        out[(b < 8 ? O_SHP + (size_t)b * 3200 : O_SHS + (size_t)(b - 8) * 3200) + c] = v; }
    for (int i = gt; i < 136 * 3072; i += ngt) { const int b = i / 3072, r = i - b * 3072, j = r >> 10, c = r & 1023; const int tok = b < 8 ? b * 2048 + 2045 + j : NPT + (b - 8) * 8 + 5 + j;
        out[(b < 8 ? O_CVP + (size_t)b * 3072 : O_CVS + (size_t)(b - 8) * 3072) + r] = bf2f(XB[(size_t)tok * 1024 + c]); }
}

constexpr int CH = 32;
constexpr int BUF_F = 6 * CH * 64;
constexpr int RW_LDS_OST = 2 * BUF_F * 4;
constexpr int OST_F = CH * 128;
struct Seg { int tok0, h, half; bool first, last; const float* S0; float* Sout; const float* shift0; };
__device__ __forceinline__ Seg get_seg(const float* srw, const float* ssh, float* out, int mode, int it0, int c, int j) {
    Seg g;
    if (mode == 0) { const int b = it0 >> 5; g.h = (it0 >> 1) & 15; g.half = it0 & 1; g.tok0 = b * 2048 + CH * c + 8 * j; g.first = (c == 0 && j == 0); g.last = (c == 2048 / CH - 1 && j == 3);
        g.S0 = nullptr; g.shift0 = nullptr; g.Sout = out + O_RWP + (size_t)(b * 16 + g.h) * 4096; }
    else { const int it = it0 + 4 * c + j, b = it >> 5; g.h = (it >> 1) & 15; g.half = it & 1; g.tok0 = NPT + b * 8; g.first = true; g.last = true;
        g.S0 = srw + (size_t)(b * 16 + g.h) * 4096; g.shift0 = ssh + (size_t)b * 3200; g.Sout = out + O_RWS + (size_t)(b * 16 + g.h) * 4096; }
    return g;
}
__device__ __forceinline__ void rwkv_prep(PREF p, LAS float* buf, const Seg g, int lw, int lane) {
    unsigned char* ws = p.ws;
    const bf16* U = (const bf16*)(ws + WS_U); const bf16* E = (const bf16*)p.out; const bf16* A = E + ZSTRIDE; float* BON = (float*)(ws + WS_BONUS);
    const int C = g.h * 64 + lane;
    const float mur = p.in[I_MU][C], muk = p.in[I_MU][1024 + C], muv = p.in[I_MU][2048 + C], kkc = p.in[I_KK][C], kac = p.in[I_KA][C], rkc = p.in[I_RK][C];
    float pr = 0.f, pk = 0.f, pv = 0.f;
    if (g.first) { if (g.shift0) { pr = g.shift0[C]; pk = g.shift0[1024 + C]; pv = g.shift0[2048 + C]; } }
    else { const bf16* up = U + (size_t)(g.tok0 - 1) * 3072 + C; pr = bf2f(up[0]); pk = bf2f(up[1024]); pv = bf2f(up[2048]); }
    bf16 ur[8], uk[8], uv[8], ee[8], aa[8];
#pragma unroll
    for (int i = 0; i < 8; ++i) { const size_t tok = (size_t)(g.tok0 + i); const bf16* up = U + tok * 3072 + C; ur[i] = up[0]; uk[i] = up[1024]; uv[i] = up[2048]; ee[i] = E[tok * 1024 + C]; aa[i] = A[tok * 1024 + C]; }
    float r8[8], kr8[8], kp8[8], v8[8], a8[8], dc8[8], xs[8], ys[8];
#pragma unroll
    for (int i = 0; i < 8; ++i) {
        const float fr = bf2f(ur[i]), fk = bf2f(uk[i]), fv = bf2f(uv[i]), e = bf2f(ee[i]), a = bf2f(aa[i]);
        const float r = fr + (pr - fr) * mur, k = fk + (pk - fk) * muk, v = fv + (pv - fv) * muv; pr = fr; pk = fk; pv = fv;
        const float kr = k * kkc, kp = k * (1.0f + (a - 1.0f) * kac);
        r8[i] = r; kr8[i] = kr; kp8[i] = kp; v8[i] = v; a8[i] = a; dc8[i] = __expf(-e); xs[i] = kr * kr; ys[i] = r * kp * rkc; }
    const bool b0 = (lane & 1) != 0, b1 = (lane & 2) != 0, b2 = (lane & 4) != 0, b3 = (lane & 8) != 0;
    float w8[8], u4[4], p2[2], f;
#pragma unroll
    for (int j = 0; j < 8; ++j) { const float keep = b0 ? ys[j] : xs[j], send = b0 ? xs[j] : ys[j]; w8[j] = keep + dppf<0xB1>(send); }
#pragma unroll
    for (int j = 0; j < 4; ++j) { const float keep = b1 ? w8[2 * j + 1] : w8[2 * j], send = b1 ? w8[2 * j] : w8[2 * j + 1]; u4[j] = keep + dppf<0x4E>(send); }
#pragma unroll
    for (int j = 0; j < 2; ++j) { const float keep = b2 ? u4[2 * j + 1] : u4[2 * j], send = b2 ? u4[2 * j] : u4[2 * j + 1];
        const int si = __builtin_bit_cast(int, send); int t = __builtin_amdgcn_update_dpp(si, si, 0x104, 0xF, 0x5, false); t = __builtin_amdgcn_update_dpp(t, si, 0x114, 0xF, 0xA, false);
        p2[j] = keep + __builtin_bit_cast(float, t); }
    { const float keep = b3 ? p2[1] : p2[0], send = b3 ? p2[0] : p2[1]; f = keep + dppf<0x128>(send); }
    f += __shfl_xor(f, 16); f += __shfl_xor(f, 32);
#pragma unroll
    for (int i = 0; i < 8; ++i) {
        const int s = 8 * lw + i; const float ss = rdl(f, 2 * i); const float kk = kr8[i] * __builtin_amdgcn_rsqf(ss + 1e-12f);
        LAS float* bp = buf + s * 64 + lane;
        bp[0] = dc8[i]; bp[CH * 64] = kk * a8[i]; bp[2 * CH * 64] = kp8[i]; bp[3 * CH * 64] = kk; bp[4 * CH * 64] = r8[i]; bp[5 * CH * 64] = v8[i]; }
    if (g.half == 0 && lane < 16 && b0) BON[(size_t)(g.tok0 + (lane >> 1)) * 16 + g.h] = f;
}
__device__ __forceinline__ void rwkv_oout(PREF p, const LAS float* ost, const Seg g, int ltid) {
    unsigned char* ws = p.ws; bf16* ORAW = (bf16*)(ws + WS_ORAW); float* ST = (float*)(ws + WS_STATS);
    const int s = ltid >> 3, q = ltid & 7;
    f32x4 o; { const LAS f32x4* pp = (const LAS f32x4*)(ost + s * 128 + q * 16);
      const f32x4 a0 = pp[0], a1 = pp[1], b0 = pp[2], b1 = pp[3]; o.x = (a0.x + a0.z) + (a1.x + a1.z); o.y = (a0.y + a0.w) + (a1.y + a1.w); o.z = (b0.x + b0.z) + (b1.x + b1.z); o.w = (b0.y + b0.w) + (b1.y + b1.w); }
    float sm = (o.x + o.y) + (o.z + o.w), sq = (o.x * o.x + o.y * o.y) + (o.z * o.z + o.w * o.w);
    sm += dppf<0xB1>(sm); sq += dppf<0xB1>(sq); sm += dppf<0x4E>(sm); sq += dppf<0x4E>(sq); sm += dppf<0x141>(sm); sq += dppf<0x141>(sq);
    const size_t tok = (size_t)(g.tok0 + (s & 7)); u32x2 w; w.x = pk2(o.x, o.y); w.y = pk2(o.z, o.w); *(u32x2*)(ORAW + tok * 1024 + g.h * 64 + 32 * g.half + 4 * q) = w;
    if (q == 0) *(f32x2*)(ST + ((tok * 16 + g.h) * 2 + g.half) * 2) = (f32x2){sm, sq};
}
struct ScanOps { f32x4 w4, b4, k4, kk4, r4; f32x2 v2; };
__device__ __forceinline__ ScanOps scan_load(const LAS float* buf, int s, int kl, int voff) { ScanOps o; const LAS float* bp = buf + s * 64 + 4 * kl;
    o.w4 = *(const LAS f32x4*)bp; o.b4 = *(const LAS f32x4*)(bp + CH * 64); o.k4 = *(const LAS f32x4*)(bp + 2 * CH * 64); o.kk4 = *(const LAS f32x4*)(bp + 3 * CH * 64); o.r4 = *(const LAS f32x4*)(bp + 4 * CH * 64);
    o.v2 = *(const LAS f32x2*)(buf + 5 * CH * 64 + s * 64 + voff); return o; }
__device__ __forceinline__ void rwkv_run(PREF p, LAS unsigned char* lds, int tid, int wave, int lane, int mode, int it0, int nch) {
    LAS float* bufs = (LAS float*)lds; LAS float* osts = (LAS float*)(lds + RW_LDS_OST);
    const float* srw = p.in[I_SRW]; const float* ssh = p.in[I_SSH]; float* out = p.out;
    const bool scan = wave < 4; const int rl = lane >> 4, kl = lane & 15, roff = 8 * wave + 2 * rl;
    f32x4 Sa = {0.f, 0.f, 0.f, 0.f}, Sb = Sa; f32x4 Na[4], Nb[4], Ma[4], Mb[4];
#pragma unroll
    for (int j = 0; j < 4; ++j) { Na[j] = Sa; Nb[j] = Sa; Ma[j] = Sa; Mb[j] = Sa; }
    if (scan) {
#pragma unroll
        for (int j = 0; j < 4; ++j) { const Seg g = get_seg(srw, ssh, out, mode, it0, 0, j); if (g.S0) { const int row = 32 * g.half + roff; Na[j] = *(const f32x4*)(g.S0 + row * 64 + 4 * kl); Nb[j] = *(const f32x4*)(g.S0 + (row + 1) * 64 + 4 * kl); } } }
    else rwkv_prep(p, bufs, get_seg(srw, ssh, out, mode, it0, 0, wave - 4), wave - 4, lane);
    __syncthreads();
    for (int c = 0; c < nch; ++c) {
        if (scan) {
            const LAS float* buf = bufs + (c & 1) * BUF_F; LAS float* ost = osts + (c & 1) * OST_F;
            ScanOps cur = scan_load(buf, 0, kl, 32 * get_seg(srw, ssh, out, mode, it0, c, 0).half + roff);
            if (c + 1 < nch) {
#pragma unroll
                for (int j = 0; j < 4; ++j) { const Seg n = get_seg(srw, ssh, out, mode, it0, c + 1, j); if (n.S0) { const int row = 32 * n.half + roff; Ma[j] = *(const f32x4*)(n.S0 + row * 64 + 4 * kl); Mb[j] = *(const f32x4*)(n.S0 + (row + 1) * 64 + 4 * kl); } } }
#pragma unroll
            for (int j = 0; j < 4; ++j) {
                const Seg g = get_seg(srw, ssh, out, mode, it0, c, j);
                if (g.first) { Sa = Na[j]; Sb = Nb[j]; }
                const int nh = get_seg(srw, ssh, out, mode, it0, c, j < 3 ? j + 1 : j).half;
#pragma unroll
                for (int i = 0; i < 8; ++i) {
                    const int s = 8 * j + i;
                    const int sn = s + 1 < CH ? s + 1 : s; const ScanOps nxt = scan_load(buf, sn, kl, 32 * (i == 7 && j < 3 ? nh : g.half) + roff);
                    const f32x2 kkL = __builtin_shufflevector(cur.kk4, cur.kk4, 0, 1), kkH = __builtin_shufflevector(cur.kk4, cur.kk4, 2, 3), wL = __builtin_shufflevector(cur.w4, cur.w4, 0, 1), wH = __builtin_shufflevector(cur.w4, cur.w4, 2, 3);
                    const f32x2 bL = __builtin_shufflevector(cur.b4, cur.b4, 0, 1), bH = __builtin_shufflevector(cur.b4, cur.b4, 2, 3), kL = __builtin_shufflevector(cur.k4, cur.k4, 0, 1), kH = __builtin_shufflevector(cur.k4, cur.k4, 2, 3);
                    const f32x2 rL = __builtin_shufflevector(cur.r4, cur.r4, 0, 1), rH = __builtin_shufflevector(cur.r4, cur.r4, 2, 3);
                    f32x2 SaL = __builtin_shufflevector(Sa, Sa, 0, 1), SaH = __builtin_shufflevector(Sa, Sa, 2, 3), SbL = __builtin_shufflevector(Sb, Sb, 0, 1), SbH = __builtin_shufflevector(Sb, Sb, 2, 3);
                    f32x2 ta = SaL * kkL; ta = __builtin_elementwise_fma(SaH, kkH, ta); f32x2 tb = SbL * kkL; tb = __builtin_elementwise_fma(SbH, kkH, tb);
                    float sa0 = ta.x + ta.y, sa1 = tb.x + tb.y;
                    sa0 += dppf<0xB1>(sa0); sa1 += dppf<0xB1>(sa1); sa0 += dppf<0x4E>(sa0); sa1 += dppf<0x4E>(sa1); sa0 += dppf<0x141>(sa0); sa1 += dppf<0x141>(sa1); sa0 += dppf<0x140>(sa0); sa1 += dppf<0x140>(sa1);
                    const f32x2 na = {-sa0, -sa0}, nb = {-sa1, -sa1}, va = {cur.v2.x, cur.v2.x}, vb = {cur.v2.y, cur.v2.y};
                    SaL = __builtin_elementwise_fma(va, kL, __builtin_elementwise_fma(na, bL, SaL * wL)); SaH = __builtin_elementwise_fma(va, kH, __builtin_elementwise_fma(na, bH, SaH * wH));
                    SbL = __builtin_elementwise_fma(vb, kL, __builtin_elementwise_fma(nb, bL, SbL * wL)); SbH = __builtin_elementwise_fma(vb, kH, __builtin_elementwise_fma(nb, bH, SbH * wH));
                    Sa = __builtin_shufflevector(SaL, SaH, 0, 1, 2, 3); Sb = __builtin_shufflevector(SbL, SbH, 0, 1, 2, 3);
                    f32x2 oa = SaL * rL; oa = __builtin_elementwise_fma(SaH, rH, oa); f32x2 ob = SbL * rL; ob = __builtin_elementwise_fma(SbH, rH, ob);
                    float o0 = oa.x + oa.y, o1 = ob.x + ob.y;
                    asm volatile("" : "+v"(o0), "+v"(o1));
                    o0 += dppf<0xB1>(o0); o1 += dppf<0xB1>(o1); o0 += dppf<0x4E>(o0); o1 += dppf<0x4E>(o1);
                    if ((kl & 3) == 0) *(LAS f32x2*)(ost + s * 128 + roff * 4 + (kl >> 2) * 2) = (f32x2){o0, o1};
                    cur = nxt;
                }
                if (g.last) { const int row = 32 * g.half + roff; *(f32x4*)(g.Sout + row * 64 + 4 * kl) = Sa; *(f32x4*)(g.Sout + (row + 1) * 64 + 4 * kl) = Sb; }
            }
#pragma unroll
            for (int j = 0; j < 4; ++j) { Na[j] = Ma[j]; Nb[j] = Mb[j]; }
        } else {
            if (c + 1 < nch) rwkv_prep(p, bufs + ((c + 1) & 1) * BUF_F, get_seg(srw, ssh, out, mode, it0, c + 1, wave - 4), wave - 4, lane);
            if (c >= 1) rwkv_oout(p, osts + ((c - 1) & 1) * OST_F, get_seg(srw, ssh, out, mode, it0, c - 1, (tid - 256) >> 6), tid - 256);
        }
        __syncthreads();
    }
    if (!scan) rwkv_oout(p, osts + ((nch - 1) & 1) * OST_F, get_seg(srw, ssh, out, mode, it0, nch - 1, (tid - 256) >> 6), tid - 256);
    __syncthreads();
}

template <int MODE> __device__ __forceinline__ void rglru_item(PREF p, LAS unsigned char* lds, int tid, int wave, int lane, int item, bool st) {
    asm volatile("" : "+v"(tid), "+v"(lane));
    constexpr int TPT = MODE ? 8 : 16, RC = 8 * TPT;
    unsigned char* ws = p.ws; const bf16* XB = (const bf16*)(ws + WS_XB); bf16* ZB = (bf16*)(ws + WS_Z) + ZSTRIDE;
    LAS float* XC = (LAS float*)lds; LAS float* GR = XC + RC * 65; LAS float* GI = GR + RC * 65; LAS bf16* XCB = (LAS bf16*)(GI + RC * 65); LAS float* TOT = (LAS float*)(XCB + RC * 72); LAS float* HC = TOT + 1024;
    const int c = tid & 63, sg = tid >> 6;
    const int g = MODE ? (item >> 4) : (item & 15), bb = MODE ? (8 * (item & 15) + sg) : (item >> 4), C = g * 64 + c;
    constexpr int nchunk = MODE ? 1 : 2048 / RC; const int rowtok = MODE ? (NPT + bb * 8) : (bb * 2048 + TPT * sg);
    const float cw0 = p.in[I_CW][C], cw1 = p.in[I_CW][1024 + C], cw2 = p.in[I_CW][2048 + C], cw3 = p.in[I_CW][3072 + C], cb = p.in[I_CB][C];
    const float sp = log1pf(__expf(-p.in[I_LAM][C]));
    const bf16* WT = (const bf16*)(ws + (wave >= 4 ? WS_WRGX : WS_WRGA)) + g * 4096; const float* bra = opq(p.in[I_BRGA]); const float* brx = opq(p.in[I_BRGX]); const float* bias = (wave >= 4 ? brx : bra) + g * 64;
    const int trow = lane & 15, kg = lane >> 4;
    bf16x8 wb0[4], wb1[4]; float bn[4];
#pragma unroll
    for (int ct = 0; ct < 4; ++ct) { const int n = 16 * ct + trow; wb0[ct] = *(const bf16x8*)(WT + n * 64 + 8 * kg); wb1[ct] = *(const bf16x8*)(WT + n * 64 + 32 + 8 * kg); bn[ct] = bias[n]; }
    float hin = 0.f; float e0 = 0.f, e1 = 0.f, e2 = 0.f;
    if (MODE) { hin = p.in[I_SLRU][(size_t)bb * 1024 + C]; const float* cv = p.in[I_SCV] + (size_t)bb * 3072 + C; e0 = cv[0]; e1 = cv[1024]; e2 = cv[2048]; }
    else { if (tid < 64) HC[c] = 0.f; if (sg > 0) { const bf16* xp = XB + (size_t)(rowtok - 3) * 1024 + C; e0 = bf2f(xp[0]); e1 = bf2f(xp[1024]); e2 = bf2f(xp[2048]); } }
    bf16 xn[TPT], zn[TPT];
#pragma unroll
    for (int i = 0; i < TPT; ++i) { xn[i] = XB[(size_t)(rowtok + i) * 1024 + C]; zn[i] = ZB[(size_t)(rowtok + i) * 1024 + C]; }
    for (int k = 0; k < nchunk; ++k) {
        const int tok = rowtok + RC * k;
        float zb[TPT];
#pragma unroll
        for (int i = 0; i < TPT; ++i) { const float e3 = bf2f(xn[i]); zb[i] = bf2f(zn[i]); const float xc = cb + e0 * cw0 + e1 * cw1 + e2 * cw2 + e3 * cw3;
            XC[(sg * TPT + i) * 65 + c] = xc; XCB[(sg * TPT + i) * 72 + c] = (bf16)f2bf(xc); e0 = e1; e1 = e2; e2 = e3; }
        if (k + 1 < nchunk) {
            const bf16* xp = XB + (size_t)(tok + RC - 3) * 1024 + C; e0 = bf2f(xp[0]); e1 = bf2f(xp[1024]); e2 = bf2f(xp[2048]);
#pragma unroll
            for (int i = 0; i < TPT; ++i) { xn[i] = XB[(size_t)(tok + RC + i) * 1024 + C]; zn[i] = ZB[(size_t)(tok + RC + i) * 1024 + C]; } }
        __syncthreads();
        { LAS float* GO = wave >= 4 ? GI : GR;
#pragma unroll
          for (int u = 0; u < RC / 64; ++u) { const int tt = (wave & 3) + 4 * u;
            const bf16x8 a0 = *(const LAS bf16x8*)(XCB + (16 * tt + trow) * 72 + 8 * kg), a1 = *(const LAS bf16x8*)(XCB + (16 * tt + trow) * 72 + 32 + 8 * kg);
#pragma unroll
            for (int ct = 0; ct < 4; ++ct) { const int n = 16 * ct + trow;
                f32x4 acc = {0.f, 0.f, 0.f, 0.f}; acc = __builtin_amdgcn_mfma_f32_16x16x32_bf16(a0, wb0[ct], acc, 0, 0, 0); acc = __builtin_amdgcn_mfma_f32_16x16x32_bf16(a1, wb1[ct], acc, 0, 0, 0);
#pragma unroll
                for (int r = 0; r < 4; ++r) GO[(16 * tt + 4 * kg + r) * 65 + n] = sigm(acc[r] + bn[ct]); } } }
        __syncthreads();
        float hl[TPT], cm[TPT]; { float h = 0.f, cum = 1.f;
#pragma unroll
          for (int i = 0; i < TPT; ++i) { const int s = sg * TPT + i; const float gr = GR[s * 65 + c], gi = GI[s * 65 + c], xc = XC[s * 65 + c];
              const float la = -8.0f * gr * sp, x2 = 2.0f * la;
              const float om = -x2 * (1.0f + x2 * 0.5f * (1.0f + x2 * (1.0f / 3.0f) * (1.0f + x2 * 0.25f * (1.0f + x2 * 0.2f * (1.0f + x2 * (1.0f / 6.0f) * (1.0f + x2 * (1.0f / 7.0f)))))));
              const float a = __expf(la), b = sqrtf(om) * gi * xc;
              h = a * h + b; cum *= a; hl[i] = h; cm[i] = cum; }
          if (!MODE) { TOT[sg * 64 + c] = cum; TOT[512 + sg * 64 + c] = h; } }
        if (!MODE) __syncthreads();
        { float h = hin;
          if (!MODE) { h = HC[(k & 1) * 64 + c]; for (int j = 0; j < sg; ++j) h = TOT[j * 64 + c] * h + TOT[512 + j * 64 + c]; }
          if (st) {
#pragma unroll
              for (int i = 0; i < TPT; ++i) ZB[(size_t)(tok + i) * 1024 + C] = (bf16)f2bf((hl[i] + cm[i] * h) * zb[i]); }
          const float hn = hl[TPT - 1] + cm[TPT - 1] * h;
          if (MODE) p.out[O_LRS + (size_t)bb * 1024 + C] = hn;
          else if (sg == 7) { HC[((k + 1) & 1) * 64 + c] = hn; if (k == nchunk - 1) p.out[O_LRP + (size_t)bb * 1024 + C] = hn; } }
    }
    __syncthreads();
}

constexpr int XA_STG = 128 * 528, XA_PL = 8448;
__device__ __forceinline__ void xa_stage(LAS unsigned char* lds, const bf16* src, size_t ld, int tid) {
#pragma unroll
    for (int i = 0; i < 8; ++i) { const int e = tid + 512 * i, row = e >> 5, seg = e & 31; *(LAS u32x4*)(lds + row * 528 + seg * 16) = *(const u32x4*)(src + (size_t)row * ld + seg * 8); }
}
__device__ __forceinline__ void xattn_prompt_item(PREF p, LAS unsigned char* lds, int tid, int wave, int lane, int item, bool st) {
    unsigned char* ws = p.ws; const bf16* Q = (const bf16*)(ws + WS_Q); const bf16* MK = (const bf16*)(ws + WS_MK); const bf16* MVT = (const bf16*)(ws + WS_MVT); bf16* ZC = (bf16*)(ws + WS_Z) + 2 * ZSTRIDE;
    LAS bf16* PL = (LAS bf16*)(lds + XA_STG + wave * XA_PL);
    const int qb = item & 15, head = (item >> 4) & 3, b = item >> 6, tok0 = b * 2048 + 128 * qb + 16 * wave, trow = lane & 15, kg = lane >> 4;
    bf16x8 qf[8];
#pragma unroll
    for (int ks = 0; ks < 8; ++ks) qf[ks] = *(const bf16x8*)(Q + (size_t)(tok0 + trow) * 1024 + head * 256 + 32 * ks + 8 * kg);
    f32x4 S[16];
#pragma unroll
    for (int hk = 0; hk < 2; ++hk) {
        __syncthreads();
        xa_stage(lds, MK + (size_t)(b * 256 + 128 * hk) * 1024 + head * 256, 1024, tid);
        __syncthreads();
#pragma unroll
        for (int mt = 0; mt < 8; ++mt) { f32x4 acc = {0.f, 0.f, 0.f, 0.f}; const LAS unsigned char* kp = lds + (16 * mt + trow) * 528 + kg * 16;
#pragma unroll
            for (int ks = 0; ks < 8; ++ks) acc = __builtin_amdgcn_mfma_f32_16x16x32_bf16(qf[ks], *(const LAS bf16x8*)(kp + ks * 64), acc, 0, 0, 0);
            S[8 * hk + mt] = acc; }
    }
    f32x4 mx = S[0];
#pragma unroll
    for (int mt = 1; mt < 16; ++mt) { mx.x = fmaxf(mx.x, S[mt].x); mx.y = fmaxf(mx.y, S[mt].y); mx.z = fmaxf(mx.z, S[mt].z); mx.w = fmaxf(mx.w, S[mt].w); }
    mx.x = row16_max(mx.x); mx.y = row16_max(mx.y); mx.z = row16_max(mx.z); mx.w = row16_max(mx.w);
    f32x4 sm = {0.f, 0.f, 0.f, 0.f};
#pragma unroll
    for (int mt = 0; mt < 16; ++mt) { f32x4 e; e.x = __expf((S[mt].x - mx.x) * 0.0625f); e.y = __expf((S[mt].y - mx.y) * 0.0625f); e.z = __expf((S[mt].z - mx.z) * 0.0625f); e.w = __expf((S[mt].w - mx.w) * 0.0625f);
        sm += e; const int col = 16 * mt + trow;
        PL[(4 * kg + 0) * 264 + col] = (bf16)f2bf(e.x); PL[(4 * kg + 1) * 264 + col] = (bf16)f2bf(e.y); PL[(4 * kg + 2) * 264 + col] = (bf16)f2bf(e.z); PL[(4 * kg + 3) * 264 + col] = (bf16)f2bf(e.w); }
    sm.x = row16_sum(sm.x); sm.y = row16_sum(sm.y); sm.z = row16_sum(sm.z); sm.w = row16_sum(sm.w);
    const f32x4 inv = {1.0f / sm.x, 1.0f / sm.y, 1.0f / sm.z, 1.0f / sm.w};
    LDS_WAIT();
    bf16x8 pf[8];
#pragma unroll
    for (int ks = 0; ks < 8; ++ks) pf[ks] = *(const LAS bf16x8*)(PL + trow * 264 + 32 * ks + 8 * kg);
#pragma unroll
    for (int hv = 0; hv < 2; ++hv) {
        __syncthreads();
        xa_stage(lds, MVT + ((size_t)((b * 4 + head) * 256 + 128 * hv)) * 256, 256, tid);
        __syncthreads();
#pragma unroll
        for (int dt = 0; dt < 8; ++dt) { f32x4 acc = {0.f, 0.f, 0.f, 0.f}; const LAS unsigned char* vp = lds + (16 * dt + trow) * 528 + kg * 16;
#pragma unroll
            for (int ks = 0; ks < 8; ++ks) acc = __builtin_amdgcn_mfma_f32_16x16x32_bf16(pf[ks], *(const LAS bf16x8*)(vp + ks * 64), acc, 0, 0, 0);
            acc = acc * inv; const int col = head * 256 + 128 * hv + 16 * dt + trow;
#pragma unroll
            for (int r = 0; r < 4; ++r) { bf16* zp = ZC + (size_t)(tok0 + 4 * kg + r) * 1024 + col; const bf16 nv = (bf16)f2bf(acc[r] * bf2f(*zp)); if (st) *zp = nv; } }
    }
    __syncthreads();
}

__device__ __forceinline__ void xattn_sample_item(PREF p, LAS unsigned char* lds, int tid, int wave, int lane, int item, bool st) {
    unsigned char* ws = p.ws; const bf16* Q = (const bf16*)(ws + WS_Q); bf16* ZC = (bf16*)(ws + WS_Z) + 2 * ZSTRIDE;
    LAS float* QS = (LAS float*)lds; LAS float* SC = QS + 2048; LAS float* PART = SC + 2048;
    const int b = item >> 2, head = item & 3, tok0 = NPT + b * 8;
    for (int i = tid; i < 2048; i += 512) QS[i] = bf2f(Q[(size_t)(tok0 + (i >> 8)) * 1024 + head * 256 + (i & 255)]);
    __syncthreads();
    const float* Vc = p.in[I_CV] + ((size_t)b * 256 * 4 + head) * 256 + 4 * lane;
    { const int kl = lane & 15, rq = lane >> 4; const float* Kc = p.in[I_CK] + ((size_t)b * 256 * 4 + head) * 256 + 4 * kl;
      f32x4 q[8][4];
#pragma unroll
      for (int i = 0; i < 8; ++i)
#pragma unroll
          for (int j = 0; j < 4; ++j) q[i][j] = *(const LAS f32x4*)(QS + i * 256 + 64 * j + 4 * kl);
#pragma unroll 2
      for (int r = 0; r < 8; ++r) { const int m = 32 * wave + 4 * r + rq; const f32x4* kp = (const f32x4*)(Kc + (size_t)m * 1024);
          const f32x4 k0 = kp[0], k1 = kp[16], k2 = kp[32], k3 = kp[48];
#pragma unroll
          for (int i = 0; i < 8; ++i) { f32x4 t = q[i][0] * k0 + q[i][1] * k1 + q[i][2] * k2 + q[i][3] * k3; float d = row16_sum((t.x + t.y) + (t.z + t.w));
              if (kl == i) SC[i * 256 + m] = d * 0.0625f; } } }
    __syncthreads();
    { float v[4]; float mx = -3.0e38f;
#pragma unroll
      for (int j = 0; j < 4; ++j) { v[j] = SC[wave * 256 + lane + 64 * j]; mx = fmaxf(mx, v[j]); }
      mx = wave_max(mx); float sm = 0.f;
#pragma unroll
      for (int j = 0; j < 4; ++j) { v[j] = __expf(v[j] - mx); sm += v[j]; }
      sm = wave_sum(sm); const float inv = 1.0f / sm;
#pragma unroll
      for (int j = 0; j < 4; ++j) SC[wave * 256 + lane + 64 * j] = v[j] * inv; }
    __syncthreads();
    { f32x4 acc[8];
#pragma unroll
      for (int i = 0; i < 8; ++i) acc[i] = (f32x4){0.f, 0.f, 0.f, 0.f};
#pragma unroll 8
      for (int r = 0; r < 32; ++r) { const int m = 32 * wave + r; const f32x4 vv = *(const f32x4*)(Vc + (size_t)m * 1024);
#pragma unroll
          for (int i = 0; i < 8; ++i) acc[i] += SC[i * 256 + m] * vv; }
#pragma unroll
      for (int i = 0; i < 8; ++i) *(LAS f32x4*)(PART + (wave * 8 + i) * 256 + 4 * lane) = acc[i]; }
    __syncthreads();
    { const int q = tid >> 6, d = 4 * (tid & 63); f32x4 s = {0.f, 0.f, 0.f, 0.f};
#pragma unroll
      for (int w = 0; w < 8; ++w) s += *(const LAS f32x4*)(PART + (w * 8 + q) * 256 + d);
      u32x2* zp = (u32x2*)(ZC + (size_t)(tok0 + q) * 1024 + head * 256 + d); const u32x2 z = *zp;
      u32x2 o; o.x = pk2(s.x * bflo(z.x), s.y * bfhi(z.x)); o.y = pk2(s.z * bflo(z.y), s.w * bfhi(z.y)); if (st) *zp = o; }
    __syncthreads();
}

__device__ __forceinline__ void p4_post(PREF p, int tid, int G, bool stw) {
    unsigned char* ws = p.ws; const bf16* ORAW = (const bf16*)(ws + WS_ORAW); const bf16* U = (const bf16*)(ws + WS_U); bf16* ZA = (bf16*)(ws + WS_Z);
    const float* ST = (const float*)(ws + WS_STATS); const float* BON = (const float*)(ws + WS_BONUS);
    const float* muv = p.in[I_MU] + 2048; const float* gng = p.in[I_GNG]; const float* gnb = p.in[I_GNB]; const float* ssh = p.in[I_SSH];
    for (int i = blockIdx.x * 512 + tid; i < NT * 128; i += G * 512) {
        const int tok = i >> 7, c0 = (i & 127) * 8, h = c0 >> 6; const bool prm = tok < NPT; const int s = prm ? (tok & 2047) : ((tok - NPT) & 7); const int bs = (tok - NPT) >> 3;
        const f32x4 st = *(const f32x4*)(ST + ((size_t)tok * 16 + h) * 4);
        const float mean = (st.x + st.z) * (1.f / 64.f), var = (st.y + st.w) * (1.f / 64.f) - mean * mean, rstd = rsqrtf(fmaxf(var, 0.f) + 64e-5f), bon = BON[(size_t)tok * 16 + h];
        const u32x4 o = *(const u32x4*)(ORAW + (size_t)tok * 1024 + c0), z = *(const u32x4*)(ZA + (size_t)tok * 1024 + c0), vc = *(const u32x4*)(U + (size_t)tok * 3072 + 2048 + c0);
        float pv[8];
        if (s > 0) { const u32x4 vp = *(const u32x4*)(U + (size_t)(tok - 1) * 3072 + 2048 + c0); pv[0] = bflo(vp.x); pv[1] = bfhi(vp.x); pv[2] = bflo(vp.y); pv[3] = bfhi(vp.y); pv[4] = bflo(vp.z); pv[5] = bfhi(vp.z); pv[6] = bflo(vp.w); pv[7] = bfhi(vp.w); }
        else if (!prm) {
#pragma unroll
            for (int j = 0; j < 8; ++j) pv[j] = ssh[(size_t)bs * 3200 + 2048 + c0 + j]; }
        else {
#pragma unroll
            for (int j = 0; j < 8; ++j) pv[j] = 0.f; }
        const unsigned ow[4] = {o.x, o.y, o.z, o.w}, zw[4] = {z.x, z.y, z.z, z.w}, vw[4] = {vc.x, vc.y, vc.z, vc.w}; unsigned rw[4];
#pragma unroll
        for (int j = 0; j < 4; ++j) { float r2[2];
#pragma unroll
            for (int e = 0; e < 2; ++e) { const int c = c0 + 2 * j + e; const float ov = e ? bfhi(ow[j]) : bflo(ow[j]), zv = e ? bfhi(zw[j]) : bflo(zw[j]), uv = e ? bfhi(vw[j]) : bflo(vw[j]);
                const float v = uv + (pv[2 * j + e] - uv) * muv[c]; r2[e] = ((ov - mean) * rstd * gng[c] + gnb[c] + bon * v) * zv; }
            rw[j] = pk2(r2[0], r2[1]); }
        if (stw) *(u32x4*)(ZA + (size_t)tok * 1024 + c0) = (u32x4){rw[0], rw[1], rw[2], rw[3]};
    }
}
__device__ __forceinline__ void p5_sum(PREF p, int tid, int G) {
    unsigned char* ws = p.ws; const float* P = (const float*)(ws + WS_P); const bf16* Gt = (const bf16*)(ws + WS_G); bf16* M = (bf16*)(ws + WS_MERGED);
    for (int i = blockIdx.x * 512 + tid; i < 1024 * 128; i += G * 512) { const int rs = i >> 7, c0 = (i & 127) * 8; const size_t tok = (size_t)(NPT + rs);
        float o[8];
#pragma unroll
        for (int j = 0; j < 8; ++j) o[j] = 0.f;
#pragma unroll
        for (int br = 0; br < 3; ++br) { f32x4 a0 = {0.f, 0.f, 0.f, 0.f}, a1 = a0;
#pragma unroll
            for (int kq = 0; kq < 4; ++kq) { const float* pp = P + (size_t)(kq * 3 + br) * 1048576 + (size_t)rs * 1024 + c0; a0 += *(const f32x4*)pp; a1 += *(const f32x4*)(pp + 4); }
            const u32x4 g = *(const u32x4*)(Gt + tok * 3072 + br * 1024 + c0);
            o[0] += a0.x * bflo(g.x); o[1] += a0.y * bfhi(g.x); o[2] += a0.z * bflo(g.y); o[3] += a0.w * bfhi(g.y); o[4] += a1.x * bflo(g.z); o[5] += a1.y * bfhi(g.z); o[6] += a1.z * bflo(g.w); o[7] += a1.w * bfhi(g.w); }
        *(u32x4*)(M + tok * 1024 + c0) = (u32x4){pk2(o[0], o[1]), pk2(o[2], o[3]), pk2(o[4], o[5]), pk2(o[6], o[7])}; }
}
__device__ __forceinline__ void p6_norm(PREF p, int r0, int r1, int vb, int nvb, int wave, int lane) {
    const f32x4* gf = (const f32x4*)p.in[I_GF] + lane;
    for (int m = r0 + vb * 8 + wave; m < r1; m += nvb * 8) { f32x4* xr = (f32x4*)(p.out + (size_t)m * 1024) + lane; f32x4 v[4]; float s = 0.f;
#pragma unroll
        for (int j = 0; j < 4; ++j) { v[j] = xr[64 * j]; s += (v[j].x * v[j].x + v[j].y * v[j].y) + (v[j].z * v[j].z + v[j].w * v[j].w); }
        const float rstd = rsqrtf(wave_sum(s) * (1.f / 1024.f) + 1e-6f);
#pragma unroll
        for (int j = 0; j < 4; ++j) xr[64 * j] = v[j] * rstd * gf[64 * j]; }
}

__device__ __forceinline__ void p6s_norm(PREF p, int vb, int nvb, int wave, int lane) {
    const f32x4* gf = (const f32x4*)p.in[I_GF] + lane; const float* YP = (const float*)(p.ws + WS_YP);
    for (int m = vb * 8 + wave; m < 1024; m += nvb * 8) { const f32x4* xr = (const f32x4*)(p.in[I_XS] + (size_t)m * 1024) + lane; f32x4 v[4]; float s = 0.f;
#pragma unroll
        for (int j = 0; j < 4; ++j) { v[j] = xr[64 * j];
#pragma unroll
            for (int kq = 0; kq < 4; ++kq) v[j] += ((const f32x4*)(YP + (size_t)kq * 1048576 + (size_t)m * 1024) + lane)[64 * j];
            s += (v[j].x * v[j].x + v[j].y * v[j].y) + (v[j].z * v[j].z + v[j].w * v[j].w); }
        const float rstd = rsqrtf(wave_sum(s) * (1.f / 1024.f) + 1e-6f); f32x4* orow = (f32x4*)(p.out + (size_t)(NPT + m) * 1024) + lane;
#pragma unroll
        for (int j = 0; j < 4; ++j) orow[64 * j] = v[j] * rstd * gf[64 * j]; }
}

#define XB_TMO      128
#define XB_XCNT(j)  (256  + 64 * (j))
#define XB_XSUB(j)  (1280 + 64 * (j))
#define XB_XGEN(j)  (2304 + 64 * (j))
#define XB_TOP      3328
#define XB_TOPGEN   3392
#define XCD_BAR_WORDS 3456
#define XB_SPIN_CAP (1u << 18)

__device__ __forceinline__ unsigned xb_ld(unsigned* p)              { return __hip_atomic_load(p, __ATOMIC_RELAXED, __HIP_MEMORY_SCOPE_AGENT); }
__device__ __forceinline__ unsigned xb_add(unsigned* p, unsigned v) { return __hip_atomic_fetch_add(p, v, __ATOMIC_RELAXED, __HIP_MEMORY_SCOPE_AGENT); }
__device__ __forceinline__ unsigned xb_xcc_id() { return (unsigned)__builtin_amdgcn_s_getreg((3 << 11) | 20) & 0xFu; }
#define XB_SPIN(cond, bar) do { unsigned _sp = 0; while (cond) { __builtin_amdgcn_s_sleep(1); \
    if ((++_sp & 255u) == 0u) { if (xb_ld(&(bar)[XB_TMO])) break; if (_sp > XB_SPIN_CAP) { atomicAdd(&(bar)[XB_TMO], 1u); break; } } } } while (0)

struct XcdBarrier {
    unsigned* bar; unsigned x;
    volatile LAS unsigned* st;
};

__device__ __forceinline__ XcdBarrier xcd_barrier_post(unsigned* bar, volatile LAS unsigned* st) {
    XcdBarrier b; b.bar = bar; b.x = xb_xcc_id(); b.st = st;
    if (threadIdx.x == 0) (void)xb_add(&bar[XB_XCNT(b.x)], 1u);
    return b;
}
__device__ __forceinline__ void xcd_barrier_complete(unsigned* bar, unsigned x, unsigned& nloc, unsigned& nx) {
    const unsigned G = gridDim.x * gridDim.y * gridDim.z;
    unsigned sum, cnt, mine, sp = 0u;
    for (;;) {
        sum = 0u; cnt = 0u; mine = 0u;
#pragma unroll
        for (unsigned j = 0; j < 16; ++j) { const unsigned c = xb_ld(&bar[XB_XCNT(j)]); sum += c; cnt += (c > 0u) ? 1u : 0u; mine = (j == x) ? c : mine; }
        if (sum == G) break;
        __builtin_amdgcn_s_sleep(1);
        if ((++sp & 255u) == 0u) { if (xb_ld(&bar[XB_TMO])) break; if (sp > XB_SPIN_CAP) { atomicAdd(&bar[XB_TMO], 1u); break; } }
    }
    nloc = mine > 0u ? mine : 1u; nx = cnt > 0u ? cnt : 1u;
}

__device__ __forceinline__ void xcd_barrier(const XcdBarrier& b) {
    asm volatile("s_waitcnt vmcnt(0)" ::: "memory");
    __syncthreads();
    if (threadIdx.x == 0) {
        unsigned* bar = b.bar;
        __builtin_amdgcn_s_waitcnt(0);
        unsigned nloc = b.st[0], nx = b.st[1];
        if (nloc == 0u) { xcd_barrier_complete(bar, b.x, nloc, nx); b.st[0] = nloc; b.st[1] = nx; }
        const unsigned old = xb_add(&bar[XB_XSUB(b.x)], 1u);
        const unsigned gen = old / nloc;
        if (old + 1u == (gen + 1u) * nloc) {
            __builtin_amdgcn_fence(__ATOMIC_RELEASE, "agent");
            asm volatile("s_waitcnt vmcnt(0)" ::: "memory");
            const unsigned og = xb_add(&bar[XB_TOP], 1u);
            const unsigned tg = og / nx;
            if (og + 1u == (tg + 1u) * nx) xb_add(&bar[XB_TOPGEN], 1u);
            else XB_SPIN(xb_ld(&bar[XB_TOPGEN]) == tg, bar);
            __builtin_amdgcn_fence(__ATOMIC_ACQUIRE, "agent");
            xb_add(&bar[XB_XGEN(b.x)], 1u);
            asm volatile("s_waitcnt vmcnt(0)" ::: "memory");
        } else {
            XB_SPIN(xb_ld(&bar[XB_XGEN(b.x)]) == gen, bar);
            __builtin_amdgcn_fence(__ATOMIC_ACQUIRE, "agent");
            asm volatile("s_waitcnt vmcnt(0)" ::: "memory");
        }
    }
    __syncthreads();
}

#ifndef MK_LAST_PHASE
#define MK_LAST_PHASE 99
#endif
__global__ void __launch_bounds__(512, 2) fwd(Params p_arg) {
    extern __shared__ __attribute__((aligned(16))) unsigned char lds_raw[];
    LAS unsigned char* lds = (LAS unsigned char*)lds_raw;
    cg::grid_group grid = cg::this_grid();
    const int tid = threadIdx.x, lane = tid & 63, wave = __builtin_amdgcn_readfirstlane(tid >> 6), G = gridDim.x, bx = blockIdx.x;
    CParams* kp = (CParams*)__builtin_amdgcn_kernarg_segment_ptr();
    unsigned char* ws = kp->ws;
#define p (*launder(kp))
    if (tid < 8) ((LAS unsigned*)(lds + LDS_BYTES - 32))[tid] = 0u;
    __syncthreads();
    const XcdBarrier xbar = xcd_barrier_post((unsigned*)(ws + WS_CTR) + 1024, (volatile LAS unsigned*)(lds + LDS_BYTES - 32));
#ifndef PROBE_DUP
#define PROBE_DUP 0
#endif
#define REP(n) for (int rep_ = (PROBE_DUP == (n) ? 0 : 1); rep_ < 2; ++rep_)
    REP(10) { p0_prologue(p, lds, tid, wave, lane, G); __syncthreads(); }
    if (kp->zero != 0) grid.sync();
    xcd_barrier(xbar);
    REP(1) { pg8::Gemm g{(const pg8::bf16_t*)(ws + WS_XN), (const pg8::bf16_t*)(ws + WS_WIN), NT, 11520, 1024}; pg8::StaticOrder S; S.init(NT, 11520, G, bx); EpiMain E{ws};
      pg8::gemm_phase<EpiMain, pg8::StaticOrder>((PG8_LAS unsigned char*)lds, g, S, E, nullptr); }
    xcd_barrier(xbar);
    REP(7) if (G >= 128) {
        if (bx < 64) { pg8::Gemm g{(const pg8::bf16_t*)(ws + WS_XN) + (size_t)NT * 1024, (const pg8::bf16_t*)(ws + WS_WIN) + (size_t)11520 * 1024, 2048, 2048, 1024}; SchedMem S{bx}; EpiMem E{ws, p.out};
            pg8::gemm_phase<EpiMem, SchedMem>((PG8_LAS unsigned char*)lds, g, S, E, nullptr); }
        else { p2_lora(p, bx - 64, G - 64, tid, wave, lane); p2_weights(p, lds, bx - 64, G - 64, wave, lane); }
    }
    xcd_barrier(xbar);
#ifndef PROBE_DUP
#define PROBE_DUP 0
#endif
    for (int rep = (PROBE_DUP == 2 ? 0 : 1); rep < 2; ++rep)
    for (int it = bx; it < 256; it += G) rwkv_run(p, lds, tid, wave, lane, 0, it, 2048 / CH);
    for (int rep = (PROBE_DUP == 3 ? 0 : 1); rep < 2; ++rep)
    for (int it = bx * 16; it < 4096; it += G * 16) rwkv_run(p, lds, tid, wave, lane, 1, it, 4);
    for (int rep = (PROBE_DUP == 4 ? 0 : 1); rep < 2; ++rep) { const bool st = (rep == 1) || (p.zero != 0);
        if (bx < 128) rglru_item<0>(p, lds, tid, wave, lane, bx, st); else { rglru_item<1>(p, lds, tid, wave, lane, bx - 128, st); rglru_item<1>(p, lds, tid, wave, lane, bx, st); } }
    { const bool st = true;
        LAS unsigned* slot = (LAS unsigned*)(lds + LDS_BYTES - 16); unsigned* ctr = (unsigned*)(ws + WS_CTR);
        for (;;) {
            if (tid == 0) *slot = atomicAdd(ctr, 1u);
            __syncthreads();
            const unsigned it = *slot;
            __syncthreads();
            if (it >= 1024u) break;
            if ((it & 1u) == 0u) xattn_sample_item(p, lds, tid, wave, lane, (int)(it >> 1), st); else xattn_prompt_item(p, lds, tid, wave, lane, (int)(it >> 1), st);
        } }
    xcd_barrier(xbar);
    p4_post(p, tid, G, true);
    xcd_barrier(xbar);
    { pg8::Gemm g{(const pg8::bf16_t*)(ws + WS_Z), (const pg8::bf16_t*)(ws + WS_WBR), 3 * NT, 3072, 1024}; SchedTail S{bx}; EpiTail E{ws};
      pg8::gemm_phase<EpiTail, SchedTail>((PG8_LAS unsigned char*)lds, g, S, E, nullptr);
      if (bx < 192) { pg8::Gemm g4 = g; g4.nt = 4; SchedBrS S2{bx}; EpiPart E2{ws}; pg8::gemm_phase<EpiPart, SchedBrS>((PG8_LAS unsigned char*)lds, g4, S2, E2, nullptr); } }
    xcd_barrier(xbar);
    p5_sum(p, tid, G);
    { pg8::Gemm g{(const pg8::bf16_t*)(ws + WS_MERGED), (const pg8::bf16_t*)(ws + WS_WOUT), NPT, 1024, 1024}; pg8::StaticOrder S; S.init(NPT, 1024, G, bx); EpiOut E{opq(p.in[I_XP]), opq(p.in[I_XS]), p.out};
      pg8::gemm_phase<EpiOut, pg8::StaticOrder>((PG8_LAS unsigned char*)lds, g, S, E, nullptr); }
    xcd_barrier(xbar);
    if (bx < 64) { pg8::Gemm g{(const pg8::bf16_t*)(ws + WS_MERGED), (const pg8::bf16_t*)(ws + WS_WOUT), NT, 1024, 1024, 4}; SchedOutS S{bx}; EpiPartY E{ws};
      pg8::gemm_phase<EpiPartY, SchedOutS>((PG8_LAS unsigned char*)lds, g, S, E, nullptr);
      p6_norm(p, 0, NPT, bx, 448, wave, lane); }
    else { p6_norm(p, 0, NPT, 64 + 2 * (bx - 64), 448, wave, lane); p6_norm(p, 0, NPT, 65 + 2 * (bx - 64), 448, wave, lane); }
    xcd_barrier(xbar);
    p6s_norm(p, bx, G, wave, lane);
#undef p
}
}

extern "C" void kernel_launch(void* const* d_in, const int* in_sizes, int n_in, void* d_out, int out_size, void* d_ws, size_t ws_size, hipStream_t stream) {
    static int grid = 0;
    if (grid == 0) {
        if (n_in != 35 || (size_t)out_size != mk::O_END || ws_size < mk::WS_END) { fprintf(stderr, "kernel_launch: unexpected shapes: n_in %d out %d ws %zu\n", n_in, out_size, ws_size); grid = -1; return; }
        int dev = 0, cus = 0, per_cu = 0;
        hipGetDevice(&dev); hipDeviceGetAttribute(&cus, hipDeviceAttributeMultiprocessorCount, dev);
        hipFuncSetAttribute((const void*)mk::fwd, hipFuncAttributeMaxDynamicSharedMemorySize, mk::LDS_BYTES);
        hipOccupancyMaxActiveBlocksPerMultiprocessor(&per_cu, (const void*)mk::fwd, 512, mk::LDS_BYTES);
        if (per_cu < 1) { fprintf(stderr, "kernel_launch: occupancy query says %d blocks per CU\n", per_cu); per_cu = 1; }
        grid = cus * 1;
        (void)hipGetLastError();
    }
    if (grid < 0) return;
    mk::Params p{};
    for (int i = 0; i < 35; ++i) p.in[i] = (const float*)d_in[i];
    p.out = (float*)d_out; p.ws = (unsigned char*)d_ws;
    (void)hipMemsetAsync((unsigned char*)d_ws + mk::WS_CTR, 0, 32768, stream);
    void* args[] = {&p};
    hipError_t e = hipLaunchCooperativeKernel((const void*)mk::fwd, dim3(grid), dim3(512), args, mk::LDS_BYTES, stream);
    if (e != hipSuccess) fprintf(stderr, "cooperative launch failed: %s (grid %d)\n", hipGetErrorString(e), grid);
}
```
